# Optimizing an MI355X kernel written in HIP

```python
import math
import jax, jax.numpy as jnp
from jax import lax
import numpy as np

D_MODEL = 2048
BATCH = 4
SEQ = 2048
DEPTH = 1

ATT_HEADS = 8
ATT_HALF_DIM = 64
ATT_V_DIM = 2 * ATT_HALF_DIM
ATT_WIDTH = ATT_HEADS * ATT_V_DIM
CONV_CH = D_MODEL - ATT_WIDTH
CONV_KERNEL = 31
MIX_WIDTH = ATT_WIDTH + CONV_CH
QK_COLS = ATT_HEADS * 2 * ATT_HALF_DIM
IN_COLS = 2 * QK_COLS + ATT_WIDTH + 2 * CONV_CH
N_BUCKETS = 32
MAX_DISTANCE = 128
Q_BLOCK = 128
N_EXPERTS = 32
TOP_K = 4
D_FF = D_MODEL
SWIGLU_LIMIT = 7.0
SWIGLU_ALPHA = 1.702
EPS = 1e-6

kernel_name = "hymba_diffattn_conformer_moe_encoder"


def rmsnorm(x, g):
    xf = x.astype(jnp.float32)
    y = xf * lax.rsqrt(jnp.mean(xf * xf, axis=-1, keepdims=True) + EPS)
    return (y * g.astype(jnp.float32)).astype(x.dtype)


def layernorm(x, g, b):
    xf = x.astype(jnp.float32)
    mu = jnp.mean(xf, axis=-1, keepdims=True)
    var = jnp.mean(jnp.square(xf - mu), axis=-1, keepdims=True)
    y = (xf - mu) * lax.rsqrt(var + EPS)
    return (y * g.astype(jnp.float32) + b.astype(jnp.float32)).astype(x.dtype)


def t5_bucket(rel):
    half = N_BUCKETS // 2
    max_exact = half // 2
    ret = jnp.where(rel > 0, half, 0)
    n = jnp.abs(rel)
    nf = jnp.maximum(n, 1).astype(jnp.float32)
    large = max_exact + (jnp.log(nf / max_exact) / math.log(MAX_DISTANCE / max_exact)
                         * (half - max_exact)).astype(jnp.int32)
    large = jnp.minimum(large, half - 1)
    return ret + jnp.where(n < max_exact, n, large)


def diff_attention(q, k, v, lam, rel_bias):
    B, S = q.shape[0], q.shape[1]
    nb = S // Q_BLOCK
    scale = ATT_HALF_DIM ** -0.5
    qb = q.reshape(B, nb, Q_BLOCK, ATT_HEADS, 2, ATT_HALF_DIM).transpose(1, 0, 2, 3, 4, 5)
    k1, k2 = k[..., 0, :], k[..., 1, :]
    kpos = jnp.arange(S)

    def block(args):
        q_blk, start = args
        qpos = start + jnp.arange(Q_BLOCK)
        bucket = t5_bucket(kpos[None, :] - qpos[:, None])
        bias = rel_bias[bucket].astype(jnp.float32).transpose(2, 0, 1)
        s1 = jnp.einsum('bqhd,bkhd->bhqk', q_blk[..., 0, :], k1).astype(jnp.float32) * scale + bias
        s2 = jnp.einsum('bqhd,bkhd->bhqk', q_blk[..., 1, :], k2).astype(jnp.float32) * scale + bias
        p = jax.nn.softmax(s1, axis=-1) - lam * jax.nn.softmax(s2, axis=-1)
        return jnp.einsum('bhqk,bkhe->bqhe', p.astype(v.dtype), v)

    out = lax.map(block, (qb, jnp.arange(nb) * Q_BLOCK))
    return out.transpose(1, 0, 2, 3, 4).reshape(B, S, ATT_HEADS, ATT_V_DIM)


def conformer_conv(u, conv_w, conv_b, ln_g, ln_b):
    a, g = jnp.split(u, 2, axis=-1)
    z = a * jax.nn.sigmoid(g)
    z = lax.conv_general_dilated(
        z, conv_w.reshape(CONV_KERNEL, 1, CONV_CH).astype(z.dtype),
        window_strides=(1,), padding=[(CONV_KERNEL // 2, CONV_KERNEL // 2)],
        dimension_numbers=('NWC', 'WIO', 'NWC'), feature_group_count=CONV_CH) + conv_b
    z = layernorm(z, ln_g, ln_b)
    return jax.nn.silu(z)


def moe_ffn(h, w_router, b_router, w_gate_up, b_gate_up, w_down, b_down):
    B, S, D = h.shape
    T = B * S
    hf = h.reshape(T, D)
    logits = (hf @ w_router + b_router).astype(jnp.float32)
    top_v, top_i = lax.top_k(logits, TOP_K)
    top_w = jax.nn.softmax(top_v, axis=-1)
    flat_ids = top_i.reshape(-1)
    flat_w = top_w.reshape(-1)
    order = jnp.argsort(flat_ids)
    sorted_ids = flat_ids[order]
    tok = order // TOP_K
    xs = hf[tok]
    group_sizes = jnp.bincount(flat_ids, length=N_EXPERTS).astype(jnp.int32)
    gu = lax.ragged_dot(xs, w_gate_up, group_sizes) + b_gate_up[sorted_ids]
    gate, up = jnp.split(gu, 2, axis=-1)
    gate = jnp.minimum(gate, SWIGLU_LIMIT)
    up = jnp.clip(up, -SWIGLU_LIMIT, SWIGLU_LIMIT)
    act = (up + 1.0) * (gate * jax.nn.sigmoid(SWIGLU_ALPHA * gate))
    y = lax.ragged_dot(act, w_down, group_sizes) + b_down[sorted_ids]
    y = y * flat_w[order][:, None].astype(y.dtype)
    out = jax.ops.segment_sum(y, tok, num_segments=T)
    return out.reshape(B, S, D)


def setup_inputs(seed: int = 0) -> dict:
    key = jax.random.key(seed)
    ks = jax.random.split(key, 26)
    f32 = jnp.float32
    nrm = lambda k, shape, s: jax.random.normal(k, shape, f32) * s
    L = DEPTH
    return {
        "x": nrm(ks[0], (BATCH, SEQ, D_MODEL), 1.0),
        "c": nrm(ks[1], (BATCH, D_MODEL), 1.0),
        "w_ada": nrm(ks[2], (L, D_MODEL, 6 * D_MODEL), 0.5 * D_MODEL ** -0.5),
        "b_ada": nrm(ks[3], (L, 6 * D_MODEL), 0.02),
        "norm1_g": 1.0 + nrm(ks[4], (L, D_MODEL), 0.02),
        "w_in": nrm(ks[5], (L, D_MODEL, IN_COLS), D_MODEL ** -0.5),
        "lambda_q1": nrm(ks[6], (L, ATT_HALF_DIM), 0.1),
        "lambda_k1": nrm(ks[7], (L, ATT_HALF_DIM), 0.1),
        "lambda_q2": nrm(ks[8], (L, ATT_HALF_DIM), 0.1),
        "lambda_k2": nrm(ks[9], (L, ATT_HALF_DIM), 0.1),
        "subln_g": 1.0 + nrm(ks[10], (L, ATT_V_DIM), 0.02),
        "rel_bias": nrm(ks[11], (N_BUCKETS, ATT_HEADS), 0.5),
        "conv_w": nrm(ks[12], (L, CONV_KERNEL, CONV_CH), CONV_KERNEL ** -0.5),
        "conv_b": nrm(ks[13], (L, CONV_CH), 0.02),
        "conv_ln_g": 1.0 + nrm(ks[14], (L, CONV_CH), 0.02),
        "conv_ln_b": nrm(ks[15], (L, CONV_CH), 0.02),
        "w_out": nrm(ks[16], (L, MIX_WIDTH, D_MODEL), MIX_WIDTH ** -0.5),
        "norm2_g": 1.0 + nrm(ks[17], (L, D_MODEL), 0.02),
        "w_router": nrm(ks[18], (L, D_MODEL, N_EXPERTS), D_MODEL ** -0.5),
        "b_router": nrm(ks[19], (L, N_EXPERTS), 0.01),
        "w_gate_up": nrm(ks[20], (L, N_EXPERTS, D_MODEL, 2 * D_FF), D_MODEL ** -0.5),
        "b_gate_up": nrm(ks[21], (L, N_EXPERTS, 2 * D_FF), 0.02),
        "w_down": nrm(ks[22], (L, N_EXPERTS, D_FF, D_MODEL), D_FF ** -0.5),
        "b_down": nrm(ks[23], (L, N_EXPERTS, D_MODEL), 0.02),
        "final_g": 1.0 + nrm(ks[24], (D_MODEL,), 0.02),
    }


def reference(x, c, w_ada, b_ada, norm1_g, w_in, lambda_q1, lambda_k1, lambda_q2, lambda_k2,
              subln_g, rel_bias, conv_w, conv_b, conv_ln_g, conv_ln_b, w_out, norm2_g,
              w_router, b_router, w_gate_up, b_gate_up, w_down, b_down, final_g):
    B, S, D = x.shape
    cs = jax.nn.silu(c)
    for l in range(DEPTH):
        mod = cs @ w_ada[l] + b_ada[l]
        shift1, scale1, gate1, shift2, scale2, gate2 = [m[:, None, :] for m in jnp.split(mod, 6, axis=-1)]

        h = rmsnorm(x, norm1_g[l]) * (1.0 + scale1) + shift1
        proj = h @ w_in[l]
        q, k, v, u = jnp.split(proj, [QK_COLS, 2 * QK_COLS, 2 * QK_COLS + ATT_WIDTH], axis=-1)
        q = q.reshape(B, S, ATT_HEADS, 2, ATT_HALF_DIM)
        k = k.reshape(B, S, ATT_HEADS, 2, ATT_HALF_DIM)
        v = v.reshape(B, S, ATT_HEADS, ATT_V_DIM)

        lambda_init = 0.8 - 0.6 * math.exp(-0.3 * l)
        lam = (jnp.exp(jnp.sum(lambda_q1[l].astype(jnp.float32) * lambda_k1[l].astype(jnp.float32)))
               - jnp.exp(jnp.sum(lambda_q2[l].astype(jnp.float32) * lambda_k2[l].astype(jnp.float32)))
               + lambda_init)
        att = diff_attention(q, k, v, lam, rel_bias)
        att = rmsnorm(att, subln_g[l]) * (1.0 - lambda_init)
        att = att.reshape(B, S, ATT_WIDTH)

        cv = conformer_conv(u, conv_w[l], conv_b[l], conv_ln_g[l], conv_ln_b[l])

        mixed = jnp.concatenate([att, cv], axis=-1) @ w_out[l]
        x = x + gate1 * mixed

        h2 = rmsnorm(x, norm2_g[l]) * (1.0 + scale2) + shift2
        x = x + gate2 * moe_ffn(h2, w_router[l], b_router[l], w_gate_up[l], b_gate_up[l],
                                w_down[l], b_down[l])
    return rmsnorm(x, final_g)
```

```cpp
#include <hip/hip_runtime.h>
#include <cstdio>
#include <cstdint>

#ifndef REP_MASK
#define REP_MASK 0
#endif
#ifndef MEGA_HI
#define MEGA_HI 9
#endif

constexpr int DM = 2048, NB = 4, SEQ = 2048, T = NB * SEQ;
constexpr int AH = 8, HD = 64, VD = 128, CCH = 1024, CK = 31;
constexpr int INC = 5120;
constexpr int NE = 32, TOPK = 4, DFF = 2048, NSLOT = T * TOPK;
constexpr float EPS = 1e-6f;
constexpr float LOG2E = 1.4426950408889634f;

typedef unsigned short bf16;
typedef short bf16x8 __attribute__((ext_vector_type(8)));
typedef short s16x4 __attribute__((ext_vector_type(4)));
typedef float f32x4 __attribute__((ext_vector_type(4)));
typedef float f32x16 __attribute__((ext_vector_type(16)));
typedef unsigned u32x4 __attribute__((ext_vector_type(4)));
typedef unsigned u32x2 __attribute__((ext_vector_type(2)));
#define GAS __attribute__((address_space(1)))
#define LAS __attribute__((address_space(3)))
typedef GAS unsigned gu32;

constexpr size_t MiB = 1u << 20;
constexpr size_t WS_CTL = 0, CTL_ZERO_BYTES = 64 * 1024;
constexpr size_t WS_MODP = 1 * MiB;
constexpr size_t WS_MOD = 3 * MiB;
constexpr size_t WS_BIAST = 4 * MiB;
constexpr size_t WS_WRF = 5 * MiB;
constexpr size_t WS_ROUTE = 6 * MiB;
constexpr size_t RT_LIST = 0;
constexpr size_t RT_SW = 1 * MiB;
constexpr size_t RT_TOKE = 2 * MiB;
constexpr size_t RT_TOKR = RT_TOKE + 128 * 1024;
constexpr size_t WS_WIN = 16 * MiB;
constexpr size_t WS_WOUT = WS_WIN + 20 * MiB;
constexpr size_t WS_H = WS_WOUT + 8 * MiB;
constexpr size_t WS_PROJ = WS_H + 32 * MiB;
constexpr size_t WS_MIX = WS_PROJ + 80 * MiB;
constexpr size_t WS_X1 = WS_MIX + 32 * MiB;
constexpr size_t WS_H2 = WS_X1 + 64 * MiB;
constexpr size_t WS_ACT = WS_H2 + 32 * MiB;
constexpr size_t WS_Y = WS_ACT + 130 * MiB;
constexpr size_t WS_WGU = WS_Y + 130 * MiB;
constexpr size_t WS_WD = WS_WGU + 512 * MiB;
constexpr size_t WS_GU = WS_WD + 256 * MiB;
constexpr size_t WS_END = WS_GU + 512 * MiB;
constexpr int CW_CNT = 0;
constexpr int CW_BAR = 1024;

__device__ __forceinline__ unsigned f2bf(float f) { unsigned u = __builtin_bit_cast(unsigned, f); return (u + 0x7fffu + ((u >> 16) & 1u)) >> 16; }
__device__ __forceinline__ float bf2f(unsigned h) { return __builtin_bit_cast(float, h << 16); }
__device__ __forceinline__ unsigned pk2(float lo, float hi) { return f2bf(lo) | (f2bf(hi) << 16); }
__device__ __forceinline__ unsigned cvt_pk_bf16(float lo, float hi) { unsigned r; asm volatile("v_cvt_pk_bf16_f32 %0, %1, %2" : "=v"(r) : "v"(lo), "v"(hi)); return r; }
__device__ __forceinline__ float silu_f(float v) { return v / (1.f + __expf(-v)); }
__device__ __forceinline__ float wave_sum(float v) {
#pragma unroll
    for (int o = 1; o < 64; o <<= 1) v += __shfl_xor(v, o);
    return v;
}
__host__ __device__ inline int t5_bucket(int rel) {
    int ret = rel > 0 ? 16 : 0; int n = rel < 0 ? -rel : rel;
    if (n < 8) return ret + n;
    int lg = n >= 91 ? 15 : n >= 64 ? 14 : n >= 46 ? 13 : n >= 32 ? 12 : n >= 23 ? 11 : n >= 16 ? 10 : n >= 12 ? 9 : 8;
    return ret + lg;
}
#define LDS_WAIT() asm volatile("s_waitcnt lgkmcnt(0)" ::: "memory")
#define VM_WAIT() asm volatile("s_waitcnt vmcnt(0)" ::: "memory")

#define XB_TMO      128
#define XB_XCNT(j)  (256  + 64 * (j))
#define XB_XSUB(j)  (1280 + 64 * (j))
#define XB_XGEN(j)  (2304 + 64 * (j))
#define XB_TOP      3328
#define XB_TOPGEN   3392
#define XCD_BAR_WORDS 3456
#define XB_SPIN_CAP (1u << 18)
__device__ __forceinline__ unsigned xb_ld(unsigned* p)              { return __hip_atomic_load(p, __ATOMIC_RELAXED, __HIP_MEMORY_SCOPE_AGENT); }
__device__ __forceinline__ unsigned xb_add(unsigned* p, unsigned v) { return __hip_atomic_fetch_add(p, v, __ATOMIC_RELAXED, __HIP_MEMORY_SCOPE_AGENT); }
__device__ __forceinline__ unsigned xb_xcc_id() { return (unsigned)__builtin_amdgcn_s_getreg((3 << 11) | 20) & 0xFu; }
#define XB_SPIN(cond, bar) do { unsigned _sp = 0; while (cond) { __builtin_amdgcn_s_sleep(1); \
    if ((++_sp & 255u) == 0u) { if (xb_ld(&(bar)[XB_TMO])) break; if (_sp > XB_SPIN_CAP) { atomicAdd(&(bar)[XB_TMO], 1u); break; } } } } while (0)
struct XcdBarrier { unsigned* bar; unsigned x; volatile LAS unsigned* st; };
__device__ __forceinline__ XcdBarrier xcd_barrier_post(unsigned* bar, volatile LAS unsigned* st) {
    XcdBarrier b; b.bar = bar; b.x = xb_xcc_id(); b.st = st;
    if (threadIdx.x == 0) st[2] = xb_add(&bar[XB_XCNT(b.x)], 1u);
    return b;
}
__device__ __forceinline__ int xcd_virtual_cu(const XcdBarrier& b) {
    if (threadIdx.x == 0) { unsigned pre = 0u; for (unsigned j = 0; j < 16; ++j) { const unsigned c = xb_ld(&b.bar[XB_XCNT(j)]); pre += (j < b.x) ? c : 0u; } b.st[3] = pre + b.st[2]; }
    __syncthreads();
    const int v = (int)b.st[3];
    __syncthreads();
    return __builtin_amdgcn_readfirstlane(v);
}
__device__ __forceinline__ void xcd_barrier_complete(unsigned* bar, unsigned x, unsigned& nloc, unsigned& nx) {
    const unsigned G = gridDim.x * gridDim.y * gridDim.z;
    unsigned sum, cnt, mine, sp = 0u;
    for (;;) {
        sum = 0u; cnt = 0u; mine = 0u;
#pragma unroll
        for (unsigned j = 0; j < 16; ++j) { const unsigned c = xb_ld(&bar[XB_XCNT(j)]); sum += c; cnt += (c > 0u) ? 1u : 0u; mine = (j == x) ? c : mine; }
        if (sum == G) break;
        __builtin_amdgcn_s_sleep(1);
        if ((++sp & 255u) == 0u) { if (xb_ld(&bar[XB_TMO])) break; if (sp > XB_SPIN_CAP) { atomicAdd(&bar[XB_TMO], 1u); break; } }
    }
    nloc = mine > 0u ? mine : 1u; nx = cnt > 0u ? cnt : 1u;
}
__device__ __forceinline__ void xcd_barrier(const XcdBarrier& b) {
    asm volatile("s_waitcnt vmcnt(0)" ::: "memory");
    __syncthreads();
    if (threadIdx.x == 0) {
        unsigned* bar = b.bar;
        __builtin_amdgcn_s_waitcnt(0);
        unsigned nloc = b.st[0], nx = b.st[1];
        if (nloc == 0u) { xcd_barrier_complete(bar, b.x, nloc, nx); b.st[0] = nloc; b.st[1] = nx; }
        const unsigned old = xb_add(&bar[XB_XSUB(b.x)], 1u);
        const unsigned gen = old / nloc;
        if (old + 1u == (gen + 1u) * nloc) {
            __builtin_amdgcn_fence(__ATOMIC_RELEASE, "agent");
            asm volatile("s_waitcnt vmcnt(0)" ::: "memory");
            const unsigned og = xb_add(&bar[XB_TOP], 1u);
            const unsigned tg = og / nx;
            if (og + 1u == (tg + 1u) * nx) xb_add(&bar[XB_TOPGEN], 1u);
            else XB_SPIN(xb_ld(&bar[XB_TOPGEN]) == tg, bar);
            __builtin_amdgcn_fence(__ATOMIC_ACQUIRE, "agent");
            xb_add(&bar[XB_XGEN(b.x)], 1u);
            asm volatile("s_waitcnt vmcnt(0)" ::: "memory");
        } else {
            XB_SPIN(xb_ld(&bar[XB_XGEN(b.x)]) == gen, bar);
            __builtin_amdgcn_fence(__ATOMIC_ACQUIRE, "agent");
            asm volatile("s_waitcnt vmcnt(0)" ::: "memory");
        }
    }
    __syncthreads();
}

namespace pg8 {
constexpr int BM = 256, BK = 64, HALF = 128, HTB = HALF * BK * 2, STAGE_BYTES = 8 * HTB, KD = 2048;
__host__ __device__ __forceinline__ int lds_byte(int r, int c) { const int st = (r >> 4) * 2 + (c >> 5), rr = r & 15, cc = c & 31, ob = rr * 64 + cc * 2; return st * 1024 + (ob ^ (((ob >> 9) & 1) << 5)); }
__host__ __device__ __forceinline__ void stage_rc(int b, int& R, int& C) { const int st = b / 1024, sb = b % 1024, swz = sb ^ (((sb >> 9) & 1) << 5); R = (st >> 1) * 16 + swz / 64; C = (st & 1) * 32 + (swz % 64) / 2; }
__host__ __device__ __forceinline__ int perm32(int rho) { const int n = rho >> 4, i = rho & 15; return 8 * (i >> 2) + 4 * n + (i & 3); }
struct Unit { int pm, pn, e, rows; };

struct DenseOrder {
    int nM, nN, nwg, G, c;
    __device__ void init(int M, int N, int G_, int c_) { nM = M / BM; nN = N / BM; nwg = nM * nN; G = G_; c = c_; }
    __device__ bool next(int i, Unit& u) const {
        const long L = (long)i * G + c; if (L >= nwg) return false;
        const int wgid = (int)L;
        const int nig = 8 * nN, gid = wgid / nig, fm = gid * 8, gsz = (nM - fm) < 8 ? (nM - fm) : 8;
        u.pm = fm + ((wgid % nig) % gsz); u.pn = (wgid % nig) / gsz; u.e = 0; u.rows = 256; return true;
    }
};

template <class P>
__device__ __forceinline__ void gemm_run(LAS unsigned char* lds, const P& prob) {
    const int tid = threadIdx.x, wid = __builtin_amdgcn_readfirstlane(tid >> 6), lane = tid & 63, wr = wid >> 2, wc = wid & 3, fr = lane & 15, fq = lane >> 4;
    constexpr int K = KD, nt = K / BK;
    int Rr[2], Cc[2]; unsigned voffB[2];
#pragma unroll
    for (int i = 0; i < 2; ++i) { int R, C; stage_rc(tid * 16 + i * 8192, R, C); Rr[i] = R; Cc[i] = C; const int Rb = P::PERM ? ((R & ~31) + perm32(R & 31)) : R; voffB[i] = (unsigned)(Rb * K + C) * 2u; }
    constexpr size_t kstep = (size_t)(BK * 2), hstep = (size_t)HALF * K * 2;
    const unsigned ldsw = (unsigned)wid * 1024u;
    const int aoff = lds_byte(wr * 64 + fr, fq * 8), boff = lds_byte(wc * 32 + fr, fq * 8);
#define PG8_SA(b, h) (((b) * 2 + (h)) * HTB)
#define PG8_SB(b, h) ((4 + (b) * 2 + (h)) * HTB)
#define PG8_STAGE(bufoff, gbase, voff) do { _Pragma("unroll") for (int _i = 0; _i < 2; ++_i) \
        __builtin_amdgcn_global_load_lds((const unsigned*)((const char*)(gbase) + (voff)[_i]), (LAS unsigned*)(lds + (bufoff) + ldsw + _i * 8192), 16, 0, 0); } while (0)
#define PG8_LDA(dst, b, h) do { _Pragma("unroll") for (int m = 0; m < 4; ++m) _Pragma("unroll") for (int k = 0; k < 2; ++k) dst[m][k] = *(const LAS bf16x8*)(lds + PG8_SA(b, h) + aoff + m * 2048 + k * 1024); } while (0)
#define PG8_LDB(dst, b, h) do { _Pragma("unroll") for (int n = 0; n < 2; ++n) _Pragma("unroll") for (int k = 0; k < 2; ++k) dst[n][k] = *(const LAS bf16x8*)(lds + PG8_SB(b, h) + boff + n * 2048 + k * 1024); } while (0)
#define PG8_MMA(ai, bj, At, Bt) do { __builtin_amdgcn_s_setprio(1); _Pragma("unroll") for (int m = 0; m < 4; ++m) _Pragma("unroll") for (int n = 0; n < 2; ++n) _Pragma("unroll") for (int k = 0; k < 2; ++k) \
        acc[ai][bj][m][n] = __builtin_amdgcn_mfma_f32_16x16x32_bf16(Bt[n][k], At[m][k], acc[ai][bj][m][n], 0, 0, 0); __builtin_amdgcn_s_setprio(0); } while (0)
#define PG8_WAIT_V(n) asm volatile("s_waitcnt vmcnt(" #n ")" ::: "memory")
#define PG8_WAIT_L(n) asm volatile("s_waitcnt lgkmcnt(" #n ")" ::: "memory")
#define PG8_BAR __builtin_amdgcn_s_barrier()
#define PG8_SCHED __builtin_amdgcn_sched_barrier(0)
    Unit cur, nxt; int ui = 0;
    if (!prob.next(0, cur)) return;
    f32x4 acc[2][2][4][2];
#pragma unroll
    for (int a = 0; a < 2; ++a)
#pragma unroll
        for (int b = 0; b < 2; ++b)
#pragma unroll
            for (int m = 0; m < 4; ++m)
#pragma unroll
                for (int n = 0; n < 2; ++n) acc[a][b][m][n] = (f32x4){0.f, 0.f, 0.f, 0.f};
    bf16x8 At[4][2], B0[2][2], B1[2][2];
    unsigned vC0[2], vC1[2], vN0[2], vN1[2];
    prob.a_off(cur, Rr, Cc, vC0, vC1);
    const char* const Ab = prob.a_base();
    const char* cB = prob.b_base(cur);
    PG8_STAGE(PG8_SB(0, 0), cB, voffB); PG8_STAGE(PG8_SB(0, 1), cB + hstep, voffB); PG8_STAGE(PG8_SA(0, 0), Ab, vC0); PG8_STAGE(PG8_SA(0, 1), Ab, vC1);
    if (wr == 1) PG8_BAR;
    PG8_WAIT_V(2); PG8_BAR;
    PG8_STAGE(PG8_SB(1, 0), cB + kstep, voffB); PG8_STAGE(PG8_SA(1, 0), Ab + kstep, vC0); PG8_STAGE(PG8_SB(1, 1), cB + hstep + kstep, voffB);
    PG8_WAIT_V(6); PG8_BAR;
    for (;;) {
        const bool has_next = prob.next(ui + 1, nxt);
        if (has_next) prob.a_off(nxt, Rr, Cc, vN0, vN1); else { vN0[0] = vC0[0]; vN0[1] = vC0[1]; vN1[0] = vC1[0]; vN1[1] = vC1[1]; }
        const char* nB = has_next ? prob.b_base(nxt) : cB;
        for (int t = 0; t < nt; t += 2) {
            const bool last = (t == nt - 2);
            const char* a1 = Ab + (size_t)(t + 1) * kstep;
            const char* a2 = last ? Ab : Ab + (size_t)(t + 2) * kstep; const char* b2 = last ? nB : cB + (size_t)(t + 2) * kstep;
            const char* a3 = a2 + kstep; const char* b3 = b2 + kstep;
            unsigned v20[2], v21[2];
            v20[0] = last ? vN0[0] : vC0[0]; v20[1] = last ? vN0[1] : vC0[1]; v21[0] = last ? vN1[0] : vC1[0]; v21[1] = last ? vN1[1] : vC1[1];
            PG8_LDB(B0, 0, 0); PG8_LDB(B1, 0, 1); PG8_SCHED; PG8_LDA(At, 0, 0); PG8_STAGE(PG8_SA(1, 1), a1, vC1);
            PG8_WAIT_V(8); PG8_WAIT_L(0); PG8_BAR; PG8_MMA(0, 0, At, B0); PG8_MMA(0, 1, At, B1); PG8_BAR; PG8_SCHED;
            PG8_LDA(At, 0, 1); PG8_STAGE(PG8_SB(0, 0), b2, voffB); PG8_STAGE(PG8_SB(0, 1), b2 + hstep, voffB); PG8_STAGE(PG8_SA(0, 0), a2, v20);
            PG8_WAIT_V(8); PG8_WAIT_L(0); PG8_BAR; PG8_MMA(1, 0, At, B0); PG8_MMA(1, 1, At, B1); PG8_BAR; PG8_SCHED;
            PG8_LDB(B0, 1, 0); PG8_LDB(B1, 1, 1); PG8_SCHED; PG8_LDA(At, 1, 0); PG8_STAGE(PG8_SA(0, 1), a2, v21);
            PG8_WAIT_V(8); PG8_WAIT_L(0); PG8_BAR; PG8_MMA(0, 0, At, B0); PG8_MMA(0, 1, At, B1); PG8_BAR; PG8_SCHED;
            PG8_LDA(At, 1, 1); PG8_STAGE(PG8_SB(1, 0), b3, voffB); PG8_STAGE(PG8_SB(1, 1), b3 + hstep, voffB); PG8_STAGE(PG8_SA(1, 0), a3, v20);
            PG8_WAIT_V(8); PG8_WAIT_L(0); PG8_BAR; PG8_MMA(1, 0, At, B0); PG8_MMA(1, 1, At, B1); PG8_BAR; PG8_SCHED;
        }
        if (wr == 0) PG8_BAR;
        prob.epi(acc, cur, wr, wc, fr, fq);
        if (!has_next) break;
#pragma unroll
        for (int a = 0; a < 2; ++a)
#pragma unroll
            for (int b = 0; b < 2; ++b)
#pragma unroll
                for (int m = 0; m < 4; ++m)
#pragma unroll
                    for (int n = 0; n < 2; ++n) acc[a][b][m][n] = (f32x4){0.f, 0.f, 0.f, 0.f};
        cur = nxt; cB = nB; ++ui; vC0[0] = vN0[0]; vC0[1] = vN0[1]; vC1[0] = vN1[0]; vC1[1] = vN1[1];
        if (wr == 1) PG8_BAR;
    }
    PG8_WAIT_V(0);
    PG8_BAR;
#undef PG8_SA
#undef PG8_SB
#undef PG8_STAGE
#undef PG8_LDA
#undef PG8_LDB
#undef PG8_MMA
#undef PG8_WAIT_V
#undef PG8_WAIT_L
#undef PG8_BAR
#undef PG8_SCHED
}

template <class P>
__device__ __forceinline__ void gemm_run_bf32(LAS unsigned char* lds, const P& prob) {
    const int tid = threadIdx.x, wid = __builtin_amdgcn_readfirstlane(tid >> 6), lane = tid & 63, wr = wid >> 2, wc = wid & 3, fr = lane & 15, fq = lane >> 4;
    constexpr int K = KD, nt = K / BK;
    constexpr size_t kstep = (size_t)(BK * 2);
    constexpr size_t ldwB = (size_t)P::LDW_BYTES;
    const unsigned ldsw = (unsigned)wid * 1024u;
    const int aoff = lds_byte(wr * 64 + fr, fq * 8), boff = lds_byte(wc * 32 + fr, fq * 8);
    const int wbo0 = lds_byte(32 * (lane >> 4) + ((lane & 1) | (((lane >> 3) & 1) << 2) | (((lane >> 2) & 1) << 3) | (((lane >> 1) & 1) << 4)), 8 * wid);
#define PG8_SA(b, h) (((b) * 2 + (h)) * HTB)
#define PG8_SB(b, h) ((4 + (b) * 2 + (h)) * HTB)
#define PG8_STAGE(bufoff, gbase, voff) do { _Pragma("unroll") for (int _i = 0; _i < 2; ++_i) \
        __builtin_amdgcn_global_load_lds((const unsigned*)((const char*)(gbase) + (voff)[_i]), (LAS unsigned*)(lds + (bufoff) + ldsw + _i * 8192), 16, 0, 0); } while (0)
#define PG8_LDA(dst, b, h) do { _Pragma("unroll") for (int m = 0; m < 4; ++m) _Pragma("unroll") for (int k = 0; k < 2; ++k) dst[m][k] = *(const LAS bf16x8*)(lds + PG8_SA(b, h) + aoff + m * 2048 + k * 1024); } while (0)
#define PG8_LDB(dst, b, h) do { _Pragma("unroll") for (int n = 0; n < 2; ++n) _Pragma("unroll") for (int k = 0; k < 2; ++k) dst[n][k] = *(const LAS bf16x8*)(lds + PG8_SB(b, h) + boff + n * 2048 + k * 1024); } while (0)
#define PG8_MMA(ai, bj, At, Bt) do { __builtin_amdgcn_s_setprio(1); _Pragma("unroll") for (int m = 0; m < 4; ++m) _Pragma("unroll") for (int n = 0; n < 2; ++n) _Pragma("unroll") for (int k = 0; k < 2; ++k) \
        acc[ai][bj][m][n] = __builtin_amdgcn_mfma_f32_16x16x32_bf16(Bt[n][k], At[m][k], acc[ai][bj][m][n], 0, 0, 0); __builtin_amdgcn_s_setprio(0); } while (0)
#define PG8_WAIT_V(n) asm volatile("s_waitcnt vmcnt(" #n ")" ::: "memory")
#define PG8_WAIT_L(n) asm volatile("s_waitcnt lgkmcnt(" #n ")" ::: "memory")
#define PG8_BAR __builtin_amdgcn_s_barrier()
#define PG8_SCHED __builtin_amdgcn_sched_barrier(0)
#define PG8_BLOAD(kk, h) do { const bool nx_ = (kk) >= nt; const unsigned so_ = (nx_ ? nBo : cBo) + (unsigned)((nx_ ? (kk) - nt : (kk)) * BK + 8 * wid) * (unsigned)ldwB + (unsigned)(h) * (unsigned)P::HALF_BYTES; const unsigned co_ = nx_ ? nCol : cCol; \
        asm volatile("s_nop 4" ::: "memory"); \
        _Pragma("unroll") for (int j_ = 0; j_ < 8; ++j_) asm volatile("buffer_load_dwordx2 %0, %1, %2, %3 offen" : "=v"(bv[j_]) : "v"(co_), "s"(wrs), "s"(so_ + (unsigned)j_ * (unsigned)ldwB) : "memory"); } while (0)
#define PG8_BWAIT(n) asm volatile("s_waitcnt vmcnt(" #n ")" : "+v"(bv[0]), "+v"(bv[1]), "+v"(bv[2]), "+v"(bv[3]), "+v"(bv[4]), "+v"(bv[5]), "+v"(bv[6]), "+v"(bv[7]) :: "memory")
#define PG8_BWRITE(b, h) do { _Pragma("unroll") for (int i_ = 0; i_ < 2; ++i_) { u32x4 o_; o_.x = cvt_pk_bf16(bv[0][i_], bv[1][i_]); o_.y = cvt_pk_bf16(bv[2][i_], bv[3][i_]); \
        o_.z = cvt_pk_bf16(bv[4][i_], bv[5][i_]); o_.w = cvt_pk_bf16(bv[6][i_], bv[7][i_]); *(LAS u32x4*)(lds + PG8_SB(b, h) + wbo0 + 128 * i_) = o_; } } while (0)
    typedef float f32x2v __attribute__((ext_vector_type(2)));
    Unit cur, nxt; int ui = 0;
    if (!prob.next(0, cur)) return;
    f32x4 acc[2][2][4][2];
    bf16x8 At[4][2], B0[2][2], B1[2][2];
    f32x2v bv[8];
    unsigned vC0[2], vC1[2], vN0[2], vN1[2];
    prob.a_off(cur, vC0, vC1);
    const char* const Ab = prob.a_base();
    const __amdgpu_buffer_rsrc_t wrs = __builtin_amdgcn_make_buffer_rsrc((void*)prob.W, 0, (unsigned)NE * (unsigned)P::W_BYTES, 0x00020000);
    unsigned cBo = (unsigned)cur.e * (unsigned)P::W_BYTES, cCol = prob.b_col(cur, lane);
    unsigned nBo = cBo, nCol = cCol;
    PG8_BLOAD(0, 0); PG8_BWAIT(0); PG8_BWRITE(0, 0); PG8_BLOAD(0, 1); PG8_BWAIT(0); PG8_BWRITE(0, 1); PG8_BLOAD(1, 0); PG8_BWAIT(0); PG8_BWRITE(1, 0); PG8_BLOAD(1, 1);
    PG8_STAGE(PG8_SA(0, 0), Ab, vC0); PG8_STAGE(PG8_SA(0, 1), Ab, vC1);
    if (wr == 1) PG8_BAR;
    PG8_WAIT_V(2); PG8_WAIT_L(0); PG8_BAR;
    PG8_STAGE(PG8_SA(1, 0), Ab + kstep, vC0);
    { f32x4 bini[2][2]; prob.bias_load(cur, wc, fq, bini);
#pragma unroll
      for (int a = 0; a < 2; ++a)
#pragma unroll
        for (int b = 0; b < 2; ++b)
#pragma unroll
            for (int m = 0; m < 4; ++m)
#pragma unroll
                for (int n = 0; n < 2; ++n) acc[a][b][m][n] = bini[b][n]; }
    PG8_WAIT_V(0); PG8_BAR;
    for (;;) {
        const bool has_next = prob.next(ui + 1, nxt);
        if (has_next) { prob.a_off(nxt, vN0, vN1); nBo = (unsigned)nxt.e * (unsigned)P::W_BYTES; nCol = prob.b_col(nxt, lane); }
        else { vN0[0] = vC0[0]; vN0[1] = vC0[1]; vN1[0] = vC1[0]; vN1[1] = vC1[1]; nBo = cBo; nCol = cCol; }
        for (int t = 0; t < nt; t += 2) {
            const bool last = (t == nt - 2);
            const char* a1 = Ab + (size_t)(t + 1) * kstep;
            const char* a2 = last ? Ab : Ab + (size_t)(t + 2) * kstep;
            const char* a3 = a2 + kstep;
            unsigned v20[2], v21[2];
            v20[0] = last ? vN0[0] : vC0[0]; v20[1] = last ? vN0[1] : vC0[1]; v21[0] = last ? vN1[0] : vC1[0]; v21[1] = last ? vN1[1] : vC1[1];
            PG8_LDB(B0, 0, 0); PG8_LDB(B1, 0, 1); PG8_SCHED; PG8_LDA(At, 0, 0); PG8_BWAIT(2); PG8_BWRITE(1, 1); PG8_BLOAD(t + 2, 0); PG8_STAGE(PG8_SA(1, 1), a1, vC1);
            PG8_WAIT_V(20); PG8_WAIT_L(0); PG8_BAR; PG8_MMA(0, 0, At, B0); PG8_MMA(0, 1, At, B1); PG8_BAR; PG8_SCHED;
            PG8_LDA(At, 0, 1); PG8_BWAIT(2); PG8_BWRITE(0, 0); PG8_BLOAD(t + 2, 1); PG8_STAGE(PG8_SA(0, 0), a2, v20);
            PG8_WAIT_V(20); PG8_WAIT_L(0); PG8_BAR; PG8_MMA(1, 0, At, B0); PG8_MMA(1, 1, At, B1); PG8_BAR; PG8_SCHED;
            PG8_LDB(B0, 1, 0); PG8_LDB(B1, 1, 1); PG8_SCHED; PG8_LDA(At, 1, 0); PG8_BWAIT(2); PG8_BWRITE(0, 1); PG8_BLOAD(t + 3, 0); PG8_STAGE(PG8_SA(0, 1), a2, v21);
            PG8_WAIT_V(20); PG8_WAIT_L(0); PG8_BAR; PG8_MMA(0, 0, At, B0); PG8_MMA(0, 1, At, B1); PG8_BAR; PG8_SCHED;
            PG8_LDA(At, 1, 1); PG8_BWAIT(2); PG8_BWRITE(1, 0); PG8_BLOAD(t + 3, 1); PG8_STAGE(PG8_SA(1, 0), a3, v20);
            PG8_WAIT_V(20); PG8_WAIT_L(0); PG8_BAR; PG8_MMA(1, 0, At, B0); PG8_MMA(1, 1, At, B1); PG8_BAR; PG8_SCHED;
        }
        if (wr == 0) PG8_BAR;
        prob.epi(acc, cur, wr, wc, fr, fq, 0);
        if (has_next) { f32x4 bini[2][2]; prob.bias_load(nxt, wc, fq, bini);
#pragma unroll
            for (int b = 0; b < 2; ++b)
#pragma unroll
                for (int m = 0; m < 4; ++m)
#pragma unroll
                    for (int n = 0; n < 2; ++n) acc[0][b][m][n] = bini[b][n]; }
        prob.epi(acc, cur, wr, wc, fr, fq, 1);
        if (!has_next) break;
#pragma unroll
        for (int b = 0; b < 2; ++b)
#pragma unroll
            for (int m = 0; m < 4; ++m)
#pragma unroll
                for (int n = 0; n < 2; ++n) acc[1][b][m][n] = acc[0][b][m][n];
        cur = nxt; cBo = nBo; cCol = nCol; ++ui; vC0[0] = vN0[0]; vC0[1] = vN0[1]; vC1[0] = vN1[0]; vC1[1] = vN1[1];
        if (wr == 1) PG8_BAR;
    }
    PG8_BWAIT(0);
    PG8_BAR;
#undef PG8_SA
#undef PG8_SB
#undef PG8_STAGE
#undef PG8_LDA
#undef PG8_LDB
#undef PG8_MMA
#undef PG8_WAIT_V
#undef PG8_WAIT_L
#undef PG8_BAR
#undef PG8_SCHED
#undef PG8_BLOAD
#undef PG8_BWAIT
#undef PG8_BWRITE
}
}

constexpr int NWAVES = 8, NTHR = 512;
constexpr int RING_BYTES = 131072;
constexpr int TAB_OFF = 147968;
constexpr int MISC_OFF = 163840 - 256;
constexpr int LDS_BYTES = 163840;

struct Frame {
    LAS unsigned char* lds; volatile LAS unsigned* MISC; unsigned* ctl;
    int tid, lane, wave, vcu, G;
    const float *x, *c, *w_ada, *b_ada, *g1, *w_in, *lq1, *lk1, *lq2, *lk2, *subln, *relb, *cw, *cb, *clg, *clb, *w_out, *g2, *w_r, *b_r, *w_gu, *b_gu, *w_d, *b_d, *fg;
    float* out; unsigned char* ws;
};
#define WSP(T_, off) ((T_*)(F.ws + (off)))

__device__ __forceinline__ void p0_transpose_item(const float* W, int ldn, int n0, int k0, bf16* dst, int drow0, LAS unsigned char* scr, int lane) {
    const int ng = lane & 31, kh = lane >> 5;
#pragma unroll
    for (int it = 0; it < 4; ++it) {
        f32x4 v[8];
#pragma unroll
        for (int j = 0; j < 8; ++j) v[j] = *(const GAS f32x4*)(W + (size_t)(k0 + 16 * it + 8 * kh + j) * ldn + n0 + 4 * ng);
        const int kc = 2 * it + kh;
#pragma unroll
        for (int i = 0; i < 4; ++i) { const int n = 4 * ng + i;
            u32x4 o; o.x = pk2(v[0][i], v[1][i]); o.y = pk2(v[2][i], v[3][i]); o.z = pk2(v[4][i], v[5][i]); o.w = pk2(v[6][i], v[7][i]);
            *(LAS u32x4*)(scr + n * 128 + ((kc ^ (ng & 7)) << 4)) = o; }
    }
    LDS_WAIT(); asm volatile("" ::: "memory");
#pragma unroll
    for (int j = 0; j < 16; ++j) { const int n = 8 * j + (lane >> 3), c = lane & 7;
        const u32x4 o = *(const LAS u32x4*)(scr + n * 128 + ((c ^ ((n >> 2) & 7)) << 4));
        *(GAS u32x4*)(dst + (size_t)(drow0 + n) * pg8::KD + k0 + 8 * c) = o; }
    LDS_WAIT(); asm volatile("" ::: "memory");
}
__device__ __forceinline__ void p0_prologue(Frame& F) {
    const int gw = F.vcu * NWAVES + F.wave, NGW = F.G * NWAVES, gt = F.vcu * NTHR + F.tid, NGT = F.G * NTHR;
    LAS float* cs = (LAS float*)(F.lds);
    for (int i = F.tid; i < NB * DM; i += NTHR) cs[i] = silu_f(F.c[i]);
    __syncthreads();
    float* modp = WSP(float, WS_MODP);
    for (int it = gw; it < 192 * 8; it += NGW) {
        const int cc = it % 192, kc = it / 192, r = F.lane >> 4, g = F.lane & 15;
        float acc[4][4];
#pragma unroll
        for (int b = 0; b < 4; ++b)
#pragma unroll
            for (int j = 0; j < 4; ++j) acc[b][j] = 0.f;
        const float* wp = F.w_ada + (size_t)(kc * 256 + r) * (6 * DM) + cc * 64 + g * 4;
#pragma unroll 8
        for (int s = 0; s < 64; ++s) {
            const f32x4 w = *(const GAS f32x4*)(wp + (size_t)(4 * s) * (6 * DM)); const int k = kc * 256 + 4 * s + r;
#pragma unroll
            for (int b = 0; b < 4; ++b) { const float cv = cs[b * DM + k];
#pragma unroll
                for (int j = 0; j < 4; ++j) acc[b][j] += cv * w[j]; }
        }
#pragma unroll
        for (int b = 0; b < 4; ++b)
#pragma unroll
            for (int j = 0; j < 4; ++j) { float v = acc[b][j]; v += __shfl_xor(v, 16); v += __shfl_xor(v, 32); acc[b][j] = v; }
        if (F.lane < 16)
#pragma unroll
            for (int b = 0; b < 4; ++b) *(GAS f32x4*)(modp + (size_t)(kc * 4 + b) * (6 * DM) + cc * 64 + g * 4) = (f32x4){acc[b][0], acc[b][1], acc[b][2], acc[b][3]};
    }
    __syncthreads();
    LAS unsigned char* scr = F.lds + F.wave * 16384;
    constexpr int I_IN = (INC / 128) * 32, I_OUT = (DM / 128) * 32;
    constexpr int I_GU = 0, I_D = 0;
    for (int it = gw; it < I_IN + I_OUT + I_GU + I_D; it += NGW) {
        int r = it;
        if (r < I_IN) { const int nb = r >> 5, kb = r & 31; p0_transpose_item(F.w_in, INC, nb * 128, kb * 64, WSP(bf16, WS_WIN), nb * 128, scr, F.lane); continue; } r -= I_IN;
        if (r < I_OUT) { const int nb = r >> 5, kb = r & 31; p0_transpose_item(F.w_out, DM, nb * 128, kb * 64, WSP(bf16, WS_WOUT), nb * 128, scr, F.lane); continue; } r -= I_OUT;
        if (r < I_GU) { const int e = r >> 10, nb = (r >> 5) & 31, kb = r & 31;
            const int drow = (nb < 16) ? nb * 256 : (nb - 16) * 256 + 128;
            p0_transpose_item(F.w_gu + (size_t)e * DM * 2 * DFF, 2 * DFF, nb * 128, kb * 64, WSP(bf16, WS_WGU) + (size_t)e * 2 * DFF * DM, drow, scr, F.lane); continue; } r -= I_GU;
        { const int e = r >> 9, nb = (r >> 5) & 15, kb = r & 31;
            p0_transpose_item(F.w_d + (size_t)e * DFF * DM, DM, nb * 128, kb * 64, WSP(bf16, WS_WD) + (size_t)e * DM * DFF, nb * 128, scr, F.lane); }
    }
    for (int i = gt; i < 64 * 2 * 64; i += NGT) {
        const int l = i & 63, nb = (i >> 6) & 1, s = i >> 7, e = 16 * nb + (l & 15), kb = 32 * s + 8 * (l >> 4);
        unsigned hi[8], lo[8];
#pragma unroll
        for (int j = 0; j < 8; ++j) { const float w = F.w_r[(size_t)(kb + j) * NE + e]; hi[j] = f2bf(w); lo[j] = f2bf(w - bf2f(hi[j])); }
        u32x4 oh, ol; oh.x = hi[0] | (hi[1] << 16); oh.y = hi[2] | (hi[3] << 16); oh.z = hi[4] | (hi[5] << 16); oh.w = hi[6] | (hi[7] << 16);
        ol.x = lo[0] | (lo[1] << 16); ol.y = lo[2] | (lo[3] << 16); ol.z = lo[4] | (lo[5] << 16); ol.w = lo[6] | (lo[7] << 16);
        *(GAS u32x4*)(WSP(unsigned char, WS_WRF) + (size_t)i * 16) = oh; *(GAS u32x4*)(WSP(unsigned char, WS_WRF) + 131072 + (size_t)i * 16) = ol;
    }
    float* bt = WSP(float, WS_BIAST);
    for (int i = gt; i < AH * 4096; i += NGT) { const int h = i >> 12, rel = (i & 4095) - 2048; bt[i] = F.relb[t5_bucket(rel) * AH + h] * LOG2E; }
    if (gt == 0) { float a = 0.f, b = 0.f; for (int i = 0; i < HD; ++i) { a += F.lq1[i] * F.lk1[i]; b += F.lq2[i] * F.lk2[i]; } bt[AH * 4096] = __expf(a) - __expf(b) + 0.2f; }
}

__device__ __forceinline__ void p1_norm1(Frame& F) {
    const float* modp = WSP(float, WS_MODP); float* mod = WSP(float, WS_MOD);
    for (int o = F.vcu * NTHR + F.tid; o < NB * 6 * DM; o += F.G * NTHR) { float s = F.b_ada[o % (6 * DM)];
#pragma unroll
        for (int kc = 0; kc < 8; ++kc) s += modp[(size_t)kc * (NB * 6 * DM) + o];
        mod[o] = s; }
    LAS float* gm = (LAS float*)F.lds; LAS float* sh = gm + DM;
    bf16* h = WSP(bf16, WS_H);
    for (int rb = F.vcu; rb < T / 32; rb += F.G) {
        const int b = rb / (SEQ / 32);
        __syncthreads();
        for (int k = F.tid; k < DM; k += NTHR) { float sc = F.b_ada[DM + k], sf = F.b_ada[k];
#pragma unroll
            for (int kc = 0; kc < 8; ++kc) { sc += modp[(size_t)(kc * 4 + b) * (6 * DM) + DM + k]; sf += modp[(size_t)(kc * 4 + b) * (6 * DM) + k]; }
            gm[k] = F.g1[k] * (1.f + sc); sh[k] = sf; }
        __syncthreads();
        for (int rr = F.wave; rr < 32; rr += NWAVES) {
            const int row = rb * 32 + rr;
            const GAS f32x4* xr = (const GAS f32x4*)(F.x + (size_t)row * DM) + F.lane;
            f32x4 v[8]; float s = 0.f;
#pragma unroll
            for (int j = 0; j < 8; ++j) { v[j] = xr[64 * j]; s += (v[j].x * v[j].x + v[j].y * v[j].y) + (v[j].z * v[j].z + v[j].w * v[j].w); }
            const float rstd = rsqrtf(wave_sum(s) * (1.f / DM) + EPS);
            GAS u32x2* o8 = (GAS u32x2*)(h + (size_t)row * DM) + F.lane;
#pragma unroll
            for (int j = 0; j < 8; ++j) { const int k = 4 * F.lane + 256 * j; const f32x4 g = *(const LAS f32x4*)(gm + k), s4 = *(const LAS f32x4*)(sh + k);
                u32x2 w; w.x = pk2(v[j].x * rstd * g.x + s4.x, v[j].y * rstd * g.y + s4.y); w.y = pk2(v[j].z * rstd * g.z + s4.z, v[j].w * rstd * g.w + s4.w); o8[64 * j] = w; }
        }
    }
}

struct InProj {
    static constexpr bool PERM = true;
    const bf16* A; const bf16* Bt; bf16* O; pg8::DenseOrder ord;
    __device__ bool next(int i, pg8::Unit& u) const { return ord.next(i, u); }
    __device__ const char* a_base() const { return (const char*)A; }
    __device__ void a_off(const pg8::Unit& u, const int (&R)[2], const int (&C)[2], unsigned (&v0)[2], unsigned (&v1)[2]) const {
#pragma unroll
        for (int i = 0; i < 2; ++i) { v0[i] = (unsigned)((u.pm * 256 + R[i]) * pg8::KD + C[i]) * 2u; v1[i] = (unsigned)((u.pm * 256 + 128 + R[i]) * pg8::KD + C[i]) * 2u; } }
    __device__ const char* b_base(const pg8::Unit& u) const { return (const char*)(Bt + (size_t)u.pn * 256 * pg8::KD); }
    __device__ void epi(const f32x4 (&acc)[2][2][4][2], const pg8::Unit& u, int wr, int wc, int fr, int fq) const {
        const int row0 = u.pm * 256 + wr * 64 + fr, col0 = u.pn * 256 + wc * 32 + 8 * fq;
#pragma unroll
        for (int ai = 0; ai < 2; ++ai)
#pragma unroll
            for (int m = 0; m < 4; ++m) { bf16* rowp = O + (size_t)(row0 + ai * 128 + m * 16) * INC + col0;
#pragma unroll
                for (int bj = 0; bj < 2; ++bj) { const f32x4 v0 = acc[ai][bj][m][0], v1 = acc[ai][bj][m][1];
                    u32x4 w; w.x = cvt_pk_bf16(v0[0], v0[1]); w.y = cvt_pk_bf16(v0[2], v0[3]); w.z = cvt_pk_bf16(v1[0], v1[1]); w.w = cvt_pk_bf16(v1[2], v1[3]);
                    *(GAS u32x4*)(rowp + bj * 128) = w; } }
    }
};
struct OutProj {
    static constexpr bool PERM = false;
    const bf16* A; const bf16* Bt; const float* x; const float* mod; float* O; pg8::DenseOrder ord;
    __device__ bool next(int i, pg8::Unit& u) const { return ord.next(i, u); }
    __device__ const char* a_base() const { return (const char*)A; }
    __device__ void a_off(const pg8::Unit& u, const int (&R)[2], const int (&C)[2], unsigned (&v0)[2], unsigned (&v1)[2]) const {
#pragma unroll
        for (int i = 0; i < 2; ++i) { v0[i] = (unsigned)((u.pm * 256 + R[i]) * pg8::KD + C[i]) * 2u; v1[i] = (unsigned)((u.pm * 256 + 128 + R[i]) * pg8::KD + C[i]) * 2u; } }
    __device__ const char* b_base(const pg8::Unit& u) const { return (const char*)(Bt + (size_t)u.pn * 256 * pg8::KD); }
    __device__ void epi(const f32x4 (&acc)[2][2][4][2], const pg8::Unit& u, int wr, int wc, int fr, int fq) const {
        const int row0 = u.pm * 256 + wr * 64 + fr, col0 = u.pn * 256 + wc * 32 + 4 * fq, b = (u.pm * 256) / SEQ;
        f32x4 gt[2][2];
#pragma unroll
        for (int bj = 0; bj < 2; ++bj)
#pragma unroll
            for (int n = 0; n < 2; ++n) gt[bj][n] = *(const GAS f32x4*)(mod + (size_t)b * 6 * DM + 2 * DM + col0 + bj * 128 + 16 * n);
#pragma unroll
        for (int ai = 0; ai < 2; ++ai)
#pragma unroll
            for (int m = 0; m < 4; ++m) { const size_t ro = (size_t)(row0 + ai * 128 + m * 16) * DM + col0;
#pragma unroll
                for (int bj = 0; bj < 2; ++bj)
#pragma unroll
                    for (int n = 0; n < 2; ++n) { const f32x4 xv = *(const GAS f32x4*)(x + ro + bj * 128 + 16 * n);
                        *(GAS f32x4*)(O + ro + bj * 128 + 16 * n) = xv + gt[bj][n] * acc[ai][bj][m][n]; } }
    }
};
struct MoeTab { const LAS int* tp; const LAS int* off; const LAS int* cnt; };
__device__ __forceinline__ void moe_tables(Frame& F) {
    LAS int* tab = (LAS int*)(F.lds + TAB_OFF);
    __syncthreads();
    if (F.tid == 0) { int tp = 0, off = 0; for (int e = 0; e < NE; ++e) { const int c = (int)__hip_atomic_load(F.ctl + CW_CNT + e, __ATOMIC_RELAXED, __HIP_MEMORY_SCOPE_AGENT);
            tab[e] = tp; tab[40 + e] = off; tab[80 + e] = c; tp += (c + 255) >> 8; off += c; } tab[NE] = tp; tab[40 + NE] = off; }
    __syncthreads();
}
template <int NTN, int REPF>
__device__ __forceinline__ bool moe_next(const MoeTab& tb, int G, int c, int i, pg8::Unit& u) {
    int L = i * G + c; const int total = NTN * __builtin_amdgcn_readfirstlane(tb.tp[NE]); if (L >= total * REPF) return false;
    if (REPF > 1 && L >= total) L -= total;
    int e = 0;
#pragma unroll
    for (int j = 1; j < NE; ++j) e += (L >= NTN * tb.tp[j]) ? 1 : 0;
    e = __builtin_amdgcn_readfirstlane(e);
    const int tpe = __builtin_amdgcn_readfirstlane(tb.tp[e]), tpe1 = __builtin_amdgcn_readfirstlane(tb.tp[e + 1]);
    const int local = L - NTN * tpe, nte = tpe1 - tpe;
    u.e = e; u.pn = __builtin_amdgcn_readfirstlane(local / nte); u.pm = local - u.pn * nte; u.rows = __builtin_amdgcn_readfirstlane(tb.cnt[e]) - 256 * u.pm; return true;
}
struct MoeGU {
    static constexpr bool PERM = true;
    const bf16* A; const float* W; const float* bias; const int* list; bf16* O; MoeTab tb; int G, c;
    __device__ bool next(int i, pg8::Unit& u) const { return moe_next<16, 1 + ((REP_MASK >> 11) & 1)>(tb, G, c, i, u); }
    __device__ const char* a_base() const { return (const char*)A; }
    __device__ void a_off(const pg8::Unit& u, unsigned (&v0)[2], unsigned (&v1)[2]) const {
        const int* lp = list + u.e * T + 256 * u.pm;
        int tb16 = (int)threadIdx.x * 16; asm volatile("" : "+v"(tb16));
#pragma unroll
        for (int i = 0; i < 2; ++i) { int R, C; pg8::stage_rc(tb16 + i * 8192, R, C);
            const int r0 = R < u.rows ? R : u.rows - 1, r1 = (128 + R) < u.rows ? (128 + R) : u.rows - 1;
            v0[i] = (unsigned)(lp[r0] * pg8::KD + C) * 2u; v1[i] = (unsigned)(lp[r1] * pg8::KD + C) * 2u; } }
    __device__ void bias_load(const pg8::Unit& u, int wc, int fq, f32x4 (&bi)[2][2]) const {
        int cb = wc * 32 + 8 * ((fq >> 1) + 2 * (fq & 1)); asm volatile("" : "+v"(cb));
        const float* bp = bias + (size_t)u.e * 2 * DFF + u.pn * 128 + cb;
#pragma unroll
        for (int bj = 0; bj < 2; ++bj)
#pragma unroll
            for (int n = 0; n < 2; ++n) { const f32x4 t = *(const GAS f32x4*)(bp + bj * DFF + 4 * n); bi[bj][n] = (f32x4){t[0], t[2], t[1], t[3]}; } }
    static constexpr int LDW_BYTES = 2 * DFF * 4, W_BYTES = DM * 2 * DFF * 4;
    __device__ const char* b_ptr(const pg8::Unit& u) const { return (const char*)(W + (size_t)u.e * DM * 2 * DFF); }
    static constexpr int HALF_BYTES = DFF * 4;
    __device__ unsigned b_col(const pg8::Unit& u, int lane) const { return (unsigned)(u.pn * 128 + 2 * lane) * 4u; }
    __device__ void epi(const f32x4 (&acc)[2][2][4][2], const pg8::Unit& u, int wr, int wc, int fr, int fq, const int ai) const {
        int rt0 = wr * 64 + fr, colt = u.pn * 128 + wc * 32 + 8 * ((fq >> 1) + 2 * (fq & 1)); asm volatile("" : "+v"(rt0), "+v"(colt)); const size_t slot0 = (size_t)__builtin_amdgcn_readfirstlane(tb.off[u.e]) + 256 * u.pm;
#pragma unroll
            for (int m = 0; m < 4; ++m) { const int rt = rt0 + ai * 128 + m * 16; float r[8];
#pragma unroll
                for (int n = 0; n < 2; ++n)
#pragma unroll
                    for (int j = 0; j < 4; ++j) { const int o = (j >> 1) + 2 * (j & 1) + 4 * n;
                        float g = acc[ai][0][m][n][j], up = acc[ai][1][m][n][j];
                        g = fminf(g, 7.f); up = fminf(fmaxf(up, -7.f), 7.f);
                        r[o] = (up + 1.f) * g * __builtin_amdgcn_rcpf(1.f + __builtin_amdgcn_exp2f(-1.702f * LOG2E * g)); }
                if (rt < u.rows) { u32x4 w; w.x = cvt_pk_bf16(r[0], r[1]); w.y = cvt_pk_bf16(r[2], r[3]); w.z = cvt_pk_bf16(r[4], r[5]); w.w = cvt_pk_bf16(r[6], r[7]);
                    *(GAS u32x4*)(O + (slot0 + rt) * DFF + colt) = w; } }
    }
};
struct MoeDown {
    static constexpr bool PERM = true;
    const bf16* A; const float* W; const float* bias; const float* sw; bf16* O; MoeTab tb; int G, c;
    __device__ bool next(int i, pg8::Unit& u) const { return moe_next<8, 1 + ((REP_MASK >> 12) & 1)>(tb, G, c, i, u); }
    __device__ const char* a_base() const { return (const char*)A; }
    __device__ void a_off(const pg8::Unit& u, unsigned (&v0)[2], unsigned (&v1)[2]) const {
        const int s0 = __builtin_amdgcn_readfirstlane(tb.off[u.e]) + 256 * u.pm;
        int tb16 = (int)threadIdx.x * 16; asm volatile("" : "+v"(tb16));
#pragma unroll
        for (int i = 0; i < 2; ++i) { int R, C; pg8::stage_rc(tb16 + i * 8192, R, C);
            v0[i] = (unsigned)((s0 + R) * pg8::KD + C) * 2u; v1[i] = (unsigned)((s0 + 128 + R) * pg8::KD + C) * 2u; } }
    __device__ void bias_load(const pg8::Unit& u, int wc, int fq, f32x4 (&bi)[2][2]) const {
        int cb = wc * 32 + 8 * ((fq >> 1) + 2 * (fq & 1)); asm volatile("" : "+v"(cb));
        const float* bp = bias + (size_t)u.e * DM + u.pn * 256 + cb;
#pragma unroll
        for (int bj = 0; bj < 2; ++bj)
#pragma unroll
            for (int n = 0; n < 2; ++n) { const f32x4 t = *(const GAS f32x4*)(bp + bj * 128 + 4 * n); bi[bj][n] = (f32x4){t[0], t[2], t[1], t[3]}; } }
    static constexpr int LDW_BYTES = DM * 4, W_BYTES = DFF * DM * 4;
    __device__ const char* b_ptr(const pg8::Unit& u) const { return (const char*)(W + (size_t)u.e * DFF * DM); }
    static constexpr int HALF_BYTES = 128 * 4;
    __device__ unsigned b_col(const pg8::Unit& u, int lane) const { return (unsigned)(u.pn * 256 + 2 * lane) * 4u; }
    __device__ void epi(const f32x4 (&acc)[2][2][4][2], const pg8::Unit& u, int wr, int wc, int fr, int fq, const int ai) const {
        int rt0 = wr * 64 + fr, col0 = u.pn * 256 + wc * 32 + 8 * ((fq >> 1) + 2 * (fq & 1)); asm volatile("" : "+v"(rt0), "+v"(col0)); const size_t slot0 = (size_t)__builtin_amdgcn_readfirstlane(tb.off[u.e]) + 256 * u.pm;
#pragma unroll
            for (int m = 0; m < 4; ++m) { const int rt = rt0 + ai * 128 + m * 16;
                if (rt < u.rows) { const float wgt = sw[(size_t)u.e * T + 256 * u.pm + rt]; bf16* rowp = O + (slot0 + rt) * DM + col0;
#pragma unroll
                    for (int bj = 0; bj < 2; ++bj) { float r[8];
#pragma unroll
                        for (int n = 0; n < 2; ++n)
#pragma unroll
                            for (int j = 0; j < 4; ++j) { const int o = (j >> 1) + 2 * (j & 1) + 4 * n; r[o] = acc[ai][bj][m][n][j] * wgt; }
                        u32x4 w; w.x = cvt_pk_bf16(r[0], r[1]); w.y = cvt_pk_bf16(r[2], r[3]); w.z = cvt_pk_bf16(r[4], r[5]); w.w = cvt_pk_bf16(r[6], r[7]);
                        *(GAS u32x4*)(rowp + bj * 128) = w; } } }
    }
};

__device__ __forceinline__ void conv_unit(Frame& F, int ct) {
    const int b = ct / (SEQ / 32), s0 = (ct % (SEQ / 32)) * 32, tid = F.tid;
    const bf16* proj = WSP(bf16, WS_PROJ); bf16* mix = WSP(bf16, WS_MIX);
    LAS unsigned* z = (LAS unsigned*)F.lds;
    LAS float* st = (LAS float*)(F.lds + 126976);
    __syncthreads();
#pragma unroll 8
    for (int r = 0; r < 62; ++r) { const int s = s0 - 15 + r; const bool ok = (s >= 0 && s < SEQ); const int sc = ok ? s : 0;
        const bf16* pr = proj + (size_t)(b * SEQ + sc) * INC + 3072 + 2 * tid; const unsigned a = *(const GAS unsigned*)pr, g = *(const GAS unsigned*)(pr + 1024);
        const float a0 = bf2f(a & 0xffffu), a1 = bf2f(a >> 16), g0 = bf2f(g & 0xffffu), g1 = bf2f(g >> 16);
        const unsigned zz = pk2(a0 * __builtin_amdgcn_rcpf(1.f + __builtin_amdgcn_exp2f(-LOG2E * g0)), a1 * __builtin_amdgcn_rcpf(1.f + __builtin_amdgcn_exp2f(-LOG2E * g1)));
        z[r * 512 + tid] = ok ? zz : 0u; }
    typedef float f32x2c __attribute__((ext_vector_type(2)));
    float w0[CK], w1[CK];
#pragma unroll
    for (int j = 0; j < CK; ++j) { const f32x2c w = *(const GAS f32x2c*)(F.cw + j * CCH + 2 * tid); w0[j] = w.x; w1[j] = w.y; }
    const f32x2c cbv = *(const GAS f32x2c*)(F.cb + 2 * tid), lg = *(const GAS f32x2c*)(F.clg + 2 * tid), lb = *(const GAS f32x2c*)(F.clb + 2 * tid);
    __syncthreads();
#pragma unroll 1
    for (int hf = 0; hf < 2; ++hf) {
        float c0[16], c1[16];
#pragma unroll
        for (int g = 0; g < 4; ++g) {
            float zl[34], zh[34];
#pragma unroll
            for (int r = 0; r < 34; ++r) { const unsigned zz = z[(16 * hf + 4 * g + r) * 512 + tid]; zl[r] = __builtin_bit_cast(float, zz << 16); zh[r] = __builtin_bit_cast(float, zz & 0xffff0000u); }
#pragma unroll
            for (int t = 0; t < 4; ++t) { float a0 = cbv.x, a1 = cbv.y;
#pragma unroll
                for (int j = 0; j < CK; ++j) { a0 = fmaf(w0[j], zl[t + j], a0); a1 = fmaf(w1[j], zh[t + j], a1); }
                c0[4 * g + t] = a0; c1[4 * g + t] = a1; }
        }
#pragma unroll
        for (int t = 0; t < 16; ++t) { const float sm = wave_sum(c0[t] + c1[t]), q = wave_sum(c0[t] * c0[t] + c1[t] * c1[t]);
            if (F.lane == 0) { st[(F.wave * 16 + t) * 2] = sm; st[(F.wave * 16 + t) * 2 + 1] = q; } }
        __syncthreads();
        if (tid < 16) { float sm = 0.f, q = 0.f;
#pragma unroll
            for (int w = 0; w < 8; ++w) { sm += st[(w * 16 + tid) * 2]; q += st[(w * 16 + tid) * 2 + 1]; }
            const float mu = sm * (1.f / CCH), var = q * (1.f / CCH) - mu * mu; st[512 + tid * 2] = mu; st[512 + tid * 2 + 1] = rsqrtf(fmaxf(var, 0.f) + EPS); }
        __syncthreads();
#pragma unroll
        for (int t = 0; t < 16; ++t) { const float mu = st[512 + t * 2], rs = st[512 + t * 2 + 1];
            const float y0 = (c0[t] - mu) * rs * lg.x + lb.x, y1 = (c1[t] - mu) * rs * lg.y + lb.y;
            const float o0 = y0 * __builtin_amdgcn_rcpf(1.f + __builtin_amdgcn_exp2f(-LOG2E * y0)), o1 = y1 * __builtin_amdgcn_rcpf(1.f + __builtin_amdgcn_exp2f(-LOG2E * y1));
            *(GAS unsigned*)(mix + (size_t)(b * SEQ + s0 + 16 * hf + t) * DM + 1024 + 2 * tid) = cvt_pk_bf16(o0, o1); }
        __syncthreads();
    }
}

namespace att {
constexpr int KVBLK = 64; constexpr size_t SHM_V = KVBLK * 128 * 2, SHM_K = KVBLK * 128 * 2;
constexpr float C = 0.125f * LOG2E, THR2 = 8.f * LOG2E;
#define KSWZ(row, colB) ((row) * 256 + ((colB) ^ (((row) & 7) << 4)))
#define SBAR() __builtin_amdgcn_sched_barrier(0)
__device__ __forceinline__ int crow(int r, int hi) { return (r & 3) + 8 * (r >> 2) + 4 * hi; }
__device__ __forceinline__ int v_st(int k, int c) { const int kk = (k & ~0xC) | ((k & 4) << 1) | ((k & 8) >> 1); return ((kk >> 3) * 4 + (c >> 5)) * 512 + ((kk & 7) * 32 + (c & 31)) * 2; }
__device__ __forceinline__ int v_rd_base(int lane) { return ((lane & 3) << 3) | (((lane >> 2) & 3) << 6) | (((lane >> 4) & 1) << 5) | (((lane >> 5) & 1) << 8); }
constexpr int v_rd_off(int d0, int ks, int half) { return d0 * 512 + ks * 4096 + half * 2048; }
template <int OFF> __device__ __forceinline__ s16x4 tr_read(int vb) { s16x4 r; asm volatile("ds_read_b64_tr_b16 %0, %1 offset:%2" : "=&v"(r) : "v"(vb), "i"(OFF) : "memory"); return r; }
template <int D0> __device__ __forceinline__ void pv_one(f32x16& od, int vb, bf16x8 pa0, bf16x8 pa1, bf16x8 pa2, bf16x8 pa3) {
    const s16x4 l0 = tr_read<v_rd_off(D0, 0, 0)>(vb), h0 = tr_read<v_rd_off(D0, 0, 1)>(vb), l1 = tr_read<v_rd_off(D0, 1, 0)>(vb), h1 = tr_read<v_rd_off(D0, 1, 1)>(vb);
    const s16x4 l2 = tr_read<v_rd_off(D0, 2, 0)>(vb), h2 = tr_read<v_rd_off(D0, 2, 1)>(vb), l3 = tr_read<v_rd_off(D0, 3, 0)>(vb), h3 = tr_read<v_rd_off(D0, 3, 1)>(vb);
    asm volatile("s_waitcnt lgkmcnt(0)" ::: "memory"); SBAR();
#define PK(L, H) (bf16x8){L[0], L[1], L[2], L[3], H[0], H[1], H[2], H[3]}
    od = __builtin_amdgcn_mfma_f32_32x32x16_bf16(pa0, PK(l0, h0), od, 0, 0, 0);
    od = __builtin_amdgcn_mfma_f32_32x32x16_bf16(pa1, PK(l1, h1), od, 0, 0, 0);
    od = __builtin_amdgcn_mfma_f32_32x32x16_bf16(pa2, PK(l2, h2), od, 0, 0, 0);
    od = __builtin_amdgcn_mfma_f32_32x32x16_bf16(pa3, PK(l3, h3), od, 0, 0, 0);
#undef PK
}
__device__ __forceinline__ void pv_d0(f32x16* o, int vb, bf16x8 pa0, bf16x8 pa1, bf16x8 pa2, bf16x8 pa3) {
    pv_one<0>(o[0], vb, pa0, pa1, pa2, pa3); pv_one<1>(o[1], vb, pa0, pa1, pa2, pa3); pv_one<2>(o[2], vb, pa0, pa1, pa2, pa3); pv_one<3>(o[3], vb, pa0, pa1, pa2, pa3);
}
__device__ __forceinline__ void qkt(f32x16& p0, f32x16& p1, const LAS char* Ks, const bf16x8* qr, int r32, int hi, int map) {
    p0 = f32x16{}; p1 = f32x16{};
#pragma unroll
    for (int d0 = 0; d0 < 4; ++d0) { const int cb = ((map * 4 + d0) * 16 + hi * 8) * 2;
        const bf16x8 b0 = *(const LAS bf16x8*)(Ks + KSWZ(r32, cb)); const bf16x8 b1 = *(const LAS bf16x8*)(Ks + KSWZ(32 + r32, cb));
        p0 = __builtin_amdgcn_mfma_f32_32x32x16_bf16(b0, qr[d0], p0, 0, 0, 0);
        p1 = __builtin_amdgcn_mfma_f32_32x32x16_bf16(b1, qr[d0], p1, 0, 0, 0); }
}
__device__ __forceinline__ void partialSM(f32x16& p0, f32x16& p1, float& m_reg, float& mn, float& alpha, int relw, int relb, int hi, const LAS float* btab, float bneg, float bpos) {
    if (relw - 31 >= 91 || relw + 63 <= -91) {
        const float bc = (relw > 0) ? bpos : bneg;
        float pmax = p0[0];
#pragma unroll
        for (int r = 1; r < 16; ++r) pmax = fmaxf(pmax, p0[r]);
#pragma unroll
        for (int r = 0; r < 16; ++r) pmax = fmaxf(pmax, p1[r]);
        { auto rr = __builtin_amdgcn_permlane32_swap(__float_as_uint(pmax), __float_as_uint(pmax), false, false); pmax = fmaxf(__uint_as_float(rr[0]), __uint_as_float(rr[1])); }
        const float tmax = fmaf(pmax, C, bc);
        if (__builtin_expect(__all(tmax - m_reg <= THR2), 1)) { mn = m_reg; alpha = 1.f; }
        else { mn = fmaxf(m_reg, tmax); alpha = __builtin_amdgcn_exp2f(m_reg - mn); m_reg = mn; }
        const float off = bc - mn;
#pragma unroll
        for (int r = 0; r < 16; ++r) p0[r] = fmaf(p0[r], C, off);
#pragma unroll
        for (int r = 0; r < 16; ++r) p1[r] = fmaf(p1[r], C, off);
    } else {
#pragma unroll
        for (int r = 0; r < 16; ++r) { const int idx = relb + crow(r, hi) + 256; p0[r] = fmaf(p0[r], C, btab[idx]); p1[r] = fmaf(p1[r], C, btab[idx + 32]); }
        float pmax = p0[0];
#pragma unroll
        for (int r = 1; r < 16; ++r) pmax = fmaxf(pmax, p0[r]);
#pragma unroll
        for (int r = 0; r < 16; ++r) pmax = fmaxf(pmax, p1[r]);
        { auto rr = __builtin_amdgcn_permlane32_swap(__float_as_uint(pmax), __float_as_uint(pmax), false, false); pmax = fmaxf(__uint_as_float(rr[0]), __uint_as_float(rr[1])); }
        if (__builtin_expect(__all(pmax - m_reg <= THR2), 1)) { mn = m_reg; alpha = 1.f; }
        else { mn = fmaxf(m_reg, pmax); alpha = __builtin_amdgcn_exp2f(m_reg - mn); m_reg = mn; }
#pragma unroll
        for (int r = 0; r < 16; ++r) p0[r] -= mn;
#pragma unroll
        for (int r = 0; r < 16; ++r) p1[r] -= mn;
    }
#pragma unroll
    for (int r = 0; r < 16; ++r) p0[r] = __builtin_amdgcn_exp2f(p0[r]);
}
__device__ __forceinline__ void finishSM(f32x16& p0, f32x16& p1, float alpha, float& l_reg, bf16x8& pa0, bf16x8& pa1, bf16x8& pa2, bf16x8& pa3) {
#pragma unroll
    for (int r = 0; r < 16; ++r) p1[r] = __builtin_amdgcn_exp2f(p1[r]);
    float ps = 0;
#pragma unroll
    for (int r = 0; r < 16; ++r) ps += p0[r];
#pragma unroll
    for (int r = 0; r < 16; ++r) ps += p1[r];
    { auto rr = __builtin_amdgcn_permlane32_swap(__float_as_uint(ps), __float_as_uint(ps), false, false); ps = __uint_as_float(rr[0]) + __uint_as_float(rr[1]); }
    l_reg = l_reg * alpha + ps;
#define PK4(P, BASE, OUT) do { unsigned a0 = cvt_pk_bf16(P[BASE + 0], P[BASE + 1]), a1 = cvt_pk_bf16(P[BASE + 2], P[BASE + 3]);   \
    unsigned b0 = cvt_pk_bf16(P[BASE + 4], P[BASE + 5]), b1 = cvt_pk_bf16(P[BASE + 6], P[BASE + 7]);                              \
    auto r0 = __builtin_amdgcn_permlane32_swap(a0, b0, false, false); auto r1 = __builtin_amdgcn_permlane32_swap(a1, b1, false, false); \
    u32x4 w = {r0[0], r1[0], r0[1], r1[1]}; OUT = __builtin_bit_cast(bf16x8, w); } while (0)
    PK4(p0, 0, pa0); PK4(p0, 8, pa1); PK4(p1, 0, pa2); PK4(p1, 8, pa3);
#undef PK4
}
constexpr int L_V = 0, L_K = 32768, L_WS = 65536, L_BT = 67584, L_CB = 69632;
__device__ __forceinline__ void attn_unit(Frame& F, int unit) {
    const int bh = unit >> 4, qb = unit & 15, b = bh >> 3, h = bh & 7, q0 = qb * 128;
    const int tid = F.tid, wid = F.wave, lane = F.lane, r32 = lane & 31, hi = lane >> 5, rg = wid & 3, map = wid >> 2;
    const bf16* proj = WSP(bf16, WS_PROJ);
    const bf16* Kh = proj + (size_t)(b * SEQ) * INC + 1024 + h * 128; const bf16* Vh = proj + (size_t)(b * SEQ) * INC + 2048 + h * 128;
    LAS char* lds = (LAS char*)F.lds; LAS char* V_lds = lds + L_V; LAS char* K_lds = lds + L_K;
    LAS float* wsf = (LAS float*)(lds + L_WS) + wid * 64; LAS float* li_l = wsf; LAS float* al_l = wsf + 32;
    LAS float* btab = (LAS float*)(lds + L_BT);
    const float* bt = WSP(float, WS_BIAST) + h * 4096;
    __syncthreads();
    btab[tid] = bt[2048 - 256 + tid];
    const float bneg = bt[2048 - 200], bpos = bt[2048 + 200], lam = WSP(float, WS_BIAST)[AH * 4096];
    float m_reg = -1e30f, l_reg = 0; f32x16 o[4] = {}; bf16x8 qr[4];
    const int qw0 = q0 + 32 * rg;
    const bf16* Qw = proj + (size_t)(b * SEQ + qw0 + r32) * INC + h * 128 + map * 64 + hi * 8;
#pragma unroll
    for (int d0 = 0; d0 < 4; ++d0) qr[d0] = *(const GAS bf16x8*)(Qw + d0 * 16);
    const int sr = tid >> 4, sc = (tid & 15) * 8, vst0 = v_st(sr, sc), vst1 = v_st(32 + sr, sc);
    const int vb0 = (int)(uintptr_t)V_lds + v_rd_base(lane);
    struct { bf16x8 vs0, vs1, ks0, ks1; } sr_[2];
#define SLOAD(i, k0) do { sr_[i].vs0 = *(const GAS bf16x8*)&Vh[(size_t)((k0) + sr) * INC + sc]; sr_[i].vs1 = *(const GAS bf16x8*)&Vh[(size_t)((k0) + 32 + sr) * INC + sc]; \
    sr_[i].ks0 = *(const GAS bf16x8*)&Kh[(size_t)((k0) + sr) * INC + sc]; sr_[i].ks1 = *(const GAS bf16x8*)&Kh[(size_t)((k0) + 32 + sr) * INC + sc]; } while (0)
#define SWRITE(bb, i) do { *(LAS bf16x8*)(V_lds + (bb) * SHM_V + vst0) = sr_[i].vs0; *(LAS bf16x8*)(V_lds + (bb) * SHM_V + vst1) = sr_[i].vs1; const int kc = sc * 2; \
    *(LAS bf16x8*)(K_lds + (bb) * SHM_K + KSWZ(sr, kc)) = sr_[i].ks0; *(LAS bf16x8*)(K_lds + (bb) * SHM_K + KSWZ(32 + sr, kc)) = sr_[i].ks1; } while (0)
#define SWAIT() asm volatile("s_waitcnt vmcnt(4)" ::: "memory")
#define RESC(a) do { if (__any((a) < 1.f)) { if (hi == 0) al_l[r32] = (a); asm volatile("s_waitcnt lgkmcnt(0)" ::: "memory"); \
    _Pragma("unroll") for (int d = 0; d < 4; ++d) _Pragma("unroll") for (int r = 0; r < 16; ++r) o[d][r] *= al_l[crow(r, hi)]; } } while (0)
#define PSM(P0, P1, MN, AL, k0) partialSM(P0, P1, m_reg, MN, AL, (k0) - qw0, (k0) - qw0 - r32, hi, btab, bneg, bpos)
    f32x16 pA0, pA1, pB0, pB1; float mnA, mnB, alA, alB; bf16x8 pa0, pa1, pa2, pa3; constexpr int NT = SEQ / KVBLK;
    constexpr int SE = 0, SO = 1;
    SLOAD(SE, 0); asm volatile("s_waitcnt vmcnt(0)" ::: "memory"); SWRITE(0, SE); __syncthreads();
    qkt(pA0, pA1, K_lds, qr, r32, hi, map); PSM(pA0, pA1, mnA, alA, 0);
    SLOAD(SO, KVBLK); SLOAD(SE, 2 * KVBLK);
    SWAIT(); SWRITE(1, SO); __syncthreads();
    for (int j = 1; j + 1 < NT; j += 2) {
        SBAR(); qkt(pB0, pB1, K_lds + SHM_K, qr, r32, hi, map);
        finishSM(pA0, pA1, alA, l_reg, pa0, pa1, pa2, pa3); SBAR();
        SLOAD(SO, (j + 2) * KVBLK); SBAR();
        pv_d0(o, vb0, pa0, pa1, pa2, pa3); PSM(pB0, pB1, mnB, alB, j * KVBLK);
        __syncthreads(); SWAIT(); SWRITE(0, SE);
        RESC(alB); __syncthreads();
        SBAR(); qkt(pA0, pA1, K_lds, qr, r32, hi, map);
        finishSM(pB0, pB1, alB, l_reg, pa0, pa1, pa2, pa3); SBAR();
        if (j + 3 < NT) SLOAD(SE, (j + 3) * KVBLK); SBAR();
        pv_d0(o, vb0 + (int)SHM_V, pa0, pa1, pa2, pa3); PSM(pA0, pA1, mnA, alA, (j + 1) * KVBLK);
        __syncthreads(); SWAIT(); SWRITE(1, SO);
        RESC(alA); __syncthreads();
    }
    SBAR(); qkt(pB0, pB1, K_lds + SHM_K, qr, r32, hi, map);
    finishSM(pA0, pA1, alA, l_reg, pa0, pa1, pa2, pa3); SBAR();
    pv_d0(o, vb0, pa0, pa1, pa2, pa3); PSM(pB0, pB1, mnB, alB, (NT - 1) * KVBLK);
    __syncthreads(); RESC(alB);
    finishSM(pB0, pB1, alB, l_reg, pa0, pa1, pa2, pa3); SBAR();
    pv_d0(o, vb0 + (int)SHM_V, pa0, pa1, pa2, pa3);
    if (hi == 0) li_l[r32] = l_reg; asm volatile("s_waitcnt lgkmcnt(0)" ::: "memory");
    float rli[16];
#pragma unroll
    for (int r = 0; r < 16; ++r) rli[r] = __builtin_amdgcn_rcpf(li_l[crow(r, hi)]);
    LAS float* cbuf = (LAS float*)(lds + L_CB) + rg * 32 * 128;
    if (map == 1) {
#pragma unroll
        for (int r = 0; r < 16; ++r)
#pragma unroll
            for (int d0 = 0; d0 < 4; ++d0) cbuf[crow(r, hi) * 128 + d0 * 32 + r32] = -lam * o[d0][r] * rli[r];
    }
    __syncthreads();
    if (map == 0) {
        bf16* mix = WSP(bf16, WS_MIX) + (size_t)(b * SEQ + qw0) * DM + h * 128;
        float sg[4];
#pragma unroll
        for (int d0 = 0; d0 < 4; ++d0) sg[d0] = F.subln[d0 * 32 + r32] * 0.8f;
#pragma unroll
        for (int r = 0; r < 16; ++r) { float v[4], ss = 0.f;
#pragma unroll
            for (int d0 = 0; d0 < 4; ++d0) { v[d0] = o[d0][r] * rli[r] + cbuf[crow(r, hi) * 128 + d0 * 32 + r32]; ss += v[d0] * v[d0]; }
#pragma unroll
            for (int s = 1; s < 32; s <<= 1) ss += __shfl_xor(ss, s);
            const float rstd = rsqrtf(ss * (1.f / VD) + EPS);
#pragma unroll
            for (int d0 = 0; d0 < 4; ++d0) mix[(size_t)crow(r, hi) * DM + d0 * 32 + r32] = (bf16)f2bf(v[d0] * rstd * sg[d0]); }
    }
#undef SLOAD
#undef SWRITE
#undef SWAIT
#undef RESC
#undef PSM
}
}

__device__ __forceinline__ void p5_router(Frame& F, bool dry = false) {
    const float* mod = WSP(float, WS_MOD); const float* x1 = WSP(float, WS_X1); bf16* h2 = WSP(bf16, WS_H2);
    int* list = (int*)(F.ws + WS_ROUTE + RT_LIST); float* sw = (float*)(F.ws + WS_ROUTE + RT_SW); int* toke = (int*)(F.ws + WS_ROUTE + RT_TOKE); int* tokr = (int*)(F.ws + WS_ROUTE + RT_TOKR);
    constexpr int RS = 4096 + 16;
    LAS unsigned char* Ahi = F.lds; LAS unsigned char* Alo = F.lds + 16 * RS; LAS float* Pl = (LAS float*)(F.lds + 32 * RS);
    const unsigned char* wrf = WSP(unsigned char, WS_WRF);
    for (int tb = F.vcu; tb < T / 16; tb += F.G) {
        const int b = (tb * 16) / SEQ;
        __syncthreads();
#pragma unroll 1
        for (int rr = 0; rr < 2; ++rr) {
            const int tl = 2 * F.wave + rr, row = tb * 16 + tl;
            const GAS f32x4* xr = (const GAS f32x4*)(x1 + (size_t)row * DM) + F.lane;
            f32x4 v[8]; float s = 0.f;
#pragma unroll
            for (int j = 0; j < 8; ++j) { v[j] = xr[64 * j]; s += (v[j].x * v[j].x + v[j].y * v[j].y) + (v[j].z * v[j].z + v[j].w * v[j].w); }
            const float rstd = rsqrtf(wave_sum(s) * (1.f / DM) + EPS);
            GAS u32x2* o8 = (GAS u32x2*)(h2 + (size_t)row * DM) + F.lane;
#pragma unroll
            for (int j = 0; j < 8; ++j) { const int k = 4 * F.lane + 256 * j;
                const f32x4 g = *(const GAS f32x4*)(F.g2 + k), sc = *(const GAS f32x4*)(mod + (size_t)b * 6 * DM + 4 * DM + k), sf = *(const GAS f32x4*)(mod + (size_t)b * 6 * DM + 3 * DM + k);
                float hv[4]; unsigned hb[4], lb[4];
#pragma unroll
                for (int q = 0; q < 4; ++q) { hv[q] = v[j][q] * rstd * g[q] * (1.f + sc[q]) + sf[q]; hb[q] = f2bf(hv[q]); lb[q] = f2bf(hv[q] - bf2f(hb[q])); }
                u32x2 wh, wl; wh.x = hb[0] | (hb[1] << 16); wh.y = hb[2] | (hb[3] << 16); wl.x = lb[0] | (lb[1] << 16); wl.y = lb[2] | (lb[3] << 16);
                o8[64 * j] = wh; *(LAS u32x2*)(Ahi + tl * RS + k * 2) = wh; *(LAS u32x2*)(Alo + tl * RS + k * 2) = wl; }
        }
        __syncthreads();
        { f32x4 acc0 = {0.f, 0.f, 0.f, 0.f}, acc1 = {0.f, 0.f, 0.f, 0.f};
#pragma unroll 2
          for (int ks = 0; ks < 8; ++ks) { const int s = 8 * F.wave + ks, k0 = 32 * s + 8 * (F.lane >> 4);
            const bf16x8 ah = *(const LAS bf16x8*)(Ahi + (F.lane & 15) * RS + k0 * 2), al = *(const LAS bf16x8*)(Alo + (F.lane & 15) * RS + k0 * 2);
            const bf16x8 bh0 = *(const GAS bf16x8*)(wrf + ((size_t)(s * 2 + 0) * 64 + F.lane) * 16), bh1 = *(const GAS bf16x8*)(wrf + ((size_t)(s * 2 + 1) * 64 + F.lane) * 16);
            const bf16x8 bl0 = *(const GAS bf16x8*)(wrf + 131072 + ((size_t)(s * 2 + 0) * 64 + F.lane) * 16), bl1 = *(const GAS bf16x8*)(wrf + 131072 + ((size_t)(s * 2 + 1) * 64 + F.lane) * 16);
            acc0 = __builtin_amdgcn_mfma_f32_16x16x32_bf16(ah, bh0, acc0, 0, 0, 0); acc0 = __builtin_amdgcn_mfma_f32_16x16x32_bf16(ah, bl0, acc0, 0, 0, 0); acc0 = __builtin_amdgcn_mfma_f32_16x16x32_bf16(al, bh0, acc0, 0, 0, 0);
            acc1 = __builtin_amdgcn_mfma_f32_16x16x32_bf16(ah, bh1, acc1, 0, 0, 0); acc1 = __builtin_amdgcn_mfma_f32_16x16x32_bf16(ah, bl1, acc1, 0, 0, 0); acc1 = __builtin_amdgcn_mfma_f32_16x16x32_bf16(al, bh1, acc1, 0, 0, 0); }
#pragma unroll
          for (int r = 0; r < 4; ++r) { const int tk = 4 * (F.lane >> 4) + r; Pl[(F.wave * 16 + tk) * 32 + (F.lane & 15)] = acc0[r]; Pl[(F.wave * 16 + tk) * 32 + 16 + (F.lane & 15)] = acc1[r]; }
        }
        __syncthreads();
        { const int tl = F.tid >> 5, e = F.tid & 31, tok = tb * 16 + tl;
          float v = F.b_r[e];
#pragma unroll
          for (int w = 0; w < 8; ++w) v += Pl[(w * 16 + tl) * 32 + e];
          float tv[4]; int ti[4];
#pragma unroll
          for (int r = 0; r < 4; ++r) { float bv = v; int bi = e;
#pragma unroll
              for (int o = 16; o > 0; o >>= 1) { const float ov = __shfl_xor(bv, o); const int oi = __shfl_xor(bi, o); if (ov > bv || (ov == bv && oi < bi)) { bv = ov; bi = oi; } }
              tv[r] = bv; ti[r] = bi; if (e == bi) v = -3.0e38f; }
          float den = 0.f, w[4];
#pragma unroll
          for (int r = 0; r < 4; ++r) { w[r] = __expf(tv[r] - tv[0]); den += w[r]; }
#pragma unroll
          for (int r = 0; r < 4; ++r) if (e == ti[r] && !dry) { const int rank = (int)atomicAdd(F.ctl + CW_CNT + e, 1u);
              list[e * T + rank] = tok; sw[e * T + rank] = w[r] / den; toke[tok * 4 + r] = e; tokr[tok * 4 + r] = rank; }
        }
    }
}

__device__ __forceinline__ void p8_final(Frame& F) {
    const float* mod = WSP(float, WS_MOD); const float* x1 = WSP(float, WS_X1); const bf16* y = WSP(bf16, WS_Y);
    const int* toke = (const int*)(F.ws + WS_ROUTE + RT_TOKE); const int* tokr = (const int*)(F.ws + WS_ROUTE + RT_TOKR);
    moe_tables(F);
    const LAS int* off = (const LAS int*)(F.lds + TAB_OFF) + 40;
    for (int row = F.vcu * NWAVES + F.wave; row < T; row += F.G * NWAVES) {
        const int b = row / SEQ;
        size_t so[4];
#pragma unroll
        for (int r = 0; r < 4; ++r) so[r] = (size_t)(off[toke[row * 4 + r]] + tokr[row * 4 + r]) * DM;
        const GAS f32x4* xr = (const GAS f32x4*)(x1 + (size_t)row * DM) + F.lane;
        f32x4 v[8]; float s = 0.f;
#pragma unroll
        for (int j = 0; j < 8; ++j) { const int k = 4 * F.lane + 256 * j; f32x4 m = {0.f, 0.f, 0.f, 0.f};
#pragma unroll
            for (int r = 0; r < 4; ++r) { const u32x2 yy = *(const GAS u32x2*)(y + so[r] + k); m[0] += bf2f(yy.x & 0xffffu); m[1] += bf2f(yy.x >> 16); m[2] += bf2f(yy.y & 0xffffu); m[3] += bf2f(yy.y >> 16); }
            const f32x4 g = *(const GAS f32x4*)(mod + (size_t)b * 6 * DM + 5 * DM + k);
            v[j] = xr[64 * j] + g * m; s += (v[j].x * v[j].x + v[j].y * v[j].y) + (v[j].z * v[j].z + v[j].w * v[j].w); }
        const float rstd = rsqrtf(wave_sum(s) * (1.f / DM) + EPS);
        GAS f32x4* orow = (GAS f32x4*)(F.out + (size_t)row * DM) + F.lane;
#pragma unroll
        for (int j = 0; j < 8; ++j) { const f32x4 g = *(const GAS f32x4*)(F.fg + 4 * F.lane + 256 * j); orow[64 * j] = v[j] * rstd * g; }
    }
}

struct Args { const float* in[25]; float* out; unsigned char* ws; int ph_lo, ph_hi, li, pad; };
__global__ void __launch_bounds__(NTHR, 2) mega_fwd(Args args) {
    extern __shared__ __attribute__((aligned(16))) unsigned char lds[];
    Frame F;
    F.lds = (LAS unsigned char*)lds; F.MISC = (volatile LAS unsigned*)(F.lds + MISC_OFF);
    F.tid = threadIdx.x; F.lane = F.tid & 63; F.wave = __builtin_amdgcn_readfirstlane(F.tid >> 6);
    F.G = gridDim.x; { const int bx = blockIdx.x; F.vcu = (F.G % 8 == 0) ? (bx % 8) * (F.G / 8) + bx / 8 : bx; }
    F.ws = args.ws; F.ctl = (unsigned*)(args.ws + WS_CTL); F.out = args.out;
    F.x = args.in[0]; F.c = args.in[1]; F.w_ada = args.in[2]; F.b_ada = args.in[3]; F.g1 = args.in[4]; F.w_in = args.in[5]; F.lq1 = args.in[6]; F.lk1 = args.in[7]; F.lq2 = args.in[8]; F.lk2 = args.in[9];
    F.subln = args.in[10]; F.relb = args.in[11]; F.cw = args.in[12]; F.cb = args.in[13]; F.clg = args.in[14]; F.clb = args.in[15]; F.w_out = args.in[16]; F.g2 = args.in[17]; F.w_r = args.in[18]; F.b_r = args.in[19];
    F.w_gu = args.in[20]; F.b_gu = args.in[21]; F.w_d = args.in[22]; F.b_d = args.in[23]; F.fg = args.in[24];
    for (int u = F.tid; u < 64; u += NTHR) ((LAS unsigned*)(F.lds + MISC_OFF))[u] = 0u;
    __syncthreads();
    XcdBarrier bar = xcd_barrier_post(F.ctl + CW_BAR + args.li * XCD_BAR_WORDS, F.MISC + 8);
    const int lo = args.ph_lo, hi = args.ph_hi;
#ifndef PH_MASK
#define PH_MASK 0x1ff
#endif
#define IN(k) (((PH_MASK >> (k)) & 1) && lo <= (k) && (k) < hi)
#define SEAM(k) do { if (IN(k) && IN((k) + 1)) { xcd_barrier(bar); if constexpr (((REP_MASK >> 14) & 1) != 0) xcd_barrier(bar); } } while (0)
#define REP2(k, ...) do { { __VA_ARGS__ } if constexpr (((REP_MASK >> (k)) & 1) != 0) { __VA_ARGS__ } } while (0)
    if (IN(0)) { REP2(0, __syncthreads(); p0_prologue(F);); } SEAM(0);
    if (IN(0) && IN(1)) F.vcu = xcd_virtual_cu(bar);
    if (IN(1)) { REP2(1, __syncthreads(); p1_norm1(F);); } SEAM(1);
    if (IN(2)) { REP2(2, InProj P{WSP(bf16, WS_H), WSP(bf16, WS_WIN), WSP(bf16, WS_PROJ), {}}; P.ord.init(T, INC, F.G, F.vcu); __syncthreads(); pg8::gemm_run(F.lds, P);); } SEAM(2);
    if (IN(3)) { REP2(3,
        for (int ct = F.vcu; ct < T / 32; ct += F.G) conv_unit(F, ct);
        if constexpr (((REP_MASK >> 9) & 1) != 0) { for (int ct = F.vcu; ct < T / 32; ct += F.G) conv_unit(F, ct); }
        for (int u = F.vcu; u < NB * AH * 16 * (1 + ((REP_MASK >> 10) & 1)); u += F.G) att::attn_unit(F, u % (NB * AH * 16));
    ); } SEAM(3);
    if (IN(4)) { REP2(4, OutProj P{WSP(bf16, WS_MIX), WSP(bf16, WS_WOUT), F.x, WSP(float, WS_MOD), WSP(float, WS_X1), {}}; P.ord.init(T, DM, F.G, F.vcu); __syncthreads(); pg8::gemm_run(F.lds, P);); } SEAM(4);
    if (IN(5)) { p5_router(F); if constexpr (((REP_MASK >> 13) & 1) != 0) { __syncthreads(); p5_router(F, true); } } SEAM(5);
    if (IN(6)) { REP2(6, moe_tables(F); const LAS int* tab = (const LAS int*)(F.lds + TAB_OFF);
        MoeGU P{WSP(bf16, WS_H2), F.w_gu, F.b_gu, (const int*)(F.ws + WS_ROUTE + RT_LIST), WSP(bf16, WS_ACT), {tab, tab + 40, tab + 80}, F.G, F.vcu}; pg8::gemm_run_bf32(F.lds, P);); } SEAM(6);
    if (IN(7)) { REP2(7, moe_tables(F); const LAS int* tab = (const LAS int*)(F.lds + TAB_OFF);
        MoeDown P{WSP(bf16, WS_ACT), F.w_d, F.b_d, (const float*)(F.ws + WS_ROUTE + RT_SW), WSP(bf16, WS_Y), {tab, tab + 40, tab + 80}, F.G, F.vcu}; pg8::gemm_run_bf32(F.lds, P);); } SEAM(7);
    if (IN(8)) { REP2(8, p8_final(F);); }
#undef IN
#undef SEAM
}

namespace ref {
__device__ __forceinline__ float block_sum(float v, float* red) {
    for (int o = 32; o > 0; o >>= 1) v += __shfl_xor(v, o);
    __syncthreads(); if ((threadIdx.x & 63) == 0) red[threadIdx.x >> 6] = v; __syncthreads();
    float s = 0.f; for (int i = 0; i < (int)(blockDim.x >> 6); ++i) s += red[i]; return s;
}
__device__ __forceinline__ float block_max(float v, float* red) {
    for (int o = 32; o > 0; o >>= 1) v = fmaxf(v, __shfl_xor(v, o));
    __syncthreads(); if ((threadIdx.x & 63) == 0) red[threadIdx.x >> 6] = v; __syncthreads();
    float s = red[0]; for (int i = 1; i < (int)(blockDim.x >> 6); ++i) s = fmaxf(s, red[i]); return s;
}
__device__ __forceinline__ float ldf(const float* p) { return *p; }
__device__ __forceinline__ float ldf(const bf16* p) { return bf2f(*p); }
__global__ void k_mod(const float* c, const float* W, const float* bias, float* mod, const float* q1, const float* k1, const float* q2, const float* k2, const float* relb, float* bt) {
    const int n = blockIdx.x * 256 + threadIdx.x, b = blockIdx.y;
    __shared__ float cs[DM];
    for (int k = threadIdx.x; k < DM; k += 256) cs[k] = silu_f(c[b * DM + k]);
    __syncthreads();
    float acc = bias[n];
    for (int k = 0; k < DM; ++k) acc += cs[k] * W[(size_t)k * (6 * DM) + n];
    mod[b * 6 * DM + n] = acc;
    if (b == 0 && n < AH * 4096) { const int h = n >> 12, rel = (n & 4095) - 2048; bt[n] = relb[t5_bucket(rel) * AH + h] * LOG2E; }
    if (b == 0 && n == 0) { float a = 0.f, bb = 0.f; for (int i = 0; i < HD; ++i) { a += q1[i] * k1[i]; bb += q2[i] * k2[i]; } bt[AH * 4096] = __expf(a) - __expf(bb) + 0.2f; }
}
__global__ void k_norm_mod(const float* x, const float* g, const float* mod, int shift_off, int scale_off, bf16* out) {
    __shared__ float red[8];
    const int row = blockIdx.x, b = row / SEQ; const float* xr = x + (size_t)row * DM;
    float v[8]; float ss = 0.f;
    for (int i = 0; i < 8; ++i) { v[i] = xr[threadIdx.x + 256 * i]; ss += v[i] * v[i]; }
    ss = block_sum(ss, red);
    const float rstd = rsqrtf(ss / DM + EPS);
    for (int i = 0; i < 8; ++i) { const int k = threadIdx.x + 256 * i;
        out[(size_t)row * DM + k] = (bf16)f2bf(v[i] * rstd * g[k] * (1.f + mod[b * 6 * DM + scale_off + k]) + mod[b * 6 * DM + shift_off + k]); }
}
template <class TA, class Epi>
__device__ __forceinline__ void gemm_tile(const TA* A, const int* rowidx, int lda, const float* B, int ldb, int Mvalid, int K, int m0, int n0, const Epi& epi) {
    __shared__ float As[16][64 + 4], Bs[16][64 + 4];
    const int tid = threadIdx.x, tx = tid & 15, ty = tid >> 4;
    float acc[4][4] = {};
    const int ar = tid >> 2, ac = (tid & 3) * 4;
    int arow = m0 + ar; arow = arow < Mvalid ? arow : (Mvalid - 1);
    const size_t aoff = (size_t)(rowidx ? rowidx[arow] : arow) * lda;
    const int br = tid >> 4, bc = (tid & 15) * 4;
    for (int k0 = 0; k0 < K; k0 += 16) {
        float av[4]; for (int i = 0; i < 4; ++i) av[i] = ldf(A + aoff + k0 + ac + i);
        const float4 bv = *(const float4*)(B + (size_t)(k0 + br) * ldb + n0 + bc);
        __syncthreads();
        for (int i = 0; i < 4; ++i) As[ac + i][ar] = av[i];
        *(float4*)&Bs[br][bc] = bv;
        __syncthreads();
#pragma unroll
        for (int k = 0; k < 16; ++k) { float a[4], b[4];
#pragma unroll
            for (int i = 0; i < 4; ++i) { a[i] = As[k][ty * 4 + i]; b[i] = Bs[k][tx * 4 + i]; }
#pragma unroll
            for (int i = 0; i < 4; ++i)
#pragma unroll
                for (int j = 0; j < 4; ++j) acc[i][j] += a[i] * b[j]; }
    }
#pragma unroll
    for (int i = 0; i < 4; ++i) { const int m = m0 + ty * 4 + i; if (m < Mvalid)
#pragma unroll
        for (int j = 0; j < 4; ++j) epi(m, n0 + tx * 4 + j, acc[i][j]); }
}
struct EpiStoreB { bf16* C; int ldc; __device__ void operator()(int m, int n, float v) const { C[(size_t)m * ldc + n] = (bf16)f2bf(v); } };
struct EpiRes { const float* x; const float* mod; float* out; __device__ void operator()(int m, int n, float v) const {
    const int b = m / SEQ; out[(size_t)m * DM + n] = x[(size_t)m * DM + n] + mod[b * 6 * DM + 2 * DM + n] * v; } };
__global__ void __launch_bounds__(256) k_gemm_inproj(const bf16* A, const float* B, bf16* C) { EpiStoreB e{C, INC}; gemm_tile(A, nullptr, DM, B, INC, T, DM, blockIdx.y * 64, blockIdx.x * 64, e); }
__global__ void __launch_bounds__(256) k_gemm_res(const bf16* A, const float* B, const float* x, const float* mod, float* out) { EpiRes e{x, mod, out}; gemm_tile(A, nullptr, DM, B, DM, T, DM, blockIdx.y * 64, blockIdx.x * 64, e); }
__global__ void __launch_bounds__(256) k_attn(const bf16* proj, const float* bt, const float* subln_g, bf16* mix) {
    __shared__ float q1[HD], q2[HD], p[SEQ], red[8];
    const int qi = blockIdx.x, h = blockIdx.y, b = blockIdx.z, tid = threadIdx.x;
    const bf16* prow = proj + (size_t)(b * SEQ + qi) * INC;
    if (tid < HD) { q1[tid] = bf2f(prow[h * 128 + tid]); q2[tid] = bf2f(prow[h * 128 + 64 + tid]); }
    __syncthreads();
    float s1[8], s2[8]; float m1 = -1e30f, m2 = -1e30f;
    for (int i = 0; i < 8; ++i) { const int k = tid + 256 * i; const bf16* kr = proj + (size_t)(b * SEQ + k) * INC + 1024 + h * 128;
        float a = 0.f, c = 0.f; for (int d = 0; d < HD; ++d) { a += q1[d] * bf2f(kr[d]); c += q2[d] * bf2f(kr[64 + d]); }
        const float bias = bt[h * 4096 + 2048 + k - qi] * (1.f / LOG2E);
        s1[i] = a * 0.125f + bias; s2[i] = c * 0.125f + bias; m1 = fmaxf(m1, s1[i]); m2 = fmaxf(m2, s2[i]); }
    m1 = block_max(m1, red); m2 = block_max(m2, red);
    float l1 = 0.f, l2 = 0.f;
    for (int i = 0; i < 8; ++i) { s1[i] = __expf(s1[i] - m1); s2[i] = __expf(s2[i] - m2); l1 += s1[i]; l2 += s2[i]; }
    l1 = block_sum(l1, red); l2 = block_sum(l2, red);
    const float lam = bt[AH * 4096];
    for (int i = 0; i < 8; ++i) p[tid + 256 * i] = s1[i] / l1 - lam * s2[i] / l2;
    __syncthreads();
    float o = 0.f;
    if (tid < VD) { const bf16* vb = proj + (size_t)(b * SEQ) * INC + 2048 + h * 128 + tid; for (int k = 0; k < SEQ; ++k) o += p[k] * bf2f(vb[(size_t)k * INC]); }
    float ss = block_sum(tid < VD ? o * o : 0.f, red);
    const float rstd = rsqrtf(ss / VD + EPS);
    if (tid < VD) mix[(size_t)(b * SEQ + qi) * DM + h * 128 + tid] = (bf16)f2bf(o * rstd * subln_g[tid] * 0.8f);
}
__global__ void __launch_bounds__(256) k_conv(const bf16* proj, const float* cw, const float* cb, const float* lg, const float* lb, bf16* mix) {
    __shared__ float red[8];
    const int s = blockIdx.x, b = blockIdx.y, tid = threadIdx.x;
    float acc[4];
    for (int i = 0; i < 4; ++i) acc[i] = cb[tid + 256 * i];
    for (int j = 0; j < CK; ++j) { const int sp = s + j - 15; if (sp < 0 || sp >= SEQ) continue;
        const bf16* pr = proj + (size_t)(b * SEQ + sp) * INC + 3072;
        for (int i = 0; i < 4; ++i) { const int c = tid + 256 * i; const float a = bf2f(pr[c]), g = bf2f(pr[1024 + c]); acc[i] += cw[j * CCH + c] * bf2f(f2bf(a / (1.f + __expf(-g)))); } }
    float sm = acc[0] + acc[1] + acc[2] + acc[3]; sm = block_sum(sm, red);
    const float mu = sm / CCH; float vq = 0.f; for (int i = 0; i < 4; ++i) vq += (acc[i] - mu) * (acc[i] - mu);
    vq = block_sum(vq, red);
    const float rstd = rsqrtf(vq / CCH + EPS);
    for (int i = 0; i < 4; ++i) { const int c = tid + 256 * i; const float y = (acc[i] - mu) * rstd * lg[c] + lb[c]; mix[(size_t)(b * SEQ + s) * DM + 1024 + c] = (bf16)f2bf(silu_f(y)); }
}
__global__ void __launch_bounds__(256) k_router(const bf16* h2, const float* wr, const float* br, unsigned* cnt, int* list, float* sw, int* toke, int* tokr) {
    const int tid = threadIdx.x, e = tid & 31, tok = blockIdx.x * 8 + (tid >> 5);
    const bf16* hr = h2 + (size_t)tok * DM;
    float acc = 0.f;
    for (int k = 0; k < DM; ++k) acc += bf2f(hr[k]) * wr[k * NE + e];
    acc += br[e];
    float v = acc; float tv[4]; int ti[4];
    for (int r = 0; r < 4; ++r) { float bv = v; int bi = e;
        for (int o = 16; o > 0; o >>= 1) { const float ov = __shfl_xor(bv, o); const int oi = __shfl_xor(bi, o); if (ov > bv || (ov == bv && oi < bi)) { bv = ov; bi = oi; } }
        tv[r] = bv; ti[r] = bi; if (e == bi) v = -3.0e38f; }
    float den = 0.f, w[4]; for (int r = 0; r < 4; ++r) { w[r] = __expf(tv[r] - tv[0]); den += w[r]; }
    for (int r = 0; r < 4; ++r) if (e == ti[r]) { const int rank = (int)atomicAdd(&cnt[e], 1u); list[e * T + rank] = tok; sw[e * T + rank] = w[r] / den; toke[tok * 4 + r] = e; tokr[tok * 4 + r] = rank; }
}
__device__ __forceinline__ int slot_off(const unsigned* cnt, int e) { int s = 0; for (int i = 0; i < e; ++i) s += (int)cnt[i]; return s; }
struct EpiGU { float* gu; int base; __device__ void operator()(int m, int n, float v) const { gu[(size_t)(base + m) * (2 * DFF) + n] = v; } };
__global__ void __launch_bounds__(256) k_moe_gu(const bf16* h2, const float* W, const unsigned* cnt, const int* list, float* gu) {
    const int e = blockIdx.z, M = (int)cnt[e], m0 = blockIdx.y * 64; if (m0 >= M) return;
    EpiGU ep{gu, slot_off(cnt, e)}; gemm_tile(h2, list + e * T, DM, W + (size_t)e * DM * 2 * DFF, 2 * DFF, M, DM, m0, blockIdx.x * 64, ep);
}
__global__ void k_act(const float* gu, const float* bgu, const unsigned* cnt, bf16* act) {
    const int slot = blockIdx.x; int e = 0, s = (int)cnt[0]; while (e < NE - 1 && slot >= s) { ++e; s += (int)cnt[e]; }
    for (int j = threadIdx.x; j < DFF; j += 256) {
        float g = gu[(size_t)slot * 2 * DFF + j] + bgu[e * 2 * DFF + j], u = gu[(size_t)slot * 2 * DFF + DFF + j] + bgu[e * 2 * DFF + DFF + j];
        g = fminf(g, 7.f); u = fminf(fmaxf(u, -7.f), 7.f);
        act[(size_t)slot * DFF + j] = (bf16)f2bf((u + 1.f) * (g / (1.f + __expf(-1.702f * g))));
    }
}
struct EpiDown { bf16* y; const float* bd; const float* sw; int base; __device__ void operator()(int m, int n, float v) const { y[(size_t)(base + m) * DM + n] = (bf16)f2bf((v + bd[n]) * sw[m]); } };
__global__ void __launch_bounds__(256) k_moe_down(const bf16* act, const float* W, const float* bd, const float* sw, const unsigned* cnt, bf16* y) {
    const int e = blockIdx.z, M = (int)cnt[e], m0 = blockIdx.y * 64; if (m0 >= M) return;
    const int base = slot_off(cnt, e);
    EpiDown ep{y, bd + e * DM, sw + e * T, base}; gemm_tile(act + (size_t)base * DFF, nullptr, DFF, W + (size_t)e * DFF * DM, DM, M, DFF, m0, blockIdx.x * 64, ep);
}
__global__ void __launch_bounds__(256) k_final(const float* x1, const bf16* y, const float* mod, const unsigned* cnt, const int* toke, const int* tokr, const float* fg, float* out) {
    __shared__ float red[8]; __shared__ int offs[NE];
    if (threadIdx.x < NE) offs[threadIdx.x] = slot_off(cnt, threadIdx.x);
    __syncthreads();
    const int row = blockIdx.x, b = row / SEQ;
    float v[8]; float ss = 0.f;
    for (int i = 0; i < 8; ++i) { const int k = threadIdx.x + 256 * i; float m = 0.f;
        for (int r = 0; r < 4; ++r) { const int slot = offs[toke[row * 4 + r]] + tokr[row * 4 + r]; m += bf2f(y[(size_t)slot * DM + k]); }
        v[i] = x1[(size_t)row * DM + k] + mod[b * 6 * DM + 5 * DM + k] * m; ss += v[i] * v[i]; }
    ss = block_sum(ss, red);
    const float rstd = rsqrtf(ss / DM + EPS);
    for (int i = 0; i < 8; ++i) { const int k = threadIdx.x + 256 * i; out[(size_t)row * DM + k] = v[i] * rstd * fg[k]; }
}
}

extern "C" void kernel_launch(void* const* d_in, const int* in_sizes, int n_in, void* d_out, int out_size, void* d_ws, size_t ws_size, hipStream_t stream) {
    static int grid = 0;
    if (grid == 0) {
        if (n_in != 25 || ws_size < WS_END || out_size != T * DM) { fprintf(stderr, "kernel_launch: n_in %d out %d ws %zu (need %zu); nothing launched\n", n_in, out_size, ws_size, (size_t)WS_END); grid = -1; return; }
        int dev = 0, cus = 0, per_cu = 0;
        if (hipGetDevice(&dev) != hipSuccess || hipDeviceGetAttribute(&cus, hipDeviceAttributeMultiprocessorCount, dev) != hipSuccess) { grid = -1; return; }
        if (hipFuncSetAttribute((const void*)mega_fwd, hipFuncAttributeMaxDynamicSharedMemorySize, LDS_BYTES) != hipSuccess) { fprintf(stderr, "kernel_launch: hipFuncSetAttribute failed\n"); grid = -1; return; }
        if (hipOccupancyMaxActiveBlocksPerMultiprocessor(&per_cu, (const void*)mega_fwd, NTHR, LDS_BYTES) != hipSuccess || per_cu < 1) { fprintf(stderr, "kernel_launch: occupancy query says %d blocks per CU\n", per_cu); }
        (void)hipGetLastError();
        grid = cus;
    }
    if (grid < 0) return;
    unsigned char* ws = (unsigned char*)d_ws;
    (void)hipMemsetAsync(ws + WS_CTL, 0, CTL_ZERO_BYTES, stream);
    Args a{};
    for (int i = 0; i < 25; ++i) a.in[i] = (const float*)d_in[i];
    a.out = (float*)d_out; a.ws = ws; a.ph_lo = 0; a.ph_hi = MEGA_HI; a.li = 0; a.pad = 0;
    const float* const* in = (const float* const*)d_in;
    unsigned* cnt = (unsigned*)(ws + WS_CTL) + CW_CNT; float* mod = (float*)(ws + WS_MOD); float* bt = (float*)(ws + WS_BIAST);
    int* list = (int*)(ws + WS_ROUTE + RT_LIST); float* sw = (float*)(ws + WS_ROUTE + RT_SW); int* toke = (int*)(ws + WS_ROUTE + RT_TOKE); int* tokr = (int*)(ws + WS_ROUTE + RT_TOKR);
    bf16* h = (bf16*)(ws + WS_H); bf16* proj = (bf16*)(ws + WS_PROJ); bf16* mix = (bf16*)(ws + WS_MIX); float* x1 = (float*)(ws + WS_X1); bf16* h2 = (bf16*)(ws + WS_H2);
    bf16* act = (bf16*)(ws + WS_ACT); bf16* y = (bf16*)(ws + WS_Y); float* gu = (float*)(ws + WS_GU);
    if (MEGA_HI > 0) hipLaunchKernelGGL(mega_fwd, dim3(grid), dim3(NTHR), LDS_BYTES, stream, a);
    if (MEGA_HI < 2) ref::k_mod<<<dim3(6 * DM / 256, NB), 256, 0, stream>>>(in[1], in[2], in[3], mod, in[6], in[7], in[8], in[9], in[11], bt);
    if (MEGA_HI < 2) ref::k_norm_mod<<<T, 256, 0, stream>>>(in[0], in[4], mod, 0, DM, h);
    if (MEGA_HI < 3) ref::k_gemm_inproj<<<dim3(INC / 64, T / 64), 256, 0, stream>>>(h, in[5], proj);
    if (MEGA_HI < 4) { ref::k_attn<<<dim3(SEQ, AH, NB), 256, 0, stream>>>(proj, bt, in[10], mix); ref::k_conv<<<dim3(SEQ, NB), 256, 0, stream>>>(proj, in[12], in[13], in[14], in[15], mix); }
    if (MEGA_HI < 5) ref::k_gemm_res<<<dim3(DM / 64, T / 64), 256, 0, stream>>>(mix, in[16], in[0], mod, x1);
    if (MEGA_HI < 6) { ref::k_norm_mod<<<T, 256, 0, stream>>>(x1, in[17], mod, 3 * DM, 4 * DM, h2); ref::k_router<<<T / 8, 256, 0, stream>>>(h2, in[18], in[19], cnt, list, sw, toke, tokr); }
    if (MEGA_HI < 7) { ref::k_moe_gu<<<dim3(2 * DFF / 64, T / 64, NE), 256, 0, stream>>>(h2, in[20], cnt, list, gu); ref::k_act<<<NSLOT, 256, 0, stream>>>(gu, in[21], cnt, act); }
    if (MEGA_HI < 8) ref::k_moe_down<<<dim3(DM / 64, T / 64, NE), 256, 0, stream>>>(act, in[22], in[23], sw, cnt, y);
    if (MEGA_HI < 9) ref::k_final<<<T, 256, 0, stream>>>(x1, y, mod, cnt, toke, tokr, in[24], (float*)d_out);
}
```

```cpp
#include <hip/hip_runtime.h>
#include <cstdio>
#include <cstdint>

#ifndef REP_MASK
#define REP_MASK 0
#endif

constexpr int DM = 2048, NB = 4, SEQ = 2048, T = NB * SEQ;
constexpr int AH = 8, HD = 64, VD = 128, CCH = 1024, CK = 31;
constexpr int INC = 5120;
constexpr int NE = 32, TOPK = 4, DFF = 2048, NSLOT = T * TOPK;
constexpr float EPS = 1e-6f;
constexpr float LOG2E = 1.4426950408889634f;

typedef unsigned short bf16;
typedef short bf16x8 __attribute__((ext_vector_type(8)));
typedef short s16x4 __attribute__((ext_vector_type(4)));
typedef float f32x4 __attribute__((ext_vector_type(4)));
typedef float f32x16 __attribute__((ext_vector_type(16)));
typedef unsigned u32x4 __attribute__((ext_vector_type(4)));
typedef unsigned u32x2 __attribute__((ext_vector_type(2)));
#define GAS __attribute__((address_space(1)))
#define LAS __attribute__((address_space(3)))
typedef GAS unsigned gu32;

constexpr size_t MiB = 1u << 20;
constexpr size_t WS_CTL = 0, CTL_ZERO_BYTES = 64 * 1024;
constexpr size_t WS_MODP = 1 * MiB;
constexpr size_t WS_MOD = 3 * MiB;
constexpr size_t WS_BIAST = 4 * MiB;
constexpr size_t WS_WRF = 5 * MiB;
constexpr size_t WS_ROUTE = 6 * MiB;
constexpr size_t RT_LIST = 0;
constexpr size_t RT_SW = 1 * MiB;
constexpr size_t RT_TOKE = 2 * MiB;
constexpr size_t RT_TOKR = RT_TOKE + 128 * 1024;
constexpr size_t WS_WIN = 16 * MiB;
constexpr size_t WS_WOUT = WS_WIN + 20 * MiB;
constexpr size_t WS_H = WS_WOUT + 8 * MiB;
constexpr size_t WS_PROJ = WS_H + 32 * MiB;
constexpr size_t WS_MIX = WS_PROJ + 80 * MiB;
constexpr size_t WS_X1 = WS_MIX + 32 * MiB;
constexpr size_t WS_H2 = WS_X1 + 64 * MiB;
constexpr size_t WS_ACT = WS_H2 + 32 * MiB;
constexpr size_t WS_Y = WS_ACT + 130 * MiB;
constexpr size_t WS_END = WS_Y + 130 * MiB;
constexpr int CW_CNT = 0;
constexpr int CW_BAR = 1024;

__device__ __forceinline__ unsigned f2bf(float f) { unsigned u = __builtin_bit_cast(unsigned, f); return (u + 0x7fffu + ((u >> 16) & 1u)) >> 16; }
__device__ __forceinline__ float bf2f(unsigned h) { return __builtin_bit_cast(float, h << 16); }
__device__ __forceinline__ unsigned pk2(float lo, float hi) { return f2bf(lo) | (f2bf(hi) << 16); }
__device__ __forceinline__ unsigned cvt_pk_bf16(float lo, float hi) { unsigned r; asm volatile("v_cvt_pk_bf16_f32 %0, %1, %2" : "=v"(r) : "v"(lo), "v"(hi)); return r; }
__device__ __forceinline__ float silu_f(float v) { return v / (1.f + __expf(-v)); }
__device__ __forceinline__ float wave_sum(float v) {
#pragma unroll
    for (int o = 1; o < 64; o <<= 1) v += __shfl_xor(v, o);
    return v;
}
__host__ __device__ inline int t5_bucket(int rel) {
    int ret = rel > 0 ? 16 : 0; int n = rel < 0 ? -rel : rel;
    if (n < 8) return ret + n;
    int lg = n >= 91 ? 15 : n >= 64 ? 14 : n >= 46 ? 13 : n >= 32 ? 12 : n >= 23 ? 11 : n >= 16 ? 10 : n >= 12 ? 9 : 8;
    return ret + lg;
}
#define LDS_WAIT() asm volatile("s_waitcnt lgkmcnt(0)" ::: "memory")
#define VM_WAIT() asm volatile("s_waitcnt vmcnt(0)" ::: "memory")

#define XB_TMO      128
#define XB_XCNT(j)  (256  + 64 * (j))
#define XB_XSUB(j)  (1280 + 64 * (j))
#define XB_XGEN(j)  (2304 + 64 * (j))
#define XB_TOP      3328
#define XB_TOPGEN   3392
#define XCD_BAR_WORDS 3456
#define XB_SPIN_CAP (1u << 18)
__device__ __forceinline__ unsigned xb_ld(unsigned* p)              { return __hip_atomic_load(p, __ATOMIC_RELAXED, __HIP_MEMORY_SCOPE_AGENT); }
__device__ __forceinline__ unsigned xb_add(unsigned* p, unsigned v) { return __hip_atomic_fetch_add(p, v, __ATOMIC_RELAXED, __HIP_MEMORY_SCOPE_AGENT); }
__device__ __forceinline__ unsigned xb_xcc_id() { return (unsigned)__builtin_amdgcn_s_getreg((3 << 11) | 20) & 0xFu; }
#define XB_SPIN(cond, bar) do { unsigned _sp = 0; while (cond) { __builtin_amdgcn_s_sleep(1); \
    if ((++_sp & 255u) == 0u) { if (xb_ld(&(bar)[XB_TMO])) break; if (_sp > XB_SPIN_CAP) { atomicAdd(&(bar)[XB_TMO], 1u); break; } } } } while (0)
struct XcdBarrier { unsigned* bar; unsigned x; volatile LAS unsigned* st; };
__device__ __forceinline__ XcdBarrier xcd_barrier_post(unsigned* bar, volatile LAS unsigned* st) {
    XcdBarrier b; b.bar = bar; b.x = xb_xcc_id(); b.st = st;
    if (threadIdx.x == 0) st[2] = xb_add(&bar[XB_XCNT(b.x)], 1u);
    return b;
}
__device__ __forceinline__ int xcd_virtual_cu(const XcdBarrier& b) {
    if (threadIdx.x == 0) { unsigned pre = 0u; for (unsigned j = 0; j < 16; ++j) { const unsigned c = xb_ld(&b.bar[XB_XCNT(j)]); pre += (j < b.x) ? c : 0u; } b.st[3] = pre + b.st[2]; }
    __syncthreads();
    const int v = (int)b.st[3];
    __syncthreads();
    return __builtin_amdgcn_readfirstlane(v);
}
__device__ __forceinline__ void xcd_barrier_complete(unsigned* bar, unsigned x, unsigned& nloc, unsigned& nx) {
    const unsigned G = gridDim.x * gridDim.y * gridDim.z;
    unsigned sum, cnt, mine, sp = 0u;
    for (;;) {
        sum = 0u; cnt = 0u; mine = 0u;
#pragma unroll
        for (unsigned j = 0; j < 16; ++j) { const unsigned c = xb_ld(&bar[XB_XCNT(j)]); sum += c; cnt += (c > 0u) ? 1u : 0u; mine = (j == x) ? c : mine; }
        if (sum == G) break;
        __builtin_amdgcn_s_sleep(1);
        if ((++sp & 255u) == 0u) { if (xb_ld(&bar[XB_TMO])) break; if (sp > XB_SPIN_CAP) { atomicAdd(&bar[XB_TMO], 1u); break; } }
    }
    nloc = mine > 0u ? mine : 1u; nx = cnt > 0u ? cnt : 1u;
}
__device__ __forceinline__ void xcd_barrier(const XcdBarrier& b) {
    asm volatile("s_waitcnt vmcnt(0)" ::: "memory");
    __syncthreads();
    if (threadIdx.x == 0) {
        unsigned* bar = b.bar;
        __builtin_amdgcn_s_waitcnt(0);
        unsigned nloc = b.st[0], nx = b.st[1];
        if (nloc == 0u) { xcd_barrier_complete(bar, b.x, nloc, nx); b.st[0] = nloc; b.st[1] = nx; }
        const unsigned old = xb_add(&bar[XB_XSUB(b.x)], 1u);
        const unsigned gen = old / nloc;
        if (old + 1u == (gen + 1u) * nloc) {
            __builtin_amdgcn_fence(__ATOMIC_RELEASE, "agent");
            asm volatile("s_waitcnt vmcnt(0)" ::: "memory");
            const unsigned og = xb_add(&bar[XB_TOP], 1u);
            const unsigned tg = og / nx;
            if (og + 1u == (tg + 1u) * nx) xb_add(&bar[XB_TOPGEN], 1u);
            else XB_SPIN(xb_ld(&bar[XB_TOPGEN]) == tg, bar);
            __builtin_amdgcn_fence(__ATOMIC_ACQUIRE, "agent");
            xb_add(&bar[XB_XGEN(b.x)], 1u);
            asm volatile("s_waitcnt vmcnt(0)" ::: "memory");
        } else {
            XB_SPIN(xb_ld(&bar[XB_XGEN(b.x)]) == gen, bar);
            __builtin_amdgcn_fence(__ATOMIC_ACQUIRE, "agent");
            asm volatile("s_waitcnt vmcnt(0)" ::: "memory");
        }
    }
    __syncthreads();
}

namespace pg8 {
constexpr int BM = 256, BK = 64, HALF = 128, HTB = HALF * BK * 2, STAGE_BYTES = 8 * HTB, KD = 2048;
__host__ __device__ __forceinline__ int lds_byte(int r, int c) { const int st = (r >> 4) * 2 + (c >> 5), rr = r & 15, cc = c & 31, ob = rr * 64 + cc * 2; return st * 1024 + (ob ^ (((ob >> 9) & 1) << 5)); }
__host__ __device__ __forceinline__ void stage_rc(int b, int& R, int& C) { const int st = b / 1024, sb = b % 1024, swz = sb ^ (((sb >> 9) & 1) << 5); R = (st >> 1) * 16 + swz / 64; C = (st & 1) * 32 + (swz % 64) / 2; }
__host__ __device__ __forceinline__ int perm32(int rho) { const int n = rho >> 4, i = rho & 15; return 8 * (i >> 2) + 4 * n + (i & 3); }
struct Unit { int pm, pn, e, rows; };

struct DenseOrder {
    int nM, nN, nwg, nfull, G, c; bool half;
    __device__ void init(int M, int N, int G_, int c_, bool half_ = false, bool split_tail = false) { nM = M / BM; nN = N / BM; nwg = nM * nN; G = G_; c = c_; half = half_; nfull = split_tail ? (nwg / G_) * G_ : nwg; }
    __device__ bool next(int i, Unit& u) const {
        long L = (long)i * G + c; int hsel = 0;
        if (half) { if (L >= 2L * (nwg - nfull)) return false; hsel = (int)(L & 1); L = nfull + (L >> 1); }
        else if (L >= nfull) return false;
        const int wgid = (int)L;
        const int nig = 8 * nN, gid = wgid / nig, fm = gid * 8, gsz = (nM - fm) < 8 ? (nM - fm) : 8;
        u.pm = fm + ((wgid % nig) % gsz); u.pn = (wgid % nig) / gsz; u.e = 0; u.rows = 256; if (half) { u.pm = 2 * u.pm + hsel; u.rows = 128; } return true;
    }
};

template <class P, bool HM = false>
__device__ __forceinline__ void gemm_run(LAS unsigned char* lds, const P& prob) {
    const int tid = threadIdx.x, wid = __builtin_amdgcn_readfirstlane(tid >> 6), lane = tid & 63, wr = wid >> 2, wc = wid & 3, fr = lane & 15, fq = lane >> 4;
    constexpr int K = KD, nt = K / BK;
    int Rr[2], Cc[2]; unsigned voffB[2];
#pragma unroll
    for (int i = 0; i < 2; ++i) { int R, C; stage_rc(tid * 16 + i * 8192, R, C); Rr[i] = R; Cc[i] = C; const int Rb = P::PERM ? ((R & ~31) + perm32(R & 31)) : R; voffB[i] = (unsigned)(Rb * K + C) * 2u; }
    constexpr size_t kstep = (size_t)(BK * 2), hstep = (size_t)HALF * K * 2;
    const unsigned ldsw = (unsigned)wid * 1024u;
    const int aoff = lds_byte(wr * 64 + fr, fq * 8), boff = lds_byte(wc * 32 + fr, fq * 8);
#define PG8_SA(b, h) (((b) * 2 + (h)) * HTB)
#define PG8_SB(b, h) ((4 + (b) * 2 + (h)) * HTB)
#define PG8_STAGE(bufoff, gbase, voff) do { _Pragma("unroll") for (int _i = 0; _i < 2; ++_i) \
        __builtin_amdgcn_global_load_lds((const unsigned*)((const char*)(gbase) + (voff)[_i]), (LAS unsigned*)(lds + (bufoff) + ldsw + _i * 8192), 16, 0, 0); } while (0)
#define PG8_LDA(dst, b, h) do { _Pragma("unroll") for (int m = 0; m < 4; ++m) _Pragma("unroll") for (int k = 0; k < 2; ++k) dst[m][k] = *(const LAS bf16x8*)(lds + PG8_SA(b, h) + aoff + m * 2048 + k * 1024); } while (0)
#define PG8_LDB(dst, b, h) do { _Pragma("unroll") for (int n = 0; n < 2; ++n) _Pragma("unroll") for (int k = 0; k < 2; ++k) dst[n][k] = *(const LAS bf16x8*)(lds + PG8_SB(b, h) + boff + n * 2048 + k * 1024); } while (0)
#define PG8_MMA(ai, bj, At, Bt) do { __builtin_amdgcn_s_setprio(1); _Pragma("unroll") for (int m = 0; m < 4; ++m) _Pragma("unroll") for (int n = 0; n < 2; ++n) _Pragma("unroll") for (int k = 0; k < 2; ++k) \
        acc[ai][bj][m][n] = __builtin_amdgcn_mfma_f32_16x16x32_bf16(Bt[n][k], At[m][k], acc[ai][bj][m][n], 0, 0, 0); __builtin_amdgcn_s_setprio(0); } while (0)
#define PG8_WAIT_V(n) asm volatile("s_waitcnt vmcnt(" #n ")" ::: "memory")
#define PG8_WAIT_L(n) asm volatile("s_waitcnt lgkmcnt(" #n ")" ::: "memory")
#define PG8_BAR __builtin_amdgcn_s_barrier()
#define PG8_SCHED __builtin_amdgcn_sched_barrier(0)
    Unit cur, nxt; int ui = 0;
    if (!prob.next(0, cur)) return;
    f32x4 acc[2][2][4][2];
#pragma unroll
    for (int a = 0; a < 2; ++a)
#pragma unroll
        for (int b = 0; b < 2; ++b)
#pragma unroll
            for (int m = 0; m < 4; ++m)
#pragma unroll
                for (int n = 0; n < 2; ++n) acc[a][b][m][n] = (f32x4){0.f, 0.f, 0.f, 0.f};
    bf16x8 At[4][2], B0[2][2], B1[2][2];
    unsigned vC0[2], vC1[2], vN0[2], vN1[2];
    prob.a_off(cur, Rr, Cc, vC0, vC1);
    const char* const Ab = prob.a_base();
    const char* cB = prob.b_base(cur);
    PG8_STAGE(PG8_SB(0, 0), cB, voffB); PG8_STAGE(PG8_SB(0, 1), cB + hstep, voffB); PG8_STAGE(PG8_SA(0, 0), Ab, vC0); if constexpr (!HM) PG8_STAGE(PG8_SA(0, 1), Ab, vC1);
    if (wr == 1) PG8_BAR;
    if constexpr (HM) PG8_WAIT_V(0); else PG8_WAIT_V(2);
    PG8_BAR;
    PG8_STAGE(PG8_SB(1, 0), cB + kstep, voffB); PG8_STAGE(PG8_SA(1, 0), Ab + kstep, vC0); PG8_STAGE(PG8_SB(1, 1), cB + hstep + kstep, voffB);
    PG8_WAIT_V(6); PG8_BAR;
    for (;;) {
        const bool has_next = prob.next(ui + 1, nxt);
        if (has_next) prob.a_off(nxt, Rr, Cc, vN0, vN1); else { vN0[0] = vC0[0]; vN0[1] = vC0[1]; vN1[0] = vC1[0]; vN1[1] = vC1[1]; }
        const char* nB = has_next ? prob.b_base(nxt) : cB;
        for (int t = 0; t < nt; t += 2) {
            const bool last = (t == nt - 2);
            const char* a1 = Ab + (size_t)(t + 1) * kstep;
            const char* a2 = last ? Ab : Ab + (size_t)(t + 2) * kstep; const char* b2 = last ? nB : cB + (size_t)(t + 2) * kstep;
            const char* a3 = a2 + kstep; const char* b3 = b2 + kstep;
            unsigned v20[2], v21[2];
            v20[0] = last ? vN0[0] : vC0[0]; v20[1] = last ? vN0[1] : vC0[1]; v21[0] = last ? vN1[0] : vC1[0]; v21[1] = last ? vN1[1] : vC1[1];
            PG8_LDB(B0, 0, 0); PG8_LDB(B1, 0, 1); PG8_SCHED; PG8_LDA(At, 0, 0); if constexpr (!HM) PG8_STAGE(PG8_SA(1, 1), a1, vC1);
            if constexpr (HM) PG8_WAIT_V(6); else PG8_WAIT_V(8); PG8_WAIT_L(0); PG8_BAR; PG8_MMA(0, 0, At, B0); PG8_MMA(0, 1, At, B1); PG8_BAR; PG8_SCHED;
            if constexpr (!HM) PG8_LDA(At, 0, 1); PG8_STAGE(PG8_SB(0, 0), b2, voffB); PG8_STAGE(PG8_SB(0, 1), b2 + hstep, voffB); PG8_STAGE(PG8_SA(0, 0), a2, v20);
            if constexpr (HM) PG8_WAIT_V(6); else PG8_WAIT_V(8);
            PG8_WAIT_L(0); PG8_BAR; if constexpr (!HM) { PG8_MMA(1, 0, At, B0); PG8_MMA(1, 1, At, B1); } PG8_BAR; PG8_SCHED;
            PG8_LDB(B0, 1, 0); PG8_LDB(B1, 1, 1); PG8_SCHED; PG8_LDA(At, 1, 0); if constexpr (!HM) PG8_STAGE(PG8_SA(0, 1), a2, v21);
            if constexpr (HM) PG8_WAIT_V(6); else PG8_WAIT_V(8); PG8_WAIT_L(0); PG8_BAR; PG8_MMA(0, 0, At, B0); PG8_MMA(0, 1, At, B1); PG8_BAR; PG8_SCHED;
            if constexpr (!HM) PG8_LDA(At, 1, 1); PG8_STAGE(PG8_SB(1, 0), b3, voffB); PG8_STAGE(PG8_SB(1, 1), b3 + hstep, voffB); PG8_STAGE(PG8_SA(1, 0), a3, v20);
            if constexpr (HM) PG8_WAIT_V(6); else PG8_WAIT_V(8);
            PG8_WAIT_L(0); PG8_BAR; if constexpr (!HM) { PG8_MMA(1, 0, At, B0); PG8_MMA(1, 1, At, B1); } PG8_BAR; PG8_SCHED;
        }
        if (wr == 0) PG8_BAR;
        prob.epi(acc, cur, wr, wc, fr, fq);
        if (!has_next) break;
#pragma unroll
        for (int a = 0; a < 2; ++a)
#pragma unroll
            for (int b = 0; b < 2; ++b)
#pragma unroll
                for (int m = 0; m < 4; ++m)
#pragma unroll
                    for (int n = 0; n < 2; ++n) acc[a][b][m][n] = (f32x4){0.f, 0.f, 0.f, 0.f};
        cur = nxt; cB = nB; ++ui; vC0[0] = vN0[0]; vC0[1] = vN0[1]; vC1[0] = vN1[0]; vC1[1] = vN1[1];
        if (wr == 1) PG8_BAR;
    }
    PG8_WAIT_V(0);
    PG8_BAR;
#undef PG8_SA
#undef PG8_SB
#undef PG8_STAGE
#undef PG8_LDA
#undef PG8_LDB
#undef PG8_MMA
#undef PG8_WAIT_V
#undef PG8_WAIT_L
#undef PG8_BAR
#undef PG8_SCHED
}

template <class P>
__device__ __forceinline__ void gemm_run_bf32(LAS unsigned char* lds, const P& prob) {
    const int tid = threadIdx.x, wid = __builtin_amdgcn_readfirstlane(tid >> 6), lane = tid & 63, wr = wid >> 2, wc = wid & 3, fr = lane & 15, fq = lane >> 4;
    constexpr int K = KD, nt = K / BK;
    constexpr size_t kstep = (size_t)(BK * 2);
    constexpr size_t ldwB = (size_t)P::LDW_BYTES;
    const unsigned ldsw = (unsigned)wid * 1024u;
    const int aoff = lds_byte(wr * 64 + fr, fq * 8), boff = lds_byte(wc * 32 + fr, fq * 8);
    const int wbo0 = lds_byte(32 * (lane >> 4) + ((lane & 1) | (((lane >> 3) & 1) << 2) | (((lane >> 2) & 1) << 3) | (((lane >> 1) & 1) << 4)), 8 * wid);
#define PG8_SA(b, h) (((b) * 2 + (h)) * HTB)
#define PG8_SB(b, h) ((4 + (b) * 2 + (h)) * HTB)
#define PG8_STAGE(bufoff, gbase, voff) do { _Pragma("unroll") for (int _i = 0; _i < 2; ++_i) \
        __builtin_amdgcn_global_load_lds((const unsigned*)((const char*)(gbase) + (voff)[_i]), (LAS unsigned*)(lds + (bufoff) + ldsw + _i * 8192), 16, 0, 0); } while (0)
#define PG8_LDA(dst, b, h) do { _Pragma("unroll") for (int m = 0; m < 4; ++m) _Pragma("unroll") for (int k = 0; k < 2; ++k) dst[m][k] = *(const LAS bf16x8*)(lds + PG8_SA(b, h) + aoff + m * 2048 + k * 1024); } while (0)
#define PG8_LDB(dst, b, h) do { _Pragma("unroll") for (int n = 0; n < 2; ++n) _Pragma("unroll") for (int k = 0; k < 2; ++k) dst[n][k] = *(const LAS bf16x8*)(lds + PG8_SB(b, h) + boff + n * 2048 + k * 1024); } while (0)
#define PG8_MMA(ai, bj, At, Bt) do { __builtin_amdgcn_s_setprio(1); _Pragma("unroll") for (int m = 0; m < 4; ++m) _Pragma("unroll") for (int n = 0; n < 2; ++n) _Pragma("unroll") for (int k = 0; k < 2; ++k) \
        acc[ai][bj][m][n] = __builtin_amdgcn_mfma_f32_16x16x32_bf16(Bt[n][k], At[m][k], acc[ai][bj][m][n], 0, 0, 0); __builtin_amdgcn_s_setprio(0); } while (0)
#define PG8_WAIT_V(n) asm volatile("s_waitcnt vmcnt(" #n ")" ::: "memory")
#define PG8_WAIT_L(n) asm volatile("s_waitcnt lgkmcnt(" #n ")" ::: "memory")
#define PG8_BAR __builtin_amdgcn_s_barrier()
#define PG8_SCHED __builtin_amdgcn_sched_barrier(0)
#define PG8_BLOAD(kk, h) do { const bool nx_ = (kk) >= nt; const unsigned so_ = (nx_ ? nBo : cBo) + (unsigned)((nx_ ? (kk) - nt : (kk)) * BK + 8 * wid) * (unsigned)ldwB + (unsigned)(h) * (unsigned)P::HALF_BYTES; const unsigned co_ = nx_ ? nCol : cCol; \
        asm volatile("s_nop 4" ::: "memory"); \
        _Pragma("unroll") for (int j_ = 0; j_ < 8; ++j_) asm volatile("buffer_load_dwordx2 %0, %1, %2, %3 offen" : "=v"(bv[j_]) : "v"(co_), "s"(wrs), "s"(so_ + (unsigned)j_ * (unsigned)ldwB) : "memory"); } while (0)
#define PG8_BWAIT(n) asm volatile("s_waitcnt vmcnt(" #n ")" : "+v"(bv[0]), "+v"(bv[1]), "+v"(bv[2]), "+v"(bv[3]), "+v"(bv[4]), "+v"(bv[5]), "+v"(bv[6]), "+v"(bv[7]) :: "memory")
#define PG8_BWRITE(b, h) do { _Pragma("unroll") for (int i_ = 0; i_ < 2; ++i_) { u32x4 o_; o_.x = cvt_pk_bf16(bv[0][i_], bv[1][i_]); o_.y = cvt_pk_bf16(bv[2][i_], bv[3][i_]); \
        o_.z = cvt_pk_bf16(bv[4][i_], bv[5][i_]); o_.w = cvt_pk_bf16(bv[6][i_], bv[7][i_]); *(LAS u32x4*)(lds + PG8_SB(b, h) + wbo0 + 128 * i_) = o_; } } while (0)
    typedef float f32x2v __attribute__((ext_vector_type(2)));
    Unit cur, nxt; int ui = 0;
    if (!prob.next(0, cur)) return;
    f32x4 acc[2][2][4][2];
    bf16x8 At[4][2], B0[2][2], B1[2][2];
    f32x2v bv[8];
    unsigned vC0[2], vC1[2], vN0[2], vN1[2];
    prob.a_off(cur, vC0, vC1);
    const char* const Ab = prob.a_base();
    const __amdgpu_buffer_rsrc_t wrs = __builtin_amdgcn_make_buffer_rsrc((void*)prob.W, 0, (unsigned)NE * (unsigned)P::W_BYTES, 0x00020000);
    unsigned cBo = (unsigned)cur.e * (unsigned)P::W_BYTES, cCol = prob.b_col(cur, lane);
    unsigned nBo = cBo, nCol = cCol;
    PG8_BLOAD(0, 0); PG8_BWAIT(0); PG8_BWRITE(0, 0); PG8_BLOAD(0, 1); PG8_BWAIT(0); PG8_BWRITE(0, 1); PG8_BLOAD(1, 0); PG8_BWAIT(0); PG8_BWRITE(1, 0); PG8_BLOAD(1, 1);
    PG8_STAGE(PG8_SA(0, 0), Ab, vC0); PG8_STAGE(PG8_SA(0, 1), Ab, vC1);
    if (wr == 1) PG8_BAR;
    PG8_WAIT_V(2); PG8_WAIT_L(0); PG8_BAR;
    PG8_STAGE(PG8_SA(1, 0), Ab + kstep, vC0);
    { f32x4 bini[2][2]; prob.bias_load(cur, wc, fq, bini);
#pragma unroll
      for (int a = 0; a < 2; ++a)
#pragma unroll
        for (int b = 0; b < 2; ++b)
#pragma unroll
            for (int m = 0; m < 4; ++m)
#pragma unroll
                for (int n = 0; n < 2; ++n) acc[a][b][m][n] = bini[b][n]; }
    PG8_WAIT_V(0); PG8_BAR;
    for (;;) {
        const bool has_next = prob.next(ui + 1, nxt);
        if (has_next) { prob.a_off(nxt, vN0, vN1); nBo = (unsigned)nxt.e * (unsigned)P::W_BYTES; nCol = prob.b_col(nxt, lane); }
        else { vN0[0] = vC0[0]; vN0[1] = vC0[1]; vN1[0] = vC1[0]; vN1[1] = vC1[1]; nBo = cBo; nCol = cCol; }
        for (int t = 0; t < nt; t += 2) {
            const bool last = (t == nt - 2);
            const char* a1 = Ab + (size_t)(t + 1) * kstep;
            const char* a2 = last ? Ab : Ab + (size_t)(t + 2) * kstep;
            const char* a3 = a2 + kstep;
            unsigned v20[2], v21[2];
            v20[0] = last ? vN0[0] : vC0[0]; v20[1] = last ? vN0[1] : vC0[1]; v21[0] = last ? vN1[0] : vC1[0]; v21[1] = last ? vN1[1] : vC1[1];
            PG8_LDB(B0, 0, 0); PG8_LDB(B1, 0, 1); PG8_SCHED; PG8_LDA(At, 0, 0); PG8_BWAIT(2); PG8_BWRITE(1, 1); PG8_BLOAD(t + 2, 0); PG8_STAGE(PG8_SA(1, 1), a1, vC1);
            PG8_WAIT_V(20); PG8_WAIT_L(0); PG8_BAR; PG8_MMA(0, 0, At, B0); PG8_MMA(0, 1, At, B1); PG8_BAR; PG8_SCHED;
            PG8_LDA(At, 0, 1); PG8_BWAIT(2); PG8_BWRITE(0, 0); PG8_BLOAD(t + 2, 1); PG8_STAGE(PG8_SA(0, 0), a2, v20);
            PG8_WAIT_V(20); PG8_WAIT_L(0); PG8_BAR; PG8_MMA(1, 0, At, B0); PG8_MMA(1, 1, At, B1); PG8_BAR; PG8_SCHED;
            PG8_LDB(B0, 1, 0); PG8_LDB(B1, 1, 1); PG8_SCHED; PG8_LDA(At, 1, 0); PG8_BWAIT(2); PG8_BWRITE(0, 1); PG8_BLOAD(t + 3, 0); PG8_STAGE(PG8_SA(0, 1), a2, v21);
            PG8_WAIT_V(20); PG8_WAIT_L(0); PG8_BAR; PG8_MMA(0, 0, At, B0); PG8_MMA(0, 1, At, B1); PG8_BAR; PG8_SCHED;
            PG8_LDA(At, 1, 1); PG8_BWAIT(2); PG8_BWRITE(1, 0); PG8_BLOAD(t + 3, 1); PG8_STAGE(PG8_SA(1, 0), a3, v20);
            PG8_WAIT_V(20); PG8_WAIT_L(0); PG8_BAR; PG8_MMA(1, 0, At, B0); PG8_MMA(1, 1, At, B1); PG8_BAR; PG8_SCHED;
        }
        if (wr == 0) PG8_BAR;
        prob.epi(acc, cur, wr, wc, fr, fq, 0);
        if (has_next) { f32x4 bini[2][2]; prob.bias_load(nxt, wc, fq, bini);
#pragma unroll
            for (int b = 0; b < 2; ++b)
#pragma unroll
                for (int m = 0; m < 4; ++m)
#pragma unroll
                    for (int n = 0; n < 2; ++n) acc[0][b][m][n] = bini[b][n]; }
        prob.epi(acc, cur, wr, wc, fr, fq, 1);
        if (!has_next) break;
#pragma unroll
        for (int b = 0; b < 2; ++b)
#pragma unroll
            for (int m = 0; m < 4; ++m)
#pragma unroll
                for (int n = 0; n < 2; ++n) acc[1][b][m][n] = acc[0][b][m][n];
        cur = nxt; cBo = nBo; cCol = nCol; ++ui; vC0[0] = vN0[0]; vC0[1] = vN0[1]; vC1[0] = vN1[0]; vC1[1] = vN1[1];
        if (wr == 1) PG8_BAR;
    }
    PG8_BWAIT(0);
    PG8_BAR;
#undef PG8_SA
#undef PG8_SB
#undef PG8_STAGE
#undef PG8_LDA
#undef PG8_LDB
#undef PG8_MMA
#undef PG8_WAIT_V
#undef PG8_WAIT_L
#undef PG8_BAR
#undef PG8_SCHED
#undef PG8_BLOAD
#undef PG8_BWAIT
#undef PG8_BWRITE
}
}

constexpr int NWAVES = 8, NTHR = 512;
constexpr int RING_BYTES = 131072;
constexpr int TAB_OFF = 147968;
constexpr int MISC_OFF = 163840 - 256;
constexpr int LDS_BYTES = 163840;

struct Frame {
    LAS unsigned char* lds; volatile LAS unsigned* MISC; unsigned* ctl;
    int tid, lane, wave, vcu, G;
    const float *x, *c, *w_ada, *b_ada, *g1, *w_in, *lq1, *lk1, *lq2, *lk2, *subln, *relb, *cw, *cb, *clg, *clb, *w_out, *g2, *w_r, *b_r, *w_gu, *b_gu, *w_d, *b_d, *fg;
    float* out; unsigned char* ws;
};
#define WSP(T_, off) ((T_*)(F.ws + (off)))

__device__ __forceinline__ void p0_transpose_item(const float* W, int ldn, int n0, int k0, bf16* dst, int drow0, LAS unsigned char* scr, int lane) {
    const int ng = lane & 31, kh = lane >> 5;
#pragma unroll
    for (int it = 0; it < 4; ++it) {
        f32x4 v[8];
#pragma unroll
        for (int j = 0; j < 8; ++j) v[j] = *(const GAS f32x4*)(W + (size_t)(k0 + 16 * it + 8 * kh + j) * ldn + n0 + 4 * ng);
        const int kc = 2 * it + kh;
#pragma unroll
        for (int i = 0; i < 4; ++i) { const int n = 4 * ng + i;
            u32x4 o; o.x = pk2(v[0][i], v[1][i]); o.y = pk2(v[2][i], v[3][i]); o.z = pk2(v[4][i], v[5][i]); o.w = pk2(v[6][i], v[7][i]);
            *(LAS u32x4*)(scr + n * 128 + ((kc ^ (ng & 7)) << 4)) = o; }
    }
    LDS_WAIT(); asm volatile("" ::: "memory");
#pragma unroll
    for (int j = 0; j < 16; ++j) { const int n = 8 * j + (lane >> 3), c = lane & 7;
        const u32x4 o = *(const LAS u32x4*)(scr + n * 128 + ((c ^ ((n >> 2) & 7)) << 4));
        *(GAS u32x4*)(dst + (size_t)(drow0 + n) * pg8::KD + k0 + 8 * c) = o; }
    LDS_WAIT(); asm volatile("" ::: "memory");
}
__device__ __forceinline__ void p0_prologue(Frame& F) {
    const int gw = F.vcu * NWAVES + F.wave, NGW = F.G * NWAVES, gt = F.vcu * NTHR + F.tid, NGT = F.G * NTHR;
    LAS float* cs = (LAS float*)(F.lds);
    for (int i = F.tid; i < NB * DM; i += NTHR) cs[i] = silu_f(F.c[i]);
    __syncthreads();
    float* modp = WSP(float, WS_MODP);
    for (int it = gw; it < 192 * 8; it += NGW) {
        const int cc = it % 192, kc = it / 192, r = F.lane >> 4, g = F.lane & 15;
        float acc[4][4];
#pragma unroll
        for (int b = 0; b < 4; ++b)
#pragma unroll
            for (int j = 0; j < 4; ++j) acc[b][j] = 0.f;
        const float* wp = F.w_ada + (size_t)(kc * 256 + r) * (6 * DM) + cc * 64 + g * 4;
#pragma unroll 8
        for (int s = 0; s < 64; ++s) {
            const f32x4 w = *(const GAS f32x4*)(wp + (size_t)(4 * s) * (6 * DM)); const int k = kc * 256 + 4 * s + r;
#pragma unroll
            for (int b = 0; b < 4; ++b) { const float cv = cs[b * DM + k];
#pragma unroll
                for (int j = 0; j < 4; ++j) acc[b][j] += cv * w[j]; }
        }
#pragma unroll
        for (int b = 0; b < 4; ++b)
#pragma unroll
            for (int j = 0; j < 4; ++j) { float v = acc[b][j]; v += __shfl_xor(v, 16); v += __shfl_xor(v, 32); acc[b][j] = v; }
        if (F.lane < 16)
#pragma unroll
            for (int b = 0; b < 4; ++b) *(GAS f32x4*)(modp + (size_t)(kc * 4 + b) * (6 * DM) + cc * 64 + g * 4) = (f32x4){acc[b][0], acc[b][1], acc[b][2], acc[b][3]};
    }
    __syncthreads();
    LAS unsigned char* scr = F.lds + F.wave * 16384;
    constexpr int I_IN = (INC / 128) * 32, I_OUT = (DM / 128) * 32;
    for (int it = gw; it < I_IN + I_OUT; it += NGW) {
        int r = it;
        if (r < I_IN) { const int nb = r >> 5, kb = r & 31; p0_transpose_item(F.w_in, INC, nb * 128, kb * 64, WSP(bf16, WS_WIN), nb * 128, scr, F.lane); continue; } r -= I_IN;
        { const int nb = r >> 5, kb = r & 31; p0_transpose_item(F.w_out, DM, nb * 128, kb * 64, WSP(bf16, WS_WOUT), nb * 128, scr, F.lane); }
    }
    for (int i = gt; i < 64 * 2 * 64; i += NGT) {
        const int l = i & 63, nb = (i >> 6) & 1, s = i >> 7, e = 16 * nb + (l & 15), kb = 32 * s + 8 * (l >> 4);
        unsigned hi[8], lo[8];
#pragma unroll
        for (int j = 0; j < 8; ++j) { const float w = F.w_r[(size_t)(kb + j) * NE + e]; hi[j] = f2bf(w); lo[j] = f2bf(w - bf2f(hi[j])); }
        u32x4 oh, ol; oh.x = hi[0] | (hi[1] << 16); oh.y = hi[2] | (hi[3] << 16); oh.z = hi[4] | (hi[5] << 16); oh.w = hi[6] | (hi[7] << 16);
        ol.x = lo[0] | (lo[1] << 16); ol.y = lo[2] | (lo[3] << 16); ol.z = lo[4] | (lo[5] << 16); ol.w = lo[6] | (lo[7] << 16);
        *(GAS u32x4*)(WSP(unsigned char, WS_WRF) + (size_t)i * 16) = oh; *(GAS u32x4*)(WSP(unsigned char, WS_WRF) + 131072 + (size_t)i * 16) = ol;
    }
    float* bt = WSP(float, WS_BIAST);
    for (int i = gt; i < AH * 4096; i += NGT) { const int h = i >> 12, rel = (i & 4095) - 2048; bt[i] = F.relb[t5_bucket(rel) * AH + h] * LOG2E; }
    if (gt == 0) { float a = 0.f, b = 0.f; for (int i = 0; i < HD; ++i) { a += F.lq1[i] * F.lk1[i]; b += F.lq2[i] * F.lk2[i]; } bt[AH * 4096] = __expf(a) - __expf(b) + 0.2f; }
}

__device__ __forceinline__ void p1_norm1(Frame& F) {
    const float* modp = WSP(float, WS_MODP); float* mod = WSP(float, WS_MOD);
    for (int o = F.vcu * NTHR + F.tid; o < NB * 6 * DM; o += F.G * NTHR) { float s = F.b_ada[o % (6 * DM)];
#pragma unroll
        for (int kc = 0; kc < 8; ++kc) s += modp[(size_t)kc * (NB * 6 * DM) + o];
        mod[o] = s; }
    LAS float* gm = (LAS float*)F.lds; LAS float* sh = gm + DM;
    bf16* h = WSP(bf16, WS_H);
    for (int rb = F.vcu; rb < T / 32; rb += F.G) {
        const int b = rb / (SEQ / 32);
        __syncthreads();
        for (int k = F.tid; k < DM; k += NTHR) { float sc = F.b_ada[DM + k], sf = F.b_ada[k];
#pragma unroll
            for (int kc = 0; kc < 8; ++kc) { sc += modp[(size_t)(kc * 4 + b) * (6 * DM) + DM + k]; sf += modp[(size_t)(kc * 4 + b) * (6 * DM) + k]; }
            gm[k] = F.g1[k] * (1.f + sc); sh[k] = sf; }
        __syncthreads();
        for (int rr = F.wave; rr < 32; rr += NWAVES) {
            const int row = rb * 32 + rr;
            const GAS f32x4* xr = (const GAS f32x4*)(F.x + (size_t)row * DM) + F.lane;
            f32x4 v[8]; float s = 0.f;
#pragma unroll
            for (int j = 0; j < 8; ++j) { v[j] = xr[64 * j]; s += (v[j].x * v[j].x + v[j].y * v[j].y) + (v[j].z * v[j].z + v[j].w * v[j].w); }
            const float rstd = rsqrtf(wave_sum(s) * (1.f / DM) + EPS);
            GAS u32x2* o8 = (GAS u32x2*)(h + (size_t)row * DM) + F.lane;
#pragma unroll
            for (int j = 0; j < 8; ++j) { const int k = 4 * F.lane + 256 * j; const f32x4 g = *(const LAS f32x4*)(gm + k), s4 = *(const LAS f32x4*)(sh + k);
                u32x2 w; w.x = pk2(v[j].x * rstd * g.x + s4.x, v[j].y * rstd * g.y + s4.y); w.y = pk2(v[j].z * rstd * g.z + s4.z, v[j].w * rstd * g.w + s4.w); o8[64 * j] = w; }
        }
    }
}

template <bool HMT> struct InProjT {
    static constexpr bool PERM = true;
    const bf16* A; const bf16* Bt; bf16* O; pg8::DenseOrder ord;
    __device__ bool next(int i, pg8::Unit& u) const { return ord.next(i, u); }
    __device__ const char* a_base() const { return (const char*)A; }
    __device__ void a_off(const pg8::Unit& u, const int (&R)[2], const int (&C)[2], unsigned (&v0)[2], unsigned (&v1)[2]) const {
#pragma unroll
        for (int i = 0; i < 2; ++i) { v0[i] = (unsigned)((u.pm * u.rows + R[i]) * pg8::KD + C[i]) * 2u; v1[i] = (unsigned)((u.pm * u.rows + 128 + R[i]) * pg8::KD + C[i]) * 2u; } }
    __device__ const char* b_base(const pg8::Unit& u) const { return (const char*)(Bt + (size_t)u.pn * 256 * pg8::KD); }
    __device__ void epi(const f32x4 (&acc)[2][2][4][2], const pg8::Unit& u, int wr, int wc, int fr, int fq) const {
        const int row0 = u.pm * u.rows + wr * 64 + fr, col0 = u.pn * 256 + wc * 32 + 8 * fq;
#pragma unroll
        for (int ai = 0; ai < (HMT ? 1 : 2); ++ai)
#pragma unroll
            for (int m = 0; m < 4; ++m) { bf16* rowp = O + (size_t)(row0 + ai * 128 + m * 16) * INC + col0;
#pragma unroll
                for (int bj = 0; bj < 2; ++bj) { const f32x4 v0 = acc[ai][bj][m][0], v1 = acc[ai][bj][m][1];
                    u32x4 w; w.x = cvt_pk_bf16(v0[0], v0[1]); w.y = cvt_pk_bf16(v0[2], v0[3]); w.z = cvt_pk_bf16(v1[0], v1[1]); w.w = cvt_pk_bf16(v1[2], v1[3]);
                    *(GAS u32x4*)(rowp + bj * 128) = w; } }
    }
};
struct OutProj {
    static constexpr bool PERM = false;
    const bf16* A; const bf16* Bt; const float* x; const float* mod; float* O; pg8::DenseOrder ord;
    __device__ bool next(int i, pg8::Unit& u) const { return ord.next(i, u); }
    __device__ const char* a_base() const { return (const char*)A; }
    __device__ void a_off(const pg8::Unit& u, const int (&R)[2], const int (&C)[2], unsigned (&v0)[2], unsigned (&v1)[2]) const {
#pragma unroll
        for (int i = 0; i < 2; ++i) { v0[i] = (unsigned)((u.pm * 256 + R[i]) * pg8::KD + C[i]) * 2u; v1[i] = (unsigned)((u.pm * 256 + 128 + R[i]) * pg8::KD + C[i]) * 2u; } }
    __device__ const char* b_base(const pg8::Unit& u) const { return (const char*)(Bt + (size_t)u.pn * 256 * pg8::KD); }
    __device__ void epi(const f32x4 (&acc)[2][2][4][2], const pg8::Unit& u, int wr, int wc, int fr, int fq) const {
        const int row0 = u.pm * 256 + wr * 64 + fr, col0 = u.pn * 256 + wc * 32 + 4 * fq, b = (u.pm * 256) / SEQ;
        f32x4 gt[2][2];
#pragma unroll
        for (int bj = 0; bj < 2; ++bj)
#pragma unroll
            for (int n = 0; n < 2; ++n) gt[bj][n] = *(const GAS f32x4*)(mod + (size_t)b * 6 * DM + 2 * DM + col0 + bj * 128 + 16 * n);
#pragma unroll
        for (int ai = 0; ai < 2; ++ai)
#pragma unroll
            for (int m = 0; m < 4; ++m) { const size_t ro = (size_t)(row0 + ai * 128 + m * 16) * DM + col0;
#pragma unroll
                for (int bj = 0; bj < 2; ++bj)
#pragma unroll
                    for (int n = 0; n < 2; ++n) { const f32x4 xv = *(const GAS f32x4*)(x + ro + bj * 128 + 16 * n);
                        *(GAS f32x4*)(O + ro + bj * 128 + 16 * n) = xv + gt[bj][n] * acc[ai][bj][m][n]; } }
    }
};
struct MoeTab { const LAS int* tp; const LAS int* off; const LAS int* cnt; };
__device__ __forceinline__ void moe_tables(Frame& F) {
    LAS int* tab = (LAS int*)(F.lds + TAB_OFF);
    __syncthreads();
    if (F.tid == 0) { int tp = 0, off = 0; for (int e = 0; e < NE; ++e) { const int c = (int)__hip_atomic_load(F.ctl + CW_CNT + e, __ATOMIC_RELAXED, __HIP_MEMORY_SCOPE_AGENT);
            tab[e] = tp; tab[40 + e] = off; tab[80 + e] = c; tp += (c + 255) >> 8; off += c; } tab[NE] = tp; tab[40 + NE] = off; }
    __syncthreads();
}
template <int NTN, int REPF>
__device__ __forceinline__ bool moe_next(const MoeTab& tb, int G, int c, int i, pg8::Unit& u) {
    int L = i * G + c; const int total = NTN * __builtin_amdgcn_readfirstlane(tb.tp[NE]); if (L >= total * REPF) return false;
    if (REPF > 1 && L >= total) L -= total;
    int e = 0;
#pragma unroll
    for (int j = 1; j < NE; ++j) e += (L >= NTN * tb.tp[j]) ? 1 : 0;
    e = __builtin_amdgcn_readfirstlane(e);
    const int tpe = __builtin_amdgcn_readfirstlane(tb.tp[e]), tpe1 = __builtin_amdgcn_readfirstlane(tb.tp[e + 1]);
    const int local = L - NTN * tpe, nte = tpe1 - tpe;
    u.e = e; u.pn = __builtin_amdgcn_readfirstlane(local / nte); u.pm = local - u.pn * nte; u.rows = __builtin_amdgcn_readfirstlane(tb.cnt[e]) - 256 * u.pm; return true;
}
struct MoeGU {
    static constexpr bool PERM = true;
    const bf16* A; const float* W; const float* bias; const int* list; bf16* O; MoeTab tb; int G, c;
    __device__ bool next(int i, pg8::Unit& u) const { return moe_next<16, 1 + ((REP_MASK >> 11) & 1)>(tb, G, c, i, u); }
    __device__ const char* a_base() const { return (const char*)A; }
    __device__ void a_off(const pg8::Unit& u, unsigned (&v0)[2], unsigned (&v1)[2]) const {
        const int* lp = list + u.e * T + 256 * u.pm;
        int tb16 = (int)threadIdx.x * 16; asm volatile("" : "+v"(tb16));
#pragma unroll
        for (int i = 0; i < 2; ++i) { int R, C; pg8::stage_rc(tb16 + i * 8192, R, C);
            const int r0 = R < u.rows ? R : u.rows - 1, r1 = (128 + R) < u.rows ? (128 + R) : u.rows - 1;
            v0[i] = (unsigned)(lp[r0] * pg8::KD + C) * 2u; v1[i] = (unsigned)(lp[r1] * pg8::KD + C) * 2u; } }
    __device__ void bias_load(const pg8::Unit& u, int wc, int fq, f32x4 (&bi)[2][2]) const {
        int cb = wc * 32 + 8 * ((fq >> 1) + 2 * (fq & 1)); asm volatile("" : "+v"(cb));
        const float* bp = bias + (size_t)u.e * 2 * DFF + u.pn * 128 + cb;
#pragma unroll
        for (int bj = 0; bj < 2; ++bj)
#pragma unroll
            for (int n = 0; n < 2; ++n) { const f32x4 t = *(const GAS f32x4*)(bp + bj * DFF + 4 * n); bi[bj][n] = (f32x4){t[0], t[2], t[1], t[3]}; } }
    static constexpr int LDW_BYTES = 2 * DFF * 4, W_BYTES = DM * 2 * DFF * 4;
    __device__ const char* b_ptr(const pg8::Unit& u) const { return (const char*)(W + (size_t)u.e * DM * 2 * DFF); }
    static constexpr int HALF_BYTES = DFF * 4;
    __device__ unsigned b_col(const pg8::Unit& u, int lane) const { return (unsigned)(u.pn * 128 + 2 * lane) * 4u; }
    __device__ void epi(const f32x4 (&acc)[2][2][4][2], const pg8::Unit& u, int wr, int wc, int fr, int fq, const int ai) const {
        int rt0 = wr * 64 + fr, colt = u.pn * 128 + wc * 32 + 8 * ((fq >> 1) + 2 * (fq & 1)); asm volatile("" : "+v"(rt0), "+v"(colt)); const size_t slot0 = (size_t)__builtin_amdgcn_readfirstlane(tb.off[u.e]) + 256 * u.pm;
#pragma unroll
            for (int m = 0; m < 4; ++m) { const int rt = rt0 + ai * 128 + m * 16; float r[8];
#pragma unroll
                for (int n = 0; n < 2; ++n)
#pragma unroll
                    for (int j = 0; j < 4; ++j) { const int o = (j >> 1) + 2 * (j & 1) + 4 * n;
                        float g = acc[ai][0][m][n][j], up = acc[ai][1][m][n][j];
                        g = fminf(g, 7.f); up = fminf(fmaxf(up, -7.f), 7.f);
                        r[o] = (up + 1.f) * g * __builtin_amdgcn_rcpf(1.f + __builtin_amdgcn_exp2f(-1.702f * LOG2E * g)); }
                if (rt < u.rows) { u32x4 w; w.x = cvt_pk_bf16(r[0], r[1]); w.y = cvt_pk_bf16(r[2], r[3]); w.z = cvt_pk_bf16(r[4], r[5]); w.w = cvt_pk_bf16(r[6], r[7]);
                    *(GAS u32x4*)(O + (slot0 + rt) * DFF + colt) = w; } }
    }
};
struct MoeDown {
    static constexpr bool PERM = true;
    const bf16* A; const float* W; const float* bias; const float* sw; bf16* O; MoeTab tb; int G, c;
    __device__ bool next(int i, pg8::Unit& u) const { return moe_next<8, 1 + ((REP_MASK >> 12) & 1)>(tb, G, c, i, u); }
    __device__ const char* a_base() const { return (const char*)A; }
    __device__ void a_off(const pg8::Unit& u, unsigned (&v0)[2], unsigned (&v1)[2]) const {
        const int s0 = __builtin_amdgcn_readfirstlane(tb.off[u.e]) + 256 * u.pm;
        int tb16 = (int)threadIdx.x * 16; asm volatile("" : "+v"(tb16));
#pragma unroll
        for (int i = 0; i < 2; ++i) { int R, C; pg8::stage_rc(tb16 + i * 8192, R, C);
            v0[i] = (unsigned)((s0 + R) * pg8::KD + C) * 2u; v1[i] = (unsigned)((s0 + 128 + R) * pg8::KD + C) * 2u; } }
    __device__ void bias_load(const pg8::Unit& u, int wc, int fq, f32x4 (&bi)[2][2]) const {
        int cb = wc * 32 + 8 * ((fq >> 1) + 2 * (fq & 1)); asm volatile("" : "+v"(cb));
        const float* bp = bias + (size_t)u.e * DM + u.pn * 256 + cb;
#pragma unroll
        for (int bj = 0; bj < 2; ++bj)
#pragma unroll
            for (int n = 0; n < 2; ++n) { const f32x4 t = *(const GAS f32x4*)(bp + bj * 128 + 4 * n); bi[bj][n] = (f32x4){t[0], t[2], t[1], t[3]}; } }
    static constexpr int LDW_BYTES = DM * 4, W_BYTES = DFF * DM * 4;
    __device__ const char* b_ptr(const pg8::Unit& u) const { return (const char*)(W + (size_t)u.e * DFF * DM); }
    static constexpr int HALF_BYTES = 128 * 4;
    __device__ unsigned b_col(const pg8::Unit& u, int lane) const { return (unsigned)(u.pn * 256 + 2 * lane) * 4u; }
    __device__ void epi(const f32x4 (&acc)[2][2][4][2], const pg8::Unit& u, int wr, int wc, int fr, int fq, const int ai) const {
        int rt0 = wr * 64 + fr, col0 = u.pn * 256 + wc * 32 + 8 * ((fq >> 1) + 2 * (fq & 1)); asm volatile("" : "+v"(rt0), "+v"(col0)); const size_t slot0 = (size_t)__builtin_amdgcn_readfirstlane(tb.off[u.e]) + 256 * u.pm;
#pragma unroll
            for (int m = 0; m < 4; ++m) { const int rt = rt0 + ai * 128 + m * 16;
                if (rt < u.rows) { const float wgt = sw[(size_t)u.e * T + 256 * u.pm + rt]; bf16* rowp = O + (slot0 + rt) * DM + col0;
#pragma unroll
                    for (int bj = 0; bj < 2; ++bj) { float r[8];
#pragma unroll
                        for (int n = 0; n < 2; ++n)
#pragma unroll
                            for (int j = 0; j < 4; ++j) { const int o = (j >> 1) + 2 * (j & 1) + 4 * n; r[o] = acc[ai][bj][m][n][j] * wgt; }
                        u32x4 w; w.x = cvt_pk_bf16(r[0], r[1]); w.y = cvt_pk_bf16(r[2], r[3]); w.z = cvt_pk_bf16(r[4], r[5]); w.w = cvt_pk_bf16(r[6], r[7]);
                        *(GAS u32x4*)(rowp + bj * 128) = w; } } }
    }
};

__device__ __forceinline__ void conv_unit(Frame& F, int ct) {
    const int b = ct / (SEQ / 32), s0 = (ct % (SEQ / 32)) * 32, tid = F.tid;
    const bf16* proj = WSP(bf16, WS_PROJ); bf16* mix = WSP(bf16, WS_MIX);
    LAS unsigned* z = (LAS unsigned*)F.lds;
    LAS float* st = (LAS float*)(F.lds + 126976);
    __syncthreads();
#pragma unroll 8
    for (int r = 0; r < 62; ++r) { const int s = s0 - 15 + r; const bool ok = (s >= 0 && s < SEQ); const int sc = ok ? s : 0;
        const bf16* pr = proj + (size_t)(b * SEQ + sc) * INC + 3072 + 2 * tid; const unsigned a = *(const GAS unsigned*)pr, g = *(const GAS unsigned*)(pr + 1024);
        const float a0 = bf2f(a & 0xffffu), a1 = bf2f(a >> 16), g0 = bf2f(g & 0xffffu), g1 = bf2f(g >> 16);
        const unsigned zz = pk2(a0 * __builtin_amdgcn_rcpf(1.f + __builtin_amdgcn_exp2f(-LOG2E * g0)), a1 * __builtin_amdgcn_rcpf(1.f + __builtin_amdgcn_exp2f(-LOG2E * g1)));
        z[r * 512 + tid] = ok ? zz : 0u; }
    typedef float f32x2c __attribute__((ext_vector_type(2)));
    float w0[CK], w1[CK];
#pragma unroll
    for (int j = 0; j < CK; ++j) { const f32x2c w = *(const GAS f32x2c*)(F.cw + j * CCH + 2 * tid); w0[j] = w.x; w1[j] = w.y; }
    const f32x2c cbv = *(const GAS f32x2c*)(F.cb + 2 * tid), lg = *(const GAS f32x2c*)(F.clg + 2 * tid), lb = *(const GAS f32x2c*)(F.clb + 2 * tid);
    __syncthreads();
#pragma unroll 1
    for (int hf = 0; hf < 2; ++hf) {
        float c0[16], c1[16];
#pragma unroll
        for (int g = 0; g < 4; ++g) {
            float zl[34], zh[34];
#pragma unroll
            for (int r = 0; r < 34; ++r) { const unsigned zz = z[(16 * hf + 4 * g + r) * 512 + tid]; zl[r] = __builtin_bit_cast(float, zz << 16); zh[r] = __builtin_bit_cast(float, zz & 0xffff0000u); }
#pragma unroll
            for (int t = 0; t < 4; ++t) { float a0 = cbv.x, a1 = cbv.y;
#pragma unroll
                for (int j = 0; j < CK; ++j) { a0 = fmaf(w0[j], zl[t + j], a0); a1 = fmaf(w1[j], zh[t + j], a1); }
                c0[4 * g + t] = a0; c1[4 * g + t] = a1; }
        }
#pragma unroll
        for (int t = 0; t < 16; ++t) { const float sm = wave_sum(c0[t] + c1[t]), q = wave_sum(c0[t] * c0[t] + c1[t] * c1[t]);
            if (F.lane == 0) { st[(F.wave * 16 + t) * 2] = sm; st[(F.wave * 16 + t) * 2 + 1] = q; } }
        __syncthreads();
        if (tid < 16) { float sm = 0.f, q = 0.f;
#pragma unroll
            for (int w = 0; w < 8; ++w) { sm += st[(w * 16 + tid) * 2]; q += st[(w * 16 + tid) * 2 + 1]; }
            const float mu = sm * (1.f / CCH), var = q * (1.f / CCH) - mu * mu; st[512 + tid * 2] = mu; st[512 + tid * 2 + 1] = rsqrtf(fmaxf(var, 0.f) + EPS); }
        __syncthreads();
#pragma unroll
        for (int t = 0; t < 16; ++t) { const float mu = st[512 + t * 2], rs = st[512 + t * 2 + 1];
            const float y0 = (c0[t] - mu) * rs * lg.x + lb.x, y1 = (c1[t] - mu) * rs * lg.y + lb.y;
            const float o0 = y0 * __builtin_amdgcn_rcpf(1.f + __builtin_amdgcn_exp2f(-LOG2E * y0)), o1 = y1 * __builtin_amdgcn_rcpf(1.f + __builtin_amdgcn_exp2f(-LOG2E * y1));
            *(GAS unsigned*)(mix + (size_t)(b * SEQ + s0 + 16 * hf + t) * DM + 1024 + 2 * tid) = cvt_pk_bf16(o0, o1); }
        __syncthreads();
    }
}

namespace att {
constexpr int KVBLK = 64; constexpr size_t SHM_V = KVBLK * 128 * 2, SHM_K = KVBLK * 128 * 2;
constexpr float C = 0.125f * LOG2E, THR2 = 8.f * LOG2E;
#define KSWZ(row, colB) ((row) * 256 + ((colB) ^ (((row) & 7) << 4)))
#define SBAR() __builtin_amdgcn_sched_barrier(0)
__device__ __forceinline__ int crow(int r, int hi) { return (r & 3) + 8 * (r >> 2) + 4 * hi; }
__device__ __forceinline__ int v_st(int k, int c) { const int kk = (k & ~0xC) | ((k & 4) << 1) | ((k & 8) >> 1); return ((kk >> 3) * 4 + (c >> 5)) * 512 + ((kk & 7) * 32 + (c & 31)) * 2; }
__device__ __forceinline__ int v_rd_base(int lane) { return ((lane & 3) << 3) | (((lane >> 2) & 3) << 6) | (((lane >> 4) & 1) << 5) | (((lane >> 5) & 1) << 8); }
constexpr int v_rd_off(int d0, int ks, int half) { return d0 * 512 + ks * 4096 + half * 2048; }
template <int OFF> __device__ __forceinline__ s16x4 tr_read(int vb) { s16x4 r; asm volatile("ds_read_b64_tr_b16 %0, %1 offset:%2" : "=&v"(r) : "v"(vb), "i"(OFF) : "memory"); return r; }
template <int D0> __device__ __forceinline__ void pv_one(f32x16& od, int vb, bf16x8 pa0, bf16x8 pa1, bf16x8 pa2, bf16x8 pa3) {
    const s16x4 l0 = tr_read<v_rd_off(D0, 0, 0)>(vb), h0 = tr_read<v_rd_off(D0, 0, 1)>(vb), l1 = tr_read<v_rd_off(D0, 1, 0)>(vb), h1 = tr_read<v_rd_off(D0, 1, 1)>(vb);
    const s16x4 l2 = tr_read<v_rd_off(D0, 2, 0)>(vb), h2 = tr_read<v_rd_off(D0, 2, 1)>(vb), l3 = tr_read<v_rd_off(D0, 3, 0)>(vb), h3 = tr_read<v_rd_off(D0, 3, 1)>(vb);
    asm volatile("s_waitcnt lgkmcnt(0)" ::: "memory"); SBAR();
#define PK(L, H) (bf16x8){L[0], L[1], L[2], L[3], H[0], H[1], H[2], H[3]}
    od = __builtin_amdgcn_mfma_f32_32x32x16_bf16(pa0, PK(l0, h0), od, 0, 0, 0);
    od = __builtin_amdgcn_mfma_f32_32x32x16_bf16(pa1, PK(l1, h1), od, 0, 0, 0);
    od = __builtin_amdgcn_mfma_f32_32x32x16_bf16(pa2, PK(l2, h2), od, 0, 0, 0);
    od = __builtin_amdgcn_mfma_f32_32x32x16_bf16(pa3, PK(l3, h3), od, 0, 0, 0);
#undef PK
}
__device__ __forceinline__ void pv_d0(f32x16* o, int vb, bf16x8 pa0, bf16x8 pa1, bf16x8 pa2, bf16x8 pa3) {
    pv_one<0>(o[0], vb, pa0, pa1, pa2, pa3); pv_one<1>(o[1], vb, pa0, pa1, pa2, pa3); pv_one<2>(o[2], vb, pa0, pa1, pa2, pa3); pv_one<3>(o[3], vb, pa0, pa1, pa2, pa3);
}
__device__ __forceinline__ void qkt(f32x16& p0, f32x16& p1, const LAS char* Ks, const bf16x8* qr, int r32, int hi, int map) {
    p0 = f32x16{}; p1 = f32x16{};
#pragma unroll
    for (int d0 = 0; d0 < 4; ++d0) { const int cb = ((map * 4 + d0) * 16 + hi * 8) * 2;
        const bf16x8 b0 = *(const LAS bf16x8*)(Ks + KSWZ(r32, cb)); const bf16x8 b1 = *(const LAS bf16x8*)(Ks + KSWZ(32 + r32, cb));
        p0 = __builtin_amdgcn_mfma_f32_32x32x16_bf16(b0, qr[d0], p0, 0, 0, 0);
        p1 = __builtin_amdgcn_mfma_f32_32x32x16_bf16(b1, qr[d0], p1, 0, 0, 0); }
}
__device__ __forceinline__ void partialSM(f32x16& p0, f32x16& p1, float& m_reg, float& mn, float& alpha, int relw, int relb, int hi, const LAS float* btab, float bneg, float bpos) {
    if (relw - 31 >= 91 || relw + 63 <= -91) {
        const float bc = (relw > 0) ? bpos : bneg;
        float pmax = p0[0];
#pragma unroll
        for (int r = 1; r < 16; ++r) pmax = fmaxf(pmax, p0[r]);
#pragma unroll
        for (int r = 0; r < 16; ++r) pmax = fmaxf(pmax, p1[r]);
        { auto rr = __builtin_amdgcn_permlane32_swap(__float_as_uint(pmax), __float_as_uint(pmax), false, false); pmax = fmaxf(__uint_as_float(rr[0]), __uint_as_float(rr[1])); }
        const float tmax = fmaf(pmax, C, bc);
        if (__builtin_expect(__all(tmax - m_reg <= THR2), 1)) { mn = m_reg; alpha = 1.f; }
        else { mn = fmaxf(m_reg, tmax); alpha = __builtin_amdgcn_exp2f(m_reg - mn); m_reg = mn; }
        const float off = bc - mn;
#pragma unroll
        for (int r = 0; r < 16; ++r) p0[r] = fmaf(p0[r], C, off);
#pragma unroll
        for (int r = 0; r < 16; ++r) p1[r] = fmaf(p1[r], C, off);
    } else {
#pragma unroll
        for (int r = 0; r < 16; ++r) { const int idx = relb + crow(r, hi) + 256; p0[r] = fmaf(p0[r], C, btab[idx]); p1[r] = fmaf(p1[r], C, btab[idx + 32]); }
        float pmax = p0[0];
#pragma unroll
        for (int r = 1; r < 16; ++r) pmax = fmaxf(pmax, p0[r]);
#pragma unroll
        for (int r = 0; r < 16; ++r) pmax = fmaxf(pmax, p1[r]);
        { auto rr = __builtin_amdgcn_permlane32_swap(__float_as_uint(pmax), __float_as_uint(pmax), false, false); pmax = fmaxf(__uint_as_float(rr[0]), __uint_as_float(rr[1])); }
        if (__builtin_expect(__all(pmax - m_reg <= THR2), 1)) { mn = m_reg; alpha = 1.f; }
        else { mn = fmaxf(m_reg, pmax); alpha = __builtin_amdgcn_exp2f(m_reg - mn); m_reg = mn; }
#pragma unroll
        for (int r = 0; r < 16; ++r) p0[r] -= mn;
#pragma unroll
        for (int r = 0; r < 16; ++r) p1[r] -= mn;
    }
#pragma unroll
    for (int r = 0; r < 16; ++r) p0[r] = __builtin_amdgcn_exp2f(p0[r]);
}
__device__ __forceinline__ void finishSM(f32x16& p0, f32x16& p1, float alpha, float& l_reg, bf16x8& pa0, bf16x8& pa1, bf16x8& pa2, bf16x8& pa3) {
#pragma unroll
    for (int r = 0; r < 16; ++r) p1[r] = __builtin_amdgcn_exp2f(p1[r]);
    float ps = 0;
#pragma unroll
    for (int r = 0; r < 16; ++r) ps += p0[r];
#pragma unroll
    for (int r = 0; r < 16; ++r) ps += p1[r];
    { auto rr = __builtin_amdgcn_permlane32_swap(__float_as_uint(ps), __float_as_uint(ps), false, false); ps = __uint_as_float(rr[0]) + __uint_as_float(rr[1]); }
    l_reg = l_reg * alpha + ps;
#define PK4(P, BASE, OUT) do { unsigned a0 = cvt_pk_bf16(P[BASE + 0], P[BASE + 1]), a1 = cvt_pk_bf16(P[BASE + 2], P[BASE + 3]);   \
    unsigned b0 = cvt_pk_bf16(P[BASE + 4], P[BASE + 5]), b1 = cvt_pk_bf16(P[BASE + 6], P[BASE + 7]);                              \
    auto r0 = __builtin_amdgcn_permlane32_swap(a0, b0, false, false); auto r1 = __builtin_amdgcn_permlane32_swap(a1, b1, false, false); \
    u32x4 w = {r0[0], r1[0], r0[1], r1[1]}; OUT = __builtin_bit_cast(bf16x8, w); } while (0)
    PK4(p0, 0, pa0); PK4(p0, 8, pa1); PK4(p1, 0, pa2); PK4(p1, 8, pa3);
#undef PK4
}
constexpr int L_V = 0, L_K = 32768, L_WS = 65536, L_BT = 67584, L_CB = 69632;
__device__ __forceinline__ void attn_unit(Frame& F, int unit) {
    const int bh = unit >> 4, qb = unit & 15, b = bh >> 3, h = bh & 7, q0 = qb * 128;
    const int tid = F.tid, wid = F.wave, lane = F.lane, r32 = lane & 31, hi = lane >> 5, rg = wid & 3, map = wid >> 2;
    const bf16* proj = WSP(bf16, WS_PROJ);
    const bf16* Kh = proj + (size_t)(b * SEQ) * INC + 1024 + h * 128; const bf16* Vh = proj + (size_t)(b * SEQ) * INC + 2048 + h * 128;
    LAS char* lds = (LAS char*)F.lds; LAS char* V_lds = lds + L_V; LAS char* K_lds = lds + L_K;
    LAS float* wsf = (LAS float*)(lds + L_WS) + wid * 64; LAS float* li_l = wsf; LAS float* al_l = wsf + 32;
    LAS float* btab = (LAS float*)(lds + L_BT);
    const float* bt = WSP(float, WS_BIAST) + h * 4096;
    __syncthreads();
    btab[tid] = bt[2048 - 256 + tid];
    const float bneg = bt[2048 - 200], bpos = bt[2048 + 200], lam = WSP(float, WS_BIAST)[AH * 4096];
    float m_reg = -1e30f, l_reg = 0; f32x16 o[4] = {}; bf16x8 qr[4];
    const int qw0 = q0 + 32 * rg;
    const bf16* Qw = proj + (size_t)(b * SEQ + qw0 + r32) * INC + h * 128 + map * 64 + hi * 8;
#pragma unroll
    for (int d0 = 0; d0 < 4; ++d0) qr[d0] = *(const GAS bf16x8*)(Qw + d0 * 16);
    const int sr = tid >> 4, sc = (tid & 15) * 8, vst0 = v_st(sr, sc), vst1 = v_st(32 + sr, sc);
    const int vb0 = (int)(uintptr_t)V_lds + v_rd_base(lane);
    struct { bf16x8 vs0, vs1, ks0, ks1; } sr_[2];
#define SLOAD(i, k0) do { sr_[i].vs0 = *(const GAS bf16x8*)&Vh[(size_t)((k0) + sr) * INC + sc]; sr_[i].vs1 = *(const GAS bf16x8*)&Vh[(size_t)((k0) + 32 + sr) * INC + sc]; \
    sr_[i].ks0 = *(const GAS bf16x8*)&Kh[(size_t)((k0) + sr) * INC + sc]; sr_[i].ks1 = *(const GAS bf16x8*)&Kh[(size_t)((k0) + 32 + sr) * INC + sc]; } while (0)
#define SWRITE(bb, i) do { *(LAS bf16x8*)(V_lds + (bb) * SHM_V + vst0) = sr_[i].vs0; *(LAS bf16x8*)(V_lds + (bb) * SHM_V + vst1) = sr_[i].vs1; const int kc = sc * 2; \
    *(LAS bf16x8*)(K_lds + (bb) * SHM_K + KSWZ(sr, kc)) = sr_[i].ks0; *(LAS bf16x8*)(K_lds + (bb) * SHM_K + KSWZ(32 + sr, kc)) = sr_[i].ks1; } while (0)
#define SWAIT() asm volatile("s_waitcnt vmcnt(4)" ::: "memory")
#define RESC(a) do { if (__any((a) < 1.f)) { if (hi == 0) al_l[r32] = (a); asm volatile("s_waitcnt lgkmcnt(0)" ::: "memory"); \
    _Pragma("unroll") for (int d = 0; d < 4; ++d) _Pragma("unroll") for (int r = 0; r < 16; ++r) o[d][r] *= al_l[crow(r, hi)]; } } while (0)
#define PSM(P0, P1, MN, AL, k0) partialSM(P0, P1, m_reg, MN, AL, (k0) - qw0, (k0) - qw0 - r32, hi, btab, bneg, bpos)
    f32x16 pA0, pA1, pB0, pB1; float mnA, mnB, alA, alB; bf16x8 pa0, pa1, pa2, pa3; constexpr int NT = SEQ / KVBLK;
    constexpr int SE = 0, SO = 1;
    SLOAD(SE, 0); asm volatile("s_waitcnt vmcnt(0)" ::: "memory"); SWRITE(0, SE); __syncthreads();
    qkt(pA0, pA1, K_lds, qr, r32, hi, map); PSM(pA0, pA1, mnA, alA, 0);
    SLOAD(SO, KVBLK); SLOAD(SE, 2 * KVBLK);
    SWAIT(); SWRITE(1, SO); __syncthreads();
    for (int j = 1; j + 1 < NT; j += 2) {
        SBAR(); qkt(pB0, pB1, K_lds + SHM_K, qr, r32, hi, map);
        finishSM(pA0, pA1, alA, l_reg, pa0, pa1, pa2, pa3); SBAR();
        SLOAD(SO, (j + 2) * KVBLK); SBAR();
        pv_d0(o, vb0, pa0, pa1, pa2, pa3); PSM(pB0, pB1, mnB, alB, j * KVBLK);
        __syncthreads(); SWAIT(); SWRITE(0, SE);
        RESC(alB); __syncthreads();
        SBAR(); qkt(pA0, pA1, K_lds, qr, r32, hi, map);
        finishSM(pB0, pB1, alB, l_reg, pa0, pa1, pa2, pa3); SBAR();
        if (j + 3 < NT) SLOAD(SE, (j + 3) * KVBLK); SBAR();
        pv_d0(o, vb0 + (int)SHM_V, pa0, pa1, pa2, pa3); PSM(pA0, pA1, mnA, alA, (j + 1) * KVBLK);
        __syncthreads(); SWAIT(); SWRITE(1, SO);
        RESC(alA); __syncthreads();
    }
    SBAR(); qkt(pB0, pB1, K_lds + SHM_K, qr, r32, hi, map);
    finishSM(pA0, pA1, alA, l_reg, pa0, pa1, pa2, pa3); SBAR();
    pv_d0(o, vb0, pa0, pa1, pa2, pa3); PSM(pB0, pB1, mnB, alB, (NT - 1) * KVBLK);
    __syncthreads(); RESC(alB);
    finishSM(pB0, pB1, alB, l_reg, pa0, pa1, pa2, pa3); SBAR();
    pv_d0(o, vb0 + (int)SHM_V, pa0, pa1, pa2, pa3);
    if (hi == 0) li_l[r32] = l_reg; asm volatile("s_waitcnt lgkmcnt(0)" ::: "memory");
    float rli[16];
#pragma unroll
    for (int r = 0; r < 16; ++r) rli[r] = __builtin_amdgcn_rcpf(li_l[crow(r, hi)]);
    LAS float* cbuf = (LAS float*)(lds + L_CB) + rg * 32 * 128;
    if (map == 1) {
#pragma unroll
        for (int r = 0; r < 16; ++r)
#pragma unroll
            for (int d0 = 0; d0 < 4; ++d0) cbuf[crow(r, hi) * 128 + d0 * 32 + r32] = -lam * o[d0][r] * rli[r];
    }
    __syncthreads();
    if (map == 0) {
        bf16* mix = WSP(bf16, WS_MIX) + (size_t)(b * SEQ + qw0) * DM + h * 128;
        float sg[4];
#pragma unroll
        for (int d0 = 0; d0 < 4; ++d0) sg[d0] = F.subln[d0 * 32 + r32] * 0.8f;
#pragma unroll
        for (int r = 0; r < 16; ++r) { float v[4], ss = 0.f;
#pragma unroll
            for (int d0 = 0; d0 < 4; ++d0) { v[d0] = o[d0][r] * rli[r] + cbuf[crow(r, hi) * 128 + d0 * 32 + r32]; ss += v[d0] * v[d0]; }
#pragma unroll
            for (int s = 1; s < 32; s <<= 1) ss += __shfl_xor(ss, s);
            const float rstd = rsqrtf(ss * (1.f / VD) + EPS);
#pragma unroll
            for (int d0 = 0; d0 < 4; ++d0) mix[(size_t)crow(r, hi) * DM + d0 * 32 + r32] = (bf16)f2bf(v[d0] * rstd * sg[d0]); }
    }
#undef SLOAD
#undef SWRITE
#undef SWAIT
#undef RESC
#undef PSM
}
}

__device__ __forceinline__ void p5_router(Frame& F, bool dry = false) {
    const float* mod = WSP(float, WS_MOD); const float* x1 = WSP(float, WS_X1); bf16* h2 = WSP(bf16, WS_H2);
    int* list = (int*)(F.ws + WS_ROUTE + RT_LIST); float* sw = (float*)(F.ws + WS_ROUTE + RT_SW); int* toke = (int*)(F.ws + WS_ROUTE + RT_TOKE); int* tokr = (int*)(F.ws + WS_ROUTE + RT_TOKR);
    constexpr int RS = 4096 + 16;
    LAS unsigned char* Ahi = F.lds; LAS unsigned char* Alo = F.lds + 16 * RS; LAS float* Pl = (LAS float*)(F.lds + 32 * RS);
    const unsigned char* wrf = WSP(unsigned char, WS_WRF);
    for (int tb = F.vcu; tb < T / 16; tb += F.G) {
        const int b = (tb * 16) / SEQ;
        __syncthreads();
#pragma unroll 1
        for (int rr = 0; rr < 2; ++rr) {
            const int tl = 2 * F.wave + rr, row = tb * 16 + tl;
            const GAS f32x4* xr = (const GAS f32x4*)(x1 + (size_t)row * DM) + F.lane;
            f32x4 v[8]; float s = 0.f;
#pragma unroll
            for (int j = 0; j < 8; ++j) { v[j] = xr[64 * j]; s += (v[j].x * v[j].x + v[j].y * v[j].y) + (v[j].z * v[j].z + v[j].w * v[j].w); }
            const float rstd = rsqrtf(wave_sum(s) * (1.f / DM) + EPS);
            GAS u32x2* o8 = (GAS u32x2*)(h2 + (size_t)row * DM) + F.lane;
#pragma unroll
            for (int j = 0; j < 8; ++j) { const int k = 4 * F.lane + 256 * j;
                const f32x4 g = *(const GAS f32x4*)(F.g2 + k), sc = *(const GAS f32x4*)(mod + (size_t)b * 6 * DM + 4 * DM + k), sf = *(const GAS f32x4*)(mod + (size_t)b * 6 * DM + 3 * DM + k);
                float hv[4]; unsigned hb[4], lb[4];
#pragma unroll
                for (int q = 0; q < 4; ++q) { hv[q] = v[j][q] * rstd * g[q] * (1.f + sc[q]) + sf[q]; hb[q] = f2bf(hv[q]); lb[q] = f2bf(hv[q] - bf2f(hb[q])); }
                u32x2 wh, wl; wh.x = hb[0] | (hb[1] << 16); wh.y = hb[2] | (hb[3] << 16); wl.x = lb[0] | (lb[1] << 16); wl.y = lb[2] | (lb[3] << 16);
                o8[64 * j] = wh; *(LAS u32x2*)(Ahi + tl * RS + k * 2) = wh; *(LAS u32x2*)(Alo + tl * RS + k * 2) = wl; }
        }
        __syncthreads();
        { f32x4 acc0 = {0.f, 0.f, 0.f, 0.f}, acc1 = {0.f, 0.f, 0.f, 0.f};
#pragma unroll 2
          for (int ks = 0; ks < 8; ++ks) { const int s = 8 * F.wave + ks, k0 = 32 * s + 8 * (F.lane >> 4);
            const bf16x8 ah = *(const LAS bf16x8*)(Ahi + (F.lane & 15) * RS + k0 * 2), al = *(const LAS bf16x8*)(Alo + (F.lane & 15) * RS + k0 * 2);
            const bf16x8 bh0 = *(const GAS bf16x8*)(wrf + ((size_t)(s * 2 + 0) * 64 + F.lane) * 16), bh1 = *(const GAS bf16x8*)(wrf + ((size_t)(s * 2 + 1) * 64 + F.lane) * 16);
            const bf16x8 bl0 = *(const GAS bf16x8*)(wrf + 131072 + ((size_t)(s * 2 + 0) * 64 + F.lane) * 16), bl1 = *(const GAS bf16x8*)(wrf + 131072 + ((size_t)(s * 2 + 1) * 64 + F.lane) * 16);
            acc0 = __builtin_amdgcn_mfma_f32_16x16x32_bf16(ah, bh0, acc0, 0, 0, 0); acc0 = __builtin_amdgcn_mfma_f32_16x16x32_bf16(ah, bl0, acc0, 0, 0, 0); acc0 = __builtin_amdgcn_mfma_f32_16x16x32_bf16(al, bh0, acc0, 0, 0, 0);
            acc1 = __builtin_amdgcn_mfma_f32_16x16x32_bf16(ah, bh1, acc1, 0, 0, 0); acc1 = __builtin_amdgcn_mfma_f32_16x16x32_bf16(ah, bl1, acc1, 0, 0, 0); acc1 = __builtin_amdgcn_mfma_f32_16x16x32_bf16(al, bh1, acc1, 0, 0, 0); }
#pragma unroll
          for (int r = 0; r < 4; ++r) { const int tk = 4 * (F.lane >> 4) + r; Pl[(F.wave * 16 + tk) * 32 + (F.lane & 15)] = acc0[r]; Pl[(F.wave * 16 + tk) * 32 + 16 + (F.lane & 15)] = acc1[r]; }
        }
        __syncthreads();
        { const int tl = F.tid >> 5, e = F.tid & 31, tok = tb * 16 + tl;
          float v = F.b_r[e];
#pragma unroll
          for (int w = 0; w < 8; ++w) v += Pl[(w * 16 + tl) * 32 + e];
          float tv[4]; int ti[4];
#pragma unroll
          for (int r = 0; r < 4; ++r) { float bv = v; int bi = e;
#pragma unroll
              for (int o = 16; o > 0; o >>= 1) { const float ov = __shfl_xor(bv, o); const int oi = __shfl_xor(bi, o); if (ov > bv || (ov == bv && oi < bi)) { bv = ov; bi = oi; } }
              tv[r] = bv; ti[r] = bi; if (e == bi) v = -3.0e38f; }
          float den = 0.f, w[4];
#pragma unroll
          for (int r = 0; r < 4; ++r) { w[r] = __expf(tv[r] - tv[0]); den += w[r]; }
#pragma unroll
          for (int r = 0; r < 4; ++r) if (e == ti[r] && !dry) { const int rank = (int)atomicAdd(F.ctl + CW_CNT + e, 1u);
              list[e * T + rank] = tok; sw[e * T + rank] = w[r] / den; toke[tok * 4 + r] = e; tokr[tok * 4 + r] = rank; }
        }
    }
}

__device__ __forceinline__ void p8_final(Frame& F) {
    const float* mod = WSP(float, WS_MOD); const float* x1 = WSP(float, WS_X1); const bf16* y = WSP(bf16, WS_Y);
    const int* toke = (const int*)(F.ws + WS_ROUTE + RT_TOKE); const int* tokr = (const int*)(F.ws + WS_ROUTE + RT_TOKR);
    moe_tables(F);
    const LAS int* off = (const LAS int*)(F.lds + TAB_OFF) + 40;
    for (int row = F.vcu * NWAVES + F.wave; row < T; row += F.G * NWAVES) {
        const int b = row / SEQ;
        size_t so[4];
#pragma unroll
        for (int r = 0; r < 4; ++r) so[r] = (size_t)(off[toke[row * 4 + r]] + tokr[row * 4 + r]) * DM;
        const GAS f32x4* xr = (const GAS f32x4*)(x1 + (size_t)row * DM) + F.lane;
        f32x4 v[8]; float s = 0.f;
#pragma unroll
        for (int j = 0; j < 8; ++j) { const int k = 4 * F.lane + 256 * j; f32x4 m = {0.f, 0.f, 0.f, 0.f};
#pragma unroll
            for (int r = 0; r < 4; ++r) { const u32x2 yy = *(const GAS u32x2*)(y + so[r] + k); m[0] += bf2f(yy.x & 0xffffu); m[1] += bf2f(yy.x >> 16); m[2] += bf2f(yy.y & 0xffffu); m[3] += bf2f(yy.y >> 16); }
            const f32x4 g = *(const GAS f32x4*)(mod + (size_t)b * 6 * DM + 5 * DM + k);
            v[j] = xr[64 * j] + g * m; s += (v[j].x * v[j].x + v[j].y * v[j].y) + (v[j].z * v[j].z + v[j].w * v[j].w); }
        const float rstd = rsqrtf(wave_sum(s) * (1.f / DM) + EPS);
        GAS f32x4* orow = (GAS f32x4*)(F.out + (size_t)row * DM) + F.lane;
#pragma unroll
        for (int j = 0; j < 8; ++j) { const f32x4 g = *(const GAS f32x4*)(F.fg + 4 * F.lane + 256 * j); orow[64 * j] = v[j] * rstd * g; }
    }
}

struct Args { const float* in[25]; float* out; unsigned char* ws; int ph_lo, ph_hi, li, pad; };
__global__ void __launch_bounds__(NTHR, 2) mega_fwd(Args args) {
    extern __shared__ __attribute__((aligned(16))) unsigned char lds[];
    Frame F;
    F.lds = (LAS unsigned char*)lds; F.MISC = (volatile LAS unsigned*)(F.lds + MISC_OFF);
    F.tid = threadIdx.x; F.lane = F.tid & 63; F.wave = __builtin_amdgcn_readfirstlane(F.tid >> 6);
    F.G = gridDim.x; { const int bx = blockIdx.x; F.vcu = (F.G % 8 == 0) ? (bx % 8) * (F.G / 8) + bx / 8 : bx; }
    F.ws = args.ws; F.ctl = (unsigned*)(args.ws + WS_CTL); F.out = args.out;
    F.x = args.in[0]; F.c = args.in[1]; F.w_ada = args.in[2]; F.b_ada = args.in[3]; F.g1 = args.in[4]; F.w_in = args.in[5]; F.lq1 = args.in[6]; F.lk1 = args.in[7]; F.lq2 = args.in[8]; F.lk2 = args.in[9];
    F.subln = args.in[10]; F.relb = args.in[11]; F.cw = args.in[12]; F.cb = args.in[13]; F.clg = args.in[14]; F.clb = args.in[15]; F.w_out = args.in[16]; F.g2 = args.in[17]; F.w_r = args.in[18]; F.b_r = args.in[19];
    F.w_gu = args.in[20]; F.b_gu = args.in[21]; F.w_d = args.in[22]; F.b_d = args.in[23]; F.fg = args.in[24];
    for (int u = F.tid; u < 64; u += NTHR) ((LAS unsigned*)(F.lds + MISC_OFF))[u] = 0u;
    __syncthreads();
    XcdBarrier bar = xcd_barrier_post(F.ctl + CW_BAR + args.li * XCD_BAR_WORDS, F.MISC + 8);
    const int lo = args.ph_lo, hi = args.ph_hi;
#ifndef PH_MASK
#define PH_MASK 0x1ff
#endif
#define IN(k) (((PH_MASK >> (k)) & 1) && lo <= (k) && (k) < hi)
#define SEAM(k) do { if (IN(k) && IN((k) + 1)) { xcd_barrier(bar); if constexpr (((REP_MASK >> 14) & 1) != 0) xcd_barrier(bar); } } while (0)
#define REP2(k, ...) do { { __VA_ARGS__ } if constexpr (((REP_MASK >> (k)) & 1) != 0) { __VA_ARGS__ } } while (0)
    if (IN(0)) { REP2(0, __syncthreads(); p0_prologue(F);); } SEAM(0);
    if (IN(0) && IN(1)) F.vcu = xcd_virtual_cu(bar);
    if (IN(1)) { REP2(1, __syncthreads(); p1_norm1(F);); } SEAM(1);
    if (IN(2)) { REP2(2, { InProjT<false> P{WSP(bf16, WS_H), WSP(bf16, WS_WIN), WSP(bf16, WS_PROJ), {}}; P.ord.init(T, INC, F.G, F.vcu, false, true); __syncthreads(); pg8::gemm_run(F.lds, P); }
        { InProjT<true> P{WSP(bf16, WS_H), WSP(bf16, WS_WIN), WSP(bf16, WS_PROJ), {}}; P.ord.init(T, INC, F.G, F.vcu, true, true); __syncthreads(); pg8::gemm_run<InProjT<true>, true>(F.lds, P); }); } SEAM(2);
    if (IN(3)) { REP2(3,
        for (int ct = F.vcu; ct < T / 32; ct += F.G) conv_unit(F, ct);
        if constexpr (((REP_MASK >> 9) & 1) != 0) { for (int ct = F.vcu; ct < T / 32; ct += F.G) conv_unit(F, ct); }
        for (int u = F.vcu; u < NB * AH * 16 * (1 + ((REP_MASK >> 10) & 1)); u += F.G) att::attn_unit(F, u % (NB * AH * 16));
    ); } SEAM(3);
    if (IN(4)) { REP2(4, OutProj P{WSP(bf16, WS_MIX), WSP(bf16, WS_WOUT), F.x, WSP(float, WS_MOD), WSP(float, WS_X1), {}}; P.ord.init(T, DM, F.G, F.vcu); __syncthreads(); pg8::gemm_run(F.lds, P);); } SEAM(4);
    if (IN(5)) { p5_router(F); if constexpr (((REP_MASK >> 13) & 1) != 0) { __syncthreads(); p5_router(F, true); } } SEAM(5);
    if (IN(6)) { REP2(6, moe_tables(F); const LAS int* tab = (const LAS int*)(F.lds + TAB_OFF);
        MoeGU P{WSP(bf16, WS_H2), F.w_gu, F.b_gu, (const int*)(F.ws + WS_ROUTE + RT_LIST), WSP(bf16, WS_ACT), {tab, tab + 40, tab + 80}, F.G, F.vcu}; pg8::gemm_run_bf32(F.lds, P);); } SEAM(6);
    if (IN(7)) { REP2(7, moe_tables(F); const LAS int* tab = (const LAS int*)(F.lds + TAB_OFF);
        MoeDown P{WSP(bf16, WS_ACT), F.w_d, F.b_d, (const float*)(F.ws + WS_ROUTE + RT_SW), WSP(bf16, WS_Y), {tab, tab + 40, tab + 80}, F.G, F.vcu}; pg8::gemm_run_bf32(F.lds, P);); } SEAM(7);
    if (IN(8)) { REP2(8, p8_final(F);); }
#undef IN
#undef SEAM
}

extern "C" void kernel_launch(void* const* d_in, const int* in_sizes, int n_in, void* d_out, int out_size, void* d_ws, size_t ws_size, hipStream_t stream) {
    static int grid = 0;
    if (grid == 0) {
        if (n_in != 25 || ws_size < WS_END || out_size != T * DM) { fprintf(stderr, "kernel_launch: n_in %d out %d ws %zu (need %zu); nothing launched\n", n_in, out_size, ws_size, (size_t)WS_END); grid = -1; return; }
        int dev = 0, cus = 0, per_cu = 0;
        if (hipGetDevice(&dev) != hipSuccess || hipDeviceGetAttribute(&cus, hipDeviceAttributeMultiprocessorCount, dev) != hipSuccess) { grid = -1; return; }
        if (hipFuncSetAttribute((const void*)mega_fwd, hipFuncAttributeMaxDynamicSharedMemorySize, LDS_BYTES) != hipSuccess) { fprintf(stderr, "kernel_launch: hipFuncSetAttribute failed\n"); grid = -1; return; }
        if (hipOccupancyMaxActiveBlocksPerMultiprocessor(&per_cu, (const void*)mega_fwd, NTHR, LDS_BYTES) != hipSuccess || per_cu < 1) { fprintf(stderr, "kernel_launch: occupancy query says %d blocks per CU\n", per_cu); }
        (void)hipGetLastError();
        grid = cus;
    }
    if (grid < 0) return;
    unsigned char* ws = (unsigned char*)d_ws;
    (void)hipMemsetAsync(ws + WS_CTL, 0, CTL_ZERO_BYTES, stream);
    Args a{};
    for (int i = 0; i < 25; ++i) a.in[i] = (const float*)d_in[i];
    a.out = (float*)d_out; a.ws = ws; a.ph_lo = 0; a.ph_hi = 9; a.li = 0; a.pad = 0;
    hipLaunchKernelGGL(mega_fwd, dim3(grid), dim3(NTHR), LDS_BYTES, stream, a);
}
```

```cpp
#include <hip/hip_runtime.h>
#include <cstdio>
#include <cstdint>

#ifndef REP_MASK
#define REP_MASK 0
#endif

constexpr int DM = 2048, NB = 4, SEQ = 2048, T = NB * SEQ;
constexpr int AH = 8, HD = 64, VD = 128, CCH = 1024, CK = 31;
constexpr int INC = 5120;
constexpr int NE = 32, TOPK = 4, DFF = 2048, NSLOT = T * TOPK;
constexpr float EPS = 1e-6f;
constexpr float LOG2E = 1.4426950408889634f;

typedef unsigned short bf16;
typedef short bf16x8 __attribute__((ext_vector_type(8)));
typedef short s16x4 __attribute__((ext_vector_type(4)));
typedef float f32x4 __attribute__((ext_vector_type(4)));
typedef float f32x16 __attribute__((ext_vector_type(16)));
typedef unsigned u32x4 __attribute__((ext_vector_type(4)));
typedef unsigned u32x2 __attribute__((ext_vector_type(2)));
#define GAS __attribute__((address_space(1)))
#define LAS __attribute__((address_space(3)))
typedef GAS unsigned gu32;

constexpr size_t MiB = 1u << 20;
constexpr size_t WS_CTL = 0, CTL_ZERO_BYTES = 64 * 1024;
constexpr size_t WS_MODP = 1 * MiB;
constexpr size_t WS_MOD = 3 * MiB;
constexpr size_t WS_BIAST = 4 * MiB;
constexpr size_t WS_WRF = 5 * MiB;
constexpr size_t WS_ROUTE = 6 * MiB;
constexpr size_t RT_LIST = 0;
constexpr size_t RT_SW = 1 * MiB;
constexpr size_t RT_TOKE = 2 * MiB;
constexpr size_t RT_TOKR = RT_TOKE + 128 * 1024;
constexpr size_t WS_WIN = 16 * MiB;
constexpr size_t WS_WOUT = WS_WIN + 20 * MiB;
constexpr size_t WS_H = WS_WOUT + 8 * MiB;
constexpr size_t WS_PROJ = WS_H + 32 * MiB;
constexpr size_t WS_MIX = WS_PROJ + 80 * MiB;
constexpr size_t WS_X1 = WS_MIX + 32 * MiB;
constexpr size_t WS_H2 = WS_X1 + 64 * MiB;
constexpr size_t WS_ACT = WS_H2 + 32 * MiB;
constexpr size_t WS_Y = WS_ACT + 130 * MiB;
constexpr size_t WS_END = WS_Y + 130 * MiB;
constexpr int CW_CNT = 0;
constexpr int CW_BAR = 1024;

__device__ __forceinline__ unsigned f2bf(float f) { unsigned u = __builtin_bit_cast(unsigned, f); return (u + 0x7fffu + ((u >> 16) & 1u)) >> 16; }
__device__ __forceinline__ float bf2f(unsigned h) { return __builtin_bit_cast(float, h << 16); }
__device__ __forceinline__ unsigned pk2(float lo, float hi) { return f2bf(lo) | (f2bf(hi) << 16); }
__device__ __forceinline__ unsigned cvt_pk_bf16(float lo, float hi) { unsigned r; asm volatile("v_cvt_pk_bf16_f32 %0, %1, %2" : "=v"(r) : "v"(lo), "v"(hi)); return r; }
__device__ __forceinline__ float silu_f(float v) { return v / (1.f + __expf(-v)); }
__device__ __forceinline__ float wave_sum(float v) {
#pragma unroll
    for (int o = 1; o < 64; o <<= 1) v += __shfl_xor(v, o);
    return v;
}
__host__ __device__ inline int t5_bucket(int rel) {
    int ret = rel > 0 ? 16 : 0; int n = rel < 0 ? -rel : rel;
    if (n < 8) return ret + n;
    int lg = n >= 91 ? 15 : n >= 64 ? 14 : n >= 46 ? 13 : n >= 32 ? 12 : n >= 23 ? 11 : n >= 16 ? 10 : n >= 12 ? 9 : 8;
    return ret + lg;
}
#define LDS_WAIT() asm volatile("s_waitcnt lgkmcnt(0)" ::: "memory")
#define VM_WAIT() asm volatile("s_waitcnt vmcnt(0)" ::: "memory")

#define XB_TMO      128
#define XB_XCNT(j)  (256  + 64 * (j))
#define XB_XSUB(j)  (1280 + 64 * (j))
#define XB_XGEN(j)  (2304 + 64 * (j))
#define XB_TOP      3328
#define XB_TOPGEN   3392
#define XCD_BAR_WORDS 3456
#define XB_SPIN_CAP (1u << 18)
__device__ __forceinline__ unsigned xb_ld(unsigned* p)              { return __hip_atomic_load(p, __ATOMIC_RELAXED, __HIP_MEMORY_SCOPE_AGENT); }
__device__ __forceinline__ unsigned xb_add(unsigned* p, unsigned v) { return __hip_atomic_fetch_add(p, v, __ATOMIC_RELAXED, __HIP_MEMORY_SCOPE_AGENT); }
__device__ __forceinline__ unsigned xb_xcc_id() { return (unsigned)__builtin_amdgcn_s_getreg((3 << 11) | 20) & 0xFu; }
#define XB_SPIN(cond, bar) do { unsigned _sp = 0; while (cond) { __builtin_amdgcn_s_sleep(1); \
    if ((++_sp & 255u) == 0u) { if (xb_ld(&(bar)[XB_TMO])) break; if (_sp > XB_SPIN_CAP) { atomicAdd(&(bar)[XB_TMO], 1u); break; } } } } while (0)
struct XcdBarrier { unsigned* bar; unsigned x; volatile LAS unsigned* st; };
__device__ __forceinline__ XcdBarrier xcd_barrier_post(unsigned* bar, volatile LAS unsigned* st) {
    XcdBarrier b; b.bar = bar; b.x = xb_xcc_id(); b.st = st;
    if (threadIdx.x == 0) st[2] = xb_add(&bar[XB_XCNT(b.x)], 1u);
    return b;
}
__device__ __forceinline__ int xcd_virtual_cu(const XcdBarrier& b) {
    if (threadIdx.x == 0) { unsigned pre = 0u; for (unsigned j = 0; j < 16; ++j) { const unsigned c = xb_ld(&b.bar[XB_XCNT(j)]); pre += (j < b.x) ? c : 0u; } b.st[3] = pre + b.st[2]; }
    __syncthreads();
    const int v = (int)b.st[3];
    __syncthreads();
    return __builtin_amdgcn_readfirstlane(v);
}
__device__ __forceinline__ void xcd_barrier_complete(unsigned* bar, unsigned x, unsigned& nloc, unsigned& nx) {
    const unsigned G = gridDim.x * gridDim.y * gridDim.z;
    unsigned sum, cnt, mine, sp = 0u;
    for (;;) {
        sum = 0u; cnt = 0u; mine = 0u;
#pragma unroll
        for (unsigned j = 0; j < 16; ++j) { const unsigned c = xb_ld(&bar[XB_XCNT(j)]); sum += c; cnt += (c > 0u) ? 1u : 0u; mine = (j == x) ? c : mine; }
        if (sum == G) break;
        __builtin_amdgcn_s_sleep(1);
        if ((++sp & 255u) == 0u) { if (xb_ld(&bar[XB_TMO])) break; if (sp > XB_SPIN_CAP) { atomicAdd(&bar[XB_TMO], 1u); break; } }
    }
    nloc = mine > 0u ? mine : 1u; nx = cnt > 0u ? cnt : 1u;
}
__device__ __forceinline__ void xcd_barrier(const XcdBarrier& b) {
    asm volatile("s_waitcnt vmcnt(0)" ::: "memory");
    __syncthreads();
    if (threadIdx.x == 0) {
        unsigned* bar = b.bar;
        __builtin_amdgcn_s_waitcnt(0);
        unsigned nloc = b.st[0], nx = b.st[1];
        if (nloc == 0u) { xcd_barrier_complete(bar, b.x, nloc, nx); b.st[0] = nloc; b.st[1] = nx; }
        const unsigned old = xb_add(&bar[XB_XSUB(b.x)], 1u);
        const unsigned gen = old / nloc;
        if (old + 1u == (gen + 1u) * nloc) {
            __builtin_amdgcn_fence(__ATOMIC_RELEASE, "agent");
            asm volatile("s_waitcnt vmcnt(0)" ::: "memory");
            const unsigned og = xb_add(&bar[XB_TOP], 1u);
            const unsigned tg = og / nx;
            if (og + 1u == (tg + 1u) * nx) xb_add(&bar[XB_TOPGEN], 1u);
            else XB_SPIN(xb_ld(&bar[XB_TOPGEN]) == tg, bar);
            __builtin_amdgcn_fence(__ATOMIC_ACQUIRE, "agent");
            xb_add(&bar[XB_XGEN(b.x)], 1u);
            asm volatile("s_waitcnt vmcnt(0)" ::: "memory");
        } else {
            XB_SPIN(xb_ld(&bar[XB_XGEN(b.x)]) == gen, bar);
            __builtin_amdgcn_fence(__ATOMIC_ACQUIRE, "agent");
            asm volatile("s_waitcnt vmcnt(0)" ::: "memory");
        }
    }
    __syncthreads();
}

namespace pg8 {
constexpr int BM = 256, BK = 64, HALF = 128, HTB = HALF * BK * 2, STAGE_BYTES = 8 * HTB, KD = 2048;
__host__ __device__ __forceinline__ int lds_byte(int r, int c) { const int st = (r >> 4) * 2 + (c >> 5), rr = r & 15, cc = c & 31, ob = rr * 64 + cc * 2; return st * 1024 + (ob ^ (((ob >> 9) & 1) << 5)); }
__host__ __device__ __forceinline__ void stage_rc(int b, int& R, int& C) { const int st = b / 1024, sb = b % 1024, swz = sb ^ (((sb >> 9) & 1) << 5); R = (st >> 1) * 16 + swz / 64; C = (st & 1) * 32 + (swz % 64) / 2; }
__host__ __device__ __forceinline__ int perm32(int rho) { const int n = rho >> 4, i = rho & 15; return 8 * (i >> 2) + 4 * n + (i & 3); }
struct Unit { int pm, pn, e, rows; };

struct DenseOrder {
    int nM, nN, nwg, nfull, G, c; bool half;
    __device__ void init(int M, int N, int G_, int c_, bool half_ = false, bool split_tail = false) { nM = M / BM; nN = N / BM; nwg = nM * nN; G = G_; c = c_; half = half_; nfull = split_tail ? (nwg / G_) * G_ : nwg; }
    __device__ bool next(int i, Unit& u) const {
        long L = (long)i * G + c; int hsel = 0;
        if (half) { if (L >= 2L * (nwg - nfull)) return false; hsel = (int)(L & 1); L = nfull + (L >> 1); }
        else if (L >= nfull) return false;
        const int wgid = (int)L;
        const int nig = 8 * nN, gid = wgid / nig, fm = gid * 8, gsz = (nM - fm) < 8 ? (nM - fm) : 8;
        u.pm = fm + ((wgid % nig) % gsz); u.pn = (wgid % nig) / gsz; u.e = 0; u.rows = 256; if (half) { u.pm = 2 * u.pm + hsel; u.rows = 128; } return true;
    }
};

template <class P, bool HM = false>
__device__ __forceinline__ void gemm_run(LAS unsigned char* lds, const P& prob) {
    const int tid = threadIdx.x, wid = __builtin_amdgcn_readfirstlane(tid >> 6), lane = tid & 63, wr = wid >> 2, wc = wid & 3, fr = lane & 15, fq = lane >> 4;
    constexpr int K = KD, nt = K / BK;
    int Rr[2], Cc[2]; unsigned voffB[2];
#pragma unroll
    for (int i = 0; i < 2; ++i) { int R, C; stage_rc(tid * 16 + i * 8192, R, C); Rr[i] = R; Cc[i] = C; const int Rb = P::PERM ? ((R & ~31) + perm32(R & 31)) : R; voffB[i] = (unsigned)(Rb * K + C) * 2u; }
    constexpr size_t kstep = (size_t)(BK * 2), hstep = (size_t)HALF * K * 2;
    const unsigned ldsw = (unsigned)wid * 1024u;
    const int aoff = lds_byte(wr * 64 + fr, fq * 8), boff = lds_byte(wc * 32 + fr, fq * 8);
#define PG8_SA(b, h) (((b) * 2 + (h)) * HTB)
#define PG8_SB(b, h) ((4 + (b) * 2 + (h)) * HTB)
#define PG8_STAGE(bufoff, gbase, voff) do { _Pragma("unroll") for (int _i = 0; _i < 2; ++_i) \
        __builtin_amdgcn_global_load_lds((const unsigned*)((const char*)(gbase) + (voff)[_i]), (LAS unsigned*)(lds + (bufoff) + ldsw + _i * 8192), 16, 0, 0); } while (0)
#define PG8_LDA(dst, b, h) do { _Pragma("unroll") for (int m = 0; m < 4; ++m) _Pragma("unroll") for (int k = 0; k < 2; ++k) dst[m][k] = *(const LAS bf16x8*)(lds + PG8_SA(b, h) + aoff + m * 2048 + k * 1024); } while (0)
#define PG8_LDB(dst, b, h) do { _Pragma("unroll") for (int n = 0; n < 2; ++n) _Pragma("unroll") for (int k = 0; k < 2; ++k) dst[n][k] = *(const LAS bf16x8*)(lds + PG8_SB(b, h) + boff + n * 2048 + k * 1024); } while (0)
#define PG8_MMA(ai, bj, At, Bt) do { __builtin_amdgcn_s_setprio(1); _Pragma("unroll") for (int m = 0; m < 4; ++m) _Pragma("unroll") for (int n = 0; n < 2; ++n) _Pragma("unroll") for (int k = 0; k < 2; ++k) \
        acc[ai][bj][m][n] = __builtin_amdgcn_mfma_f32_16x16x32_bf16(Bt[n][k], At[m][k], acc[ai][bj][m][n], 0, 0, 0); __builtin_amdgcn_s_setprio(0); } while (0)
#define PG8_WAIT_V(n) asm volatile("s_waitcnt vmcnt(" #n ")" ::: "memory")
#define PG8_WAIT_L(n) asm volatile("s_waitcnt lgkmcnt(" #n ")" ::: "memory")
#define PG8_BAR __builtin_amdgcn_s_barrier()
#define PG8_SCHED __builtin_amdgcn_sched_barrier(0)
    Unit cur, nxt; int ui = 0;
    if (!prob.next(0, cur)) return;
    f32x4 acc[2][2][4][2];
#pragma unroll
    for (int a = 0; a < 2; ++a)
#pragma unroll
        for (int b = 0; b < 2; ++b)
#pragma unroll
            for (int m = 0; m < 4; ++m)
#pragma unroll
                for (int n = 0; n < 2; ++n) acc[a][b][m][n] = (f32x4){0.f, 0.f, 0.f, 0.f};
    bf16x8 At[4][2], B0[2][2], B1[2][2];
    unsigned vC0[2], vC1[2], vN0[2], vN1[2];
    prob.a_off(cur, Rr, Cc, vC0, vC1);
    const char* const Ab = prob.a_base();
    const char* cB = prob.b_base(cur);
    PG8_STAGE(PG8_SB(0, 0), cB, voffB); PG8_STAGE(PG8_SB(0, 1), cB + hstep, voffB); PG8_STAGE(PG8_SA(0, 0), Ab, vC0); if constexpr (!HM) PG8_STAGE(PG8_SA(0, 1), Ab, vC1);
    if (wr == 1) PG8_BAR;
    if constexpr (HM) PG8_WAIT_V(0); else PG8_WAIT_V(2);
    PG8_BAR;
    PG8_STAGE(PG8_SB(1, 0), cB + kstep, voffB); PG8_STAGE(PG8_SA(1, 0), Ab + kstep, vC0); PG8_STAGE(PG8_SB(1, 1), cB + hstep + kstep, voffB);
    PG8_WAIT_V(6); PG8_BAR;
    for (;;) {
        const bool has_next = prob.next(ui + 1, nxt);
        if (has_next) prob.a_off(nxt, Rr, Cc, vN0, vN1); else { vN0[0] = vC0[0]; vN0[1] = vC0[1]; vN1[0] = vC1[0]; vN1[1] = vC1[1]; }
        const char* nB = has_next ? prob.b_base(nxt) : cB;
        for (int t = 0; t < nt; t += 2) {
            const bool last = (t == nt - 2);
            const char* a1 = Ab + (size_t)(t + 1) * kstep;
            const char* a2 = last ? Ab : Ab + (size_t)(t + 2) * kstep; const char* b2 = last ? nB : cB + (size_t)(t + 2) * kstep;
            const char* a3 = a2 + kstep; const char* b3 = b2 + kstep;
            unsigned v20[2], v21[2];
            v20[0] = last ? vN0[0] : vC0[0]; v20[1] = last ? vN0[1] : vC0[1]; v21[0] = last ? vN1[0] : vC1[0]; v21[1] = last ? vN1[1] : vC1[1];
            PG8_LDB(B0, 0, 0); PG8_LDB(B1, 0, 1); PG8_SCHED; PG8_LDA(At, 0, 0); if constexpr (!HM) PG8_STAGE(PG8_SA(1, 1), a1, vC1);
            if constexpr (HM) PG8_WAIT_V(6); else PG8_WAIT_V(8); PG8_WAIT_L(0); PG8_BAR; PG8_MMA(0, 0, At, B0); PG8_MMA(0, 1, At, B1); PG8_BAR; PG8_SCHED;
            if constexpr (!HM) PG8_LDA(At, 0, 1); PG8_STAGE(PG8_SB(0, 0), b2, voffB); PG8_STAGE(PG8_SB(0, 1), b2 + hstep, voffB); PG8_STAGE(PG8_SA(0, 0), a2, v20);
            if constexpr (HM) PG8_WAIT_V(6); else PG8_WAIT_V(8);
            PG8_WAIT_L(0); PG8_BAR; if constexpr (!HM) { PG8_MMA(1, 0, At, B0); PG8_MMA(1, 1, At, B1); } PG8_BAR; PG8_SCHED;
            PG8_LDB(B0, 1, 0); PG8_LDB(B1, 1, 1); PG8_SCHED; PG8_LDA(At, 1, 0); if constexpr (!HM) PG8_STAGE(PG8_SA(0, 1), a2, v21);
            if constexpr (HM) PG8_WAIT_V(6); else PG8_WAIT_V(8); PG8_WAIT_L(0); PG8_BAR; PG8_MMA(0, 0, At, B0); PG8_MMA(0, 1, At, B1); PG8_BAR; PG8_SCHED;
            if constexpr (!HM) PG8_LDA(At, 1, 1); PG8_STAGE(PG8_SB(1, 0), b3, voffB); PG8_STAGE(PG8_SB(1, 1), b3 + hstep, voffB); PG8_STAGE(PG8_SA(1, 0), a3, v20);
            if constexpr (HM) PG8_WAIT_V(6); else PG8_WAIT_V(8);
            PG8_WAIT_L(0); PG8_BAR; if constexpr (!HM) { PG8_MMA(1, 0, At, B0); PG8_MMA(1, 1, At, B1); } PG8_BAR; PG8_SCHED;
        }
        if (wr == 0) PG8_BAR;
        prob.epi(acc, cur, wr, wc, fr, fq);
        if (!has_next) break;
#pragma unroll
        for (int a = 0; a < 2; ++a)
#pragma unroll
            for (int b = 0; b < 2; ++b)
#pragma unroll
                for (int m = 0; m < 4; ++m)
#pragma unroll
                    for (int n = 0; n < 2; ++n) acc[a][b][m][n] = (f32x4){0.f, 0.f, 0.f, 0.f};
        cur = nxt; cB = nB; ++ui; vC0[0] = vN0[0]; vC0[1] = vN0[1]; vC1[0] = vN1[0]; vC1[1] = vN1[1];
        if (wr == 1) PG8_BAR;
    }
    PG8_WAIT_V(0);
    PG8_BAR;
#undef PG8_SA
#undef PG8_SB
#undef PG8_STAGE
#undef PG8_LDA
#undef PG8_LDB
#undef PG8_MMA
#undef PG8_WAIT_V
#undef PG8_WAIT_L
#undef PG8_BAR
#undef PG8_SCHED
}

template <class P>
__device__ __forceinline__ void gemm_run_bf32(LAS unsigned char* lds, const P& prob) {
    const int tid = threadIdx.x, wid = __builtin_amdgcn_readfirstlane(tid >> 6), lane = tid & 63, wr = wid >> 2, wc = wid & 3, fr = lane & 15, fq = lane >> 4;
    constexpr int K = KD, nt = K / BK;
    constexpr size_t kstep = (size_t)(BK * 2);
    constexpr size_t ldwB = (size_t)P::LDW_BYTES;
    const unsigned ldsw = (unsigned)wid * 1024u;
    const int aoff = lds_byte(wr * 64 + fr, fq * 8), boff = lds_byte(wc * 32 + fr, fq * 8);
    const int wbo0 = lds_byte(32 * (lane >> 4) + ((lane & 1) | (((lane >> 3) & 1) << 2) | (((lane >> 2) & 1) << 3) | (((lane >> 1) & 1) << 4)), 8 * wid);
#define PG8_SA(b, h) (((b) * 2 + (h)) * HTB)
#define PG8_SB(b, h) ((4 + (b) * 2 + (h)) * HTB)
#define PG8_STAGE(bufoff, gbase, voff) do { _Pragma("unroll") for (int _i = 0; _i < 2; ++_i) \
        __builtin_amdgcn_global_load_lds((const unsigned*)((const char*)(gbase) + (voff)[_i]), (LAS unsigned*)(lds + (bufoff) + ldsw + _i * 8192), 16, 0, 0); } while (0)
#define PG8_LDA(dst, b, h) do { _Pragma("unroll") for (int m = 0; m < 4; ++m) _Pragma("unroll") for (int k = 0; k < 2; ++k) dst[m][k] = *(const LAS bf16x8*)(lds + PG8_SA(b, h) + aoff + m * 2048 + k * 1024); } while (0)
#define PG8_LDB(dst, b, h) do { _Pragma("unroll") for (int n = 0; n < 2; ++n) _Pragma("unroll") for (int k = 0; k < 2; ++k) dst[n][k] = *(const LAS bf16x8*)(lds + PG8_SB(b, h) + boff + n * 2048 + k * 1024); } while (0)
#define PG8_MMA(ai, bj, At, Bt) do { __builtin_amdgcn_s_setprio(1); _Pragma("unroll") for (int m = 0; m < 4; ++m) _Pragma("unroll") for (int n = 0; n < 2; ++n) _Pragma("unroll") for (int k = 0; k < 2; ++k) \
        acc[ai][bj][m][n] = __builtin_amdgcn_mfma_f32_16x16x32_bf16(Bt[n][k], At[m][k], acc[ai][bj][m][n], 0, 0, 0); __builtin_amdgcn_s_setprio(0); } while (0)
#define PG8_WAIT_V(n) asm volatile("s_waitcnt vmcnt(" #n ")" ::: "memory")
#define PG8_WAIT_L(n) asm volatile("s_waitcnt lgkmcnt(" #n ")" ::: "memory")
#define PG8_BAR __builtin_amdgcn_s_barrier()
#define PG8_SCHED __builtin_amdgcn_sched_barrier(0)
#define PG8_BLOAD(kk, h) do { const bool nx_ = (kk) >= nt; const unsigned so_ = (nx_ ? nBo : cBo) + (unsigned)((nx_ ? (kk) - nt : (kk)) * BK + 8 * wid) * (unsigned)ldwB + (unsigned)(h) * (unsigned)P::HALF_BYTES; \
        const unsigned co_ = nx_ ? nCol : cCol; \
        asm volatile("s_nop 4" ::: "memory"); \
        _Pragma("unroll") for (int j_ = 0; j_ < 4; ++j_) asm volatile("buffer_load_dwordx4 %0, %1, %2, %3 offen" : "=v"(bv[j_]) : "v"(co_), "s"(wrs), "s"(so_ + (unsigned)j_ * (unsigned)ldwB) : "memory"); } while (0)
#define PG8_BWAIT(n) asm volatile("s_waitcnt vmcnt(" #n ")" : "+v"(bv[0]), "+v"(bv[1]), "+v"(bv[2]), "+v"(bv[3]) :: "memory")
#define PG8_BWRITE(b, h) do { unsigned pk_[4][2]; _Pragma("unroll") for (int i_ = 0; i_ < 4; ++i_) { pk_[i_][0] = cvt_pk_bf16(bv[0][i_], bv[1][i_]); pk_[i_][1] = cvt_pk_bf16(bv[2][i_], bv[3][i_]); } \
        const bool od_ = (lane & 1) != 0; \
        _Pragma("unroll") for (int i_ = 0; i_ < 2; ++i_) { \
            const unsigned s0_ = od_ ? pk_[i_][0] : pk_[2 + i_][0], s1_ = od_ ? pk_[i_][1] : pk_[2 + i_][1]; \
            const unsigned k0_ = od_ ? pk_[2 + i_][0] : pk_[i_][0], k1_ = od_ ? pk_[2 + i_][1] : pk_[i_][1]; \
            const unsigned r0_ = (unsigned)__builtin_amdgcn_update_dpp(0, (int)s0_, 0xB1, 0xF, 0xF, true), r1_ = (unsigned)__builtin_amdgcn_update_dpp(0, (int)s1_, 0xB1, 0xF, 0xF, true); \
            u32x4 o_; o_.x = od_ ? r0_ : k0_; o_.y = od_ ? r1_ : k1_; o_.z = od_ ? k0_ : r0_; o_.w = od_ ? k1_ : r1_; \
            *(LAS u32x4*)(lds + PG8_SB(b, h) + wbo0 + 128 * i_) = o_; } } while (0)
    typedef float f32x2v __attribute__((ext_vector_type(2)));
    Unit cur, nxt; int ui = 0;
    if (!prob.next(0, cur)) return;
    f32x4 acc[2][2][4][2];
    bf16x8 At[4][2], B0[2][2], B1[2][2];
    f32x4 bv[4];
    unsigned vC0[2], vC1[2], vN0[2], vN1[2];
    prob.a_off(cur, vC0, vC1);
    const char* const Ab = prob.a_base();
    const __amdgpu_buffer_rsrc_t wrs = __builtin_amdgcn_make_buffer_rsrc((void*)prob.W, 0, (unsigned)NE * (unsigned)P::W_BYTES, 0x00020000);
    unsigned cBo = (unsigned)cur.e * (unsigned)P::W_BYTES, cCol = prob.b_col(cur, lane & ~1) + (unsigned)(lane & 1) * 4u * (unsigned)ldwB;
    unsigned nBo = cBo, nCol = cCol;
    PG8_BLOAD(0, 0); PG8_BWAIT(0); PG8_BWRITE(0, 0); PG8_BLOAD(0, 1); PG8_BWAIT(0); PG8_BWRITE(0, 1); PG8_BLOAD(1, 0); PG8_BWAIT(0); PG8_BWRITE(1, 0); PG8_BLOAD(1, 1);
    PG8_STAGE(PG8_SA(0, 0), Ab, vC0); PG8_STAGE(PG8_SA(0, 1), Ab, vC1);
    if (wr == 1) PG8_BAR;
    PG8_WAIT_V(2); PG8_WAIT_L(0); PG8_BAR;
    PG8_STAGE(PG8_SA(1, 0), Ab + kstep, vC0);
    { f32x4 bini[2][2]; prob.bias_load(cur, wc, fq, bini);
#pragma unroll
      for (int a = 0; a < 2; ++a)
#pragma unroll
        for (int b = 0; b < 2; ++b)
#pragma unroll
            for (int m = 0; m < 4; ++m)
#pragma unroll
                for (int n = 0; n < 2; ++n) acc[a][b][m][n] = bini[b][n]; }
    PG8_WAIT_V(0); PG8_BAR;
    for (;;) {
        const bool has_next = prob.next(ui + 1, nxt);
        if (has_next) { prob.a_off(nxt, vN0, vN1); nBo = (unsigned)nxt.e * (unsigned)P::W_BYTES; nCol = prob.b_col(nxt, lane & ~1) + (unsigned)(lane & 1) * 4u * (unsigned)ldwB; }
        else { vN0[0] = vC0[0]; vN0[1] = vC0[1]; vN1[0] = vC1[0]; vN1[1] = vC1[1]; nBo = cBo; nCol = cCol; }
        for (int t = 0; t < nt; t += 2) {
            const bool last = (t == nt - 2);
            const char* a1 = Ab + (size_t)(t + 1) * kstep;
            const char* a2 = last ? Ab : Ab + (size_t)(t + 2) * kstep;
            const char* a3 = a2 + kstep;
            unsigned v20[2], v21[2];
            v20[0] = last ? vN0[0] : vC0[0]; v20[1] = last ? vN0[1] : vC0[1]; v21[0] = last ? vN1[0] : vC1[0]; v21[1] = last ? vN1[1] : vC1[1];
            PG8_LDB(B0, 0, 0); PG8_LDB(B1, 0, 1); PG8_SCHED; PG8_LDA(At, 0, 0); PG8_BWAIT(2); PG8_BWRITE(1, 1); PG8_BLOAD(t + 2, 0); PG8_STAGE(PG8_SA(1, 1), a1, vC1);
            PG8_WAIT_V(12); PG8_WAIT_L(0); PG8_BAR; PG8_MMA(0, 0, At, B0); PG8_MMA(0, 1, At, B1); PG8_BAR; PG8_SCHED;
            PG8_LDA(At, 0, 1); PG8_BWAIT(2); PG8_BWRITE(0, 0); PG8_BLOAD(t + 2, 1); PG8_STAGE(PG8_SA(0, 0), a2, v20);
            PG8_WAIT_V(12); PG8_WAIT_L(0); PG8_BAR; PG8_MMA(1, 0, At, B0); PG8_MMA(1, 1, At, B1); PG8_BAR; PG8_SCHED;
            PG8_LDB(B0, 1, 0); PG8_LDB(B1, 1, 1); PG8_SCHED; PG8_LDA(At, 1, 0); PG8_BWAIT(2); PG8_BWRITE(0, 1); PG8_BLOAD(t + 3, 0); PG8_STAGE(PG8_SA(0, 1), a2, v21);
            PG8_WAIT_V(12); PG8_WAIT_L(0); PG8_BAR; PG8_MMA(0, 0, At, B0); PG8_MMA(0, 1, At, B1); PG8_BAR; PG8_SCHED;
            PG8_LDA(At, 1, 1); PG8_BWAIT(2); PG8_BWRITE(1, 0); PG8_BLOAD(t + 3, 1); PG8_STAGE(PG8_SA(1, 0), a3, v20);
            PG8_WAIT_V(12); PG8_WAIT_L(0); PG8_BAR; PG8_MMA(1, 0, At, B0); PG8_MMA(1, 1, At, B1); PG8_BAR; PG8_SCHED;
        }
        if (wr == 0) PG8_BAR;
        prob.epi(acc, cur, wr, wc, fr, fq, 0);
        if (has_next) { f32x4 bini[2][2]; prob.bias_load(nxt, wc, fq, bini);
#pragma unroll
            for (int b = 0; b < 2; ++b)
#pragma unroll
                for (int m = 0; m < 4; ++m)
#pragma unroll
                    for (int n = 0; n < 2; ++n) acc[0][b][m][n] = bini[b][n]; }
        prob.epi(acc, cur, wr, wc, fr, fq, 1);
        if (!has_next) break;
#pragma unroll
        for (int b = 0; b < 2; ++b)
#pragma unroll
            for (int m = 0; m < 4; ++m)
#pragma unroll
                for (int n = 0; n < 2; ++n) acc[1][b][m][n] = acc[0][b][m][n];
        cur = nxt; cBo = nBo; cCol = nCol; ++ui; vC0[0] = vN0[0]; vC0[1] = vN0[1]; vC1[0] = vN1[0]; vC1[1] = vN1[1];
        if (wr == 1) PG8_BAR;
    }
    PG8_BWAIT(0);
    PG8_BAR;
#undef PG8_SA
#undef PG8_SB
#undef PG8_STAGE
#undef PG8_LDA
#undef PG8_LDB
#undef PG8_MMA
#undef PG8_WAIT_V
#undef PG8_WAIT_L
#undef PG8_BAR
#undef PG8_SCHED
#undef PG8_BLOAD
#undef PG8_BWAIT
#undef PG8_BWRITE
}
}

constexpr int NWAVES = 8, NTHR = 512;
constexpr int RING_BYTES = 131072;
constexpr int TAB_OFF = 147968;
constexpr int MISC_OFF = 163840 - 256;
constexpr int LDS_BYTES = 163840;

struct Frame {
    LAS unsigned char* lds; volatile LAS unsigned* MISC; unsigned* ctl;
    int tid, lane, wave, vcu, G;
    const float *x, *c, *w_ada, *b_ada, *g1, *w_in, *lq1, *lk1, *lq2, *lk2, *subln, *relb, *cw, *cb, *clg, *clb, *w_out, *g2, *w_r, *b_r, *w_gu, *b_gu, *w_d, *b_d, *fg;
    float* out; unsigned char* ws;
};
#define WSP(T_, off) ((T_*)(F.ws + (off)))

__device__ __forceinline__ void p0_transpose_item(const float* W, int ldn, int n0, int k0, bf16* dst, int drow0, LAS unsigned char* scr, int lane) {
    const int ng = lane & 31, kh = lane >> 5;
#pragma unroll
    for (int it = 0; it < 4; ++it) {
        f32x4 v[8];
#pragma unroll
        for (int j = 0; j < 8; ++j) v[j] = *(const GAS f32x4*)(W + (size_t)(k0 + 16 * it + 8 * kh + j) * ldn + n0 + 4 * ng);
        const int kc = 2 * it + kh;
#pragma unroll
        for (int i = 0; i < 4; ++i) { const int n = 4 * ng + i;
            u32x4 o; o.x = pk2(v[0][i], v[1][i]); o.y = pk2(v[2][i], v[3][i]); o.z = pk2(v[4][i], v[5][i]); o.w = pk2(v[6][i], v[7][i]);
            *(LAS u32x4*)(scr + n * 128 + ((kc ^ (ng & 7)) << 4)) = o; }
    }
    LDS_WAIT(); asm volatile("" ::: "memory");
#pragma unroll
    for (int j = 0; j < 16; ++j) { const int n = 8 * j + (lane >> 3), c = lane & 7;
        const u32x4 o = *(const LAS u32x4*)(scr + n * 128 + ((c ^ ((n >> 2) & 7)) << 4));
        *(GAS u32x4*)(dst + (size_t)(drow0 + n) * pg8::KD + k0 + 8 * c) = o; }
    LDS_WAIT(); asm volatile("" ::: "memory");
}
__device__ __forceinline__ void p0_prologue(Frame& F) {
    const int gw = F.vcu * NWAVES + F.wave, NGW = F.G * NWAVES, gt = F.vcu * NTHR + F.tid, NGT = F.G * NTHR;
    LAS float* cs = (LAS float*)(F.lds);
    for (int i = F.tid; i < NB * DM; i += NTHR) cs[i] = silu_f(F.c[i]);
    __syncthreads();
    float* modp = WSP(float, WS_MODP);
    for (int it = gw; it < 192 * 8; it += NGW) {
        const int cc = it % 192, kc = it / 192, r = F.lane >> 4, g = F.lane & 15;
        float acc[4][4];
#pragma unroll
        for (int b = 0; b < 4; ++b)
#pragma unroll
            for (int j = 0; j < 4; ++j) acc[b][j] = 0.f;
        const float* wp = F.w_ada + (size_t)(kc * 256 + r) * (6 * DM) + cc * 64 + g * 4;
#pragma unroll 8
        for (int s = 0; s < 64; ++s) {
            const f32x4 w = *(const GAS f32x4*)(wp + (size_t)(4 * s) * (6 * DM)); const int k = kc * 256 + 4 * s + r;
#pragma unroll
            for (int b = 0; b < 4; ++b) { const float cv = cs[b * DM + k];
#pragma unroll
                for (int j = 0; j < 4; ++j) acc[b][j] += cv * w[j]; }
        }
#pragma unroll
        for (int b = 0; b < 4; ++b)
#pragma unroll
            for (int j = 0; j < 4; ++j) { float v = acc[b][j]; v += __shfl_xor(v, 16); v += __shfl_xor(v, 32); acc[b][j] = v; }
        if (F.lane < 16)
#pragma unroll
            for (int b = 0; b < 4; ++b) *(GAS f32x4*)(modp + (size_t)(kc * 4 + b) * (6 * DM) + cc * 64 + g * 4) = (f32x4){acc[b][0], acc[b][1], acc[b][2], acc[b][3]};
    }
    __syncthreads();
    LAS unsigned char* scr = F.lds + F.wave * 16384;
    constexpr int I_IN = (INC / 128) * 32, I_OUT = (DM / 128) * 32;
    for (int it = gw; it < I_IN + I_OUT; it += NGW) {
        int r = it;
        if (r < I_IN) { const int nb = r >> 5, kb = r & 31; p0_transpose_item(F.w_in, INC, nb * 128, kb * 64, WSP(bf16, WS_WIN), nb * 128, scr, F.lane); continue; } r -= I_IN;
        { const int nb = r >> 5, kb = r & 31; p0_transpose_item(F.w_out, DM, nb * 128, kb * 64, WSP(bf16, WS_WOUT), nb * 128, scr, F.lane); }
    }
    for (int i = gt; i < 64 * 2 * 64; i += NGT) {
        const int l = i & 63, nb = (i >> 6) & 1, s = i >> 7, e = 16 * nb + (l & 15), kb = 32 * s + 8 * (l >> 4);
        unsigned hi[8], lo[8];
#pragma unroll
        for (int j = 0; j < 8; ++j) { const float w = F.w_r[(size_t)(kb + j) * NE + e]; hi[j] = f2bf(w); lo[j] = f2bf(w - bf2f(hi[j])); }
        u32x4 oh, ol; oh.x = hi[0] | (hi[1] << 16); oh.y = hi[2] | (hi[3] << 16); oh.z = hi[4] | (hi[5] << 16); oh.w = hi[6] | (hi[7] << 16);
        ol.x = lo[0] | (lo[1] << 16); ol.y = lo[2] | (lo[3] << 16); ol.z = lo[4] | (lo[5] << 16); ol.w = lo[6] | (lo[7] << 16);
        *(GAS u32x4*)(WSP(unsigned char, WS_WRF) + (size_t)i * 16) = oh; *(GAS u32x4*)(WSP(unsigned char, WS_WRF) + 131072 + (size_t)i * 16) = ol;
    }
    float* bt = WSP(float, WS_BIAST);
    for (int i = gt; i < AH * 4096; i += NGT) { const int h = i >> 12, rel = (i & 4095) - 2048; bt[i] = F.relb[t5_bucket(rel) * AH + h] * LOG2E; }
    if (gt == 0) { float a = 0.f, b = 0.f; for (int i = 0; i < HD; ++i) { a += F.lq1[i] * F.lk1[i]; b += F.lq2[i] * F.lk2[i]; } bt[AH * 4096] = __expf(a) - __expf(b) + 0.2f; }
}

__device__ __forceinline__ void p1_norm1(Frame& F) {
    const float* modp = WSP(float, WS_MODP); float* mod = WSP(float, WS_MOD);
    for (int o = F.vcu * NTHR + F.tid; o < NB * 6 * DM; o += F.G * NTHR) { float s = F.b_ada[o % (6 * DM)];
#pragma unroll
        for (int kc = 0; kc < 8; ++kc) s += modp[(size_t)kc * (NB * 6 * DM) + o];
        mod[o] = s; }
    LAS float* gm = (LAS float*)F.lds; LAS float* sh = gm + DM;
    bf16* h = WSP(bf16, WS_H);
    for (int rb = F.vcu; rb < T / 32; rb += F.G) {
        const int b = rb / (SEQ / 32);
        __syncthreads();
        for (int k = F.tid; k < DM; k += NTHR) { float sc = F.b_ada[DM + k], sf = F.b_ada[k];
#pragma unroll
            for (int kc = 0; kc < 8; ++kc) { sc += modp[(size_t)(kc * 4 + b) * (6 * DM) + DM + k]; sf += modp[(size_t)(kc * 4 + b) * (6 * DM) + k]; }
            gm[k] = F.g1[k] * (1.f + sc); sh[k] = sf; }
        __syncthreads();
        for (int rr = F.wave; rr < 32; rr += NWAVES) {
            const int row = rb * 32 + rr;
            const GAS f32x4* xr = (const GAS f32x4*)(F.x + (size_t)row * DM) + F.lane;
            f32x4 v[8]; float s = 0.f;
#pragma unroll
            for (int j = 0; j < 8; ++j) { v[j] = xr[64 * j]; s += (v[j].x * v[j].x + v[j].y * v[j].y) + (v[j].z * v[j].z + v[j].w * v[j].w); }
            const float rstd = rsqrtf(wave_sum(s) * (1.f / DM) + EPS);
            GAS u32x2* o8 = (GAS u32x2*)(h + (size_t)row * DM) + F.lane;
#pragma unroll
            for (int j = 0; j < 8; ++j) { const int k = 4 * F.lane + 256 * j; const f32x4 g = *(const LAS f32x4*)(gm + k), s4 = *(const LAS f32x4*)(sh + k);
                u32x2 w; w.x = pk2(v[j].x * rstd * g.x + s4.x, v[j].y * rstd * g.y + s4.y); w.y = pk2(v[j].z * rstd * g.z + s4.z, v[j].w * rstd * g.w + s4.w); o8[64 * j] = w; }
        }
    }
}

template <bool HMT> struct InProjT {
    static constexpr bool PERM = true;
    const bf16* A; const bf16* Bt; bf16* O; pg8::DenseOrder ord;
    __device__ bool next(int i, pg8::Unit& u) const { return ord.next(i, u); }
    __device__ const char* a_base() const { return (const char*)A; }
    __device__ void a_off(const pg8::Unit& u, const int (&R)[2], const int (&C)[2], unsigned (&v0)[2], unsigned (&v1)[2]) const {
#pragma unroll
        for (int i = 0; i < 2; ++i) { v0[i] = (unsigned)((u.pm * u.rows + R[i]) * pg8::KD + C[i]) * 2u; v1[i] = (unsigned)((u.pm * u.rows + 128 + R[i]) * pg8::KD + C[i]) * 2u; } }
    __device__ const char* b_base(const pg8::Unit& u) const { return (const char*)(Bt + (size_t)u.pn * 256 * pg8::KD); }
    __device__ void epi(const f32x4 (&acc)[2][2][4][2], const pg8::Unit& u, int wr, int wc, int fr, int fq) const {
        const int row0 = u.pm * u.rows + wr * 64 + fr, col0 = u.pn * 256 + wc * 32 + 8 * fq;
#pragma unroll
        for (int ai = 0; ai < (HMT ? 1 : 2); ++ai)
#pragma unroll
            for (int m = 0; m < 4; ++m) { bf16* rowp = O + (size_t)(row0 + ai * 128 + m * 16) * INC + col0;
#pragma unroll
                for (int bj = 0; bj < 2; ++bj) { const f32x4 v0 = acc[ai][bj][m][0], v1 = acc[ai][bj][m][1];
                    u32x4 w; w.x = cvt_pk_bf16(v0[0], v0[1]); w.y = cvt_pk_bf16(v0[2], v0[3]); w.z = cvt_pk_bf16(v1[0], v1[1]); w.w = cvt_pk_bf16(v1[2], v1[3]);
                    *(GAS u32x4*)(rowp + bj * 128) = w; } }
    }
};
struct OutProj {
    static constexpr bool PERM = false;
    const bf16* A; const bf16* Bt; const float* x; const float* mod; float* O; pg8::DenseOrder ord;
    __device__ bool next(int i, pg8::Unit& u) const { return ord.next(i, u); }
    __device__ const char* a_base() const { return (const char*)A; }
    __device__ void a_off(const pg8::Unit& u, const int (&R)[2], const int (&C)[2], unsigned (&v0)[2], unsigned (&v1)[2]) const {
#pragma unroll
        for (int i = 0; i < 2; ++i) { v0[i] = (unsigned)((u.pm * 256 + R[i]) * pg8::KD + C[i]) * 2u; v1[i] = (unsigned)((u.pm * 256 + 128 + R[i]) * pg8::KD + C[i]) * 2u; } }
    __device__ const char* b_base(const pg8::Unit& u) const { return (const char*)(Bt + (size_t)u.pn * 256 * pg8::KD); }
    __device__ void epi(const f32x4 (&acc)[2][2][4][2], const pg8::Unit& u, int wr, int wc, int fr, int fq) const {
        const int row0 = u.pm * 256 + wr * 64 + fr, col0 = u.pn * 256 + wc * 32 + 4 * fq, b = (u.pm * 256) / SEQ;
        f32x4 gt[2][2];
#pragma unroll
        for (int bj = 0; bj < 2; ++bj)
#pragma unroll
            for (int n = 0; n < 2; ++n) gt[bj][n] = *(const GAS f32x4*)(mod + (size_t)b * 6 * DM + 2 * DM + col0 + bj * 128 + 16 * n);
#pragma unroll
        for (int ai = 0; ai < 2; ++ai)
#pragma unroll
            for (int m = 0; m < 4; ++m) { const size_t ro = (size_t)(row0 + ai * 128 + m * 16) * DM + col0;
#pragma unroll
                for (int bj = 0; bj < 2; ++bj)
#pragma unroll
                    for (int n = 0; n < 2; ++n) { const f32x4 xv = *(const GAS f32x4*)(x + ro + bj * 128 + 16 * n);
                        *(GAS f32x4*)(O + ro + bj * 128 + 16 * n) = xv + gt[bj][n] * acc[ai][bj][m][n]; } }
    }
};
struct MoeTab { const LAS int* tp; const LAS int* off; const LAS int* cnt; };
__device__ __forceinline__ void moe_tables(Frame& F) {
    LAS int* tab = (LAS int*)(F.lds + TAB_OFF);
    __syncthreads();
    if (F.tid == 0) { int tp = 0, off = 0; for (int e = 0; e < NE; ++e) { const int c = (int)__hip_atomic_load(F.ctl + CW_CNT + e, __ATOMIC_RELAXED, __HIP_MEMORY_SCOPE_AGENT);
            tab[e] = tp; tab[40 + e] = off; tab[80 + e] = c; tp += (c + 255) >> 8; off += c; } tab[NE] = tp; tab[40 + NE] = off; }
    __syncthreads();
}
template <int NTN, int REPF>
__device__ __forceinline__ bool moe_next(const MoeTab& tb, int G, int c, int i, pg8::Unit& u) {
    int L = i * G + c; const int total = NTN * __builtin_amdgcn_readfirstlane(tb.tp[NE]); if (L >= total * REPF) return false;
    if (REPF > 1 && L >= total) L -= total;
    int e = 0;
#pragma unroll
    for (int j = 1; j < NE; ++j) e += (L >= NTN * tb.tp[j]) ? 1 : 0;
    e = __builtin_amdgcn_readfirstlane(e);
    const int tpe = __builtin_amdgcn_readfirstlane(tb.tp[e]), tpe1 = __builtin_amdgcn_readfirstlane(tb.tp[e + 1]);
    const int local = L - NTN * tpe, nte = tpe1 - tpe;
    u.e = e; u.pn = __builtin_amdgcn_readfirstlane(local / nte); u.pm = local - u.pn * nte; u.rows = __builtin_amdgcn_readfirstlane(tb.cnt[e]) - 256 * u.pm; return true;
}
struct MoeGU {
    static constexpr bool PERM = true;
    const bf16* A; const float* W; const float* bias; const int* list; bf16* O; MoeTab tb; int G, c;
    __device__ bool next(int i, pg8::Unit& u) const { return moe_next<16, 1 + ((REP_MASK >> 11) & 1)>(tb, G, c, i, u); }
    __device__ const char* a_base() const { return (const char*)A; }
    __device__ void a_off(const pg8::Unit& u, unsigned (&v0)[2], unsigned (&v1)[2]) const {
        const int* lp = list + u.e * T + 256 * u.pm;
        int tb16 = (int)threadIdx.x * 16; asm volatile("" : "+v"(tb16));
#pragma unroll
        for (int i = 0; i < 2; ++i) { int R, C; pg8::stage_rc(tb16 + i * 8192, R, C);
            const int r0 = R < u.rows ? R : u.rows - 1, r1 = (128 + R) < u.rows ? (128 + R) : u.rows - 1;
            v0[i] = (unsigned)(lp[r0] * pg8::KD + C) * 2u; v1[i] = (unsigned)(lp[r1] * pg8::KD + C) * 2u; } }
    __device__ void bias_load(const pg8::Unit& u, int wc, int fq, f32x4 (&bi)[2][2]) const {
        int cb = wc * 32 + 8 * ((fq >> 1) + 2 * (fq & 1)); asm volatile("" : "+v"(cb));
        const float* bp = bias + (size_t)u.e * 2 * DFF + u.pn * 128 + cb;
#pragma unroll
        for (int bj = 0; bj < 2; ++bj)
#pragma unroll
            for (int n = 0; n < 2; ++n) { const f32x4 t = *(const GAS f32x4*)(bp + bj * DFF + 4 * n); bi[bj][n] = (f32x4){t[0], t[2], t[1], t[3]}; } }
    static constexpr int LDW_BYTES = 2 * DFF * 4, W_BYTES = DM * 2 * DFF * 4;
    __device__ const char* b_ptr(const pg8::Unit& u) const { return (const char*)(W + (size_t)u.e * DM * 2 * DFF); }
    static constexpr int HALF_BYTES = DFF * 4;
    __device__ unsigned b_col(const pg8::Unit& u, int lane) const { return (unsigned)(u.pn * 128 + 2 * lane) * 4u; }
    __device__ void epi(const f32x4 (&acc)[2][2][4][2], const pg8::Unit& u, int wr, int wc, int fr, int fq, const int ai) const {
        int rt0 = wr * 64 + fr, colt = u.pn * 128 + wc * 32 + 8 * ((fq >> 1) + 2 * (fq & 1)); asm volatile("" : "+v"(rt0), "+v"(colt)); const size_t slot0 = (size_t)__builtin_amdgcn_readfirstlane(tb.off[u.e]) + 256 * u.pm;
#pragma unroll
            for (int m = 0; m < 4; ++m) { const int rt = rt0 + ai * 128 + m * 16; float r[8];
#pragma unroll
                for (int n = 0; n < 2; ++n)
#pragma unroll
                    for (int j = 0; j < 4; ++j) { const int o = (j >> 1) + 2 * (j & 1) + 4 * n;
                        float g = acc[ai][0][m][n][j], up = acc[ai][1][m][n][j];
                        g = fminf(g, 7.f); up = fminf(fmaxf(up, -7.f), 7.f);
                        r[o] = (up + 1.f) * g * __builtin_amdgcn_rcpf(1.f + __builtin_amdgcn_exp2f(-1.702f * LOG2E * g)); }
                if (rt < u.rows) { u32x4 w; w.x = cvt_pk_bf16(r[0], r[1]); w.y = cvt_pk_bf16(r[2], r[3]); w.z = cvt_pk_bf16(r[4], r[5]); w.w = cvt_pk_bf16(r[6], r[7]);
                    *(GAS u32x4*)(O + (slot0 + rt) * DFF + colt) = w; } }
    }
};
struct MoeDown {
    static constexpr bool PERM = true;
    const bf16* A; const float* W; const float* bias; const float* sw; bf16* O; MoeTab tb; int G, c;
    __device__ bool next(int i, pg8::Unit& u) const { return moe_next<8, 1 + ((REP_MASK >> 12) & 1)>(tb, G, c, i, u); }
    __device__ const char* a_base() const { return (const char*)A; }
    __device__ void a_off(const pg8::Unit& u, unsigned (&v0)[2], unsigned (&v1)[2]) const {
        const int s0 = __builtin_amdgcn_readfirstlane(tb.off[u.e]) + 256 * u.pm;
        int tb16 = (int)threadIdx.x * 16; asm volatile("" : "+v"(tb16));
#pragma unroll
        for (int i = 0; i < 2; ++i) { int R, C; pg8::stage_rc(tb16 + i * 8192, R, C);
            v0[i] = (unsigned)((s0 + R) * pg8::KD + C) * 2u; v1[i] = (unsigned)((s0 + 128 + R) * pg8::KD + C) * 2u; } }
    __device__ void bias_load(const pg8::Unit& u, int wc, int fq, f32x4 (&bi)[2][2]) const {
        int cb = wc * 32 + 8 * ((fq >> 1) + 2 * (fq & 1)); asm volatile("" : "+v"(cb));
        const float* bp = bias + (size_t)u.e * DM + u.pn * 256 + cb;
#pragma unroll
        for (int bj = 0; bj < 2; ++bj)
#pragma unroll
            for (int n = 0; n < 2; ++n) { const f32x4 t = *(const GAS f32x4*)(bp + bj * 128 + 4 * n); bi[bj][n] = (f32x4){t[0], t[2], t[1], t[3]}; } }
    static constexpr int LDW_BYTES = DM * 4, W_BYTES = DFF * DM * 4;
    __device__ const char* b_ptr(const pg8::Unit& u) const { return (const char*)(W + (size_t)u.e * DFF * DM); }
    static constexpr int HALF_BYTES = 128 * 4;
    __device__ unsigned b_col(const pg8::Unit& u, int lane) const { return (unsigned)(u.pn * 256 + 2 * lane) * 4u; }
    __device__ void epi(const f32x4 (&acc)[2][2][4][2], const pg8::Unit& u, int wr, int wc, int fr, int fq, const int ai) const {
        int rt0 = wr * 64 + fr, col0 = u.pn * 256 + wc * 32 + 8 * ((fq >> 1) + 2 * (fq & 1)); asm volatile("" : "+v"(rt0), "+v"(col0)); const size_t slot0 = (size_t)__builtin_amdgcn_readfirstlane(tb.off[u.e]) + 256 * u.pm;
#pragma unroll
            for (int m = 0; m < 4; ++m) { const int rt = rt0 + ai * 128 + m * 16;
                if (rt < u.rows) { const float wgt = sw[(size_t)u.e * T + 256 * u.pm + rt]; bf16* rowp = O + (slot0 + rt) * DM + col0;
#pragma unroll
                    for (int bj = 0; bj < 2; ++bj) { float r[8];
#pragma unroll
                        for (int n = 0; n < 2; ++n)
#pragma unroll
                            for (int j = 0; j < 4; ++j) { const int o = (j >> 1) + 2 * (j & 1) + 4 * n; r[o] = acc[ai][bj][m][n][j] * wgt; }
                        u32x4 w; w.x = cvt_pk_bf16(r[0], r[1]); w.y = cvt_pk_bf16(r[2], r[3]); w.z = cvt_pk_bf16(r[4], r[5]); w.w = cvt_pk_bf16(r[6], r[7]);
                        *(GAS u32x4*)(rowp + bj * 128) = w; } } }
    }
};

__device__ __forceinline__ void conv_unit(Frame& F, int ct) {
    const int b = ct / (SEQ / 32), s0 = (ct % (SEQ / 32)) * 32, tid = F.tid;
    const bf16* proj = WSP(bf16, WS_PROJ); bf16* mix = WSP(bf16, WS_MIX);
    LAS unsigned* z = (LAS unsigned*)F.lds;
    LAS float* st = (LAS float*)(F.lds + 126976);
    __syncthreads();
#pragma unroll 8
    for (int r = 0; r < 62; ++r) { const int s = s0 - 15 + r; const bool ok = (s >= 0 && s < SEQ); const int sc = ok ? s : 0;
        const bf16* pr = proj + (size_t)(b * SEQ + sc) * INC + 3072 + 2 * tid; const unsigned a = *(const GAS unsigned*)pr, g = *(const GAS unsigned*)(pr + 1024);
        const float a0 = bf2f(a & 0xffffu), a1 = bf2f(a >> 16), g0 = bf2f(g & 0xffffu), g1 = bf2f(g >> 16);
        const unsigned zz = pk2(a0 * __builtin_amdgcn_rcpf(1.f + __builtin_amdgcn_exp2f(-LOG2E * g0)), a1 * __builtin_amdgcn_rcpf(1.f + __builtin_amdgcn_exp2f(-LOG2E * g1)));
        z[r * 512 + tid] = ok ? zz : 0u; }
    typedef float f32x2c __attribute__((ext_vector_type(2)));
    float w0[CK], w1[CK];
#pragma unroll
    for (int j = 0; j < CK; ++j) { const f32x2c w = *(const GAS f32x2c*)(F.cw + j * CCH + 2 * tid); w0[j] = w.x; w1[j] = w.y; }
    const f32x2c cbv = *(const GAS f32x2c*)(F.cb + 2 * tid), lg = *(const GAS f32x2c*)(F.clg + 2 * tid), lb = *(const GAS f32x2c*)(F.clb + 2 * tid);
    __syncthreads();
#pragma unroll 1
    for (int hf = 0; hf < 2; ++hf) {
        float c0[16], c1[16];
#pragma unroll
        for (int g = 0; g < 4; ++g) {
            float zl[34], zh[34];
#pragma unroll
            for (int r = 0; r < 34; ++r) { const unsigned zz = z[(16 * hf + 4 * g + r) * 512 + tid]; zl[r] = __builtin_bit_cast(float, zz << 16); zh[r] = __builtin_bit_cast(float, zz & 0xffff0000u); }
#pragma unroll
            for (int t = 0; t < 4; ++t) { float a0 = cbv.x, a1 = cbv.y;
#pragma unroll
                for (int j = 0; j < CK; ++j) { a0 = fmaf(w0[j], zl[t + j], a0); a1 = fmaf(w1[j], zh[t + j], a1); }
                c0[4 * g + t] = a0; c1[4 * g + t] = a1; }
        }
#pragma unroll
        for (int t = 0; t < 16; ++t) { const float sm = wave_sum(c0[t] + c1[t]), q = wave_sum(c0[t] * c0[t] + c1[t] * c1[t]);
            if (F.lane == 0) { st[(F.wave * 16 + t) * 2] = sm; st[(F.wave * 16 + t) * 2 + 1] = q; } }
        __syncthreads();
        if (tid < 16) { float sm = 0.f, q = 0.f;
#pragma unroll
            for (int w = 0; w < 8; ++w) { sm += st[(w * 16 + tid) * 2]; q += st[(w * 16 + tid) * 2 + 1]; }
            const float mu = sm * (1.f / CCH), var = q * (1.f / CCH) - mu * mu; st[512 + tid * 2] = mu; st[512 + tid * 2 + 1] = rsqrtf(fmaxf(var, 0.f) + EPS); }
        __syncthreads();
#pragma unroll
        for (int t = 0; t < 16; ++t) { const float mu = st[512 + t * 2], rs = st[512 + t * 2 + 1];
            const float y0 = (c0[t] - mu) * rs * lg.x + lb.x, y1 = (c1[t] - mu) * rs * lg.y + lb.y;
            const float o0 = y0 * __builtin_amdgcn_rcpf(1.f + __builtin_amdgcn_exp2f(-LOG2E * y0)), o1 = y1 * __builtin_amdgcn_rcpf(1.f + __builtin_amdgcn_exp2f(-LOG2E * y1));
            *(GAS unsigned*)(mix + (size_t)(b * SEQ + s0 + 16 * hf + t) * DM + 1024 + 2 * tid) = cvt_pk_bf16(o0, o1); }
        __syncthreads();
    }
}

namespace att {
constexpr int KVBLK = 64; constexpr size_t SHM_V = KVBLK * 128 * 2, SHM_K = KVBLK * 128 * 2;
constexpr float C = 0.125f * LOG2E, THR2 = 8.f * LOG2E;
#define KSWZ(row, colB) ((row) * 256 + ((colB) ^ (((row) & 7) << 4)))
#define SBAR() __builtin_amdgcn_sched_barrier(0)
__device__ __forceinline__ int crow(int r, int hi) { return (r & 3) + 8 * (r >> 2) + 4 * hi; }
__device__ __forceinline__ int v_st(int k, int c) { const int kk = (k & ~0xC) | ((k & 4) << 1) | ((k & 8) >> 1); return ((kk >> 3) * 4 + (c >> 5)) * 512 + ((kk & 7) * 32 + (c & 31)) * 2; }
__device__ __forceinline__ int v_rd_base(int lane) { return ((lane & 3) << 3) | (((lane >> 2) & 3) << 6) | (((lane >> 4) & 1) << 5) | (((lane >> 5) & 1) << 8); }
constexpr int v_rd_off(int d0, int ks, int half) { return d0 * 512 + ks * 4096 + half * 2048; }
template <int OFF> __device__ __forceinline__ s16x4 tr_read(int vb) { s16x4 r; asm volatile("ds_read_b64_tr_b16 %0, %1 offset:%2" : "=&v"(r) : "v"(vb), "i"(OFF) : "memory"); return r; }
template <int D0> __device__ __forceinline__ void pv_one(f32x16& od, int vb, bf16x8 pa0, bf16x8 pa1, bf16x8 pa2, bf16x8 pa3) {
    const s16x4 l0 = tr_read<v_rd_off(D0, 0, 0)>(vb), h0 = tr_read<v_rd_off(D0, 0, 1)>(vb), l1 = tr_read<v_rd_off(D0, 1, 0)>(vb), h1 = tr_read<v_rd_off(D0, 1, 1)>(vb);
    const s16x4 l2 = tr_read<v_rd_off(D0, 2, 0)>(vb), h2 = tr_read<v_rd_off(D0, 2, 1)>(vb), l3 = tr_read<v_rd_off(D0, 3, 0)>(vb), h3 = tr_read<v_rd_off(D0, 3, 1)>(vb);
    asm volatile("s_waitcnt lgkmcnt(0)" ::: "memory"); SBAR();
#define PK(L, H) (bf16x8){L[0], L[1], L[2], L[3], H[0], H[1], H[2], H[3]}
    od = __builtin_amdgcn_mfma_f32_32x32x16_bf16(pa0, PK(l0, h0), od, 0, 0, 0);
    od = __builtin_amdgcn_mfma_f32_32x32x16_bf16(pa1, PK(l1, h1), od, 0, 0, 0);
    od = __builtin_amdgcn_mfma_f32_32x32x16_bf16(pa2, PK(l2, h2), od, 0, 0, 0);
    od = __builtin_amdgcn_mfma_f32_32x32x16_bf16(pa3, PK(l3, h3), od, 0, 0, 0);
#undef PK
}
__device__ __forceinline__ void pv_d0(f32x16* o, int vb, bf16x8 pa0, bf16x8 pa1, bf16x8 pa2, bf16x8 pa3) {
    pv_one<0>(o[0], vb, pa0, pa1, pa2, pa3); pv_one<1>(o[1], vb, pa0, pa1, pa2, pa3); pv_one<2>(o[2], vb, pa0, pa1, pa2, pa3); pv_one<3>(o[3], vb, pa0, pa1, pa2, pa3);
}
__device__ __forceinline__ void qkt(f32x16& p0, f32x16& p1, const LAS char* Ks, const bf16x8* qr, int r32, int hi, int map) {
    p0 = f32x16{}; p1 = f32x16{};
#pragma unroll
    for (int d0 = 0; d0 < 4; ++d0) { const int cb = ((map * 4 + d0) * 16 + hi * 8) * 2;
        const bf16x8 b0 = *(const LAS bf16x8*)(Ks + KSWZ(r32, cb)); const bf16x8 b1 = *(const LAS bf16x8*)(Ks + KSWZ(32 + r32, cb));
        p0 = __builtin_amdgcn_mfma_f32_32x32x16_bf16(b0, qr[d0], p0, 0, 0, 0);
        p1 = __builtin_amdgcn_mfma_f32_32x32x16_bf16(b1, qr[d0], p1, 0, 0, 0); }
}
__device__ __forceinline__ void partialSM(f32x16& p0, f32x16& p1, float& m_reg, float& mn, float& alpha, int relw, int relb, int hi, const LAS float* btab, float bneg, float bpos) {
    if (relw - 31 >= 91 || relw + 63 <= -91) {
        const float bc = (relw > 0) ? bpos : bneg;
        float pmax = p0[0];
#pragma unroll
        for (int r = 1; r < 16; ++r) pmax = fmaxf(pmax, p0[r]);
#pragma unroll
        for (int r = 0; r < 16; ++r) pmax = fmaxf(pmax, p1[r]);
        { auto rr = __builtin_amdgcn_permlane32_swap(__float_as_uint(pmax), __float_as_uint(pmax), false, false); pmax = fmaxf(__uint_as_float(rr[0]), __uint_as_float(rr[1])); }
        const float tmax = fmaf(pmax, C, bc);
        if (__builtin_expect(__all(tmax - m_reg <= THR2), 1)) { mn = m_reg; alpha = 1.f; }
        else { mn = fmaxf(m_reg, tmax); alpha = __builtin_amdgcn_exp2f(m_reg - mn); m_reg = mn; }
        const float off = bc - mn;
#pragma unroll
        for (int r = 0; r < 16; ++r) p0[r] = fmaf(p0[r], C, off);
#pragma unroll
        for (int r = 0; r < 16; ++r) p1[r] = fmaf(p1[r], C, off);
    } else {
#pragma unroll
        for (int r = 0; r < 16; ++r) { const int idx = relb + crow(r, hi) + 256; p0[r] = fmaf(p0[r], C, btab[idx]); p1[r] = fmaf(p1[r], C, btab[idx + 32]); }
        float pmax = p0[0];
#pragma unroll
        for (int r = 1; r < 16; ++r) pmax = fmaxf(pmax, p0[r]);
#pragma unroll
        for (int r = 0; r < 16; ++r) pmax = fmaxf(pmax, p1[r]);
        { auto rr = __builtin_amdgcn_permlane32_swap(__float_as_uint(pmax), __float_as_uint(pmax), false, false); pmax = fmaxf(__uint_as_float(rr[0]), __uint_as_float(rr[1])); }
        if (__builtin_expect(__all(pmax - m_reg <= THR2), 1)) { mn = m_reg; alpha = 1.f; }
        else { mn = fmaxf(m_reg, pmax); alpha = __builtin_amdgcn_exp2f(m_reg - mn); m_reg = mn; }
#pragma unroll
        for (int r = 0; r < 16; ++r) p0[r] -= mn;
#pragma unroll
        for (int r = 0; r < 16; ++r) p1[r] -= mn;
    }
#pragma unroll
    for (int r = 0; r < 16; ++r) p0[r] = __builtin_amdgcn_exp2f(p0[r]);
}
__device__ __forceinline__ void finishSM(f32x16& p0, f32x16& p1, float alpha, float& l_reg, bf16x8& pa0, bf16x8& pa1, bf16x8& pa2, bf16x8& pa3) {
#pragma unroll
    for (int r = 0; r < 16; ++r) p1[r] = __builtin_amdgcn_exp2f(p1[r]);
    float ps = 0;
#pragma unroll
    for (int r = 0; r < 16; ++r) ps += p0[r];
#pragma unroll
    for (int r = 0; r < 16; ++r) ps += p1[r];
    { auto rr = __builtin_amdgcn_permlane32_swap(__float_as_uint(ps), __float_as_uint(ps), false, false); ps = __uint_as_float(rr[0]) + __uint_as_float(rr[1]); }
    l_reg = l_reg * alpha + ps;
#define PK4(P, BASE, OUT) do { unsigned a0 = cvt_pk_bf16(P[BASE + 0], P[BASE + 1]), a1 = cvt_pk_bf16(P[BASE + 2], P[BASE + 3]);   \
    unsigned b0 = cvt_pk_bf16(P[BASE + 4], P[BASE + 5]), b1 = cvt_pk_bf16(P[BASE + 6], P[BASE + 7]);                              \
    auto r0 = __builtin_amdgcn_permlane32_swap(a0, b0, false, false); auto r1 = __builtin_amdgcn_permlane32_swap(a1, b1, false, false); \
    u32x4 w = {r0[0], r1[0], r0[1], r1[1]}; OUT = __builtin_bit_cast(bf16x8, w); } while (0)
    PK4(p0, 0, pa0); PK4(p0, 8, pa1); PK4(p1, 0, pa2); PK4(p1, 8, pa3);
#undef PK4
}
constexpr int L_V = 0, L_K = 32768, L_WS = 65536, L_BT = 67584, L_CB = 69632;
__device__ __forceinline__ void attn_unit(Frame& F, int unit) {
    const int bh = unit >> 4, qb = unit & 15, b = bh >> 3, h = bh & 7, q0 = qb * 128;
    const int tid = F.tid, wid = F.wave, lane = F.lane, r32 = lane & 31, hi = lane >> 5, rg = wid & 3, map = wid >> 2;
    const bf16* proj = WSP(bf16, WS_PROJ);
    const bf16* Kh = proj + (size_t)(b * SEQ) * INC + 1024 + h * 128; const bf16* Vh = proj + (size_t)(b * SEQ) * INC + 2048 + h * 128;
    LAS char* lds = (LAS char*)F.lds; LAS char* V_lds = lds + L_V; LAS char* K_lds = lds + L_K;
    LAS float* wsf = (LAS float*)(lds + L_WS) + wid * 64; LAS float* li_l = wsf; LAS float* al_l = wsf + 32;
    LAS float* btab = (LAS float*)(lds + L_BT);
    const float* bt = WSP(float, WS_BIAST) + h * 4096;
    __syncthreads();
    btab[tid] = bt[2048 - 256 + tid];
    const float bneg = bt[2048 - 200], bpos = bt[2048 + 200], lam = WSP(float, WS_BIAST)[AH * 4096];
    float m_reg = -1e30f, l_reg = 0; f32x16 o[4] = {}; bf16x8 qr[4];
    const int qw0 = q0 + 32 * rg;
    const bf16* Qw = proj + (size_t)(b * SEQ + qw0 + r32) * INC + h * 128 + map * 64 + hi * 8;
#pragma unroll
    for (int d0 = 0; d0 < 4; ++d0) qr[d0] = *(const GAS bf16x8*)(Qw + d0 * 16);
    const int sr = tid >> 4, sc = (tid & 15) * 8, vst0 = v_st(sr, sc), vst1 = v_st(32 + sr, sc);
    const int vb0 = (int)(uintptr_t)V_lds + v_rd_base(lane);
    struct { bf16x8 vs0, vs1, ks0, ks1; } sr_[2];
#define SLOAD(i, k0) do { sr_[i].vs0 = *(const GAS bf16x8*)&Vh[(size_t)((k0) + sr) * INC + sc]; sr_[i].vs1 = *(const GAS bf16x8*)&Vh[(size_t)((k0) + 32 + sr) * INC + sc]; \
    sr_[i].ks0 = *(const GAS bf16x8*)&Kh[(size_t)((k0) + sr) * INC + sc]; sr_[i].ks1 = *(const GAS bf16x8*)&Kh[(size_t)((k0) + 32 + sr) * INC + sc]; } while (0)
#define SWRITE(bb, i) do { *(LAS bf16x8*)(V_lds + (bb) * SHM_V + vst0) = sr_[i].vs0; *(LAS bf16x8*)(V_lds + (bb) * SHM_V + vst1) = sr_[i].vs1; const int kc = sc * 2; \
    *(LAS bf16x8*)(K_lds + (bb) * SHM_K + KSWZ(sr, kc)) = sr_[i].ks0; *(LAS bf16x8*)(K_lds + (bb) * SHM_K + KSWZ(32 + sr, kc)) = sr_[i].ks1; } while (0)
#define SWAIT() asm volatile("s_waitcnt vmcnt(4)" ::: "memory")
#define RESC(a) do { if (__any((a) < 1.f)) { if (hi == 0) al_l[r32] = (a); asm volatile("s_waitcnt lgkmcnt(0)" ::: "memory"); \
    _Pragma("unroll") for (int d = 0; d < 4; ++d) _Pragma("unroll") for (int r = 0; r < 16; ++r) o[d][r] *= al_l[crow(r, hi)]; } } while (0)
#define PSM(P0, P1, MN, AL, k0) partialSM(P0, P1, m_reg, MN, AL, (k0) - qw0, (k0) - qw0 - r32, hi, btab, bneg, bpos)
    f32x16 pA0, pA1, pB0, pB1; float mnA, mnB, alA, alB; bf16x8 pa0, pa1, pa2, pa3; constexpr int NT = SEQ / KVBLK;
    constexpr int SE = 0, SO = 1;
    SLOAD(SE, 0); asm volatile("s_waitcnt vmcnt(0)" ::: "memory"); SWRITE(0, SE); __syncthreads();
    qkt(pA0, pA1, K_lds, qr, r32, hi, map); PSM(pA0, pA1, mnA, alA, 0);
    SLOAD(SO, KVBLK); SLOAD(SE, 2 * KVBLK);
    SWAIT(); SWRITE(1, SO); __syncthreads();
    for (int j = 1; j + 1 < NT; j += 2) {
        SBAR(); qkt(pB0, pB1, K_lds + SHM_K, qr, r32, hi, map);
        finishSM(pA0, pA1, alA, l_reg, pa0, pa1, pa2, pa3); SBAR();
        SLOAD(SO, (j + 2) * KVBLK); SBAR();
        pv_d0(o, vb0, pa0, pa1, pa2, pa3); PSM(pB0, pB1, mnB, alB, j * KVBLK);
        __syncthreads(); SWAIT(); SWRITE(0, SE);
        RESC(alB); __syncthreads();
        SBAR(); qkt(pA0, pA1, K_lds, qr, r32, hi, map);
        finishSM(pB0, pB1, alB, l_reg, pa0, pa1, pa2, pa3); SBAR();
        if (j + 3 < NT) SLOAD(SE, (j + 3) * KVBLK); SBAR();
        pv_d0(o, vb0 + (int)SHM_V, pa0, pa1, pa2, pa3); PSM(pA0, pA1, mnA, alA, (j + 1) * KVBLK);
        __syncthreads(); SWAIT(); SWRITE(1, SO);
        RESC(alA); __syncthreads();
    }
    SBAR(); qkt(pB0, pB1, K_lds + SHM_K, qr, r32, hi, map);
    finishSM(pA0, pA1, alA, l_reg, pa0, pa1, pa2, pa3); SBAR();
    pv_d0(o, vb0, pa0, pa1, pa2, pa3); PSM(pB0, pB1, mnB, alB, (NT - 1) * KVBLK);
    __syncthreads(); RESC(alB);
    finishSM(pB0, pB1, alB, l_reg, pa0, pa1, pa2, pa3); SBAR();
    pv_d0(o, vb0 + (int)SHM_V, pa0, pa1, pa2, pa3);
    if (hi == 0) li_l[r32] = l_reg; asm volatile("s_waitcnt lgkmcnt(0)" ::: "memory");
    float rli[16];
#pragma unroll
    for (int r = 0; r < 16; ++r) rli[r] = __builtin_amdgcn_rcpf(li_l[crow(r, hi)]);
    LAS float* cbuf = (LAS float*)(lds + L_CB) + rg * 32 * 128;
    if (map == 1) {
#pragma unroll
        for (int r = 0; r < 16; ++r)
#pragma unroll
            for (int d0 = 0; d0 < 4; ++d0) cbuf[crow(r, hi) * 128 + d0 * 32 + r32] = -lam * o[d0][r] * rli[r];
    }
    __syncthreads();
    if (map == 0) {
        bf16* mix = WSP(bf16, WS_MIX) + (size_t)(b * SEQ + qw0) * DM + h * 128;
        float sg[4];
#pragma unroll
        for (int d0 = 0; d0 < 4; ++d0) sg[d0] = F.subln[d0 * 32 + r32] * 0.8f;
#pragma unroll
        for (int r = 0; r < 16; ++r) { float v[4], ss = 0.f;
#pragma unroll
            for (int d0 = 0; d0 < 4; ++d0) { v[d0] = o[d0][r] * rli[r] + cbuf[crow(r, hi) * 128 + d0 * 32 + r32]; ss += v[d0] * v[d0]; }
#pragma unroll
            for (int s = 1; s < 32; s <<= 1) ss += __shfl_xor(ss, s);
            const float rstd = rsqrtf(ss * (1.f / VD) + EPS);
#pragma unroll
            for (int d0 = 0; d0 < 4; ++d0) mix[(size_t)crow(r, hi) * DM + d0 * 32 + r32] = (bf16)f2bf(v[d0] * rstd * sg[d0]); }
    }
#undef SLOAD
#undef SWRITE
#undef SWAIT
#undef RESC
#undef PSM
}
}

__device__ __forceinline__ void p5_router(Frame& F, bool dry = false) {
    const float* mod = WSP(float, WS_MOD); const float* x1 = WSP(float, WS_X1); bf16* h2 = WSP(bf16, WS_H2);
    int* list = (int*)(F.ws + WS_ROUTE + RT_LIST); float* sw = (float*)(F.ws + WS_ROUTE + RT_SW); int* toke = (int*)(F.ws + WS_ROUTE + RT_TOKE); int* tokr = (int*)(F.ws + WS_ROUTE + RT_TOKR);
    constexpr int RS = 4096 + 16;
    LAS unsigned char* Ahi = F.lds; LAS unsigned char* Alo = F.lds + 16 * RS; LAS float* Pl = (LAS float*)(F.lds + 32 * RS);
    const unsigned char* wrf = WSP(unsigned char, WS_WRF);
    for (int tb = F.vcu; tb < T / 16; tb += F.G) {
        const int b = (tb * 16) / SEQ;
        __syncthreads();
#pragma unroll 1
        for (int rr = 0; rr < 2; ++rr) {
            const int tl = 2 * F.wave + rr, row = tb * 16 + tl;
            const GAS f32x4* xr = (const GAS f32x4*)(x1 + (size_t)row * DM) + F.lane;
            f32x4 v[8]; float s = 0.f;
#pragma unroll
            for (int j = 0; j < 8; ++j) { v[j] = xr[64 * j]; s += (v[j].x * v[j].x + v[j].y * v[j].y) + (v[j].z * v[j].z + v[j].w * v[j].w); }
            const float rstd = rsqrtf(wave_sum(s) * (1.f / DM) + EPS);
            GAS u32x2* o8 = (GAS u32x2*)(h2 + (size_t)row * DM) + F.lane;
#pragma unroll
            for (int j = 0; j < 8; ++j) { const int k = 4 * F.lane + 256 * j;
                const f32x4 g = *(const GAS f32x4*)(F.g2 + k), sc = *(const GAS f32x4*)(mod + (size_t)b * 6 * DM + 4 * DM + k), sf = *(const GAS f32x4*)(mod + (size_t)b * 6 * DM + 3 * DM + k);
                float hv[4]; unsigned hb[4], lb[4];
#pragma unroll
                for (int q = 0; q < 4; ++q) { hv[q] = v[j][q] * rstd * g[q] * (1.f + sc[q]) + sf[q]; hb[q] = f2bf(hv[q]); lb[q] = f2bf(hv[q] - bf2f(hb[q])); }
                u32x2 wh, wl; wh.x = hb[0] | (hb[1] << 16); wh.y = hb[2] | (hb[3] << 16); wl.x = lb[0] | (lb[1] << 16); wl.y = lb[2] | (lb[3] << 16);
                o8[64 * j] = wh; *(LAS u32x2*)(Ahi + tl * RS + k * 2) = wh; *(LAS u32x2*)(Alo + tl * RS + k * 2) = wl; }
        }
        __syncthreads();
        { f32x4 acc0 = {0.f, 0.f, 0.f, 0.f}, acc1 = {0.f, 0.f, 0.f, 0.f};
#pragma unroll 2
          for (int ks = 0; ks < 8; ++ks) { const int s = 8 * F.wave + ks, k0 = 32 * s + 8 * (F.lane >> 4);
            const bf16x8 ah = *(const LAS bf16x8*)(Ahi + (F.lane & 15) * RS + k0 * 2), al = *(const LAS bf16x8*)(Alo + (F.lane & 15) * RS + k0 * 2);
            const bf16x8 bh0 = *(const GAS bf16x8*)(wrf + ((size_t)(s * 2 + 0) * 64 + F.lane) * 16), bh1 = *(const GAS bf16x8*)(wrf + ((size_t)(s * 2 + 1) * 64 + F.lane) * 16);
            const bf16x8 bl0 = *(const GAS bf16x8*)(wrf + 131072 + ((size_t)(s * 2 + 0) * 64 + F.lane) * 16), bl1 = *(const GAS bf16x8*)(wrf + 131072 + ((size_t)(s * 2 + 1) * 64 + F.lane) * 16);
            acc0 = __builtin_amdgcn_mfma_f32_16x16x32_bf16(ah, bh0, acc0, 0, 0, 0); acc0 = __builtin_amdgcn_mfma_f32_16x16x32_bf16(ah, bl0, acc0, 0, 0, 0); acc0 = __builtin_amdgcn_mfma_f32_16x16x32_bf16(al, bh0, acc0, 0, 0, 0);
            acc1 = __builtin_amdgcn_mfma_f32_16x16x32_bf16(ah, bh1, acc1, 0, 0, 0); acc1 = __builtin_amdgcn_mfma_f32_16x16x32_bf16(ah, bl1, acc1, 0, 0, 0); acc1 = __builtin_amdgcn_mfma_f32_16x16x32_bf16(al, bh1, acc1, 0, 0, 0); }
#pragma unroll
          for (int r = 0; r < 4; ++r) { const int tk = 4 * (F.lane >> 4) + r; Pl[(F.wave * 16 + tk) * 32 + (F.lane & 15)] = acc0[r]; Pl[(F.wave * 16 + tk) * 32 + 16 + (F.lane & 15)] = acc1[r]; }
        }
        __syncthreads();
        { const int tl = F.tid >> 5, e = F.tid & 31, tok = tb * 16 + tl;
          float v = F.b_r[e];
#pragma unroll
          for (int w = 0; w < 8; ++w) v += Pl[(w * 16 + tl) * 32 + e];
          float tv[4]; int ti[4];
#pragma unroll
          for (int r = 0; r < 4; ++r) { float bv = v; int bi = e;
#pragma unroll
              for (int o = 16; o > 0; o >>= 1) { const float ov = __shfl_xor(bv, o); const int oi = __shfl_xor(bi, o); if (ov > bv || (ov == bv && oi < bi)) { bv = ov; bi = oi; } }
              tv[r] = bv; ti[r] = bi; if (e == bi) v = -3.0e38f; }
          float den = 0.f, w[4];
#pragma unroll
          for (int r = 0; r < 4; ++r) { w[r] = __expf(tv[r] - tv[0]); den += w[r]; }
#pragma unroll
          for (int r = 0; r < 4; ++r) if (e == ti[r] && !dry) { const int rank = (int)atomicAdd(F.ctl + CW_CNT + e, 1u);
              list[e * T + rank] = tok; sw[e * T + rank] = w[r] / den; toke[tok * 4 + r] = e; tokr[tok * 4 + r] = rank; }
        }
    }
}

__device__ __forceinline__ void p8_final(Frame& F) {
    const float* mod = WSP(float, WS_MOD); const float* x1 = WSP(float, WS_X1); const bf16* y = WSP(bf16, WS_Y);
    const int* toke = (const int*)(F.ws + WS_ROUTE + RT_TOKE); const int* tokr = (const int*)(F.ws + WS_ROUTE + RT_TOKR);
    moe_tables(F);
    const LAS int* off = (const LAS int*)(F.lds + TAB_OFF) + 40;
    for (int row = F.vcu * NWAVES + F.wave; row < T; row += F.G * NWAVES) {
        const int b = row / SEQ;
        size_t so[4];
#pragma unroll
        for (int r = 0; r < 4; ++r) so[r] = (size_t)(off[toke[row * 4 + r]] + tokr[row * 4 + r]) * DM;
        const GAS f32x4* xr = (const GAS f32x4*)(x1 + (size_t)row * DM) + F.lane;
        f32x4 v[8]; float s = 0.f;
#pragma unroll
        for (int j = 0; j < 8; ++j) { const int k = 4 * F.lane + 256 * j; f32x4 m = {0.f, 0.f, 0.f, 0.f};
#pragma unroll
            for (int r = 0; r < 4; ++r) { const u32x2 yy = *(const GAS u32x2*)(y + so[r] + k); m[0] += bf2f(yy.x & 0xffffu); m[1] += bf2f(yy.x >> 16); m[2] += bf2f(yy.y & 0xffffu); m[3] += bf2f(yy.y >> 16); }
            const f32x4 g = *(const GAS f32x4*)(mod + (size_t)b * 6 * DM + 5 * DM + k);
            v[j] = xr[64 * j] + g * m; s += (v[j].x * v[j].x + v[j].y * v[j].y) + (v[j].z * v[j].z + v[j].w * v[j].w); }
        const float rstd = rsqrtf(wave_sum(s) * (1.f / DM) + EPS);
        GAS f32x4* orow = (GAS f32x4*)(F.out + (size_t)row * DM) + F.lane;
#pragma unroll
        for (int j = 0; j < 8; ++j) { const f32x4 g = *(const GAS f32x4*)(F.fg + 4 * F.lane + 256 * j); orow[64 * j] = v[j] * rstd * g; }
    }
}

struct Args { const float* in[25]; float* out; unsigned char* ws; int ph_lo, ph_hi, li, pad; };
__global__ void __launch_bounds__(NTHR, 2) mega_fwd(Args args) {
    extern __shared__ __attribute__((aligned(16))) unsigned char lds[];
    Frame F;
    F.lds = (LAS unsigned char*)lds; F.MISC = (volatile LAS unsigned*)(F.lds + MISC_OFF);
    F.tid = threadIdx.x; F.lane = F.tid & 63; F.wave = __builtin_amdgcn_readfirstlane(F.tid >> 6);
    F.G = gridDim.x; { const int bx = blockIdx.x; F.vcu = (F.G % 8 == 0) ? (bx % 8) * (F.G / 8) + bx / 8 : bx; }
    F.ws = args.ws; F.ctl = (unsigned*)(args.ws + WS_CTL); F.out = args.out;
    F.x = args.in[0]; F.c = args.in[1]; F.w_ada = args.in[2]; F.b_ada = args.in[3]; F.g1 = args.in[4]; F.w_in = args.in[5]; F.lq1 = args.in[6]; F.lk1 = args.in[7]; F.lq2 = args.in[8]; F.lk2 = args.in[9];
    F.subln = args.in[10]; F.relb = args.in[11]; F.cw = args.in[12]; F.cb = args.in[13]; F.clg = args.in[14]; F.clb = args.in[15]; F.w_out = args.in[16]; F.g2 = args.in[17]; F.w_r = args.in[18]; F.b_r = args.in[19];
    F.w_gu = args.in[20]; F.b_gu = args.in[21]; F.w_d = args.in[22]; F.b_d = args.in[23]; F.fg = args.in[24];
    for (int u = F.tid; u < 64; u += NTHR) ((LAS unsigned*)(F.lds + MISC_OFF))[u] = 0u;
    __syncthreads();
    XcdBarrier bar = xcd_barrier_post(F.ctl + CW_BAR + args.li * XCD_BAR_WORDS, F.MISC + 8);
    const int lo = args.ph_lo, hi = args.ph_hi;
#ifndef PH_MASK
#define PH_MASK 0x1ff
#endif
#define IN(k) (((PH_MASK >> (k)) & 1) && lo <= (k) && (k) < hi)
#define SEAM(k) do { if (IN(k) && IN((k) + 1)) { xcd_barrier(bar); if constexpr (((REP_MASK >> 14) & 1) != 0) xcd_barrier(bar); } } while (0)
#define REP2(k, ...) do { { __VA_ARGS__ } if constexpr (((REP_MASK >> (k)) & 1) != 0) { __VA_ARGS__ } } while (0)
    if (IN(0)) { REP2(0, __syncthreads(); p0_prologue(F);); } SEAM(0);
    if (IN(0) && IN(1)) F.vcu = xcd_virtual_cu(bar);
    if (IN(1)) { REP2(1, __syncthreads(); p1_norm1(F);); } SEAM(1);
    if (IN(2)) { REP2(2, { InProjT<false> P{WSP(bf16, WS_H), WSP(bf16, WS_WIN), WSP(bf16, WS_PROJ), {}}; P.ord.init(T, INC, F.G, F.vcu, false, true); __syncthreads(); pg8::gemm_run(F.lds, P); }
        { InProjT<true> P{WSP(bf16, WS_H), WSP(bf16, WS_WIN), WSP(bf16, WS_PROJ), {}}; P.ord.init(T, INC, F.G, F.vcu, true, true); __syncthreads(); pg8::gemm_run<InProjT<true>, true>(F.lds, P); }); } SEAM(2);
    if (IN(3)) { REP2(3,
        for (int ct = F.vcu; ct < T / 32; ct += F.G) conv_unit(F, ct);
        if constexpr (((REP_MASK >> 9) & 1) != 0) { for (int ct = F.vcu; ct < T / 32; ct += F.G) conv_unit(F, ct); }
        for (int u = F.vcu; u < NB * AH * 16 * (1 + ((REP_MASK >> 10) & 1)); u += F.G) att::attn_unit(F, u % (NB * AH * 16));
    ); } SEAM(3);
    if (IN(4)) { REP2(4, OutProj P{WSP(bf16, WS_MIX), WSP(bf16, WS_WOUT), F.x, WSP(float, WS_MOD), WSP(float, WS_X1), {}}; P.ord.init(T, DM, F.G, F.vcu); __syncthreads(); pg8::gemm_run(F.lds, P);); } SEAM(4);
    if (IN(5)) { p5_router(F); if constexpr (((REP_MASK >> 13) & 1) != 0) { __syncthreads(); p5_router(F, true); } } SEAM(5);
    if (IN(6)) { REP2(6, moe_tables(F); const LAS int* tab = (const LAS int*)(F.lds + TAB_OFF);
        MoeGU P{WSP(bf16, WS_H2), F.w_gu, F.b_gu, (const int*)(F.ws + WS_ROUTE + RT_LIST), WSP(bf16, WS_ACT), {tab, tab + 40, tab + 80}, F.G, F.vcu}; pg8::gemm_run_bf32(F.lds, P);); } SEAM(6);
    if (IN(7)) { REP2(7, moe_tables(F); const LAS int* tab = (const LAS int*)(F.lds + TAB_OFF);
        MoeDown P{WSP(bf16, WS_ACT), F.w_d, F.b_d, (const float*)(F.ws + WS_ROUTE + RT_SW), WSP(bf16, WS_Y), {tab, tab + 40, tab + 80}, F.G, F.vcu}; pg8::gemm_run_bf32(F.lds, P);); } SEAM(7);
    if (IN(8)) { REP2(8, p8_final(F);); }
#undef IN
#undef SEAM
}

extern "C" void kernel_launch(void* const* d_in, const int* in_sizes, int n_in, void* d_out, int out_size, void* d_ws, size_t ws_size, hipStream_t stream) {
    static int grid = 0;
    if (grid == 0) {
        if (n_in != 25 || ws_size < WS_END || out_size != T * DM) { fprintf(stderr, "kernel_launch: n_in %d out %d ws %zu (need %zu); nothing launched\n", n_in, out_size, ws_size, (size_t)WS_END); grid = -1; return; }
        int dev = 0, cus = 0, per_cu = 0;
        if (hipGetDevice(&dev) != hipSuccess || hipDeviceGetAttribute(&cus, hipDeviceAttributeMultiprocessorCount, dev) != hipSuccess) { grid = -1; return; }
        if (hipFuncSetAttribute((const void*)mega_fwd, hipFuncAttributeMaxDynamicSharedMemorySize, LDS_BYTES) != hipSuccess) { fprintf(stderr, "kernel_launch: hipFuncSetAttribute failed\n"); grid = -1; return; }
        if (hipOccupancyMaxActiveBlocksPerMultiprocessor(&per_cu, (const void*)mega_fwd, NTHR, LDS_BYTES) != hipSuccess || per_cu < 1) { fprintf(stderr, "kernel_launch: occupancy query says %d blocks per CU\n", per_cu); }
        (void)hipGetLastError();
        grid = cus;
    }
    if (grid < 0) return;
    unsigned char* ws = (unsigned char*)d_ws;
    (void)hipMemsetAsync(ws + WS_CTL, 0, CTL_ZERO_BYTES, stream);
    Args a{};
    for (int i = 0; i < 25; ++i) a.in[i] = (const float*)d_in[i];
    a.out = (float*)d_out; a.ws = ws; a.ph_lo = 0; a.ph_hi = 9; a.li = 0; a.pad = 0;
    hipLaunchKernelGGL(mega_fwd, dim3(grid), dim3(NTHR), LDS_BYTES, stream, a);
}
```

```cpp
#include <hip/hip_runtime.h>
#include <cstdio>
#include <cstdint>

#ifndef REP_MASK
#define REP_MASK 0
#endif

constexpr int DM = 2048, NB = 4, SEQ = 2048, T = NB * SEQ;
constexpr int AH = 8, HD = 64, VD = 128, CCH = 1024, CK = 31;
constexpr int INC = 5120;
constexpr int NE = 32, TOPK = 4, DFF = 2048, NSLOT = T * TOPK;
constexpr float EPS = 1e-6f;
constexpr float LOG2E = 1.4426950408889634f;

typedef unsigned short bf16;
typedef short bf16x8 __attribute__((ext_vector_type(8)));
typedef short s16x4 __attribute__((ext_vector_type(4)));
typedef float f32x4 __attribute__((ext_vector_type(4)));
typedef float f32x16 __attribute__((ext_vector_type(16)));
typedef unsigned u32x4 __attribute__((ext_vector_type(4)));
typedef unsigned u32x2 __attribute__((ext_vector_type(2)));
#define GAS __attribute__((address_space(1)))
#define LAS __attribute__((address_space(3)))
typedef GAS unsigned gu32;

constexpr size_t MiB = 1u << 20;
constexpr size_t WS_CTL = 0, CTL_ZERO_BYTES = 64 * 1024;
constexpr size_t WS_MODP = 1 * MiB;
constexpr size_t WS_MOD = 3 * MiB;
constexpr size_t WS_BIAST = 4 * MiB;
constexpr size_t WS_WRF = 5 * MiB;
constexpr size_t WS_ROUTE = 6 * MiB;
constexpr size_t RT_LIST = 0;
constexpr size_t RT_SW = 1 * MiB;
constexpr size_t RT_TOKE = 2 * MiB;
constexpr size_t RT_TOKR = RT_TOKE + 128 * 1024;
constexpr size_t WS_WIN = 16 * MiB;
constexpr size_t WS_WOUT = WS_WIN + 20 * MiB;
constexpr size_t WS_H = WS_WOUT + 8 * MiB;
constexpr size_t WS_PROJ = WS_H + 32 * MiB;
constexpr size_t WS_MIX = WS_PROJ + 80 * MiB;
constexpr size_t WS_X1 = WS_MIX + 32 * MiB;
constexpr size_t WS_H2 = WS_X1 + 64 * MiB;
constexpr size_t WS_ACT = WS_H2 + 32 * MiB;
constexpr size_t WS_Y = WS_ACT + 130 * MiB;
constexpr size_t WS_END = WS_Y + 130 * MiB;
constexpr int CW_CNT = 0;
constexpr int CW_BAR = 1024;

__device__ __forceinline__ unsigned f2bf(float f) { unsigned u = __builtin_bit_cast(unsigned, f); return (u + 0x7fffu + ((u >> 16) & 1u)) >> 16; }
__device__ __forceinline__ float bf2f(unsigned h) { return __builtin_bit_cast(float, h << 16); }
__device__ __forceinline__ unsigned pk2(float lo, float hi) { return f2bf(lo) | (f2bf(hi) << 16); }
__device__ __forceinline__ unsigned cvt_pk_bf16(float lo, float hi) { unsigned r; asm volatile("v_cvt_pk_bf16_f32 %0, %1, %2" : "=v"(r) : "v"(lo), "v"(hi)); return r; }
__device__ __forceinline__ float silu_f(float v) { return v / (1.f + __expf(-v)); }
__device__ __forceinline__ float wave_sum(float v) {
#pragma unroll
    for (int o = 1; o < 64; o <<= 1) v += __shfl_xor(v, o);
    return v;
}
__host__ __device__ inline int t5_bucket(int rel) {
    int ret = rel > 0 ? 16 : 0; int n = rel < 0 ? -rel : rel;
    if (n < 8) return ret + n;
    int lg = n >= 91 ? 15 : n >= 64 ? 14 : n >= 46 ? 13 : n >= 32 ? 12 : n >= 23 ? 11 : n >= 16 ? 10 : n >= 12 ? 9 : 8;
    return ret + lg;
}
#define LDS_WAIT() asm volatile("s_waitcnt lgkmcnt(0)" ::: "memory")
#define VM_WAIT() asm volatile("s_waitcnt vmcnt(0)" ::: "memory")

#define XB_TMO      128
#define XB_XCNT(j)  (256  + 64 * (j))
#define XB_XSUB(j)  (1280 + 64 * (j))
#define XB_XGEN(j)  (2304 + 64 * (j))
#define XB_TOP      3328
#define XB_TOPGEN   3392
#define XCD_BAR_WORDS 3456
#define XB_SPIN_CAP (1u << 18)
__device__ __forceinline__ unsigned xb_ld(unsigned* p)              { return __hip_atomic_load(p, __ATOMIC_RELAXED, __HIP_MEMORY_SCOPE_AGENT); }
__device__ __forceinline__ unsigned xb_add(unsigned* p, unsigned v) { return __hip_atomic_fetch_add(p, v, __ATOMIC_RELAXED, __HIP_MEMORY_SCOPE_AGENT); }
__device__ __forceinline__ unsigned xb_xcc_id() { return (unsigned)__builtin_amdgcn_s_getreg((3 << 11) | 20) & 0xFu; }
#define XB_SPIN(cond, bar) do { unsigned _sp = 0; while (cond) { __builtin_amdgcn_s_sleep(1); \
    if ((++_sp & 255u) == 0u) { if (xb_ld(&(bar)[XB_TMO])) break; if (_sp > XB_SPIN_CAP) { atomicAdd(&(bar)[XB_TMO], 1u); break; } } } } while (0)
struct XcdBarrier { unsigned* bar; unsigned x; volatile LAS unsigned* st; };
__device__ __forceinline__ XcdBarrier xcd_barrier_post(unsigned* bar, volatile LAS unsigned* st) {
    XcdBarrier b; b.bar = bar; b.x = xb_xcc_id(); b.st = st;
    if (threadIdx.x == 0) st[2] = xb_add(&bar[XB_XCNT(b.x)], 1u);
    return b;
}
__device__ __forceinline__ int xcd_virtual_cu(const XcdBarrier& b) {
    if (threadIdx.x == 0) { unsigned pre = 0u; for (unsigned j = 0; j < 16; ++j) { const unsigned c = xb_ld(&b.bar[XB_XCNT(j)]); pre += (j < b.x) ? c : 0u; } b.st[3] = pre + b.st[2]; }
    __syncthreads();
    const int v = (int)b.st[3];
    __syncthreads();
    return __builtin_amdgcn_readfirstlane(v);
}
__device__ __forceinline__ void xcd_barrier_complete(unsigned* bar, unsigned x, unsigned& nloc, unsigned& nx) {
    const unsigned G = gridDim.x * gridDim.y * gridDim.z;
    unsigned sum, cnt, mine, sp = 0u;
    for (;;) {
        sum = 0u; cnt = 0u; mine = 0u;
#pragma unroll
        for (unsigned j = 0; j < 16; ++j) { const unsigned c = xb_ld(&bar[XB_XCNT(j)]); sum += c; cnt += (c > 0u) ? 1u : 0u; mine = (j == x) ? c : mine; }
        if (sum == G) break;
        __builtin_amdgcn_s_sleep(1);
        if ((++sp & 255u) == 0u) { if (xb_ld(&bar[XB_TMO])) break; if (sp > XB_SPIN_CAP) { atomicAdd(&bar[XB_TMO], 1u); break; } }
    }
    nloc = mine > 0u ? mine : 1u; nx = cnt > 0u ? cnt : 1u;
}
__device__ __forceinline__ void xcd_barrier(const XcdBarrier& b) {
    asm volatile("s_waitcnt vmcnt(0)" ::: "memory");
    __syncthreads();
    if (threadIdx.x == 0) {
        unsigned* bar = b.bar;
        __builtin_amdgcn_s_waitcnt(0);
        unsigned nloc = b.st[0], nx = b.st[1];
        if (nloc == 0u) { xcd_barrier_complete(bar, b.x, nloc, nx); b.st[0] = nloc; b.st[1] = nx; }
        const unsigned old = xb_add(&bar[XB_XSUB(b.x)], 1u);
        const unsigned gen = old / nloc;
        if (old + 1u == (gen + 1u) * nloc) {
            __builtin_amdgcn_fence(__ATOMIC_RELEASE, "agent");
            asm volatile("s_waitcnt vmcnt(0)" ::: "memory");
            const unsigned og = xb_add(&bar[XB_TOP], 1u);
            const unsigned tg = og / nx;
            if (og + 1u == (tg + 1u) * nx) xb_add(&bar[XB_TOPGEN], 1u);
            else XB_SPIN(xb_ld(&bar[XB_TOPGEN]) == tg, bar);
            __builtin_amdgcn_fence(__ATOMIC_ACQUIRE, "agent");
            xb_add(&bar[XB_XGEN(b.x)], 1u);
            asm volatile("s_waitcnt vmcnt(0)" ::: "memory");
        } else {
            XB_SPIN(xb_ld(&bar[XB_XGEN(b.x)]) == gen, bar);
            __builtin_amdgcn_fence(__ATOMIC_ACQUIRE, "agent");
            asm volatile("s_waitcnt vmcnt(0)" ::: "memory");
        }
    }
    __syncthreads();
}

namespace pg8 {
constexpr int BM = 256, BK = 64, HALF = 128, HTB = HALF * BK * 2, STAGE_BYTES = 8 * HTB, KD = 2048;
__host__ __device__ __forceinline__ int lds_byte(int r, int c) { const int st = (r >> 4) * 2 + (c >> 5), rr = r & 15, cc = c & 31, ob = rr * 64 + cc * 2; return st * 1024 + (ob ^ (((ob >> 9) & 1) << 5)); }
__host__ __device__ __forceinline__ void stage_rc(int b, int& R, int& C) { const int st = b / 1024, sb = b % 1024, swz = sb ^ (((sb >> 9) & 1) << 5); R = (st >> 1) * 16 + swz / 64; C = (st & 1) * 32 + (swz % 64) / 2; }
__host__ __device__ __forceinline__ int perm32(int rho) { const int n = rho >> 4, i = rho & 15; return 8 * (i >> 2) + 4 * n + (i & 3); }
struct Unit { int pm, pn, e, rows; };

struct DenseOrder {
    int nM, nN, nwg, nfull, G, c; bool half;
    __device__ void init(int M, int N, int G_, int c_, bool half_ = false, bool split_tail = false) { nM = M / BM; nN = N / BM; nwg = nM * nN; G = G_; c = c_; half = half_; nfull = split_tail ? (nwg / G_) * G_ : nwg; }
    __device__ bool next(int i, Unit& u) const {
        long L = (long)i * G + c; int hsel = 0;
        if (half) { if (L >= 2L * (nwg - nfull)) return false; hsel = (int)(L & 1); L = nfull + (L >> 1); }
        else if (L >= nfull) return false;
        const int wgid = (int)L;
        const int nig = 8 * nN, gid = wgid / nig, fm = gid * 8, gsz = (nM - fm) < 8 ? (nM - fm) : 8;
        u.pm = fm + ((wgid % nig) % gsz); u.pn = (wgid % nig) / gsz; u.e = 0; u.rows = 256; if (half) { u.pm = 2 * u.pm + hsel; u.rows = 128; } return true;
    }
};

template <class P, bool HM = false>
__device__ __forceinline__ void gemm_run(LAS unsigned char* lds, const P& prob) {
    const int tid = threadIdx.x, wid = __builtin_amdgcn_readfirstlane(tid >> 6), lane = tid & 63, wr = wid >> 2, wc = wid & 3, fr = lane & 15, fq = lane >> 4;
    constexpr int K = KD, nt = K / BK;
    int Rr[2], Cc[2]; unsigned voffB[2];
#pragma unroll
    for (int i = 0; i < 2; ++i) { int R, C; stage_rc(tid * 16 + i * 8192, R, C); Rr[i] = R; Cc[i] = C; const int Rb = P::PERM ? ((R & ~31) + perm32(R & 31)) : R; voffB[i] = (unsigned)(Rb * K + C) * 2u; }
    constexpr size_t kstep = (size_t)(BK * 2), hstep = (size_t)HALF * K * 2;
    const unsigned ldsw = (unsigned)wid * 1024u;
    const int aoff = lds_byte(wr * 64 + fr, fq * 8), boff = lds_byte(wc * 32 + fr, fq * 8);
#define PG8_SA(b, h) (((b) * 2 + (h)) * HTB)
#define PG8_SB(b, h) ((4 + (b) * 2 + (h)) * HTB)
#define PG8_STAGE(bufoff, gbase, voff) do { _Pragma("unroll") for (int _i = 0; _i < 2; ++_i) \
        __builtin_amdgcn_global_load_lds((const unsigned*)((const char*)(gbase) + (voff)[_i]), (LAS unsigned*)(lds + (bufoff) + ldsw + _i * 8192), 16, 0, 0); } while (0)
#define PG8_LDA(dst, b, h) do { _Pragma("unroll") for (int m = 0; m < 4; ++m) _Pragma("unroll") for (int k = 0; k < 2; ++k) dst[m][k] = *(const LAS bf16x8*)(lds + PG8_SA(b, h) + aoff + m * 2048 + k * 1024); } while (0)
#define PG8_LDB(dst, b, h) do { _Pragma("unroll") for (int n = 0; n < 2; ++n) _Pragma("unroll") for (int k = 0; k < 2; ++k) dst[n][k] = *(const LAS bf16x8*)(lds + PG8_SB(b, h) + boff + n * 2048 + k * 1024); } while (0)
#define PG8_MMA(ai, bj, At, Bt) do { __builtin_amdgcn_s_setprio(1); _Pragma("unroll") for (int m = 0; m < 4; ++m) _Pragma("unroll") for (int n = 0; n < 2; ++n) _Pragma("unroll") for (int k = 0; k < 2; ++k) \
        acc[ai][bj][m][n] = __builtin_amdgcn_mfma_f32_16x16x32_bf16(Bt[n][k], At[m][k], acc[ai][bj][m][n], 0, 0, 0); __builtin_amdgcn_s_setprio(0); } while (0)
#define PG8_WAIT_V(n) asm volatile("s_waitcnt vmcnt(" #n ")" ::: "memory")
#define PG8_WAIT_L(n) asm volatile("s_waitcnt lgkmcnt(" #n ")" ::: "memory")
#define PG8_BAR __builtin_amdgcn_s_barrier()
#define PG8_SCHED __builtin_amdgcn_sched_barrier(0)
    Unit cur, nxt; int ui = 0;
    if (!prob.next(0, cur)) return;
    f32x4 acc[2][2][4][2];
#pragma unroll
    for (int a = 0; a < 2; ++a)
#pragma unroll
        for (int b = 0; b < 2; ++b)
#pragma unroll
            for (int m = 0; m < 4; ++m)
#pragma unroll
                for (int n = 0; n < 2; ++n) acc[a][b][m][n] = (f32x4){0.f, 0.f, 0.f, 0.f};
    bf16x8 At[4][2], B0[2][2], B1[2][2];
    unsigned vC0[2], vC1[2], vN0[2], vN1[2];
    prob.a_off(cur, Rr, Cc, vC0, vC1);
    const char* const Ab = prob.a_base();
    const char* cB = prob.b_base(cur);
    PG8_STAGE(PG8_SB(0, 0), cB, voffB); PG8_STAGE(PG8_SB(0, 1), cB + hstep, voffB); PG8_STAGE(PG8_SA(0, 0), Ab, vC0); if constexpr (!HM) PG8_STAGE(PG8_SA(0, 1), Ab, vC1);
    if (wr == 1) PG8_BAR;
    if constexpr (HM) PG8_WAIT_V(0); else PG8_WAIT_V(2);
    PG8_BAR;
    PG8_STAGE(PG8_SB(1, 0), cB + kstep, voffB); PG8_STAGE(PG8_SA(1, 0), Ab + kstep, vC0); PG8_STAGE(PG8_SB(1, 1), cB + hstep + kstep, voffB);
    PG8_WAIT_V(6); PG8_BAR;
    for (;;) {
        const bool has_next = prob.next(ui + 1, nxt);
        if (has_next) prob.a_off(nxt, Rr, Cc, vN0, vN1); else { vN0[0] = vC0[0]; vN0[1] = vC0[1]; vN1[0] = vC1[0]; vN1[1] = vC1[1]; }
        const char* nB = has_next ? prob.b_base(nxt) : cB;
        for (int t = 0; t < nt; t += 2) {
            const bool last = (t == nt - 2);
            const char* a1 = Ab + (size_t)(t + 1) * kstep;
            const char* a2 = last ? Ab : Ab + (size_t)(t + 2) * kstep; const char* b2 = last ? nB : cB + (size_t)(t + 2) * kstep;
            const char* a3 = a2 + kstep; const char* b3 = b2 + kstep;
            unsigned v20[2], v21[2];
            v20[0] = last ? vN0[0] : vC0[0]; v20[1] = last ? vN0[1] : vC0[1]; v21[0] = last ? vN1[0] : vC1[0]; v21[1] = last ? vN1[1] : vC1[1];
            PG8_LDB(B0, 0, 0); PG8_LDB(B1, 0, 1); PG8_SCHED; PG8_LDA(At, 0, 0); if constexpr (!HM) PG8_STAGE(PG8_SA(1, 1), a1, vC1);
            if constexpr (HM) PG8_WAIT_V(6); else PG8_WAIT_V(8); PG8_WAIT_L(0); PG8_BAR; PG8_MMA(0, 0, At, B0); PG8_MMA(0, 1, At, B1); PG8_BAR; PG8_SCHED;
            if constexpr (!HM) PG8_LDA(At, 0, 1); PG8_STAGE(PG8_SB(0, 0), b2, voffB); PG8_STAGE(PG8_SB(0, 1), b2 + hstep, voffB); PG8_STAGE(PG8_SA(0, 0), a2, v20);
            if constexpr (HM) PG8_WAIT_V(6); else PG8_WAIT_V(8);
            PG8_WAIT_L(0); PG8_BAR; if constexpr (!HM) { PG8_MMA(1, 0, At, B0); PG8_MMA(1, 1, At, B1); } PG8_BAR; PG8_SCHED;
            PG8_LDB(B0, 1, 0); PG8_LDB(B1, 1, 1); PG8_SCHED; PG8_LDA(At, 1, 0); if constexpr (!HM) PG8_STAGE(PG8_SA(0, 1), a2, v21);
            if constexpr (HM) PG8_WAIT_V(6); else PG8_WAIT_V(8); PG8_WAIT_L(0); PG8_BAR; PG8_MMA(0, 0, At, B0); PG8_MMA(0, 1, At, B1); PG8_BAR; PG8_SCHED;
            if constexpr (!HM) PG8_LDA(At, 1, 1); PG8_STAGE(PG8_SB(1, 0), b3, voffB); PG8_STAGE(PG8_SB(1, 1), b3 + hstep, voffB); PG8_STAGE(PG8_SA(1, 0), a3, v20);
            if constexpr (HM) PG8_WAIT_V(6); else PG8_WAIT_V(8);
            PG8_WAIT_L(0); PG8_BAR; if constexpr (!HM) { PG8_MMA(1, 0, At, B0); PG8_MMA(1, 1, At, B1); } PG8_BAR; PG8_SCHED;
        }
        if (wr == 0) PG8_BAR;
        prob.epi(acc, cur, wr, wc, fr, fq);
        if (!has_next) break;
#pragma unroll
        for (int a = 0; a < 2; ++a)
#pragma unroll
            for (int b = 0; b < 2; ++b)
#pragma unroll
                for (int m = 0; m < 4; ++m)
#pragma unroll
                    for (int n = 0; n < 2; ++n) acc[a][b][m][n] = (f32x4){0.f, 0.f, 0.f, 0.f};
        cur = nxt; cB = nB; ++ui; vC0[0] = vN0[0]; vC0[1] = vN0[1]; vC1[0] = vN1[0]; vC1[1] = vN1[1];
        if (wr == 1) PG8_BAR;
    }
    PG8_WAIT_V(0);
    PG8_BAR;
#undef PG8_SA
#undef PG8_SB
#undef PG8_STAGE
#undef PG8_LDA
#undef PG8_LDB
#undef PG8_MMA
#undef PG8_WAIT_V
#undef PG8_WAIT_L
#undef PG8_BAR
#undef PG8_SCHED
}

template <class P>
__device__ __forceinline__ void gemm_run_bf32(LAS unsigned char* lds, const P& prob) {
    const int tid = threadIdx.x, wid = __builtin_amdgcn_readfirstlane(tid >> 6), lane = tid & 63, wr = wid >> 2, wc = wid & 3, fr = lane & 15, fq = lane >> 4;
    constexpr int K = KD, nt = K / BK;
    constexpr size_t kstep = (size_t)(BK * 2);
    constexpr size_t ldwB = (size_t)P::LDW_BYTES;
    const unsigned ldsw = (unsigned)wid * 1024u;
    const int aoff = lds_byte(wr * 64 + fr, fq * 8), boff = lds_byte(wc * 32 + fr, fq * 8);
    const int wbo0 = lds_byte(32 * (lane >> 4) + (((lane >> 1) & 1) | (((lane >> 3) & 1) << 2) | (((lane >> 2) & 1) << 3)), 8 * wid + 4 * (lane & 1));
#define PG8_SA(b, h) (((b) * 2 + (h)) * HTB)
#define PG8_SB(b, h) ((4 + (b) * 2 + (h)) * HTB)
#define PG8_STAGE(bufoff, gbase, voff) do { _Pragma("unroll") for (int _i = 0; _i < 2; ++_i) \
        __builtin_amdgcn_global_load_lds((const unsigned*)((const char*)(gbase) + (voff)[_i]), (LAS unsigned*)(lds + (bufoff) + ldsw + _i * 8192), 16, 0, 0); } while (0)
#define PG8_LDA(dst, b, h) do { _Pragma("unroll") for (int m = 0; m < 4; ++m) _Pragma("unroll") for (int k = 0; k < 2; ++k) dst[m][k] = *(const LAS bf16x8*)(lds + PG8_SA(b, h) + aoff + m * 2048 + k * 1024); } while (0)
#define PG8_LDB(dst, b, h) do { _Pragma("unroll") for (int n = 0; n < 2; ++n) _Pragma("unroll") for (int k = 0; k < 2; ++k) dst[n][k] = *(const LAS bf16x8*)(lds + PG8_SB(b, h) + boff + n * 2048 + k * 1024); } while (0)
#define PG8_MMA(ai, bj, At, Bt) do { __builtin_amdgcn_s_setprio(1); _Pragma("unroll") for (int m = 0; m < 4; ++m) _Pragma("unroll") for (int n = 0; n < 2; ++n) _Pragma("unroll") for (int k = 0; k < 2; ++k) \
        acc[ai][bj][m][n] = __builtin_amdgcn_mfma_f32_16x16x32_bf16(Bt[n][k], At[m][k], acc[ai][bj][m][n], 0, 0, 0); __builtin_amdgcn_s_setprio(0); } while (0)
#define PG8_WAIT_V(n) asm volatile("s_waitcnt vmcnt(" #n ")" ::: "memory")
#define PG8_WAIT_L(n) asm volatile("s_waitcnt lgkmcnt(" #n ")" ::: "memory")
#define PG8_BAR __builtin_amdgcn_s_barrier()
#define PG8_SCHED __builtin_amdgcn_sched_barrier(0)
#define PG8_BLOAD(kk, h) do { const bool nx_ = (kk) >= nt; const unsigned so_ = (nx_ ? nBo : cBo) + (unsigned)((nx_ ? (kk) - nt : (kk)) * BK + 8 * wid) * (unsigned)ldwB + (unsigned)(h) * (unsigned)P::HALF_BYTES; \
        const unsigned co_ = nx_ ? nCol : cCol; \
        asm volatile("s_nop 4" ::: "memory"); \
        _Pragma("unroll") for (int j_ = 0; j_ < 4; ++j_) asm volatile("buffer_load_dwordx4 %0, %1, %2, %3 offen" : "=v"(bv[j_]) : "v"(co_), "s"(wrs), "s"(so_ + (unsigned)j_ * (unsigned)ldwB) : "memory"); } while (0)
#define PG8_BWAIT(n) asm volatile("s_waitcnt vmcnt(" #n ")" : "+v"(bv[0]), "+v"(bv[1]), "+v"(bv[2]), "+v"(bv[3]) :: "memory")
#define PG8_BWRITE(b, h) do { _Pragma("unroll") for (int i_ = 0; i_ < 4; ++i_) { u32x2 o_; o_.x = cvt_pk_bf16(bv[0][i_], bv[1][i_]); o_.y = cvt_pk_bf16(bv[2][i_], bv[3][i_]); \
        *(LAS u32x2*)(lds + PG8_SB(b, h) + wbo0 + 128 * (i_ & 1) + 2048 * (i_ >> 1)) = o_; } } while (0)
    typedef float f32x2v __attribute__((ext_vector_type(2)));
    Unit cur, nxt; int ui = 0;
    if (!prob.next(0, cur)) return;
    f32x4 acc[2][2][4][2];
    bf16x8 At[4][2], B0[2][2], B1[2][2];
    f32x4 bv[4];
    unsigned vC0[2], vC1[2], vN0[2], vN1[2];
    prob.a_off(cur, vC0, vC1);
    const char* const Ab = prob.a_base();
    const __amdgpu_buffer_rsrc_t wrs = __builtin_amdgcn_make_buffer_rsrc((void*)prob.W, 0, (unsigned)NE * (unsigned)P::W_BYTES, 0x00020000);
    unsigned cBo = (unsigned)cur.e * (unsigned)P::W_BYTES, cCol = prob.b_col(cur, lane & ~1) + (unsigned)(lane & 1) * 4u * (unsigned)ldwB;
    unsigned nBo = cBo, nCol = cCol;
    PG8_BLOAD(0, 0); PG8_BWAIT(0); PG8_BWRITE(0, 0); PG8_BLOAD(0, 1); PG8_BWAIT(0); PG8_BWRITE(0, 1); PG8_BLOAD(1, 0); PG8_BWAIT(0); PG8_BWRITE(1, 0); PG8_BLOAD(1, 1);
    PG8_STAGE(PG8_SA(0, 0), Ab, vC0); PG8_STAGE(PG8_SA(0, 1), Ab, vC1);
    if (wr == 1) PG8_BAR;
    PG8_WAIT_V(2); PG8_WAIT_L(0); PG8_BAR;
    PG8_STAGE(PG8_SA(1, 0), Ab + kstep, vC0);
    { f32x4 bini[2][2]; prob.bias_load(cur, wc, fq, bini);
#pragma unroll
      for (int a = 0; a < 2; ++a)
#pragma unroll
        for (int b = 0; b < 2; ++b)
#pragma unroll
            for (int m = 0; m < 4; ++m)
#pragma unroll
                for (int n = 0; n < 2; ++n) acc[a][b][m][n] = bini[b][n]; }
    PG8_WAIT_V(0); PG8_BAR;
    for (;;) {
        const bool has_next = prob.next(ui + 1, nxt);
        if (has_next) { prob.a_off(nxt, vN0, vN1); nBo = (unsigned)nxt.e * (unsigned)P::W_BYTES; nCol = prob.b_col(nxt, lane & ~1) + (unsigned)(lane & 1) * 4u * (unsigned)ldwB; }
        else { vN0[0] = vC0[0]; vN0[1] = vC0[1]; vN1[0] = vC1[0]; vN1[1] = vC1[1]; nBo = cBo; nCol = cCol; }
        for (int t = 0; t < nt; t += 2) {
            const bool last = (t == nt - 2);
            const char* a1 = Ab + (size_t)(t + 1) * kstep;
            const char* a2 = last ? Ab : Ab + (size_t)(t + 2) * kstep;
            const char* a3 = a2 + kstep;
            unsigned v20[2], v21[2];
            v20[0] = last ? vN0[0] : vC0[0]; v20[1] = last ? vN0[1] : vC0[1]; v21[0] = last ? vN1[0] : vC1[0]; v21[1] = last ? vN1[1] : vC1[1];
            PG8_LDB(B0, 0, 0); PG8_LDB(B1, 0, 1); PG8_SCHED; PG8_LDA(At, 0, 0); PG8_BWAIT(2); PG8_BWRITE(1, 1); PG8_BLOAD(t + 2, 0); PG8_STAGE(PG8_SA(1, 1), a1, vC1);
            PG8_WAIT_V(12); PG8_WAIT_L(0); PG8_BAR; PG8_MMA(0, 0, At, B0); PG8_MMA(0, 1, At, B1); PG8_BAR; PG8_SCHED;
            PG8_LDA(At, 0, 1); PG8_BWAIT(2); PG8_BWRITE(0, 0); PG8_BLOAD(t + 2, 1); PG8_STAGE(PG8_SA(0, 0), a2, v20);
            PG8_WAIT_V(12); PG8_WAIT_L(0); PG8_BAR; PG8_MMA(1, 0, At, B0); PG8_MMA(1, 1, At, B1); PG8_BAR; PG8_SCHED;
            PG8_LDB(B0, 1, 0); PG8_LDB(B1, 1, 1); PG8_SCHED; PG8_LDA(At, 1, 0); PG8_BWAIT(2); PG8_BWRITE(0, 1); PG8_BLOAD(t + 3, 0); PG8_STAGE(PG8_SA(0, 1), a2, v21);
            PG8_WAIT_V(12); PG8_WAIT_L(0); PG8_BAR; PG8_MMA(0, 0, At, B0); PG8_MMA(0, 1, At, B1); PG8_BAR; PG8_SCHED;
            PG8_LDA(At, 1, 1); PG8_BWAIT(2); PG8_BWRITE(1, 0); PG8_BLOAD(t + 3, 1); PG8_STAGE(PG8_SA(1, 0), a3, v20);
            PG8_WAIT_V(12); PG8_WAIT_L(0); PG8_BAR; PG8_MMA(1, 0, At, B0); PG8_MMA(1, 1, At, B1); PG8_BAR; PG8_SCHED;
        }
        if (wr == 0) PG8_BAR;
        prob.epi(acc, cur, wr, wc, fr, fq, 0);
        if (has_next) { f32x4 bini[2][2]; prob.bias_load(nxt, wc, fq, bini);
#pragma unroll
            for (int b = 0; b < 2; ++b)
#pragma unroll
                for (int m = 0; m < 4; ++m)
#pragma unroll
                    for (int n = 0; n < 2; ++n) acc[0][b][m][n] = bini[b][n]; }
        prob.epi(acc, cur, wr, wc, fr, fq, 1);
        if (!has_next) break;
#pragma unroll
        for (int b = 0; b < 2; ++b)
#pragma unroll
            for (int m = 0; m < 4; ++m)
#pragma unroll
                for (int n = 0; n < 2; ++n) acc[1][b][m][n] = acc[0][b][m][n];
        cur = nxt; cBo = nBo; cCol = nCol; ++ui; vC0[0] = vN0[0]; vC0[1] = vN0[1]; vC1[0] = vN1[0]; vC1[1] = vN1[1];
        if (wr == 1) PG8_BAR;
    }
    PG8_BWAIT(0);
    PG8_BAR;
#undef PG8_SA
#undef PG8_SB
#undef PG8_STAGE
#undef PG8_LDA
#undef PG8_LDB
#undef PG8_MMA
#undef PG8_WAIT_V
#undef PG8_WAIT_L
#undef PG8_BAR
#undef PG8_SCHED
#undef PG8_BLOAD
#undef PG8_BWAIT
#undef PG8_BWRITE
}
}

constexpr int NWAVES = 8, NTHR = 512;
constexpr int RING_BYTES = 131072;
constexpr int TAB_OFF = 147968;
constexpr int MISC_OFF = 163840 - 256;
constexpr int LDS_BYTES = 163840;

struct Frame {
    LAS unsigned char* lds; volatile LAS unsigned* MISC; unsigned* ctl;
    int tid, lane, wave, vcu, G;
    const float *x, *c, *w_ada, *b_ada, *g1, *w_in, *lq1, *lk1, *lq2, *lk2, *subln, *relb, *cw, *cb, *clg, *clb, *w_out, *g2, *w_r, *b_r, *w_gu, *b_gu, *w_d, *b_d, *fg;
    float* out; unsigned char* ws;
};
#define WSP(T_, off) ((T_*)(F.ws + (off)))

__device__ __forceinline__ void p0_transpose_item(const float* W, int ldn, int n0, int k0, bf16* dst, int drow0, LAS unsigned char* scr, int lane) {
    const int ng = lane & 31, kh = lane >> 5;
#pragma unroll
    for (int it = 0; it < 4; ++it) {
        f32x4 v[8];
#pragma unroll
        for (int j = 0; j < 8; ++j) v[j] = *(const GAS f32x4*)(W + (size_t)(k0 + 16 * it + 8 * kh + j) * ldn + n0 + 4 * ng);
        const int kc = 2 * it + kh;
#pragma unroll
        for (int i = 0; i < 4; ++i) { const int n = 4 * ng + i;
            u32x4 o; o.x = pk2(v[0][i], v[1][i]); o.y = pk2(v[2][i], v[3][i]); o.z = pk2(v[4][i], v[5][i]); o.w = pk2(v[6][i], v[7][i]);
            *(LAS u32x4*)(scr + n * 128 + ((kc ^ (ng & 7)) << 4)) = o; }
    }
    LDS_WAIT(); asm volatile("" ::: "memory");
#pragma unroll
    for (int j = 0; j < 16; ++j) { const int n = 8 * j + (lane >> 3), c = lane & 7;
        const u32x4 o = *(const LAS u32x4*)(scr + n * 128 + ((c ^ ((n >> 2) & 7)) << 4));
        *(GAS u32x4*)(dst + (size_t)(drow0 + n) * pg8::KD + k0 + 8 * c) = o; }
    LDS_WAIT(); asm volatile("" ::: "memory");
}
__device__ __forceinline__ void p0_prologue(Frame& F) {
    const int gw = F.vcu * NWAVES + F.wave, NGW = F.G * NWAVES, gt = F.vcu * NTHR + F.tid, NGT = F.G * NTHR;
    LAS float* cs = (LAS float*)(F.lds);
    for (int i = F.tid; i < NB * DM; i += NTHR) cs[i] = silu_f(F.c[i]);
    __syncthreads();
    float* modp = WSP(float, WS_MODP);
    for (int it = gw; it < 192 * 8; it += NGW) {
        const int cc = it % 192, kc = it / 192, r = F.lane >> 4, g = F.lane & 15;
        float acc[4][4];
#pragma unroll
        for (int b = 0; b < 4; ++b)
#pragma unroll
            for (int j = 0; j < 4; ++j) acc[b][j] = 0.f;
        const float* wp = F.w_ada + (size_t)(kc * 256 + r) * (6 * DM) + cc * 64 + g * 4;
#pragma unroll 8
        for (int s = 0; s < 64; ++s) {
            const f32x4 w = *(const GAS f32x4*)(wp + (size_t)(4 * s) * (6 * DM)); const int k = kc * 256 + 4 * s + r;
#pragma unroll
            for (int b = 0; b < 4; ++b) { const float cv = cs[b * DM + k];
#pragma unroll
                for (int j = 0; j < 4; ++j) acc[b][j] += cv * w[j]; }
        }
#pragma unroll
        for (int b = 0; b < 4; ++b)
#pragma unroll
            for (int j = 0; j < 4; ++j) { float v = acc[b][j]; v += __shfl_xor(v, 16); v += __shfl_xor(v, 32); acc[b][j] = v; }
        if (F.lane < 16)
#pragma unroll
            for (int b = 0; b < 4; ++b) *(GAS f32x4*)(modp + (size_t)(kc * 4 + b) * (6 * DM) + cc * 64 + g * 4) = (f32x4){acc[b][0], acc[b][1], acc[b][2], acc[b][3]};
    }
    __syncthreads();
    LAS unsigned char* scr = F.lds + F.wave * 16384;
    constexpr int I_IN = (INC / 128) * 32, I_OUT = (DM / 128) * 32;
    for (int it = gw; it < I_IN + I_OUT; it += NGW) {
        int r = it;
        if (r < I_IN) { const int nb = r >> 5, kb = r & 31; p0_transpose_item(F.w_in, INC, nb * 128, kb * 64, WSP(bf16, WS_WIN), nb * 128, scr, F.lane); continue; } r -= I_IN;
        { const int nb = r >> 5, kb = r & 31; p0_transpose_item(F.w_out, DM, nb * 128, kb * 64, WSP(bf16, WS_WOUT), nb * 128, scr, F.lane); }
    }
    for (int i = gt; i < 64 * 2 * 64; i += NGT) {
        const int l = i & 63, nb = (i >> 6) & 1, s = i >> 7, e = 16 * nb + (l & 15), kb = 32 * s + 8 * (l >> 4);
        unsigned hi[8], lo[8];
#pragma unroll
        for (int j = 0; j < 8; ++j) { const float w = F.w_r[(size_t)(kb + j) * NE + e]; hi[j] = f2bf(w); lo[j] = f2bf(w - bf2f(hi[j])); }
        u32x4 oh, ol; oh.x = hi[0] | (hi[1] << 16); oh.y = hi[2] | (hi[3] << 16); oh.z = hi[4] | (hi[5] << 16); oh.w = hi[6] | (hi[7] << 16);
        ol.x = lo[0] | (lo[1] << 16); ol.y = lo[2] | (lo[3] << 16); ol.z = lo[4] | (lo[5] << 16); ol.w = lo[6] | (lo[7] << 16);
        *(GAS u32x4*)(WSP(unsigned char, WS_WRF) + (size_t)i * 16) = oh; *(GAS u32x4*)(WSP(unsigned char, WS_WRF) + 131072 + (size_t)i * 16) = ol;
    }
    float* bt = WSP(float, WS_BIAST);
    for (int i = gt; i < AH * 4096; i += NGT) { const int h = i >> 12, rel = (i & 4095) - 2048; bt[i] = F.relb[t5_bucket(rel) * AH + h] * LOG2E; }
    if (gt == 0) { float a = 0.f, b = 0.f; for (int i = 0; i < HD; ++i) { a += F.lq1[i] * F.lk1[i]; b += F.lq2[i] * F.lk2[i]; } bt[AH * 4096] = __expf(a) - __expf(b) + 0.2f; }
}

__device__ __forceinline__ void p1_norm1(Frame& F) {
    const float* modp = WSP(float, WS_MODP); float* mod = WSP(float, WS_MOD);
    for (int o = F.vcu * NTHR + F.tid; o < NB * 6 * DM; o += F.G * NTHR) { float s = F.b_ada[o % (6 * DM)];
#pragma unroll
        for (int kc = 0; kc < 8; ++kc) s += modp[(size_t)kc * (NB * 6 * DM) + o];
        mod[o] = s; }
    LAS float* gm = (LAS float*)F.lds; LAS float* sh = gm + DM;
    bf16* h = WSP(bf16, WS_H);
    for (int rb = F.vcu; rb < T / 32; rb += F.G) {
        const int b = rb / (SEQ / 32);
        __syncthreads();
        for (int k = F.tid; k < DM; k += NTHR) { float sc = F.b_ada[DM + k], sf = F.b_ada[k];
#pragma unroll
            for (int kc = 0; kc < 8; ++kc) { sc += modp[(size_t)(kc * 4 + b) * (6 * DM) + DM + k]; sf += modp[(size_t)(kc * 4 + b) * (6 * DM) + k]; }
            gm[k] = F.g1[k] * (1.f + sc); sh[k] = sf; }
        __syncthreads();
        for (int rr = F.wave; rr < 32; rr += NWAVES) {
            const int row = rb * 32 + rr;
            const GAS f32x4* xr = (const GAS f32x4*)(F.x + (size_t)row * DM) + F.lane;
            f32x4 v[8]; float s = 0.f;
#pragma unroll
            for (int j = 0; j < 8; ++j) { v[j] = xr[64 * j]; s += (v[j].x * v[j].x + v[j].y * v[j].y) + (v[j].z * v[j].z + v[j].w * v[j].w); }
            const float rstd = rsqrtf(wave_sum(s) * (1.f / DM) + EPS);
            GAS u32x2* o8 = (GAS u32x2*)(h + (size_t)row * DM) + F.lane;
#pragma unroll
            for (int j = 0; j < 8; ++j) { const int k = 4 * F.lane + 256 * j; const f32x4 g = *(const LAS f32x4*)(gm + k), s4 = *(const LAS f32x4*)(sh + k);
                u32x2 w; w.x = pk2(v[j].x * rstd * g.x + s4.x, v[j].y * rstd * g.y + s4.y); w.y = pk2(v[j].z * rstd * g.z + s4.z, v[j].w * rstd * g.w + s4.w); o8[64 * j] = w; }
        }
    }
}

template <bool HMT> struct InProjT {
    static constexpr bool PERM = true;
    const bf16* A; const bf16* Bt; bf16* O; pg8::DenseOrder ord;
    __device__ bool next(int i, pg8::Unit& u) const { return ord.next(i, u); }
    __device__ const char* a_base() const { return (const char*)A; }
    __device__ void a_off(const pg8::Unit& u, const int (&R)[2], const int (&C)[2], unsigned (&v0)[2], unsigned (&v1)[2]) const {
#pragma unroll
        for (int i = 0; i < 2; ++i) { v0[i] = (unsigned)((u.pm * u.rows + R[i]) * pg8::KD + C[i]) * 2u; v1[i] = (unsigned)((u.pm * u.rows + 128 + R[i]) * pg8::KD + C[i]) * 2u; } }
    __device__ const char* b_base(const pg8::Unit& u) const { return (const char*)(Bt + (size_t)u.pn * 256 * pg8::KD); }
    __device__ void epi(const f32x4 (&acc)[2][2][4][2], const pg8::Unit& u, int wr, int wc, int fr, int fq) const {
        const int row0 = u.pm * u.rows + wr * 64 + fr, col0 = u.pn * 256 + wc * 32 + 8 * fq;
#pragma unroll
        for (int ai = 0; ai < (HMT ? 1 : 2); ++ai)
#pragma unroll
            for (int m = 0; m < 4; ++m) { bf16* rowp = O + (size_t)(row0 + ai * 128 + m * 16) * INC + col0;
#pragma unroll
                for (int bj = 0; bj < 2; ++bj) { const f32x4 v0 = acc[ai][bj][m][0], v1 = acc[ai][bj][m][1];
                    u32x4 w; w.x = cvt_pk_bf16(v0[0], v0[1]); w.y = cvt_pk_bf16(v0[2], v0[3]); w.z = cvt_pk_bf16(v1[0], v1[1]); w.w = cvt_pk_bf16(v1[2], v1[3]);
                    *(GAS u32x4*)(rowp + bj * 128) = w; } }
    }
};
struct OutProj {
    static constexpr bool PERM = true;
    const bf16* A; const bf16* Bt; const float* x; const float* mod; bf16* O; pg8::DenseOrder ord;
    __device__ bool next(int i, pg8::Unit& u) const { return ord.next(i, u); }
    __device__ const char* a_base() const { return (const char*)A; }
    __device__ void a_off(const pg8::Unit& u, const int (&R)[2], const int (&C)[2], unsigned (&v0)[2], unsigned (&v1)[2]) const {
#pragma unroll
        for (int i = 0; i < 2; ++i) { v0[i] = (unsigned)((u.pm * 256 + R[i]) * pg8::KD + C[i]) * 2u; v1[i] = (unsigned)((u.pm * 256 + 128 + R[i]) * pg8::KD + C[i]) * 2u; } }
    __device__ const char* b_base(const pg8::Unit& u) const { return (const char*)(Bt + (size_t)u.pn * 256 * pg8::KD); }
    __device__ void epi(const f32x4 (&acc)[2][2][4][2], const pg8::Unit& u, int wr, int wc, int fr, int fq) const {
        const int row0 = u.pm * 256 + wr * 64 + fr, col0 = u.pn * 256 + wc * 32 + 8 * fq, b = (u.pm * 256) / SEQ;
        f32x4 gt[2][2];
#pragma unroll
        for (int bj = 0; bj < 2; ++bj)
#pragma unroll
            for (int n = 0; n < 2; ++n) gt[bj][n] = *(const GAS f32x4*)(mod + (size_t)b * 6 * DM + 2 * DM + col0 + bj * 128 + 4 * n);
#pragma unroll
        for (int ai = 0; ai < 2; ++ai)
#pragma unroll
            for (int m = 0; m < 4; ++m) { const size_t ro = (size_t)(row0 + ai * 128 + m * 16) * DM + col0;
#pragma unroll
                for (int bj = 0; bj < 2; ++bj) { const f32x4 x0 = *(const GAS f32x4*)(x + ro + bj * 128), x1v = *(const GAS f32x4*)(x + ro + bj * 128 + 4);
                    const f32x4 v0 = x0 + gt[bj][0] * acc[ai][bj][m][0], v1 = x1v + gt[bj][1] * acc[ai][bj][m][1];
                    u32x4 w; w.x = cvt_pk_bf16(v0[0], v0[1]); w.y = cvt_pk_bf16(v0[2], v0[3]); w.z = cvt_pk_bf16(v1[0], v1[1]); w.w = cvt_pk_bf16(v1[2], v1[3]);
                    *(GAS u32x4*)(O + ro + bj * 128) = w; } }
    }
};
struct MoeTab { const LAS int* tp; const LAS int* off; const LAS int* cnt; };
__device__ __forceinline__ void moe_tables(Frame& F) {
    LAS int* tab = (LAS int*)(F.lds + TAB_OFF);
    __syncthreads();
    if (F.tid == 0) { int tp = 0, off = 0; for (int e = 0; e < NE; ++e) { const int c = (int)__hip_atomic_load(F.ctl + CW_CNT + e, __ATOMIC_RELAXED, __HIP_MEMORY_SCOPE_AGENT);
            tab[e] = tp; tab[40 + e] = off; tab[80 + e] = c; tp += (c + 255) >> 8; off += c; } tab[NE] = tp; tab[40 + NE] = off; }
    __syncthreads();
}
template <int NTN, int REPF>
__device__ __forceinline__ bool moe_next(const MoeTab& tb, int G, int c, int i, pg8::Unit& u) {
    int L = i * G + c; const int total = NTN * __builtin_amdgcn_readfirstlane(tb.tp[NE]); if (L >= total * REPF) return false;
    if (REPF > 1 && L >= total) L -= total;
    int e = 0;
#pragma unroll
    for (int j = 1; j < NE; ++j) e += (L >= NTN * tb.tp[j]) ? 1 : 0;
    e = __builtin_amdgcn_readfirstlane(e);
    const int tpe = __builtin_amdgcn_readfirstlane(tb.tp[e]), tpe1 = __builtin_amdgcn_readfirstlane(tb.tp[e + 1]);
    const int local = L - NTN * tpe, nte = tpe1 - tpe;
    u.e = e; u.pn = __builtin_amdgcn_readfirstlane(local / nte); u.pm = local - u.pn * nte; u.rows = __builtin_amdgcn_readfirstlane(tb.cnt[e]) - 256 * u.pm; return true;
}
struct MoeGU {
    static constexpr bool PERM = true;
    const bf16* A; const float* W; const float* bias; const int* list; bf16* O; MoeTab tb; int G, c;
    __device__ bool next(int i, pg8::Unit& u) const { return moe_next<16, 1 + ((REP_MASK >> 11) & 1)>(tb, G, c, i, u); }
    __device__ const char* a_base() const { return (const char*)A; }
    __device__ void a_off(const pg8::Unit& u, unsigned (&v0)[2], unsigned (&v1)[2]) const {
        const int* lp = list + u.e * T + 256 * u.pm;
        int tb16 = (int)threadIdx.x * 16; asm volatile("" : "+v"(tb16));
#pragma unroll
        for (int i = 0; i < 2; ++i) { int R, C; pg8::stage_rc(tb16 + i * 8192, R, C);
            const int r0 = R < u.rows ? R : u.rows - 1, r1 = (128 + R) < u.rows ? (128 + R) : u.rows - 1;
            v0[i] = (unsigned)(lp[r0] * pg8::KD + C) * 2u; v1[i] = (unsigned)(lp[r1] * pg8::KD + C) * 2u; } }
    __device__ void bias_load(const pg8::Unit& u, int wc, int fq, f32x4 (&bi)[2][2]) const {
        int cb = wc * 32 + 8 * ((fq >> 1) + 2 * (fq & 1)); asm volatile("" : "+v"(cb));
        const float* bp = bias + (size_t)u.e * 2 * DFF + u.pn * 128 + cb;
#pragma unroll
        for (int bj = 0; bj < 2; ++bj)
            { const f32x4 t0 = *(const GAS f32x4*)(bp + bj * DFF), t1 = *(const GAS f32x4*)(bp + bj * DFF + 4); bi[bj][0] = (f32x4){t0[0], t1[0], t0[1], t1[1]}; bi[bj][1] = (f32x4){t0[2], t1[2], t0[3], t1[3]}; } }
    static constexpr int LDW_BYTES = 2 * DFF * 4, W_BYTES = DM * 2 * DFF * 4;
    __device__ const char* b_ptr(const pg8::Unit& u) const { return (const char*)(W + (size_t)u.e * DM * 2 * DFF); }
    static constexpr int HALF_BYTES = DFF * 4;
    __device__ unsigned b_col(const pg8::Unit& u, int lane) const { return (unsigned)(u.pn * 128 + 2 * lane) * 4u; }
    __device__ void epi(const f32x4 (&acc)[2][2][4][2], const pg8::Unit& u, int wr, int wc, int fr, int fq, const int ai) const {
        int rt0 = wr * 64 + fr, colt = u.pn * 128 + wc * 32 + 8 * ((fq >> 1) + 2 * (fq & 1)); asm volatile("" : "+v"(rt0), "+v"(colt)); const size_t slot0 = (size_t)__builtin_amdgcn_readfirstlane(tb.off[u.e]) + 256 * u.pm;
#pragma unroll
            for (int m = 0; m < 4; ++m) { const int rt = rt0 + ai * 128 + m * 16; float r[8];
#pragma unroll
                for (int n = 0; n < 2; ++n)
#pragma unroll
                    for (int j = 0; j < 4; ++j) { const int o = (j >> 1) + 2 * n + 4 * (j & 1);
                        float g = acc[ai][0][m][n][j], up = acc[ai][1][m][n][j];
                        g = fminf(g, 7.f); up = fminf(fmaxf(up, -7.f), 7.f);
                        r[o] = (up + 1.f) * g * __builtin_amdgcn_rcpf(1.f + __builtin_amdgcn_exp2f(-1.702f * LOG2E * g)); }
                if (rt < u.rows) { u32x4 w; w.x = cvt_pk_bf16(r[0], r[1]); w.y = cvt_pk_bf16(r[2], r[3]); w.z = cvt_pk_bf16(r[4], r[5]); w.w = cvt_pk_bf16(r[6], r[7]);
                    *(GAS u32x4*)(O + (slot0 + rt) * DFF + colt) = w; } }
    }
};
struct MoeDown {
    static constexpr bool PERM = true;
    const bf16* A; const float* W; const float* bias; const float* sw; bf16* O; MoeTab tb; int G, c;
    __device__ bool next(int i, pg8::Unit& u) const { return moe_next<8, 1 + ((REP_MASK >> 12) & 1)>(tb, G, c, i, u); }
    __device__ const char* a_base() const { return (const char*)A; }
    __device__ void a_off(const pg8::Unit& u, unsigned (&v0)[2], unsigned (&v1)[2]) const {
        const int s0 = __builtin_amdgcn_readfirstlane(tb.off[u.e]) + 256 * u.pm;
        int tb16 = (int)threadIdx.x * 16; asm volatile("" : "+v"(tb16));
#pragma unroll
        for (int i = 0; i < 2; ++i) { int R, C; pg8::stage_rc(tb16 + i * 8192, R, C);
            v0[i] = (unsigned)((s0 + R) * pg8::KD + C) * 2u; v1[i] = (unsigned)((s0 + 128 + R) * pg8::KD + C) * 2u; } }
    __device__ void bias_load(const pg8::Unit& u, int wc, int fq, f32x4 (&bi)[2][2]) const {
        int cb = wc * 32 + 8 * ((fq >> 1) + 2 * (fq & 1)); asm volatile("" : "+v"(cb));
        const float* bp = bias + (size_t)u.e * DM + u.pn * 256 + cb;
#pragma unroll
        for (int bj = 0; bj < 2; ++bj)
            { const f32x4 t0 = *(const GAS f32x4*)(bp + bj * 128), t1 = *(const GAS f32x4*)(bp + bj * 128 + 4); bi[bj][0] = (f32x4){t0[0], t1[0], t0[1], t1[1]}; bi[bj][1] = (f32x4){t0[2], t1[2], t0[3], t1[3]}; } }
    static constexpr int LDW_BYTES = DM * 4, W_BYTES = DFF * DM * 4;
    __device__ const char* b_ptr(const pg8::Unit& u) const { return (const char*)(W + (size_t)u.e * DFF * DM); }
    static constexpr int HALF_BYTES = 128 * 4;
    __device__ unsigned b_col(const pg8::Unit& u, int lane) const { return (unsigned)(u.pn * 256 + 2 * lane) * 4u; }
    __device__ void epi(const f32x4 (&acc)[2][2][4][2], const pg8::Unit& u, int wr, int wc, int fr, int fq, const int ai) const {
        int rt0 = wr * 64 + fr, col0 = u.pn * 256 + wc * 32 + 8 * ((fq >> 1) + 2 * (fq & 1)); asm volatile("" : "+v"(rt0), "+v"(col0)); const size_t slot0 = (size_t)__builtin_amdgcn_readfirstlane(tb.off[u.e]) + 256 * u.pm;
#pragma unroll
            for (int m = 0; m < 4; ++m) { const int rt = rt0 + ai * 128 + m * 16;
                if (rt < u.rows) { const float wgt = sw[(size_t)u.e * T + 256 * u.pm + rt]; bf16* rowp = O + (slot0 + rt) * DM + col0;
#pragma unroll
                    for (int bj = 0; bj < 2; ++bj) { float r[8];
#pragma unroll
                        for (int n = 0; n < 2; ++n)
#pragma unroll
                            for (int j = 0; j < 4; ++j) { const int o = (j >> 1) + 2 * n + 4 * (j & 1); r[o] = acc[ai][bj][m][n][j] * wgt; }
                        u32x4 w; w.x = cvt_pk_bf16(r[0], r[1]); w.y = cvt_pk_bf16(r[2], r[3]); w.z = cvt_pk_bf16(r[4], r[5]); w.w = cvt_pk_bf16(r[6], r[7]);
                        *(GAS u32x4*)(rowp + bj * 128) = w; } } }
    }
};

__device__ __forceinline__ void conv_unit(Frame& F, int ct) {
    const int b = ct / (SEQ / 32), s0 = (ct % (SEQ / 32)) * 32, tid = F.tid;
    const bf16* proj = WSP(bf16, WS_PROJ); bf16* mix = WSP(bf16, WS_MIX);
    LAS unsigned* z = (LAS unsigned*)F.lds;
    LAS float* st = (LAS float*)(F.lds + 126976);
    __syncthreads();
#pragma unroll 8
    for (int r = 0; r < 62; ++r) { const int s = s0 - 15 + r; const bool ok = (s >= 0 && s < SEQ); const int sc = ok ? s : 0;
        const bf16* pr = proj + (size_t)(b * SEQ + sc) * INC + 3072 + 2 * tid; const unsigned a = *(const GAS unsigned*)pr, g = *(const GAS unsigned*)(pr + 1024);
        const float a0 = bf2f(a & 0xffffu), a1 = bf2f(a >> 16), g0 = bf2f(g & 0xffffu), g1 = bf2f(g >> 16);
        const unsigned zz = pk2(a0 * __builtin_amdgcn_rcpf(1.f + __builtin_amdgcn_exp2f(-LOG2E * g0)), a1 * __builtin_amdgcn_rcpf(1.f + __builtin_amdgcn_exp2f(-LOG2E * g1)));
        z[r * 512 + tid] = ok ? zz : 0u; }
    typedef float f32x2c __attribute__((ext_vector_type(2)));
    float w0[CK], w1[CK];
#pragma unroll
    for (int j = 0; j < CK; ++j) { const f32x2c w = *(const GAS f32x2c*)(F.cw + j * CCH + 2 * tid); w0[j] = w.x; w1[j] = w.y; }
    const f32x2c cbv = *(const GAS f32x2c*)(F.cb + 2 * tid), lg = *(const GAS f32x2c*)(F.clg + 2 * tid), lb = *(const GAS f32x2c*)(F.clb + 2 * tid);
    __syncthreads();
#pragma unroll 1
    for (int hf = 0; hf < 2; ++hf) {
        float c0[16], c1[16];
#pragma unroll
        for (int g = 0; g < 4; ++g) {
            float zl[34], zh[34];
#pragma unroll
            for (int r = 0; r < 34; ++r) { const unsigned zz = z[(16 * hf + 4 * g + r) * 512 + tid]; zl[r] = __builtin_bit_cast(float, zz << 16); zh[r] = __builtin_bit_cast(float, zz & 0xffff0000u); }
#pragma unroll
            for (int t = 0; t < 4; ++t) { float a0 = cbv.x, a1 = cbv.y;
#pragma unroll
                for (int j = 0; j < CK; ++j) { a0 = fmaf(w0[j], zl[t + j], a0); a1 = fmaf(w1[j], zh[t + j], a1); }
                c0[4 * g + t] = a0; c1[4 * g + t] = a1; }
        }
#pragma unroll
        for (int t = 0; t < 16; ++t) { const float sm = wave_sum(c0[t] + c1[t]), q = wave_sum(c0[t] * c0[t] + c1[t] * c1[t]);
            if (F.lane == 0) { st[(F.wave * 16 + t) * 2] = sm; st[(F.wave * 16 + t) * 2 + 1] = q; } }
        __syncthreads();
        if (tid < 16) { float sm = 0.f, q = 0.f;
#pragma unroll
            for (int w = 0; w < 8; ++w) { sm += st[(w * 16 + tid) * 2]; q += st[(w * 16 + tid) * 2 + 1]; }
            const float mu = sm * (1.f / CCH), var = q * (1.f / CCH) - mu * mu; st[512 + tid * 2] = mu; st[512 + tid * 2 + 1] = rsqrtf(fmaxf(var, 0.f) + EPS); }
        __syncthreads();
#pragma unroll
        for (int t = 0; t < 16; ++t) { const float mu = st[512 + t * 2], rs = st[512 + t * 2 + 1];
            const float y0 = (c0[t] - mu) * rs * lg.x + lb.x, y1 = (c1[t] - mu) * rs * lg.y + lb.y;
            const float o0 = y0 * __builtin_amdgcn_rcpf(1.f + __builtin_amdgcn_exp2f(-LOG2E * y0)), o1 = y1 * __builtin_amdgcn_rcpf(1.f + __builtin_amdgcn_exp2f(-LOG2E * y1));
            *(GAS unsigned*)(mix + (size_t)(b * SEQ + s0 + 16 * hf + t) * DM + 1024 + 2 * tid) = cvt_pk_bf16(o0, o1); }
        __syncthreads();
    }
}

namespace att {
constexpr int KVBLK = 64; constexpr size_t SHM_V = KVBLK * 128 * 2, SHM_K = KVBLK * 128 * 2;
constexpr float C = 0.125f * LOG2E, THR2 = 8.f * LOG2E;
#define KSWZ(row, colB) ((row) * 256 + ((colB) ^ (((row) & 7) << 4)))
#define SBAR() __builtin_amdgcn_sched_barrier(0)
__device__ __forceinline__ int crow(int r, int hi) { return (r & 3) + 8 * (r >> 2) + 4 * hi; }
__device__ __forceinline__ int v_st(int k, int c) { const int kk = (k & ~0xC) | ((k & 4) << 1) | ((k & 8) >> 1); return ((kk >> 3) * 4 + (c >> 5)) * 512 + ((kk & 7) * 32 + (c & 31)) * 2; }
__device__ __forceinline__ int v_rd_base(int lane) { return ((lane & 3) << 3) | (((lane >> 2) & 3) << 6) | (((lane >> 4) & 1) << 5) | (((lane >> 5) & 1) << 8); }
constexpr int v_rd_off(int d0, int ks, int half) { return d0 * 512 + ks * 4096 + half * 2048; }
template <int OFF> __device__ __forceinline__ s16x4 tr_read(int vb) { s16x4 r; asm volatile("ds_read_b64_tr_b16 %0, %1 offset:%2" : "=&v"(r) : "v"(vb), "i"(OFF) : "memory"); return r; }
template <int D0> __device__ __forceinline__ void pv_one(f32x16& od, int vb, bf16x8 pa0, bf16x8 pa1, bf16x8 pa2, bf16x8 pa3) {
    const s16x4 l0 = tr_read<v_rd_off(D0, 0, 0)>(vb), h0 = tr_read<v_rd_off(D0, 0, 1)>(vb), l1 = tr_read<v_rd_off(D0, 1, 0)>(vb), h1 = tr_read<v_rd_off(D0, 1, 1)>(vb);
    const s16x4 l2 = tr_read<v_rd_off(D0, 2, 0)>(vb), h2 = tr_read<v_rd_off(D0, 2, 1)>(vb), l3 = tr_read<v_rd_off(D0, 3, 0)>(vb), h3 = tr_read<v_rd_off(D0, 3, 1)>(vb);
    asm volatile("s_waitcnt lgkmcnt(0)" ::: "memory"); SBAR();
#define PK(L, H) (bf16x8){L[0], L[1], L[2], L[3], H[0], H[1], H[2], H[3]}
    od = __builtin_amdgcn_mfma_f32_32x32x16_bf16(pa0, PK(l0, h0), od, 0, 0, 0);
    od = __builtin_amdgcn_mfma_f32_32x32x16_bf16(pa1, PK(l1, h1), od, 0, 0, 0);
    od = __builtin_amdgcn_mfma_f32_32x32x16_bf16(pa2, PK(l2, h2), od, 0, 0, 0);
    od = __builtin_amdgcn_mfma_f32_32x32x16_bf16(pa3, PK(l3, h3), od, 0, 0, 0);
#undef PK
}
__device__ __forceinline__ void pv_d0(f32x16* o, int vb, bf16x8 pa0, bf16x8 pa1, bf16x8 pa2, bf16x8 pa3) {
    pv_one<0>(o[0], vb, pa0, pa1, pa2, pa3); pv_one<1>(o[1], vb, pa0, pa1, pa2, pa3); pv_one<2>(o[2], vb, pa0, pa1, pa2, pa3); pv_one<3>(o[3], vb, pa0, pa1, pa2, pa3);
}
__device__ __forceinline__ void qkt(f32x16& p0, f32x16& p1, const LAS char* Ks, const bf16x8* qr, int r32, int hi, int map) {
    p0 = f32x16{}; p1 = f32x16{};
#pragma unroll
    for (int d0 = 0; d0 < 4; ++d0) { const int cb = ((map * 4 + d0) * 16 + hi * 8) * 2;
        const bf16x8 b0 = *(const LAS bf16x8*)(Ks + KSWZ(r32, cb)); const bf16x8 b1 = *(const LAS bf16x8*)(Ks + KSWZ(32 + r32, cb));
        p0 = __builtin_amdgcn_mfma_f32_32x32x16_bf16(b0, qr[d0], p0, 0, 0, 0);
        p1 = __builtin_amdgcn_mfma_f32_32x32x16_bf16(b1, qr[d0], p1, 0, 0, 0); }
}
__device__ __forceinline__ void partialSM(f32x16& p0, f32x16& p1, float& m_reg, float& mn, float& alpha, int relw, int relb, int hi, const LAS float* btab, float bneg, float bpos) {
    if (relw - 31 >= 91 || relw + 63 <= -91) {
        const float bc = (relw > 0) ? bpos : bneg;
        float pmax = p0[0];
#pragma unroll
        for (int r = 1; r < 16; ++r) pmax = fmaxf(pmax, p0[r]);
#pragma unroll
        for (int r = 0; r < 16; ++r) pmax = fmaxf(pmax, p1[r]);
        { auto rr = __builtin_amdgcn_permlane32_swap(__float_as_uint(pmax), __float_as_uint(pmax), false, false); pmax = fmaxf(__uint_as_float(rr[0]), __uint_as_float(rr[1])); }
        const float tmax = fmaf(pmax, C, bc);
        if (__builtin_expect(__all(tmax - m_reg <= THR2), 1)) { mn = m_reg; alpha = 1.f; }
        else { mn = fmaxf(m_reg, tmax); alpha = __builtin_amdgcn_exp2f(m_reg - mn); m_reg = mn; }
        const float off = bc - mn;
#pragma unroll
        for (int r = 0; r < 16; ++r) p0[r] = fmaf(p0[r], C, off);
#pragma unroll
        for (int r = 0; r < 16; ++r) p1[r] = fmaf(p1[r], C, off);
    } else {
#pragma unroll
        for (int r = 0; r < 16; ++r) { const int idx = relb + crow(r, hi) + 256; p0[r] = fmaf(p0[r], C, btab[idx]); p1[r] = fmaf(p1[r], C, btab[idx + 32]); }
        float pmax = p0[0];
#pragma unroll
        for (int r = 1; r < 16; ++r) pmax = fmaxf(pmax, p0[r]);
#pragma unroll
        for (int r = 0; r < 16; ++r) pmax = fmaxf(pmax, p1[r]);
        { auto rr = __builtin_amdgcn_permlane32_swap(__float_as_uint(pmax), __float_as_uint(pmax), false, false); pmax = fmaxf(__uint_as_float(rr[0]), __uint_as_float(rr[1])); }
        if (__builtin_expect(__all(pmax - m_reg <= THR2), 1)) { mn = m_reg; alpha = 1.f; }
        else { mn = fmaxf(m_reg, pmax); alpha = __builtin_amdgcn_exp2f(m_reg - mn); m_reg = mn; }
#pragma unroll
        for (int r = 0; r < 16; ++r) p0[r] -= mn;
#pragma unroll
        for (int r = 0; r < 16; ++r) p1[r] -= mn;
    }
#pragma unroll
    for (int r = 0; r < 16; ++r) p0[r] = __builtin_amdgcn_exp2f(p0[r]);
}
__device__ __forceinline__ void finishSM(f32x16& p0, f32x16& p1, float alpha, float& l_reg, bf16x8& pa0, bf16x8& pa1, bf16x8& pa2, bf16x8& pa3) {
#pragma unroll
    for (int r = 0; r < 16; ++r) p1[r] = __builtin_amdgcn_exp2f(p1[r]);
    float ps = 0;
#pragma unroll
    for (int r = 0; r < 16; ++r) ps += p0[r];
#pragma unroll
    for (int r = 0; r < 16; ++r) ps += p1[r];
    { auto rr = __builtin_amdgcn_permlane32_swap(__float_as_uint(ps), __float_as_uint(ps), false, false); ps = __uint_as_float(rr[0]) + __uint_as_float(rr[1]); }
    l_reg = l_reg * alpha + ps;
#define PK4(P, BASE, OUT) do { unsigned a0 = cvt_pk_bf16(P[BASE + 0], P[BASE + 1]), a1 = cvt_pk_bf16(P[BASE + 2], P[BASE + 3]);   \
    unsigned b0 = cvt_pk_bf16(P[BASE + 4], P[BASE + 5]), b1 = cvt_pk_bf16(P[BASE + 6], P[BASE + 7]);                              \
    auto r0 = __builtin_amdgcn_permlane32_swap(a0, b0, false, false); auto r1 = __builtin_amdgcn_permlane32_swap(a1, b1, false, false); \
    u32x4 w = {r0[0], r1[0], r0[1], r1[1]}; OUT = __builtin_bit_cast(bf16x8, w); } while (0)
    PK4(p0, 0, pa0); PK4(p0, 8, pa1); PK4(p1, 0, pa2); PK4(p1, 8, pa3);
#undef PK4
}
constexpr int L_V = 0, L_K = 32768, L_WS = 65536, L_BT = 67584, L_CB = 69632;
__device__ __forceinline__ void attn_unit(Frame& F, int unit) {
    const int bh = unit >> 4, qb = unit & 15, b = bh >> 3, h = bh & 7, q0 = qb * 128;
    const int tid = F.tid, wid = F.wave, lane = F.lane, r32 = lane & 31, hi = lane >> 5, rg = wid & 3, map = wid >> 2;
    const bf16* proj = WSP(bf16, WS_PROJ);
    const bf16* Kh = proj + (size_t)(b * SEQ) * INC + 1024 + h * 128; const bf16* Vh = proj + (size_t)(b * SEQ) * INC + 2048 + h * 128;
    LAS char* lds = (LAS char*)F.lds; LAS char* V_lds = lds + L_V; LAS char* K_lds = lds + L_K;
    LAS float* wsf = (LAS float*)(lds + L_WS) + wid * 64; LAS float* li_l = wsf; LAS float* al_l = wsf + 32;
    LAS float* btab = (LAS float*)(lds + L_BT);
    const float* bt = WSP(float, WS_BIAST) + h * 4096;
    __syncthreads();
    btab[tid] = bt[2048 - 256 + tid];
    const float bneg = bt[2048 - 200], bpos = bt[2048 + 200], lam = WSP(float, WS_BIAST)[AH * 4096];
    float m_reg = -1e30f, l_reg = 0; f32x16 o[4] = {}; bf16x8 qr[4];
    const int qw0 = q0 + 32 * rg;
    const bf16* Qw = proj + (size_t)(b * SEQ + qw0 + r32) * INC + h * 128 + map * 64 + hi * 8;
#pragma unroll
    for (int d0 = 0; d0 < 4; ++d0) qr[d0] = *(const GAS bf16x8*)(Qw + d0 * 16);
    const int sr = tid >> 4, sc = (tid & 15) * 8, vst0 = v_st(sr, sc), vst1 = v_st(32 + sr, sc);
    const int vb0 = (int)(uintptr_t)V_lds + v_rd_base(lane);
    struct { bf16x8 vs0, vs1, ks0, ks1; } sr_[2];
#define SLOAD(i, k0) do { sr_[i].vs0 = *(const GAS bf16x8*)&Vh[(size_t)((k0) + sr) * INC + sc]; sr_[i].vs1 = *(const GAS bf16x8*)&Vh[(size_t)((k0) + 32 + sr) * INC + sc]; \
    sr_[i].ks0 = *(const GAS bf16x8*)&Kh[(size_t)((k0) + sr) * INC + sc]; sr_[i].ks1 = *(const GAS bf16x8*)&Kh[(size_t)((k0) + 32 + sr) * INC + sc]; } while (0)
#define SWRITE(bb, i) do { *(LAS bf16x8*)(V_lds + (bb) * SHM_V + vst0) = sr_[i].vs0; *(LAS bf16x8*)(V_lds + (bb) * SHM_V + vst1) = sr_[i].vs1; const int kc = sc * 2; \
    *(LAS bf16x8*)(K_lds + (bb) * SHM_K + KSWZ(sr, kc)) = sr_[i].ks0; *(LAS bf16x8*)(K_lds + (bb) * SHM_K + KSWZ(32 + sr, kc)) = sr_[i].ks1; } while (0)
#define SWAIT() asm volatile("s_waitcnt vmcnt(4)" ::: "memory")
#define RESC(a) do { if (__any((a) < 1.f)) { if (hi == 0) al_l[r32] = (a); asm volatile("s_waitcnt lgkmcnt(0)" ::: "memory"); \
    _Pragma("unroll") for (int d = 0; d < 4; ++d) _Pragma("unroll") for (int r = 0; r < 16; ++r) o[d][r] *= al_l[crow(r, hi)]; } } while (0)
#define PSM(P0, P1, MN, AL, k0) partialSM(P0, P1, m_reg, MN, AL, (k0) - qw0, (k0) - qw0 - r32, hi, btab, bneg, bpos)
    f32x16 pA0, pA1, pB0, pB1; float mnA, mnB, alA, alB; bf16x8 pa0, pa1, pa2, pa3; constexpr int NT = SEQ / KVBLK;
    constexpr int SE = 0, SO = 1;
    SLOAD(SE, 0); asm volatile("s_waitcnt vmcnt(0)" ::: "memory"); SWRITE(0, SE); __syncthreads();
    qkt(pA0, pA1, K_lds, qr, r32, hi, map); PSM(pA0, pA1, mnA, alA, 0);
    SLOAD(SO, KVBLK); SLOAD(SE, 2 * KVBLK);
    SWAIT(); SWRITE(1, SO); __syncthreads();
    for (int j = 1; j + 1 < NT; j += 2) {
        SBAR(); qkt(pB0, pB1, K_lds + SHM_K, qr, r32, hi, map);
        finishSM(pA0, pA1, alA, l_reg, pa0, pa1, pa2, pa3); SBAR();
        SLOAD(SO, (j + 2) * KVBLK); SBAR();
        pv_d0(o, vb0, pa0, pa1, pa2, pa3); PSM(pB0, pB1, mnB, alB, j * KVBLK);
        __syncthreads(); SWAIT(); SWRITE(0, SE);
        RESC(alB); __syncthreads();
        SBAR(); qkt(pA0, pA1, K_lds, qr, r32, hi, map);
        finishSM(pB0, pB1, alB, l_reg, pa0, pa1, pa2, pa3); SBAR();
        if (j + 3 < NT) SLOAD(SE, (j + 3) * KVBLK); SBAR();
        pv_d0(o, vb0 + (int)SHM_V, pa0, pa1, pa2, pa3); PSM(pA0, pA1, mnA, alA, (j + 1) * KVBLK);
        __syncthreads(); SWAIT(); SWRITE(1, SO);
        RESC(alA); __syncthreads();
    }
    SBAR(); qkt(pB0, pB1, K_lds + SHM_K, qr, r32, hi, map);
    finishSM(pA0, pA1, alA, l_reg, pa0, pa1, pa2, pa3); SBAR();
    pv_d0(o, vb0, pa0, pa1, pa2, pa3); PSM(pB0, pB1, mnB, alB, (NT - 1) * KVBLK);
    __syncthreads(); RESC(alB);
    finishSM(pB0, pB1, alB, l_reg, pa0, pa1, pa2, pa3); SBAR();
    pv_d0(o, vb0 + (int)SHM_V, pa0, pa1, pa2, pa3);
    if (hi == 0) li_l[r32] = l_reg; asm volatile("s_waitcnt lgkmcnt(0)" ::: "memory");
    float rli[16];
#pragma unroll
    for (int r = 0; r < 16; ++r) rli[r] = __builtin_amdgcn_rcpf(li_l[crow(r, hi)]);
    LAS float* cbuf = (LAS float*)(lds + L_CB) + rg * 32 * 128;
    if (map == 1) {
#pragma unroll
        for (int r = 0; r < 16; ++r)
#pragma unroll
            for (int d0 = 0; d0 < 4; ++d0) cbuf[crow(r, hi) * 128 + d0 * 32 + r32] = -lam * o[d0][r] * rli[r];
    }
    __syncthreads();
    if (map == 0) {
        bf16* mix = WSP(bf16, WS_MIX) + (size_t)(b * SEQ + qw0) * DM + h * 128;
        float sg[4];
#pragma unroll
        for (int d0 = 0; d0 < 4; ++d0) sg[d0] = F.subln[d0 * 32 + r32] * 0.8f;
#pragma unroll
        for (int r = 0; r < 16; ++r) { float v[4], ss = 0.f;
#pragma unroll
            for (int d0 = 0; d0 < 4; ++d0) { v[d0] = o[d0][r] * rli[r] + cbuf[crow(r, hi) * 128 + d0 * 32 + r32]; ss += v[d0] * v[d0]; }
#pragma unroll
            for (int s = 1; s < 32; s <<= 1) ss += __shfl_xor(ss, s);
            const float rstd = rsqrtf(ss * (1.f / VD) + EPS);
#pragma unroll
            for (int d0 = 0; d0 < 4; ++d0) mix[(size_t)crow(r, hi) * DM + d0 * 32 + r32] = (bf16)f2bf(v[d0] * rstd * sg[d0]); }
    }
#undef SLOAD
#undef SWRITE
#undef SWAIT
#undef RESC
#undef PSM
}
}

__device__ __forceinline__ void p5_router(Frame& F, bool dry = false) {
    const float* mod = WSP(float, WS_MOD); const bf16* x1 = WSP(bf16, WS_X1); bf16* h2 = WSP(bf16, WS_H2);
    int* list = (int*)(F.ws + WS_ROUTE + RT_LIST); float* sw = (float*)(F.ws + WS_ROUTE + RT_SW); int* toke = (int*)(F.ws + WS_ROUTE + RT_TOKE); int* tokr = (int*)(F.ws + WS_ROUTE + RT_TOKR);
    constexpr int RS = 4096 + 16;
    LAS unsigned char* Ahi = F.lds; LAS unsigned char* Alo = F.lds + 16 * RS; LAS float* Pl = (LAS float*)(F.lds + 32 * RS);
    const unsigned char* wrf = WSP(unsigned char, WS_WRF);
    for (int tb = F.vcu; tb < T / 16; tb += F.G) {
        const int b = (tb * 16) / SEQ;
        __syncthreads();
#pragma unroll 1
        for (int rr = 0; rr < 2; ++rr) {
            const int tl = 2 * F.wave + rr, row = tb * 16 + tl;
            const GAS u32x2* xr = (const GAS u32x2*)(x1 + (size_t)row * DM) + F.lane;
            f32x4 v[8]; float s = 0.f;
#pragma unroll
            for (int j = 0; j < 8; ++j) { const u32x2 xx = xr[64 * j]; v[j] = (f32x4){bf2f(xx.x & 0xffffu), bf2f(xx.x >> 16), bf2f(xx.y & 0xffffu), bf2f(xx.y >> 16)}; s += (v[j].x * v[j].x + v[j].y * v[j].y) + (v[j].z * v[j].z + v[j].w * v[j].w); }
            const float rstd = rsqrtf(wave_sum(s) * (1.f / DM) + EPS);
            GAS u32x2* o8 = (GAS u32x2*)(h2 + (size_t)row * DM) + F.lane;
#pragma unroll
            for (int j = 0; j < 8; ++j) { const int k = 4 * F.lane + 256 * j;
                const f32x4 g = *(const GAS f32x4*)(F.g2 + k), sc = *(const GAS f32x4*)(mod + (size_t)b * 6 * DM + 4 * DM + k), sf = *(const GAS f32x4*)(mod + (size_t)b * 6 * DM + 3 * DM + k);
                float hv[4]; unsigned hb[4], lb[4];
#pragma unroll
                for (int q = 0; q < 4; ++q) { hv[q] = v[j][q] * rstd * g[q] * (1.f + sc[q]) + sf[q]; hb[q] = f2bf(hv[q]); lb[q] = f2bf(hv[q] - bf2f(hb[q])); }
                u32x2 wh, wl; wh.x = hb[0] | (hb[1] << 16); wh.y = hb[2] | (hb[3] << 16); wl.x = lb[0] | (lb[1] << 16); wl.y = lb[2] | (lb[3] << 16);
                o8[64 * j] = wh; *(LAS u32x2*)(Ahi + tl * RS + k * 2) = wh; *(LAS u32x2*)(Alo + tl * RS + k * 2) = wl; }
        }
        __syncthreads();
        { f32x4 acc0 = {0.f, 0.f, 0.f, 0.f}, acc1 = {0.f, 0.f, 0.f, 0.f};
#pragma unroll 2
          for (int ks = 0; ks < 8; ++ks) { const int s = 8 * F.wave + ks, k0 = 32 * s + 8 * (F.lane >> 4);
            const bf16x8 ah = *(const LAS bf16x8*)(Ahi + (F.lane & 15) * RS + k0 * 2), al = *(const LAS bf16x8*)(Alo + (F.lane & 15) * RS + k0 * 2);
            const bf16x8 bh0 = *(const GAS bf16x8*)(wrf + ((size_t)(s * 2 + 0) * 64 + F.lane) * 16), bh1 = *(const GAS bf16x8*)(wrf + ((size_t)(s * 2 + 1) * 64 + F.lane) * 16);
            const bf16x8 bl0 = *(const GAS bf16x8*)(wrf + 131072 + ((size_t)(s * 2 + 0) * 64 + F.lane) * 16), bl1 = *(const GAS bf16x8*)(wrf + 131072 + ((size_t)(s * 2 + 1) * 64 + F.lane) * 16);
            acc0 = __builtin_amdgcn_mfma_f32_16x16x32_bf16(ah, bh0, acc0, 0, 0, 0); acc0 = __builtin_amdgcn_mfma_f32_16x16x32_bf16(ah, bl0, acc0, 0, 0, 0); acc0 = __builtin_amdgcn_mfma_f32_16x16x32_bf16(al, bh0, acc0, 0, 0, 0);
            acc1 = __builtin_amdgcn_mfma_f32_16x16x32_bf16(ah, bh1, acc1, 0, 0, 0); acc1 = __builtin_amdgcn_mfma_f32_16x16x32_bf16(ah, bl1, acc1, 0, 0, 0); acc1 = __builtin_amdgcn_mfma_f32_16x16x32_bf16(al, bh1, acc1, 0, 0, 0); }
#pragma unroll
          for (int r = 0; r < 4; ++r) { const int tk = 4 * (F.lane >> 4) + r; Pl[(F.wave * 16 + tk) * 32 + (F.lane & 15)] = acc0[r]; Pl[(F.wave * 16 + tk) * 32 + 16 + (F.lane & 15)] = acc1[r]; }
        }
        __syncthreads();
        { const int tl = F.tid >> 5, e = F.tid & 31, tok = tb * 16 + tl;
          float v = F.b_r[e];
#pragma unroll
          for (int w = 0; w < 8; ++w) v += Pl[(w * 16 + tl) * 32 + e];
          float tv[4]; int ti[4];
#pragma unroll
          for (int r = 0; r < 4; ++r) { float bv = v; int bi = e;
#pragma unroll
              for (int o = 16; o > 0; o >>= 1) { const float ov = __shfl_xor(bv, o); const int oi = __shfl_xor(bi, o); if (ov > bv || (ov == bv && oi < bi)) { bv = ov; bi = oi; } }
              tv[r] = bv; ti[r] = bi; if (e == bi) v = -3.0e38f; }
          float den = 0.f, w[4];
#pragma unroll
          for (int r = 0; r < 4; ++r) { w[r] = __expf(tv[r] - tv[0]); den += w[r]; }
#pragma unroll
          for (int r = 0; r < 4; ++r) if (e == ti[r] && !dry) { const int rank = (int)atomicAdd(F.ctl + CW_CNT + e, 1u);
              list[e * T + rank] = tok; sw[e * T + rank] = w[r] / den; toke[tok * 4 + r] = e; tokr[tok * 4 + r] = rank; }
        }
    }
}

__device__ __forceinline__ void p8_final(Frame& F) {
    const float* mod = WSP(float, WS_MOD); const bf16* x1 = WSP(bf16, WS_X1); const bf16* y = WSP(bf16, WS_Y);
    const int* toke = (const int*)(F.ws + WS_ROUTE + RT_TOKE); const int* tokr = (const int*)(F.ws + WS_ROUTE + RT_TOKR);
    moe_tables(F);
    const LAS int* off = (const LAS int*)(F.lds + TAB_OFF) + 40;
    for (int row = F.vcu * NWAVES + F.wave; row < T; row += F.G * NWAVES) {
        const int b = row / SEQ;
        size_t so[4];
#pragma unroll
        for (int r = 0; r < 4; ++r) so[r] = (size_t)(off[toke[row * 4 + r]] + tokr[row * 4 + r]) * DM;
        const GAS u32x2* xr = (const GAS u32x2*)(x1 + (size_t)row * DM) + F.lane;
        f32x4 v[8]; float s = 0.f;
#pragma unroll
        for (int j = 0; j < 8; ++j) { const int k = 4 * F.lane + 256 * j; f32x4 m = {0.f, 0.f, 0.f, 0.f};
#pragma unroll
            for (int r = 0; r < 4; ++r) { const u32x2 yy = *(const GAS u32x2*)(y + so[r] + k); m[0] += bf2f(yy.x & 0xffffu); m[1] += bf2f(yy.x >> 16); m[2] += bf2f(yy.y & 0xffffu); m[3] += bf2f(yy.y >> 16); }
            const f32x4 g = *(const GAS f32x4*)(mod + (size_t)b * 6 * DM + 5 * DM + k);
            const u32x2 xx = xr[64 * j]; v[j] = (f32x4){bf2f(xx.x & 0xffffu), bf2f(xx.x >> 16), bf2f(xx.y & 0xffffu), bf2f(xx.y >> 16)} + g * m; s += (v[j].x * v[j].x + v[j].y * v[j].y) + (v[j].z * v[j].z + v[j].w * v[j].w); }
        const float rstd = rsqrtf(wave_sum(s) * (1.f / DM) + EPS);
        GAS f32x4* orow = (GAS f32x4*)(F.out + (size_t)row * DM) + F.lane;
#pragma unroll
        for (int j = 0; j < 8; ++j) { const f32x4 g = *(const GAS f32x4*)(F.fg + 4 * F.lane + 256 * j); orow[64 * j] = v[j] * rstd * g; }
    }
}

struct Args { const float* in[25]; float* out; unsigned char* ws; int ph_lo, ph_hi, li, pad; };
__global__ void __launch_bounds__(NTHR, 2) mega_fwd(Args args) {
    extern __shared__ __attribute__((aligned(16))) unsigned char lds[];
    Frame F;
    F.lds = (LAS unsigned char*)lds; F.MISC = (volatile LAS unsigned*)(F.lds + MISC_OFF);
    F.tid = threadIdx.x; F.lane = F.tid & 63; F.wave = __builtin_amdgcn_readfirstlane(F.tid >> 6);
    F.G = gridDim.x; { const int bx = blockIdx.x; F.vcu = (F.G % 8 == 0) ? (bx % 8) * (F.G / 8) + bx / 8 : bx; }
    F.ws = args.ws; F.ctl = (unsigned*)(args.ws + WS_CTL); F.out = args.out;
    F.x = args.in[0]; F.c = args.in[1]; F.w_ada = args.in[2]; F.b_ada = args.in[3]; F.g1 = args.in[4]; F.w_in = args.in[5]; F.lq1 = args.in[6]; F.lk1 = args.in[7]; F.lq2 = args.in[8]; F.lk2 = args.in[9];
    F.subln = args.in[10]; F.relb = args.in[11]; F.cw = args.in[12]; F.cb = args.in[13]; F.clg = args.in[14]; F.clb = args.in[15]; F.w_out = args.in[16]; F.g2 = args.in[17]; F.w_r = args.in[18]; F.b_r = args.in[19];
    F.w_gu = args.in[20]; F.b_gu = args.in[21]; F.w_d = args.in[22]; F.b_d = args.in[23]; F.fg = args.in[24];
    for (int u = F.tid; u < 64; u += NTHR) ((LAS unsigned*)(F.lds + MISC_OFF))[u] = 0u;
    __syncthreads();
    XcdBarrier bar = xcd_barrier_post(F.ctl + CW_BAR + args.li * XCD_BAR_WORDS, F.MISC + 8);
    const int lo = args.ph_lo, hi = args.ph_hi;
#ifndef PH_MASK
#define PH_MASK 0x1ff
#endif
#define IN(k) (((PH_MASK >> (k)) & 1) && lo <= (k) && (k) < hi)
#define SEAM(k) do { if (IN(k) && IN((k) + 1)) { xcd_barrier(bar); if constexpr (((REP_MASK >> 14) & 1) != 0) xcd_barrier(bar); } } while (0)
#define REP2(k, ...) do { { __VA_ARGS__ } if constexpr (((REP_MASK >> (k)) & 1) != 0) { __VA_ARGS__ } } while (0)
    if (IN(0)) { REP2(0, __syncthreads(); p0_prologue(F);); } SEAM(0);
    if (IN(0) && IN(1)) F.vcu = xcd_virtual_cu(bar);
    if (IN(1)) { REP2(1, __syncthreads(); p1_norm1(F);); } SEAM(1);
    if (IN(2)) { REP2(2, { InProjT<false> P{WSP(bf16, WS_H), WSP(bf16, WS_WIN), WSP(bf16, WS_PROJ), {}}; P.ord.init(T, INC, F.G, F.vcu, false, true); __syncthreads(); pg8::gemm_run(F.lds, P); }
        { InProjT<true> P{WSP(bf16, WS_H), WSP(bf16, WS_WIN), WSP(bf16, WS_PROJ), {}}; P.ord.init(T, INC, F.G, F.vcu, true, true); __syncthreads(); pg8::gemm_run<InProjT<true>, true>(F.lds, P); }); } SEAM(2);
    if (IN(3)) { REP2(3,
        for (int ct = F.vcu; ct < T / 32; ct += F.G) conv_unit(F, ct);
        if constexpr (((REP_MASK >> 9) & 1) != 0) { for (int ct = F.vcu; ct < T / 32; ct += F.G) conv_unit(F, ct); }
        for (int u = F.vcu; u < NB * AH * 16 * (1 + ((REP_MASK >> 10) & 1)); u += F.G) att::attn_unit(F, u % (NB * AH * 16));
    ); } SEAM(3);
    if (IN(4)) { REP2(4, OutProj P{WSP(bf16, WS_MIX), WSP(bf16, WS_WOUT), F.x, WSP(float, WS_MOD), WSP(bf16, WS_X1), {}}; P.ord.init(T, DM, F.G, F.vcu); __syncthreads(); pg8::gemm_run(F.lds, P);); } SEAM(4);
    if (IN(5)) { p5_router(F); if constexpr (((REP_MASK >> 13) & 1) != 0) { __syncthreads(); p5_router(F, true); } } SEAM(5);
    if (IN(6)) { REP2(6, moe_tables(F); const LAS int* tab = (const LAS int*)(F.lds + TAB_OFF);
        MoeGU P{WSP(bf16, WS_H2), F.w_gu, F.b_gu, (const int*)(F.ws + WS_ROUTE + RT_LIST), WSP(bf16, WS_ACT), {tab, tab + 40, tab + 80}, F.G, F.vcu}; pg8::gemm_run_bf32(F.lds, P);); } SEAM(6);
    if (IN(7)) { REP2(7, moe_tables(F); const LAS int* tab = (const LAS int*)(F.lds + TAB_OFF);
        MoeDown P{WSP(bf16, WS_ACT), F.w_d, F.b_d, (const float*)(F.ws + WS_ROUTE + RT_SW), WSP(bf16, WS_Y), {tab, tab + 40, tab + 80}, F.G, F.vcu}; pg8::gemm_run_bf32(F.lds, P);); } SEAM(7);
    if (IN(8)) { REP2(8, p8_final(F);); }
#undef IN
#undef SEAM
}

extern "C" void kernel_launch(void* const* d_in, const int* in_sizes, int n_in, void* d_out, int out_size, void* d_ws, size_t ws_size, hipStream_t stream) {
    static int grid = 0;
    if (grid == 0) {
        if (n_in != 25 || ws_size < WS_END || out_size != T * DM) { fprintf(stderr, "kernel_launch: n_in %d out %d ws %zu (need %zu); nothing launched\n", n_in, out_size, ws_size, (size_t)WS_END); grid = -1; return; }
        int dev = 0, cus = 0, per_cu = 0;
        if (hipGetDevice(&dev) != hipSuccess || hipDeviceGetAttribute(&cus, hipDeviceAttributeMultiprocessorCount, dev) != hipSuccess) { grid = -1; return; }
        if (hipFuncSetAttribute((const void*)mega_fwd, hipFuncAttributeMaxDynamicSharedMemorySize, LDS_BYTES) != hipSuccess) { fprintf(stderr, "kernel_launch: hipFuncSetAttribute failed\n"); grid = -1; return; }
        if (hipOccupancyMaxActiveBlocksPerMultiprocessor(&per_cu, (const void*)mega_fwd, NTHR, LDS_BYTES) != hipSuccess || per_cu < 1) { fprintf(stderr, "kernel_launch: occupancy query says %d blocks per CU\n", per_cu); }
        (void)hipGetLastError();
        grid = cus;
    }
    if (grid < 0) return;
    unsigned char* ws = (unsigned char*)d_ws;
    (void)hipMemsetAsync(ws + WS_CTL, 0, CTL_ZERO_BYTES, stream);
    Args a{};
    for (int i = 0; i < 25; ++i) a.in[i] = (const float*)d_in[i];
    a.out = (float*)d_out; a.ws = ws; a.ph_lo = 0; a.ph_hi = 9; a.li = 0; a.pad = 0;
    hipLaunchKernelGGL(mega_fwd, dim3(grid), dim3(NTHR), LDS_BYTES, stream, a);
}
```

```cpp
#include <hip/hip_runtime.h>
#include <cstdio>
#include <cstdint>

#ifndef REP_MASK
#define REP_MASK 0
#endif

constexpr int DM = 2048, NB = 4, SEQ = 2048, T = NB * SEQ;
constexpr int AH = 8, HD = 64, VD = 128, CCH = 1024, CK = 31;
constexpr int INC = 5120;
constexpr int NE = 32, TOPK = 4, DFF = 2048, NSLOT = T * TOPK;
constexpr float EPS = 1e-6f;
constexpr float LOG2E = 1.4426950408889634f;

typedef unsigned short bf16;
typedef short bf16x8 __attribute__((ext_vector_type(8)));
typedef short s16x4 __attribute__((ext_vector_type(4)));
typedef float f32x4 __attribute__((ext_vector_type(4)));
typedef float f32x16 __attribute__((ext_vector_type(16)));
typedef unsigned u32x4 __attribute__((ext_vector_type(4)));
typedef unsigned u32x2 __attribute__((ext_vector_type(2)));
#define GAS __attribute__((address_space(1)))
#define LAS __attribute__((address_space(3)))
typedef GAS unsigned gu32;

constexpr size_t MiB = 1u << 20;
constexpr size_t WS_CTL = 0, CTL_ZERO_BYTES = 64 * 1024;
constexpr size_t WS_MODP = 1 * MiB;
constexpr size_t WS_MOD = 3 * MiB;
constexpr size_t WS_BIAST = 4 * MiB;
constexpr size_t WS_WRF = 5 * MiB;
constexpr size_t WS_ROUTE = 6 * MiB;
constexpr size_t RT_LIST = 0;
constexpr size_t RT_SW = 1 * MiB;
constexpr size_t RT_TOKE = 2 * MiB;
constexpr size_t RT_TOKR = RT_TOKE + 128 * 1024;
constexpr size_t WS_WIN = 16 * MiB;
constexpr size_t WS_WOUT = WS_WIN + 20 * MiB;
constexpr size_t WS_H = WS_WOUT + 8 * MiB;
constexpr size_t WS_PROJ = WS_H + 32 * MiB;
constexpr size_t WS_MIX = WS_PROJ + 80 * MiB;
constexpr size_t WS_X1 = WS_MIX + 32 * MiB;
constexpr size_t WS_H2 = WS_X1 + 64 * MiB;
constexpr size_t WS_ACT = WS_H2 + 32 * MiB;
constexpr size_t WS_Y = WS_ACT + 130 * MiB;
constexpr size_t WS_END = WS_Y + 130 * MiB;
constexpr int CW_CNT = 0;
constexpr int CW_BAR = 1024;

__device__ __forceinline__ unsigned f2bf(float f) { unsigned u = __builtin_bit_cast(unsigned, f); return (u + 0x7fffu + ((u >> 16) & 1u)) >> 16; }
__device__ __forceinline__ float bf2f(unsigned h) { return __builtin_bit_cast(float, h << 16); }
__device__ __forceinline__ unsigned pk2(float lo, float hi) { return f2bf(lo) | (f2bf(hi) << 16); }
__device__ __forceinline__ unsigned cvt_pk_bf16(float lo, float hi) { unsigned r; asm volatile("v_cvt_pk_bf16_f32 %0, %1, %2" : "=v"(r) : "v"(lo), "v"(hi)); return r; }
__device__ __forceinline__ float silu_f(float v) { return v / (1.f + __expf(-v)); }
__device__ __forceinline__ float wave_sum(float v) {
#pragma unroll
    for (int o = 1; o < 64; o <<= 1) v += __shfl_xor(v, o);
    return v;
}
__host__ __device__ inline int t5_bucket(int rel) {
    int ret = rel > 0 ? 16 : 0; int n = rel < 0 ? -rel : rel;
    if (n < 8) return ret + n;
    int lg = n >= 91 ? 15 : n >= 64 ? 14 : n >= 46 ? 13 : n >= 32 ? 12 : n >= 23 ? 11 : n >= 16 ? 10 : n >= 12 ? 9 : 8;
    return ret + lg;
}
#define LDS_WAIT() asm volatile("s_waitcnt lgkmcnt(0)" ::: "memory")
#define VM_WAIT() asm volatile("s_waitcnt vmcnt(0)" ::: "memory")

#define XB_TMO      128
#define XB_XCNT(j)  (256  + 64 * (j))
#define XB_XSUB(j)  (1280 + 64 * (j))
#define XB_XGEN(j)  (2304 + 64 * (j))
#define XB_TOP      3328
#define XB_TOPGEN   3392
#define XCD_BAR_WORDS 3456
#define XB_SPIN_CAP (1u << 18)
__device__ __forceinline__ unsigned xb_ld(unsigned* p)              { return __hip_atomic_load(p, __ATOMIC_RELAXED, __HIP_MEMORY_SCOPE_AGENT); }
__device__ __forceinline__ unsigned xb_add(unsigned* p, unsigned v) { return __hip_atomic_fetch_add(p, v, __ATOMIC_RELAXED, __HIP_MEMORY_SCOPE_AGENT); }
__device__ __forceinline__ unsigned xb_xcc_id() { return (unsigned)__builtin_amdgcn_s_getreg((3 << 11) | 20) & 0xFu; }
#define XB_SPIN(cond, bar) do { unsigned _sp = 0; while (cond) { __builtin_amdgcn_s_sleep(1); \
    if ((++_sp & 255u) == 0u) { if (xb_ld(&(bar)[XB_TMO])) break; if (_sp > XB_SPIN_CAP) { atomicAdd(&(bar)[XB_TMO], 1u); break; } } } } while (0)
struct XcdBarrier { unsigned* bar; unsigned x; volatile LAS unsigned* st; };
__device__ __forceinline__ XcdBarrier xcd_barrier_post(unsigned* bar, volatile LAS unsigned* st) {
    XcdBarrier b; b.bar = bar; b.x = xb_xcc_id(); b.st = st;
    if (threadIdx.x == 0) st[2] = xb_add(&bar[XB_XCNT(b.x)], 1u);
    return b;
}
__device__ __forceinline__ int xcd_virtual_cu(const XcdBarrier& b) {
    if (threadIdx.x == 0) { unsigned pre = 0u; for (unsigned j = 0; j < 16; ++j) { const unsigned c = xb_ld(&b.bar[XB_XCNT(j)]); pre += (j < b.x) ? c : 0u; } b.st[3] = pre + b.st[2]; }
    __syncthreads();
    const int v = (int)b.st[3];
    __syncthreads();
    return __builtin_amdgcn_readfirstlane(v);
}
__device__ __forceinline__ void xcd_barrier_complete(unsigned* bar, unsigned x, unsigned& nloc, unsigned& nx) {
    const unsigned G = gridDim.x * gridDim.y * gridDim.z;
    unsigned sum, cnt, mine, sp = 0u;
    for (;;) {
        sum = 0u; cnt = 0u; mine = 0u;
#pragma unroll
        for (unsigned j = 0; j < 16; ++j) { const unsigned c = xb_ld(&bar[XB_XCNT(j)]); sum += c; cnt += (c > 0u) ? 1u : 0u; mine = (j == x) ? c : mine; }
        if (sum == G) break;
        __builtin_amdgcn_s_sleep(1);
        if ((++sp & 255u) == 0u) { if (xb_ld(&bar[XB_TMO])) break; if (sp > XB_SPIN_CAP) { atomicAdd(&bar[XB_TMO], 1u); break; } }
    }
    nloc = mine > 0u ? mine : 1u; nx = cnt > 0u ? cnt : 1u;
}
__device__ __forceinline__ void xcd_barrier(const XcdBarrier& b) {
    asm volatile("s_waitcnt vmcnt(0)" ::: "memory");
    __syncthreads();
    if (threadIdx.x == 0) {
        unsigned* bar = b.bar;
        __builtin_amdgcn_s_waitcnt(0);
        unsigned nloc = b.st[0], nx = b.st[1];
        if (nloc == 0u) { xcd_barrier_complete(bar, b.x, nloc, nx); b.st[0] = nloc; b.st[1] = nx; }
        const unsigned old = xb_add(&bar[XB_XSUB(b.x)], 1u);
        const unsigned gen = old / nloc;
        if (old + 1u == (gen + 1u) * nloc) {
            __builtin_amdgcn_fence(__ATOMIC_RELEASE, "agent");
            asm volatile("s_waitcnt vmcnt(0)" ::: "memory");
            const unsigned og = xb_add(&bar[XB_TOP], 1u);
            const unsigned tg = og / nx;
            if (og + 1u == (tg + 1u) * nx) xb_add(&bar[XB_TOPGEN], 1u);
            else XB_SPIN(xb_ld(&bar[XB_TOPGEN]) == tg, bar);
            __builtin_amdgcn_fence(__ATOMIC_ACQUIRE, "agent");
            xb_add(&bar[XB_XGEN(b.x)], 1u);
            asm volatile("s_waitcnt vmcnt(0)" ::: "memory");
        } else {
            XB_SPIN(xb_ld(&bar[XB_XGEN(b.x)]) == gen, bar);
            __builtin_amdgcn_fence(__ATOMIC_ACQUIRE, "agent");
            asm volatile("s_waitcnt vmcnt(0)" ::: "memory");
        }
    }
    __syncthreads();
}

namespace pg8 {
constexpr int BM = 256, BK = 64, HALF = 128, HTB = HALF * BK * 2, STAGE_BYTES = 8 * HTB, KD = 2048;
__host__ __device__ __forceinline__ int lds_byte(int r, int c) { const int st = (r >> 4) * 2 + (c >> 5), rr = r & 15, cc = c & 31, ob = rr * 64 + cc * 2; return st * 1024 + (ob ^ (((ob >> 9) & 1) << 5)); }
__host__ __device__ __forceinline__ void stage_rc(int b, int& R, int& C) { const int st = b / 1024, sb = b % 1024, swz = sb ^ (((sb >> 9) & 1) << 5); R = (st >> 1) * 16 + swz / 64; C = (st & 1) * 32 + (swz % 64) / 2; }
__host__ __device__ __forceinline__ int perm32(int rho) { const int n = rho >> 4, i = rho & 15; return 8 * (i >> 2) + 4 * n + (i & 3); }
struct Unit { int pm, pn, e, rows, hs; };

struct DenseOrder {
    int nM, nN, nwg, nfull, G, c; bool half;
    __device__ void init(int M, int N, int G_, int c_, bool half_ = false, bool split_tail = false) { nM = M / BM; nN = N / BM; nwg = nM * nN; G = G_; c = c_; half = half_; nfull = split_tail ? (nwg / G_) * G_ : nwg; }
    __device__ bool next(int i, Unit& u) const {
        long L = (long)i * G + c; int hsel = 0;
        if (half) { if (L >= 2L * (nwg - nfull)) return false; hsel = (int)(L & 1); L = nfull + (L >> 1); }
        else if (L >= nfull) return false;
        const int wgid = (int)L;
        const int nig = 8 * nN, gid = wgid / nig, fm = gid * 8, gsz = (nM - fm) < 8 ? (nM - fm) : 8;
        u.pm = fm + ((wgid % nig) % gsz); u.pn = (wgid % nig) / gsz; u.e = 0; u.hs = 0; u.rows = 256; if (half) { u.pm = 2 * u.pm + hsel; u.rows = 128; } return true;
    }
};

template <class P, bool HM = false>
__device__ __forceinline__ void gemm_run(LAS unsigned char* lds, const P& prob) {
    const int tid = threadIdx.x, wid = __builtin_amdgcn_readfirstlane(tid >> 6), lane = tid & 63, wr = wid >> 2, wc = wid & 3, fr = lane & 15, fq = lane >> 4;
    constexpr int K = KD, nt = K / BK;
    int Rr[2], Cc[2]; unsigned voffB[2];
#pragma unroll
    for (int i = 0; i < 2; ++i) { int R, C; stage_rc(tid * 16 + i * 8192, R, C); Rr[i] = R; Cc[i] = C; const int Rb = P::PERM ? ((R & ~31) + perm32(R & 31)) : R; voffB[i] = (unsigned)(Rb * K + C) * 2u; }
    constexpr size_t kstep = (size_t)(BK * 2), hstep = (size_t)HALF * K * 2;
    const unsigned ldsw = (unsigned)wid * 1024u;
    const int aoff = lds_byte(wr * 64 + fr, fq * 8), boff = lds_byte(wc * 32 + fr, fq * 8);
#define PG8_SA(b, h) (((b) * 2 + (h)) * HTB)
#define PG8_SB(b, h) ((4 + (b) * 2 + (h)) * HTB)
#define PG8_STAGE(bufoff, gbase, voff) do { _Pragma("unroll") for (int _i = 0; _i < 2; ++_i) \
        __builtin_amdgcn_global_load_lds((const unsigned*)((const char*)(gbase) + (voff)[_i]), (LAS unsigned*)(lds + (bufoff) + ldsw + _i * 8192), 16, 0, 0); } while (0)
#define PG8_LDA(dst, b, h) do { _Pragma("unroll") for (int m = 0; m < 4; ++m) _Pragma("unroll") for (int k = 0; k < 2; ++k) dst[m][k] = *(const LAS bf16x8*)(lds + PG8_SA(b, h) + aoff + m * 2048 + k * 1024); } while (0)
#define PG8_LDB(dst, b, h) do { _Pragma("unroll") for (int n = 0; n < 2; ++n) _Pragma("unroll") for (int k = 0; k < 2; ++k) dst[n][k] = *(const LAS bf16x8*)(lds + PG8_SB(b, h) + boff + n * 2048 + k * 1024); } while (0)
#define PG8_MMA(ai, bj, At, Bt) do { __builtin_amdgcn_s_setprio(1); _Pragma("unroll") for (int m = 0; m < 4; ++m) _Pragma("unroll") for (int n = 0; n < 2; ++n) _Pragma("unroll") for (int k = 0; k < 2; ++k) \
        acc[ai][bj][m][n] = __builtin_amdgcn_mfma_f32_16x16x32_bf16(Bt[n][k], At[m][k], acc[ai][bj][m][n], 0, 0, 0); __builtin_amdgcn_s_setprio(0); } while (0)
#define PG8_WAIT_V(n) asm volatile("s_waitcnt vmcnt(" #n ")" ::: "memory")
#define PG8_WAIT_L(n) asm volatile("s_waitcnt lgkmcnt(" #n ")" ::: "memory")
#define PG8_BAR __builtin_amdgcn_s_barrier()
#define PG8_SCHED __builtin_amdgcn_sched_barrier(0)
    Unit cur, nxt; int ui = 0;
    if (!prob.next(0, cur)) return;
    f32x4 acc[2][2][4][2];
#pragma unroll
    for (int a = 0; a < 2; ++a)
#pragma unroll
        for (int b = 0; b < 2; ++b)
#pragma unroll
            for (int m = 0; m < 4; ++m)
#pragma unroll
                for (int n = 0; n < 2; ++n) acc[a][b][m][n] = (f32x4){0.f, 0.f, 0.f, 0.f};
    bf16x8 At[4][2], B0[2][2], B1[2][2];
    unsigned vC0[2], vC1[2], vN0[2], vN1[2];
    prob.a_off(cur, Rr, Cc, vC0, vC1);
    const char* const Ab = prob.a_base();
    const char* cB = prob.b_base(cur);
    PG8_STAGE(PG8_SB(0, 0), cB, voffB); PG8_STAGE(PG8_SB(0, 1), cB + hstep, voffB); PG8_STAGE(PG8_SA(0, 0), Ab, vC0); if constexpr (!HM) PG8_STAGE(PG8_SA(0, 1), Ab, vC1);
    if (wr == 1) PG8_BAR;
    if constexpr (HM) PG8_WAIT_V(0); else PG8_WAIT_V(2);
    PG8_BAR;
    PG8_STAGE(PG8_SB(1, 0), cB + kstep, voffB); PG8_STAGE(PG8_SA(1, 0), Ab + kstep, vC0); PG8_STAGE(PG8_SB(1, 1), cB + hstep + kstep, voffB);
    PG8_WAIT_V(6); PG8_BAR;
    for (;;) {
        const bool has_next = prob.next(ui + 1, nxt);
        if (has_next) prob.a_off(nxt, Rr, Cc, vN0, vN1); else { vN0[0] = vC0[0]; vN0[1] = vC0[1]; vN1[0] = vC1[0]; vN1[1] = vC1[1]; }
        const char* nB = has_next ? prob.b_base(nxt) : cB;
        for (int t = 0; t < nt; t += 2) {
            const bool last = (t == nt - 2);
            const char* a1 = Ab + (size_t)(t + 1) * kstep;
            const char* a2 = last ? Ab : Ab + (size_t)(t + 2) * kstep; const char* b2 = last ? nB : cB + (size_t)(t + 2) * kstep;
            const char* a3 = a2 + kstep; const char* b3 = b2 + kstep;
            unsigned v20[2], v21[2];
            v20[0] = last ? vN0[0] : vC0[0]; v20[1] = last ? vN0[1] : vC0[1]; v21[0] = last ? vN1[0] : vC1[0]; v21[1] = last ? vN1[1] : vC1[1];
            PG8_LDB(B0, 0, 0); PG8_LDB(B1, 0, 1); PG8_SCHED; PG8_LDA(At, 0, 0); if constexpr (!HM) PG8_STAGE(PG8_SA(1, 1), a1, vC1);
            if constexpr (HM) PG8_WAIT_V(6); else PG8_WAIT_V(8); PG8_WAIT_L(0); PG8_BAR; PG8_MMA(0, 0, At, B0); PG8_MMA(0, 1, At, B1); PG8_BAR; PG8_SCHED;
            if constexpr (!HM) PG8_LDA(At, 0, 1); PG8_STAGE(PG8_SB(0, 0), b2, voffB); PG8_STAGE(PG8_SB(0, 1), b2 + hstep, voffB); PG8_STAGE(PG8_SA(0, 0), a2, v20);
            if constexpr (HM) PG8_WAIT_V(6); else PG8_WAIT_V(8);
            PG8_WAIT_L(0); PG8_BAR; if constexpr (!HM) { PG8_MMA(1, 0, At, B0); PG8_MMA(1, 1, At, B1); } PG8_BAR; PG8_SCHED;
            PG8_LDB(B0, 1, 0); PG8_LDB(B1, 1, 1); PG8_SCHED; PG8_LDA(At, 1, 0); if constexpr (!HM) PG8_STAGE(PG8_SA(0, 1), a2, v21);
            if constexpr (HM) PG8_WAIT_V(6); else PG8_WAIT_V(8); PG8_WAIT_L(0); PG8_BAR; PG8_MMA(0, 0, At, B0); PG8_MMA(0, 1, At, B1); PG8_BAR; PG8_SCHED;
            if constexpr (!HM) PG8_LDA(At, 1, 1); PG8_STAGE(PG8_SB(1, 0), b3, voffB); PG8_STAGE(PG8_SB(1, 1), b3 + hstep, voffB); PG8_STAGE(PG8_SA(1, 0), a3, v20);
            if constexpr (HM) PG8_WAIT_V(6); else PG8_WAIT_V(8);
            PG8_WAIT_L(0); PG8_BAR; if constexpr (!HM) { PG8_MMA(1, 0, At, B0); PG8_MMA(1, 1, At, B1); } PG8_BAR; PG8_SCHED;
        }
        if (wr == 0) PG8_BAR;
        prob.epi(acc, cur, wr, wc, fr, fq);
        if (!has_next) break;
#pragma unroll
        for (int a = 0; a < 2; ++a)
#pragma unroll
            for (int b = 0; b < 2; ++b)
#pragma unroll
                for (int m = 0; m < 4; ++m)
#pragma unroll
                    for (int n = 0; n < 2; ++n) acc[a][b][m][n] = (f32x4){0.f, 0.f, 0.f, 0.f};
        cur = nxt; cB = nB; ++ui; vC0[0] = vN0[0]; vC0[1] = vN0[1]; vC1[0] = vN1[0]; vC1[1] = vN1[1];
        if (wr == 1) PG8_BAR;
    }
    PG8_WAIT_V(0);
    PG8_BAR;
#undef PG8_SA
#undef PG8_SB
#undef PG8_STAGE
#undef PG8_LDA
#undef PG8_LDB
#undef PG8_MMA
#undef PG8_WAIT_V
#undef PG8_WAIT_L
#undef PG8_BAR
#undef PG8_SCHED
}

template <class P, bool HN = false>
__device__ __forceinline__ void gemm_run_bf32(LAS unsigned char* lds, const P& prob) {
    const int tid = threadIdx.x, wid = __builtin_amdgcn_readfirstlane(tid >> 6), lane = tid & 63, wr = wid >> 2, wc = wid & 3, fr = lane & 15, fq = lane >> 4;
    constexpr int K = KD, nt = K / BK;
    constexpr size_t kstep = (size_t)(BK * 2);
    constexpr size_t ldwB = (size_t)P::LDW_BYTES;
    const unsigned ldsw = (unsigned)wid * 1024u;
    const int aoff = lds_byte(wr * 64 + fr, fq * 8), boff = lds_byte(wc * 32 + fr, fq * 8);
    const int wbo0 = lds_byte(32 * (lane >> 4) + (((lane >> 1) & 1) | (((lane >> 3) & 1) << 2) | (((lane >> 2) & 1) << 3)), 8 * wid + 4 * (lane & 1));
#define PG8_SA(b, h) (((b) * 2 + (h)) * HTB)
#define PG8_SB(b, h) ((4 + (b) * 2 + (h)) * HTB)
#define PG8_STAGE(bufoff, gbase, voff) do { _Pragma("unroll") for (int _i = 0; _i < 2; ++_i) \
        __builtin_amdgcn_global_load_lds((const unsigned*)((const char*)(gbase) + (voff)[_i]), (LAS unsigned*)(lds + (bufoff) + ldsw + _i * 8192), 16, 0, 0); } while (0)
#define PG8_LDA(dst, b, h) do { _Pragma("unroll") for (int m = 0; m < 4; ++m) _Pragma("unroll") for (int k = 0; k < 2; ++k) dst[m][k] = *(const LAS bf16x8*)(lds + PG8_SA(b, h) + aoff + m * 2048 + k * 1024); } while (0)
#define PG8_LDB(dst, b, h) do { _Pragma("unroll") for (int n = 0; n < 2; ++n) _Pragma("unroll") for (int k = 0; k < 2; ++k) dst[n][k] = *(const LAS bf16x8*)(lds + PG8_SB(b, h) + boff + n * 2048 + k * 1024); } while (0)
#define PG8_MMA(ai, bj, At, Bt) do { __builtin_amdgcn_s_setprio(1); _Pragma("unroll") for (int m = 0; m < 4; ++m) _Pragma("unroll") for (int n = 0; n < 2; ++n) _Pragma("unroll") for (int k = 0; k < 2; ++k) \
        acc[ai][bj][m][n] = __builtin_amdgcn_mfma_f32_16x16x32_bf16(Bt[n][k], At[m][k], acc[ai][bj][m][n], 0, 0, 0); __builtin_amdgcn_s_setprio(0); } while (0)
#define PG8_WAIT_V(n) asm volatile("s_waitcnt vmcnt(" #n ")" ::: "memory")
#define PG8_WAIT_L(n) asm volatile("s_waitcnt lgkmcnt(" #n ")" ::: "memory")
#define PG8_BAR __builtin_amdgcn_s_barrier()
#define PG8_SCHED __builtin_amdgcn_sched_barrier(0)
#define PG8_BLOAD(kk, h) do { const bool nx_ = (kk) >= nt; const unsigned so_ = (nx_ ? nBo : cBo) + (unsigned)((nx_ ? (kk) - nt : (kk)) * BK + 8 * wid) * (unsigned)ldwB + (unsigned)(h) * (unsigned)P::HALF_BYTES; \
        const unsigned co_ = nx_ ? nCol : cCol; \
        asm volatile("s_nop 4" ::: "memory"); \
        _Pragma("unroll") for (int j_ = 0; j_ < 4; ++j_) asm volatile("buffer_load_dwordx4 %0, %1, %2, %3 offen" : "=v"(bv[j_]) : "v"(co_), "s"(wrs), "s"(so_ + (unsigned)j_ * (unsigned)ldwB) : "memory"); } while (0)
#define PG8_BWAIT(n) asm volatile("s_waitcnt vmcnt(" #n ")" : "+v"(bv[0]), "+v"(bv[1]), "+v"(bv[2]), "+v"(bv[3]) :: "memory")
#define PG8_BWRITE(b, h) do { _Pragma("unroll") for (int i_ = 0; i_ < 4; ++i_) { u32x2 o_; o_.x = cvt_pk_bf16(bv[0][i_], bv[1][i_]); o_.y = cvt_pk_bf16(bv[2][i_], bv[3][i_]); \
        *(LAS u32x2*)(lds + PG8_SB(b, h) + wbo0 + 128 * (i_ & 1) + 2048 * (i_ >> 1)) = o_; } } while (0)
    typedef float f32x2v __attribute__((ext_vector_type(2)));
    Unit cur, nxt; int ui = 0;
    if (!prob.next(0, cur)) return;
    f32x4 acc[2][2][4][2];
    bf16x8 At[4][2], B0[2][2], B1[2][2];
    f32x4 bv[4];
    unsigned vC0[2], vC1[2], vN0[2], vN1[2];
    prob.a_off(cur, vC0, vC1);
    const char* const Ab = prob.a_base();
    const __amdgpu_buffer_rsrc_t wrs = __builtin_amdgcn_make_buffer_rsrc((void*)prob.W, 0, (unsigned)NE * (unsigned)P::W_BYTES, 0x00020000);
    unsigned cBo = (unsigned)cur.e * (unsigned)P::W_BYTES, cCol = prob.b_col(cur, lane & ~1) + (unsigned)(lane & 1) * 4u * (unsigned)ldwB;
    unsigned nBo = cBo, nCol = cCol;
    PG8_BLOAD(0, 0); PG8_BWAIT(0); PG8_BWRITE(0, 0); if constexpr (!HN) { PG8_BLOAD(0, 1); PG8_BWAIT(0); PG8_BWRITE(0, 1); } PG8_BLOAD(1, 0); PG8_BWAIT(0); PG8_BWRITE(1, 0); if constexpr (!HN) PG8_BLOAD(1, 1);
    PG8_STAGE(PG8_SA(0, 0), Ab, vC0); PG8_STAGE(PG8_SA(0, 1), Ab, vC1);
    if (wr == 1) PG8_BAR;
    PG8_WAIT_V(2); PG8_WAIT_L(0); PG8_BAR;
    PG8_STAGE(PG8_SA(1, 0), Ab + kstep, vC0);
    { f32x4 bini[2][2]; prob.bias_load(cur, wc, fq, bini);
#pragma unroll
      for (int a = 0; a < 2; ++a)
#pragma unroll
        for (int b = 0; b < 2; ++b)
#pragma unroll
            for (int m = 0; m < 4; ++m)
#pragma unroll
                for (int n = 0; n < 2; ++n) acc[a][b][m][n] = bini[b][n]; }
    PG8_WAIT_V(0); PG8_BAR;
    for (;;) {
        const bool has_next = prob.next(ui + 1, nxt);
        if (has_next) { prob.a_off(nxt, vN0, vN1); nBo = (unsigned)nxt.e * (unsigned)P::W_BYTES; nCol = prob.b_col(nxt, lane & ~1) + (unsigned)(lane & 1) * 4u * (unsigned)ldwB; }
        else { vN0[0] = vC0[0]; vN0[1] = vC0[1]; vN1[0] = vC1[0]; vN1[1] = vC1[1]; nBo = cBo; nCol = cCol; }
        for (int t = 0; t < nt; t += 2) {
            const bool last = (t == nt - 2);
            const char* a1 = Ab + (size_t)(t + 1) * kstep;
            const char* a2 = last ? Ab : Ab + (size_t)(t + 2) * kstep;
            const char* a3 = a2 + kstep;
            unsigned v20[2], v21[2];
            v20[0] = last ? vN0[0] : vC0[0]; v20[1] = last ? vN0[1] : vC0[1]; v21[0] = last ? vN1[0] : vC1[0]; v21[1] = last ? vN1[1] : vC1[1];
            PG8_LDB(B0, 0, 0); if constexpr (!HN) PG8_LDB(B1, 0, 1); PG8_SCHED; PG8_LDA(At, 0, 0); if constexpr (!HN) { PG8_BWAIT(2); PG8_BWRITE(1, 1); } PG8_BLOAD(t + 2, 0); PG8_STAGE(PG8_SA(1, 1), a1, vC1);
            if constexpr (HN) PG8_WAIT_V(8); else PG8_WAIT_V(12);
            PG8_WAIT_L(0); PG8_BAR; PG8_MMA(0, 0, At, B0); if constexpr (!HN) PG8_MMA(0, 1, At, B1); PG8_BAR; PG8_SCHED;
            PG8_LDA(At, 0, 1); PG8_BWAIT(2); PG8_BWRITE(0, 0); if constexpr (!HN) PG8_BLOAD(t + 2, 1); PG8_STAGE(PG8_SA(0, 0), a2, v20);
            if constexpr (HN) PG8_WAIT_V(8); else PG8_WAIT_V(12);
            PG8_WAIT_L(0); PG8_BAR; PG8_MMA(1, 0, At, B0); if constexpr (!HN) PG8_MMA(1, 1, At, B1); PG8_BAR; PG8_SCHED;
            PG8_LDB(B0, 1, 0); if constexpr (!HN) PG8_LDB(B1, 1, 1); PG8_SCHED; PG8_LDA(At, 1, 0); if constexpr (!HN) { PG8_BWAIT(2); PG8_BWRITE(0, 1); } PG8_BLOAD(t + 3, 0); PG8_STAGE(PG8_SA(0, 1), a2, v21);
            if constexpr (HN) PG8_WAIT_V(8); else PG8_WAIT_V(12);
            PG8_WAIT_L(0); PG8_BAR; PG8_MMA(0, 0, At, B0); if constexpr (!HN) PG8_MMA(0, 1, At, B1); PG8_BAR; PG8_SCHED;
            PG8_LDA(At, 1, 1); PG8_BWAIT(2); PG8_BWRITE(1, 0); if constexpr (!HN) PG8_BLOAD(t + 3, 1); PG8_STAGE(PG8_SA(1, 0), a3, v20);
            if constexpr (HN) PG8_WAIT_V(8); else PG8_WAIT_V(12);
            PG8_WAIT_L(0); PG8_BAR; PG8_MMA(1, 0, At, B0); if constexpr (!HN) PG8_MMA(1, 1, At, B1); PG8_BAR; PG8_SCHED;
        }
        if (wr == 0) PG8_BAR;
        prob.epi(acc, cur, wr, wc, fr, fq, 0);
        if (has_next) { f32x4 bini[2][2]; prob.bias_load(nxt, wc, fq, bini);
#pragma unroll
            for (int b = 0; b < 2; ++b)
#pragma unroll
                for (int m = 0; m < 4; ++m)
#pragma unroll
                    for (int n = 0; n < 2; ++n) acc[0][b][m][n] = bini[b][n]; }
        prob.epi(acc, cur, wr, wc, fr, fq, 1);
        if (!has_next) break;
#pragma unroll
        for (int b = 0; b < 2; ++b)
#pragma unroll
            for (int m = 0; m < 4; ++m)
#pragma unroll
                for (int n = 0; n < 2; ++n) acc[1][b][m][n] = acc[0][b][m][n];
        cur = nxt; cBo = nBo; cCol = nCol; ++ui; vC0[0] = vN0[0]; vC0[1] = vN0[1]; vC1[0] = vN1[0]; vC1[1] = vN1[1];
        if (wr == 1) PG8_BAR;
    }
    PG8_BWAIT(0);
    PG8_BAR;
#undef PG8_SA
#undef PG8_SB
#undef PG8_STAGE
#undef PG8_LDA
#undef PG8_LDB
#undef PG8_MMA
#undef PG8_WAIT_V
#undef PG8_WAIT_L
#undef PG8_BAR
#undef PG8_SCHED
#undef PG8_BLOAD
#undef PG8_BWAIT
#undef PG8_BWRITE
}
}

constexpr int NWAVES = 8, NTHR = 512;
constexpr int RING_BYTES = 131072;
constexpr int TAB_OFF = 147968;
constexpr int MISC_OFF = 163840 - 256;
constexpr int LDS_BYTES = 163840;

struct Frame {
    LAS unsigned char* lds; volatile LAS unsigned* MISC; unsigned* ctl;
    int tid, lane, wave, vcu, G;
    const float *x, *c, *w_ada, *b_ada, *g1, *w_in, *lq1, *lk1, *lq2, *lk2, *subln, *relb, *cw, *cb, *clg, *clb, *w_out, *g2, *w_r, *b_r, *w_gu, *b_gu, *w_d, *b_d, *fg;
    float* out; unsigned char* ws;
};
#define WSP(T_, off) ((T_*)(F.ws + (off)))

__device__ __forceinline__ void p0_transpose_item(const float* W, int ldn, int n0, int k0, bf16* dst, int drow0, LAS unsigned char* scr, int lane) {
    const int ng = lane & 31, kh = lane >> 5;
#pragma unroll
    for (int it = 0; it < 4; ++it) {
        f32x4 v[8];
#pragma unroll
        for (int j = 0; j < 8; ++j) v[j] = *(const GAS f32x4*)(W + (size_t)(k0 + 16 * it + 8 * kh + j) * ldn + n0 + 4 * ng);
        const int kc = 2 * it + kh;
#pragma unroll
        for (int i = 0; i < 4; ++i) { const int n = 4 * ng + i;
            u32x4 o; o.x = pk2(v[0][i], v[1][i]); o.y = pk2(v[2][i], v[3][i]); o.z = pk2(v[4][i], v[5][i]); o.w = pk2(v[6][i], v[7][i]);
            *(LAS u32x4*)(scr + n * 128 + ((kc ^ (ng & 7)) << 4)) = o; }
    }
    LDS_WAIT(); asm volatile("" ::: "memory");
#pragma unroll
    for (int j = 0; j < 16; ++j) { const int n = 8 * j + (lane >> 3), c = lane & 7;
        const u32x4 o = *(const LAS u32x4*)(scr + n * 128 + ((c ^ ((n >> 2) & 7)) << 4));
        *(GAS u32x4*)(dst + (size_t)(drow0 + n) * pg8::KD + k0 + 8 * c) = o; }
    LDS_WAIT(); asm volatile("" ::: "memory");
}
__device__ __forceinline__ void p0_prologue(Frame& F) {
    const int gw = F.vcu * NWAVES + F.wave, NGW = F.G * NWAVES, gt = F.vcu * NTHR + F.tid, NGT = F.G * NTHR;
    LAS float* cs = (LAS float*)(F.lds);
    for (int i = F.tid; i < NB * DM; i += NTHR) cs[i] = silu_f(F.c[i]);
    __syncthreads();
    float* modp = WSP(float, WS_MODP);
    for (int it = gw; it < 192 * 8; it += NGW) {
        const int cc = it % 192, kc = it / 192, r = F.lane >> 4, g = F.lane & 15;
        float acc[4][4];
#pragma unroll
        for (int b = 0; b < 4; ++b)
#pragma unroll
            for (int j = 0; j < 4; ++j) acc[b][j] = 0.f;
        const float* wp = F.w_ada + (size_t)(kc * 256 + r) * (6 * DM) + cc * 64 + g * 4;
#pragma unroll 8
        for (int s = 0; s < 64; ++s) {
            const f32x4 w = *(const GAS f32x4*)(wp + (size_t)(4 * s) * (6 * DM)); const int k = kc * 256 + 4 * s + r;
#pragma unroll
            for (int b = 0; b < 4; ++b) { const float cv = cs[b * DM + k];
#pragma unroll
                for (int j = 0; j < 4; ++j) acc[b][j] += cv * w[j]; }
        }
#pragma unroll
        for (int b = 0; b < 4; ++b)
#pragma unroll
            for (int j = 0; j < 4; ++j) { float v = acc[b][j]; v += __shfl_xor(v, 16); v += __shfl_xor(v, 32); acc[b][j] = v; }
        if (F.lane < 16)
#pragma unroll
            for (int b = 0; b < 4; ++b) *(GAS f32x4*)(modp + (size_t)(kc * 4 + b) * (6 * DM) + cc * 64 + g * 4) = (f32x4){acc[b][0], acc[b][1], acc[b][2], acc[b][3]};
    }
    __syncthreads();
    LAS unsigned char* scr = F.lds + F.wave * 16384;
    constexpr int I_IN = (INC / 128) * 32, I_OUT = (DM / 128) * 32;
    for (int it = gw; it < I_IN + I_OUT; it += NGW) {
        int r = it;
        if (r < I_IN) { const int nb = r >> 5, kb = r & 31;
            const int drow = nb < 24 ? nb * 128 : (nb < 32 ? 3072 + (nb - 24) * 256 : 3072 + (nb - 32) * 256 + 128);
            p0_transpose_item(F.w_in, INC, nb * 128, kb * 64, WSP(bf16, WS_WIN), drow, scr, F.lane); continue; } r -= I_IN;
        { const int nb = r >> 5, kb = r & 31; p0_transpose_item(F.w_out, DM, nb * 128, kb * 64, WSP(bf16, WS_WOUT), nb * 128, scr, F.lane); }
    }
    for (int i = gt; i < 64 * 2 * 64; i += NGT) {
        const int l = i & 63, nb = (i >> 6) & 1, s = i >> 7, e = 16 * nb + (l & 15), kb = 32 * s + 8 * (l >> 4);
        unsigned hi[8], lo[8];
#pragma unroll
        for (int j = 0; j < 8; ++j) { const float w = F.w_r[(size_t)(kb + j) * NE + e]; hi[j] = f2bf(w); lo[j] = f2bf(w - bf2f(hi[j])); }
        u32x4 oh, ol; oh.x = hi[0] | (hi[1] << 16); oh.y = hi[2] | (hi[3] << 16); oh.z = hi[4] | (hi[5] << 16); oh.w = hi[6] | (hi[7] << 16);
        ol.x = lo[0] | (lo[1] << 16); ol.y = lo[2] | (lo[3] << 16); ol.z = lo[4] | (lo[5] << 16); ol.w = lo[6] | (lo[7] << 16);
        *(GAS u32x4*)(WSP(unsigned char, WS_WRF) + (size_t)i * 16) = oh; *(GAS u32x4*)(WSP(unsigned char, WS_WRF) + 131072 + (size_t)i * 16) = ol;
    }
    float* bt = WSP(float, WS_BIAST);
    for (int i = gt; i < AH * 4096; i += NGT) { const int h = i >> 12, rel = (i & 4095) - 2048; bt[i] = F.relb[t5_bucket(rel) * AH + h] * LOG2E; }
    if (gt == 0) { float a = 0.f, b = 0.f; for (int i = 0; i < HD; ++i) { a += F.lq1[i] * F.lk1[i]; b += F.lq2[i] * F.lk2[i]; } bt[AH * 4096] = __expf(a) - __expf(b) + 0.2f; }
}

__device__ __forceinline__ void p1_norm1(Frame& F) {
    const float* modp = WSP(float, WS_MODP); float* mod = WSP(float, WS_MOD);
    for (int o = F.vcu * NTHR + F.tid; o < NB * 6 * DM; o += F.G * NTHR) { float s = F.b_ada[o % (6 * DM)];
#pragma unroll
        for (int kc = 0; kc < 8; ++kc) s += modp[(size_t)kc * (NB * 6 * DM) + o];
        mod[o] = s; }
    LAS float* gm = (LAS float*)F.lds; LAS float* sh = gm + DM;
    bf16* h = WSP(bf16, WS_H);
    for (int rb = F.vcu; rb < T / 32; rb += F.G) {
        const int b = rb / (SEQ / 32);
        __syncthreads();
        for (int k = F.tid; k < DM; k += NTHR) { float sc = F.b_ada[DM + k], sf = F.b_ada[k];
#pragma unroll
            for (int kc = 0; kc < 8; ++kc) { sc += modp[(size_t)(kc * 4 + b) * (6 * DM) + DM + k]; sf += modp[(size_t)(kc * 4 + b) * (6 * DM) + k]; }
            gm[k] = F.g1[k] * (1.f + sc); sh[k] = sf; }
        __syncthreads();
        for (int rr = F.wave; rr < 32; rr += NWAVES) {
            const int row = rb * 32 + rr;
            const GAS f32x4* xr = (const GAS f32x4*)(F.x + (size_t)row * DM) + F.lane;
            f32x4 v[8]; float s = 0.f;
#pragma unroll
            for (int j = 0; j < 8; ++j) { v[j] = xr[64 * j]; s += (v[j].x * v[j].x + v[j].y * v[j].y) + (v[j].z * v[j].z + v[j].w * v[j].w); }
            const float rstd = rsqrtf(wave_sum(s) * (1.f / DM) + EPS);
            GAS u32x2* o8 = (GAS u32x2*)(h + (size_t)row * DM) + F.lane;
#pragma unroll
            for (int j = 0; j < 8; ++j) { const int k = 4 * F.lane + 256 * j; const f32x4 g = *(const LAS f32x4*)(gm + k), s4 = *(const LAS f32x4*)(sh + k);
                u32x2 w; w.x = pk2(v[j].x * rstd * g.x + s4.x, v[j].y * rstd * g.y + s4.y); w.y = pk2(v[j].z * rstd * g.z + s4.z, v[j].w * rstd * g.w + s4.w); o8[64 * j] = w; }
        }
    }
}

template <bool HMT> struct InProjT {
    static constexpr bool PERM = true;
    const bf16* A; const bf16* Bt; bf16* O; pg8::DenseOrder ord;
    __device__ bool next(int i, pg8::Unit& u) const { return ord.next(i, u); }
    __device__ const char* a_base() const { return (const char*)A; }
    __device__ void a_off(const pg8::Unit& u, const int (&R)[2], const int (&C)[2], unsigned (&v0)[2], unsigned (&v1)[2]) const {
#pragma unroll
        for (int i = 0; i < 2; ++i) { v0[i] = (unsigned)((u.pm * u.rows + R[i]) * pg8::KD + C[i]) * 2u; v1[i] = (unsigned)((u.pm * u.rows + 128 + R[i]) * pg8::KD + C[i]) * 2u; } }
    __device__ const char* b_base(const pg8::Unit& u) const { return (const char*)(Bt + (size_t)u.pn * 256 * pg8::KD); }
    __device__ void epi(const f32x4 (&acc)[2][2][4][2], const pg8::Unit& u, int wr, int wc, int fr, int fq) const {
        const int row0 = u.pm * u.rows + wr * 64 + fr, col0 = u.pn * 256 + wc * 32 + 8 * fq;
        if (u.pn >= 12) {
            const int zc = 3072 + (u.pn - 12) * 128 + wc * 32 + 8 * fq;
#pragma unroll
            for (int ai = 0; ai < (HMT ? 1 : 2); ++ai)
#pragma unroll
                for (int m = 0; m < 4; ++m) { float r[8];
#pragma unroll
                    for (int n = 0; n < 2; ++n)
#pragma unroll
                        for (int j = 0; j < 4; ++j) r[4 * n + j] = acc[ai][0][m][n][j] * __builtin_amdgcn_rcpf(1.f + __builtin_amdgcn_exp2f(-LOG2E * acc[ai][1][m][n][j]));
                    u32x4 w; w.x = cvt_pk_bf16(r[0], r[1]); w.y = cvt_pk_bf16(r[2], r[3]); w.z = cvt_pk_bf16(r[4], r[5]); w.w = cvt_pk_bf16(r[6], r[7]);
                    *(GAS u32x4*)(O + (size_t)(row0 + ai * 128 + m * 16) * INC + zc) = w; }
            return; }
#pragma unroll
        for (int ai = 0; ai < (HMT ? 1 : 2); ++ai)
#pragma unroll
            for (int m = 0; m < 4; ++m) { bf16* rowp = O + (size_t)(row0 + ai * 128 + m * 16) * INC + col0;
#pragma unroll
                for (int bj = 0; bj < 2; ++bj) { const f32x4 v0 = acc[ai][bj][m][0], v1 = acc[ai][bj][m][1];
                    u32x4 w; w.x = cvt_pk_bf16(v0[0], v0[1]); w.y = cvt_pk_bf16(v0[2], v0[3]); w.z = cvt_pk_bf16(v1[0], v1[1]); w.w = cvt_pk_bf16(v1[2], v1[3]);
                    *(GAS u32x4*)(rowp + bj * 128) = w; } }
    }
};
struct OutProj {
    static constexpr bool PERM = true;
    const bf16* A; const bf16* Bt; const float* x; const float* mod; bf16* O; pg8::DenseOrder ord;
    __device__ bool next(int i, pg8::Unit& u) const { return ord.next(i, u); }
    __device__ const char* a_base() const { return (const char*)A; }
    __device__ void a_off(const pg8::Unit& u, const int (&R)[2], const int (&C)[2], unsigned (&v0)[2], unsigned (&v1)[2]) const {
#pragma unroll
        for (int i = 0; i < 2; ++i) { v0[i] = (unsigned)((u.pm * 256 + R[i]) * pg8::KD + C[i]) * 2u; v1[i] = (unsigned)((u.pm * 256 + 128 + R[i]) * pg8::KD + C[i]) * 2u; } }
    __device__ const char* b_base(const pg8::Unit& u) const { return (const char*)(Bt + (size_t)u.pn * 256 * pg8::KD); }
    __device__ void epi(const f32x4 (&acc)[2][2][4][2], const pg8::Unit& u, int wr, int wc, int fr, int fq) const {
        const int row0 = u.pm * 256 + wr * 64 + fr, col0 = u.pn * 256 + wc * 32 + 8 * fq, b = (u.pm * 256) / SEQ;
        f32x4 gt[2][2];
#pragma unroll
        for (int bj = 0; bj < 2; ++bj)
#pragma unroll
            for (int n = 0; n < 2; ++n) gt[bj][n] = *(const GAS f32x4*)(mod + (size_t)b * 6 * DM + 2 * DM + col0 + bj * 128 + 4 * n);
#pragma unroll
        for (int ai = 0; ai < 2; ++ai)
#pragma unroll
            for (int m = 0; m < 4; ++m) { const size_t ro = (size_t)(row0 + ai * 128 + m * 16) * DM + col0;
#pragma unroll
                for (int bj = 0; bj < 2; ++bj) { const f32x4 x0 = *(const GAS f32x4*)(x + ro + bj * 128), x1v = *(const GAS f32x4*)(x + ro + bj * 128 + 4);
                    const f32x4 v0 = x0 + gt[bj][0] * acc[ai][bj][m][0], v1 = x1v + gt[bj][1] * acc[ai][bj][m][1];
                    u32x4 w; w.x = cvt_pk_bf16(v0[0], v0[1]); w.y = cvt_pk_bf16(v0[2], v0[3]); w.z = cvt_pk_bf16(v1[0], v1[1]); w.w = cvt_pk_bf16(v1[2], v1[3]);
                    *(GAS u32x4*)(O + ro + bj * 128) = w; } }
    }
};
struct MoeTab { const LAS int* tp; const LAS int* off; const LAS int* cnt; };
__device__ __forceinline__ void moe_tables(Frame& F) {
    LAS int* tab = (LAS int*)(F.lds + TAB_OFF);
    __syncthreads();
    if (F.tid == 0) { int tp = 0, off = 0; for (int e = 0; e < NE; ++e) { const int c = (int)__hip_atomic_load(F.ctl + CW_CNT + e, __ATOMIC_RELAXED, __HIP_MEMORY_SCOPE_AGENT);
            tab[e] = tp; tab[40 + e] = off; tab[80 + e] = c; tp += (c + 255) >> 8; off += c; } tab[NE] = tp; tab[40 + NE] = off; }
    __syncthreads();
}
template <int NTN, int REPF, int SPLIT>
__device__ __forceinline__ bool moe_next(const MoeTab& tb, int G, int c, int i, pg8::Unit& u) {
    int L = i * G + c; const int total = NTN * __builtin_amdgcn_readfirstlane(tb.tp[NE]); int hs = 0;
    if (SPLIT != 0) {
        const int nrem = total % G, nful = (2 * nrem <= G) ? total - nrem : total;
        if (SPLIT == 1) { if (L >= nful) return false; }
        else { if (L >= 2 * (total - nful)) return false; hs = L & 1; L = nful + (L >> 1); }
    } else { if (L >= total * REPF) return false; if (REPF > 1 && L >= total) L -= total; }
    int e = 0;
#pragma unroll
    for (int j = 1; j < NE; ++j) e += (L >= NTN * tb.tp[j]) ? 1 : 0;
    e = __builtin_amdgcn_readfirstlane(e);
    const int tpe = __builtin_amdgcn_readfirstlane(tb.tp[e]), tpe1 = __builtin_amdgcn_readfirstlane(tb.tp[e + 1]);
    const int local = L - NTN * tpe, nte = tpe1 - tpe;
    u.e = e; u.hs = hs; u.pn = __builtin_amdgcn_readfirstlane(local / nte); u.pm = local - u.pn * nte; u.rows = __builtin_amdgcn_readfirstlane(tb.cnt[e]) - 256 * u.pm; return true;
}
struct MoeGU {
    static constexpr bool PERM = true;
    const bf16* A; const float* W; const float* bias; const int* list; bf16* O; MoeTab tb; int G, c;
    __device__ bool next(int i, pg8::Unit& u) const { return moe_next<16, 1 + ((REP_MASK >> 11) & 1), 0>(tb, G, c, i, u); }
    __device__ const char* a_base() const { return (const char*)A; }
    __device__ void a_off(const pg8::Unit& u, unsigned (&v0)[2], unsigned (&v1)[2]) const {
        const int* lp = list + u.e * T + 256 * u.pm;
        int tb16 = (int)threadIdx.x * 16; asm volatile("" : "+v"(tb16));
#pragma unroll
        for (int i = 0; i < 2; ++i) { int R, C; pg8::stage_rc(tb16 + i * 8192, R, C);
            const int r0 = R < u.rows ? R : u.rows - 1, r1 = (128 + R) < u.rows ? (128 + R) : u.rows - 1;
            v0[i] = (unsigned)(lp[r0] * pg8::KD + C) * 2u; v1[i] = (unsigned)(lp[r1] * pg8::KD + C) * 2u; } }
    __device__ void bias_load(const pg8::Unit& u, int wc, int fq, f32x4 (&bi)[2][2]) const {
        int cb = wc * 32 + 8 * ((fq >> 1) + 2 * (fq & 1)); asm volatile("" : "+v"(cb));
        const float* bp = bias + (size_t)u.e * 2 * DFF + u.pn * 128 + cb;
#pragma unroll
        for (int bj = 0; bj < 2; ++bj)
            { const f32x4 t0 = *(const GAS f32x4*)(bp + bj * DFF), t1 = *(const GAS f32x4*)(bp + bj * DFF + 4); bi[bj][0] = (f32x4){t0[0], t1[0], t0[1], t1[1]}; bi[bj][1] = (f32x4){t0[2], t1[2], t0[3], t1[3]}; } }
    static constexpr int LDW_BYTES = 2 * DFF * 4, W_BYTES = DM * 2 * DFF * 4;
    __device__ const char* b_ptr(const pg8::Unit& u) const { return (const char*)(W + (size_t)u.e * DM * 2 * DFF); }
    static constexpr int HALF_BYTES = DFF * 4;
    __device__ unsigned b_col(const pg8::Unit& u, int lane) const { return (unsigned)(u.pn * 128 + 2 * lane) * 4u; }
    __device__ void epi(const f32x4 (&acc)[2][2][4][2], const pg8::Unit& u, int wr, int wc, int fr, int fq, const int ai) const {
        int rt0 = wr * 64 + fr, colt = u.pn * 128 + wc * 32 + 8 * ((fq >> 1) + 2 * (fq & 1)); asm volatile("" : "+v"(rt0), "+v"(colt)); const size_t slot0 = (size_t)__builtin_amdgcn_readfirstlane(tb.off[u.e]) + 256 * u.pm;
#pragma unroll
            for (int m = 0; m < 4; ++m) { const int rt = rt0 + ai * 128 + m * 16; float r[8];
#pragma unroll
                for (int n = 0; n < 2; ++n)
#pragma unroll
                    for (int j = 0; j < 4; ++j) { const int o = (j >> 1) + 2 * n + 4 * (j & 1);
                        float g = acc[ai][0][m][n][j], up = acc[ai][1][m][n][j];
                        g = fminf(g, 7.f); up = fminf(fmaxf(up, -7.f), 7.f);
                        r[o] = (up + 1.f) * g * __builtin_amdgcn_rcpf(1.f + __builtin_amdgcn_exp2f(-1.702f * LOG2E * g)); }
                if (rt < u.rows) { u32x4 w; w.x = cvt_pk_bf16(r[0], r[1]); w.y = cvt_pk_bf16(r[2], r[3]); w.z = cvt_pk_bf16(r[4], r[5]); w.w = cvt_pk_bf16(r[6], r[7]);
                    *(GAS u32x4*)(O + (slot0 + rt) * DFF + colt) = w; } }
    }
};
template <int SPLIT> struct MoeDownT {
    static constexpr bool PERM = true;
    const bf16* A; const float* W; const float* bias; const float* sw; bf16* O; MoeTab tb; int G, c;
    __device__ bool next(int i, pg8::Unit& u) const { return moe_next<8, 1 + ((REP_MASK >> 12) & 1), SPLIT>(tb, G, c, i, u); }
    __device__ const char* a_base() const { return (const char*)A; }
    __device__ void a_off(const pg8::Unit& u, unsigned (&v0)[2], unsigned (&v1)[2]) const {
        const int s0 = __builtin_amdgcn_readfirstlane(tb.off[u.e]) + 256 * u.pm;
        int tb16 = (int)threadIdx.x * 16; asm volatile("" : "+v"(tb16));
#pragma unroll
        for (int i = 0; i < 2; ++i) { int R, C; pg8::stage_rc(tb16 + i * 8192, R, C);
            v0[i] = (unsigned)((s0 + R) * pg8::KD + C) * 2u; v1[i] = (unsigned)((s0 + 128 + R) * pg8::KD + C) * 2u; } }
    __device__ void bias_load(const pg8::Unit& u, int wc, int fq, f32x4 (&bi)[2][2]) const {
        int cb = wc * 32 + 8 * ((fq >> 1) + 2 * (fq & 1)); asm volatile("" : "+v"(cb));
        const float* bp = bias + (size_t)u.e * DM + u.pn * 256 + u.hs * 128 + cb;
#pragma unroll
        for (int bj = 0; bj < (SPLIT == 2 ? 1 : 2); ++bj)
            { const f32x4 t0 = *(const GAS f32x4*)(bp + bj * 128), t1 = *(const GAS f32x4*)(bp + bj * 128 + 4); bi[bj][0] = (f32x4){t0[0], t1[0], t0[1], t1[1]}; bi[bj][1] = (f32x4){t0[2], t1[2], t0[3], t1[3]}; } }
    static constexpr int LDW_BYTES = DM * 4, W_BYTES = DFF * DM * 4;
    __device__ const char* b_ptr(const pg8::Unit& u) const { return (const char*)(W + (size_t)u.e * DFF * DM); }
    static constexpr int HALF_BYTES = 128 * 4;
    __device__ unsigned b_col(const pg8::Unit& u, int lane) const { return (unsigned)(u.pn * 256 + u.hs * 128 + 2 * lane) * 4u; }
    __device__ void epi(const f32x4 (&acc)[2][2][4][2], const pg8::Unit& u, int wr, int wc, int fr, int fq, const int ai) const {
        int rt0 = wr * 64 + fr, col0 = u.pn * 256 + u.hs * 128 + wc * 32 + 8 * ((fq >> 1) + 2 * (fq & 1)); asm volatile("" : "+v"(rt0), "+v"(col0)); const size_t slot0 = (size_t)__builtin_amdgcn_readfirstlane(tb.off[u.e]) + 256 * u.pm;
#pragma unroll
            for (int m = 0; m < 4; ++m) { const int rt = rt0 + ai * 128 + m * 16;
                if (rt < u.rows) { const float wgt = sw[(size_t)u.e * T + 256 * u.pm + rt]; bf16* rowp = O + (slot0 + rt) * DM + col0;
#pragma unroll
                    for (int bj = 0; bj < (SPLIT == 2 ? 1 : 2); ++bj) { float r[8];
#pragma unroll
                        for (int n = 0; n < 2; ++n)
#pragma unroll
                            for (int j = 0; j < 4; ++j) { const int o = (j >> 1) + 2 * n + 4 * (j & 1); r[o] = acc[ai][bj][m][n][j] * wgt; }
                        u32x4 w; w.x = cvt_pk_bf16(r[0], r[1]); w.y = cvt_pk_bf16(r[2], r[3]); w.z = cvt_pk_bf16(r[4], r[5]); w.w = cvt_pk_bf16(r[6], r[7]);
                        *(GAS u32x4*)(rowp + bj * 128) = w; } } }
    }
};

__device__ __forceinline__ void conv_unit(Frame& F, int ct) {
    const int b = ct / (SEQ / 32), s0 = (ct % (SEQ / 32)) * 32, tid = F.tid;
    const bf16* proj = WSP(bf16, WS_PROJ); bf16* mix = WSP(bf16, WS_MIX);
    LAS unsigned* z = (LAS unsigned*)F.lds;
    LAS float* st = (LAS float*)(F.lds + 126976);
    __syncthreads();
#pragma unroll 8
    for (int r = 0; r < 62; ++r) { const int s = s0 - 15 + r; const bool ok = (s >= 0 && s < SEQ); const int sc = ok ? s : 0;
        const unsigned zz = *(const GAS unsigned*)(proj + (size_t)(b * SEQ + sc) * INC + 3072 + 2 * tid);
        z[r * 512 + tid] = ok ? zz : 0u; }
    typedef float f32x2c __attribute__((ext_vector_type(2)));
    float w0[CK], w1[CK];
#pragma unroll
    for (int j = 0; j < CK; ++j) { const f32x2c w = *(const GAS f32x2c*)(F.cw + j * CCH + 2 * tid); w0[j] = w.x; w1[j] = w.y; }
    const f32x2c cbv = *(const GAS f32x2c*)(F.cb + 2 * tid), lg = *(const GAS f32x2c*)(F.clg + 2 * tid), lb = *(const GAS f32x2c*)(F.clb + 2 * tid);
    __syncthreads();
#pragma unroll 1
    for (int hf = 0; hf < 2; ++hf) {
        float c0[16], c1[16];
#pragma unroll
        for (int g = 0; g < 4; ++g) {
            float zl[34], zh[34];
#pragma unroll
            for (int r = 0; r < 34; ++r) { const unsigned zz = z[(16 * hf + 4 * g + r) * 512 + tid]; zl[r] = __builtin_bit_cast(float, zz << 16); zh[r] = __builtin_bit_cast(float, zz & 0xffff0000u); }
#pragma unroll
            for (int t = 0; t < 4; ++t) { float a0 = cbv.x, a1 = cbv.y;
#pragma unroll
                for (int j = 0; j < CK; ++j) { a0 = fmaf(w0[j], zl[t + j], a0); a1 = fmaf(w1[j], zh[t + j], a1); }
                c0[4 * g + t] = a0; c1[4 * g + t] = a1; }
        }
#pragma unroll
        for (int t = 0; t < 16; ++t) { const float sm = wave_sum(c0[t] + c1[t]), q = wave_sum(c0[t] * c0[t] + c1[t] * c1[t]);
            if (F.lane == 0) { st[(F.wave * 16 + t) * 2] = sm; st[(F.wave * 16 + t) * 2 + 1] = q; } }
        __syncthreads();
        if (tid < 16) { float sm = 0.f, q = 0.f;
#pragma unroll
            for (int w = 0; w < 8; ++w) { sm += st[(w * 16 + tid) * 2]; q += st[(w * 16 + tid) * 2 + 1]; }
            const float mu = sm * (1.f / CCH), var = q * (1.f / CCH) - mu * mu; st[512 + tid * 2] = mu; st[512 + tid * 2 + 1] = rsqrtf(fmaxf(var, 0.f) + EPS); }
        __syncthreads();
#pragma unroll
        for (int t = 0; t < 16; ++t) { const float mu = st[512 + t * 2], rs = st[512 + t * 2 + 1];
            const float y0 = (c0[t] - mu) * rs * lg.x + lb.x, y1 = (c1[t] - mu) * rs * lg.y + lb.y;
            const float o0 = y0 * __builtin_amdgcn_rcpf(1.f + __builtin_amdgcn_exp2f(-LOG2E * y0)), o1 = y1 * __builtin_amdgcn_rcpf(1.f + __builtin_amdgcn_exp2f(-LOG2E * y1));
            *(GAS unsigned*)(mix + (size_t)(b * SEQ + s0 + 16 * hf + t) * DM + 1024 + 2 * tid) = cvt_pk_bf16(o0, o1); }
        __syncthreads();
    }
}

namespace att {
constexpr int KVBLK = 64; constexpr size_t SHM_V = KVBLK * 128 * 2, SHM_K = KVBLK * 128 * 2;
constexpr float C = 0.125f * LOG2E, THR2 = 8.f * LOG2E;
#define KSWZ(row, colB) ((row) * 256 + ((colB) ^ (((row) & 7) << 4)))
#define SBAR() __builtin_amdgcn_sched_barrier(0)
__device__ __forceinline__ int crow(int r, int hi) { return (r & 3) + 8 * (r >> 2) + 4 * hi; }
__device__ __forceinline__ int v_st(int k, int c) { const int kk = (k & ~0xC) | ((k & 4) << 1) | ((k & 8) >> 1); return ((kk >> 3) * 4 + (c >> 5)) * 512 + ((kk & 7) * 32 + (c & 31)) * 2; }
__device__ __forceinline__ int v_rd_base(int lane) { return ((lane & 3) << 3) | (((lane >> 2) & 3) << 6) | (((lane >> 4) & 1) << 5) | (((lane >> 5) & 1) << 8); }
constexpr int v_rd_off(int d0, int ks, int half) { return d0 * 512 + ks * 4096 + half * 2048; }
template <int OFF> __device__ __forceinline__ s16x4 tr_read(int vb) { s16x4 r; asm volatile("ds_read_b64_tr_b16 %0, %1 offset:%2" : "=&v"(r) : "v"(vb), "i"(OFF) : "memory"); return r; }
template <int D0> __device__ __forceinline__ void pv_one(f32x16& od, int vb, bf16x8 pa0, bf16x8 pa1, bf16x8 pa2, bf16x8 pa3) {
    const s16x4 l0 = tr_read<v_rd_off(D0, 0, 0)>(vb), h0 = tr_read<v_rd_off(D0, 0, 1)>(vb), l1 = tr_read<v_rd_off(D0, 1, 0)>(vb), h1 = tr_read<v_rd_off(D0, 1, 1)>(vb);
    const s16x4 l2 = tr_read<v_rd_off(D0, 2, 0)>(vb), h2 = tr_read<v_rd_off(D0, 2, 1)>(vb), l3 = tr_read<v_rd_off(D0, 3, 0)>(vb), h3 = tr_read<v_rd_off(D0, 3, 1)>(vb);
    asm volatile("s_waitcnt lgkmcnt(0)" ::: "memory"); SBAR();
#define PK(L, H) (bf16x8){L[0], L[1], L[2], L[3], H[0], H[1], H[2], H[3]}
    od = __builtin_amdgcn_mfma_f32_32x32x16_bf16(pa0, PK(l0, h0), od, 0, 0, 0);
    od = __builtin_amdgcn_mfma_f32_32x32x16_bf16(pa1, PK(l1, h1), od, 0, 0, 0);
    od = __builtin_amdgcn_mfma_f32_32x32x16_bf16(pa2, PK(l2, h2), od, 0, 0, 0);
    od = __builtin_amdgcn_mfma_f32_32x32x16_bf16(pa3, PK(l3, h3), od, 0, 0, 0);
#undef PK
}
__device__ __forceinline__ void pv_d0(f32x16* o, int vb, bf16x8 pa0, bf16x8 pa1, bf16x8 pa2, bf16x8 pa3) {
    pv_one<0>(o[0], vb, pa0, pa1, pa2, pa3); pv_one<1>(o[1], vb, pa0, pa1, pa2, pa3); pv_one<2>(o[2], vb, pa0, pa1, pa2, pa3); pv_one<3>(o[3], vb, pa0, pa1, pa2, pa3);
}
__device__ __forceinline__ void qkt(f32x16& p0, f32x16& p1, const LAS char* Ks, const bf16x8* qr, int r32, int hi, int map) {
    p0 = f32x16{}; p1 = f32x16{};
#pragma unroll
    for (int d0 = 0; d0 < 4; ++d0) { const int cb = ((map * 4 + d0) * 16 + hi * 8) * 2;
        const bf16x8 b0 = *(const LAS bf16x8*)(Ks + KSWZ(r32, cb)); const bf16x8 b1 = *(const LAS bf16x8*)(Ks + KSWZ(32 + r32, cb));
        p0 = __builtin_amdgcn_mfma_f32_32x32x16_bf16(b0, qr[d0], p0, 0, 0, 0);
        p1 = __builtin_amdgcn_mfma_f32_32x32x16_bf16(b1, qr[d0], p1, 0, 0, 0); }
}
__device__ __forceinline__ void partialSM(f32x16& p0, f32x16& p1, float& m_reg, float& mn, float& alpha, int relw, int relb, int hi, const LAS float* btab, float bneg, float bpos) {
    if (relw - 31 >= 91 || relw + 63 <= -91) {
        const float bc = (relw > 0) ? bpos : bneg;
        float pmax = p0[0];
#pragma unroll
        for (int r = 1; r < 16; ++r) pmax = fmaxf(pmax, p0[r]);
#pragma unroll
        for (int r = 0; r < 16; ++r) pmax = fmaxf(pmax, p1[r]);
        { auto rr = __builtin_amdgcn_permlane32_swap(__float_as_uint(pmax), __float_as_uint(pmax), false, false); pmax = fmaxf(__uint_as_float(rr[0]), __uint_as_float(rr[1])); }
        const float tmax = fmaf(pmax, C, bc);
        if (__builtin_expect(__all(tmax - m_reg <= THR2), 1)) { mn = m_reg; alpha = 1.f; }
        else { mn = fmaxf(m_reg, tmax); alpha = __builtin_amdgcn_exp2f(m_reg - mn); m_reg = mn; }
        const float off = bc - mn;
#pragma unroll
        for (int r = 0; r < 16; ++r) p0[r] = fmaf(p0[r], C, off);
#pragma unroll
        for (int r = 0; r < 16; ++r) p1[r] = fmaf(p1[r], C, off);
    } else {
#pragma unroll
        for (int r = 0; r < 16; ++r) { const int idx = relb + crow(r, hi) + 256; p0[r] = fmaf(p0[r], C, btab[idx]); p1[r] = fmaf(p1[r], C, btab[idx + 32]); }
        float pmax = p0[0];
#pragma unroll
        for (int r = 1; r < 16; ++r) pmax = fmaxf(pmax, p0[r]);
#pragma unroll
        for (int r = 0; r < 16; ++r) pmax = fmaxf(pmax, p1[r]);
        { auto rr = __builtin_amdgcn_permlane32_swap(__float_as_uint(pmax), __float_as_uint(pmax), false, false); pmax = fmaxf(__uint_as_float(rr[0]), __uint_as_float(rr[1])); }
        if (__builtin_expect(__all(pmax - m_reg <= THR2), 1)) { mn = m_reg; alpha = 1.f; }
        else { mn = fmaxf(m_reg, pmax); alpha = __builtin_amdgcn_exp2f(m_reg - mn); m_reg = mn; }
#pragma unroll
        for (int r = 0; r < 16; ++r) p0[r] -= mn;
#pragma unroll
        for (int r = 0; r < 16; ++r) p1[r] -= mn;
    }
#pragma unroll
    for (int r = 0; r < 16; ++r) p0[r] = __builtin_amdgcn_exp2f(p0[r]);
}
__device__ __forceinline__ void finishSM(f32x16& p0, f32x16& p1, float alpha, float& l_reg, bf16x8& pa0, bf16x8& pa1, bf16x8& pa2, bf16x8& pa3) {
#pragma unroll
    for (int r = 0; r < 16; ++r) p1[r] = __builtin_amdgcn_exp2f(p1[r]);
    float ps = 0;
#pragma unroll
    for (int r = 0; r < 16; ++r) ps += p0[r];
#pragma unroll
    for (int r = 0; r < 16; ++r) ps += p1[r];
    { auto rr = __builtin_amdgcn_permlane32_swap(__float_as_uint(ps), __float_as_uint(ps), false, false); ps = __uint_as_float(rr[0]) + __uint_as_float(rr[1]); }
    l_reg = l_reg * alpha + ps;
#define PK4(P, BASE, OUT) do { unsigned a0 = cvt_pk_bf16(P[BASE + 0], P[BASE + 1]), a1 = cvt_pk_bf16(P[BASE + 2], P[BASE + 3]);   \
    unsigned b0 = cvt_pk_bf16(P[BASE + 4], P[BASE + 5]), b1 = cvt_pk_bf16(P[BASE + 6], P[BASE + 7]);                              \
    auto r0 = __builtin_amdgcn_permlane32_swap(a0, b0, false, false); auto r1 = __builtin_amdgcn_permlane32_swap(a1, b1, false, false); \
    u32x4 w = {r0[0], r1[0], r0[1], r1[1]}; OUT = __builtin_bit_cast(bf16x8, w); } while (0)
    PK4(p0, 0, pa0); PK4(p0, 8, pa1); PK4(p1, 0, pa2); PK4(p1, 8, pa3);
#undef PK4
}
constexpr int L_V = 0, L_K = 32768, L_WS = 65536, L_BT = 67584, L_CB = 69632;
__device__ __forceinline__ void attn_unit(Frame& F, int unit) {
    const int bh = unit >> 4, qb = unit & 15, b = bh >> 3, h = bh & 7, q0 = qb * 128;
    const int tid = F.tid, wid = F.wave, lane = F.lane, r32 = lane & 31, hi = lane >> 5, rg = wid & 3, map = wid >> 2;
    const bf16* proj = WSP(bf16, WS_PROJ);
    const bf16* Kh = proj + (size_t)(b * SEQ) * INC + 1024 + h * 128; const bf16* Vh = proj + (size_t)(b * SEQ) * INC + 2048 + h * 128;
    LAS char* lds = (LAS char*)F.lds; LAS char* V_lds = lds + L_V; LAS char* K_lds = lds + L_K;
    LAS float* wsf = (LAS float*)(lds + L_WS) + wid * 64; LAS float* li_l = wsf; LAS float* al_l = wsf + 32;
    LAS float* btab = (LAS float*)(lds + L_BT);
    const float* bt = WSP(float, WS_BIAST) + h * 4096;
    __syncthreads();
    btab[tid] = bt[2048 - 256 + tid];
    const float bneg = bt[2048 - 200], bpos = bt[2048 + 200], lam = WSP(float, WS_BIAST)[AH * 4096];
    float m_reg = -1e30f, l_reg = 0; f32x16 o[4] = {}; bf16x8 qr[4];
    const int qw0 = q0 + 32 * rg;
    const bf16* Qw = proj + (size_t)(b * SEQ + qw0 + r32) * INC + h * 128 + map * 64 + hi * 8;
#pragma unroll
    for (int d0 = 0; d0 < 4; ++d0) qr[d0] = *(const GAS bf16x8*)(Qw + d0 * 16);
    const int sr = tid >> 4, sc = (tid & 15) * 8, vst0 = v_st(sr, sc), vst1 = v_st(32 + sr, sc);
    const int vb0 = (int)(uintptr_t)V_lds + v_rd_base(lane);
    struct { bf16x8 vs0, vs1, ks0, ks1; } sr_[2];
#define SLOAD(i, k0) do { sr_[i].vs0 = *(const GAS bf16x8*)&Vh[(size_t)((k0) + sr) * INC + sc]; sr_[i].vs1 = *(const GAS bf16x8*)&Vh[(size_t)((k0) + 32 + sr) * INC + sc]; \
    sr_[i].ks0 = *(const GAS bf16x8*)&Kh[(size_t)((k0) + sr) * INC + sc]; sr_[i].ks1 = *(const GAS bf16x8*)&Kh[(size_t)((k0) + 32 + sr) * INC + sc]; } while (0)
#define SWRITE(bb, i) do { *(LAS bf16x8*)(V_lds + (bb) * SHM_V + vst0) = sr_[i].vs0; *(LAS bf16x8*)(V_lds + (bb) * SHM_V + vst1) = sr_[i].vs1; const int kc = sc * 2; \
    *(LAS bf16x8*)(K_lds + (bb) * SHM_K + KSWZ(sr, kc)) = sr_[i].ks0; *(LAS bf16x8*)(K_lds + (bb) * SHM_K + KSWZ(32 + sr, kc)) = sr_[i].ks1; } while (0)
#define SWAIT() asm volatile("s_waitcnt vmcnt(4)" ::: "memory")
#define RESC(a) do { if (__any((a) < 1.f)) { if (hi == 0) al_l[r32] = (a); asm volatile("s_waitcnt lgkmcnt(0)" ::: "memory"); \
    _Pragma("unroll") for (int d = 0; d < 4; ++d) _Pragma("unroll") for (int r = 0; r < 16; ++r) o[d][r] *= al_l[crow(r, hi)]; } } while (0)
#define PSM(P0, P1, MN, AL, k0) partialSM(P0, P1, m_reg, MN, AL, (k0) - qw0, (k0) - qw0 - r32, hi, btab, bneg, bpos)
    f32x16 pA0, pA1, pB0, pB1; float mnA, mnB, alA, alB; bf16x8 pa0, pa1, pa2, pa3; constexpr int NT = SEQ / KVBLK;
    constexpr int SE = 0, SO = 1;
    SLOAD(SE, 0); asm volatile("s_waitcnt vmcnt(0)" ::: "memory"); SWRITE(0, SE); __syncthreads();
    qkt(pA0, pA1, K_lds, qr, r32, hi, map); PSM(pA0, pA1, mnA, alA, 0);
    SLOAD(SO, KVBLK); SLOAD(SE, 2 * KVBLK);
    SWAIT(); SWRITE(1, SO); __syncthreads();
    for (int j = 1; j + 1 < NT; j += 2) {
        SBAR(); qkt(pB0, pB1, K_lds + SHM_K, qr, r32, hi, map);
        finishSM(pA0, pA1, alA, l_reg, pa0, pa1, pa2, pa3); SBAR();
        SLOAD(SO, (j + 2) * KVBLK); SBAR();
        pv_d0(o, vb0, pa0, pa1, pa2, pa3); PSM(pB0, pB1, mnB, alB, j * KVBLK);
        __syncthreads(); SWAIT(); SWRITE(0, SE);
        RESC(alB); __syncthreads();
        SBAR(); qkt(pA0, pA1, K_lds, qr, r32, hi, map);
        finishSM(pB0, pB1, alB, l_reg, pa0, pa1, pa2, pa3); SBAR();
        if (j + 3 < NT) SLOAD(SE, (j + 3) * KVBLK); SBAR();
        pv_d0(o, vb0 + (int)SHM_V, pa0, pa1, pa2, pa3); PSM(pA0, pA1, mnA, alA, (j + 1) * KVBLK);
        __syncthreads(); SWAIT(); SWRITE(1, SO);
        RESC(alA); __syncthreads();
    }
    SBAR(); qkt(pB0, pB1, K_lds + SHM_K, qr, r32, hi, map);
    finishSM(pA0, pA1, alA, l_reg, pa0, pa1, pa2, pa3); SBAR();
    pv_d0(o, vb0, pa0, pa1, pa2, pa3); PSM(pB0, pB1, mnB, alB, (NT - 1) * KVBLK);
    __syncthreads(); RESC(alB);
    finishSM(pB0, pB1, alB, l_reg, pa0, pa1, pa2, pa3); SBAR();
    pv_d0(o, vb0 + (int)SHM_V, pa0, pa1, pa2, pa3);
    if (hi == 0) li_l[r32] = l_reg; asm volatile("s_waitcnt lgkmcnt(0)" ::: "memory");
    float rli[16];
#pragma unroll
    for (int r = 0; r < 16; ++r) rli[r] = __builtin_amdgcn_rcpf(li_l[crow(r, hi)]);
    LAS float* cbuf = (LAS float*)(lds + L_CB) + rg * 32 * 128;
    if (map == 1) {
#pragma unroll
        for (int r = 0; r < 16; ++r)
#pragma unroll
            for (int d0 = 0; d0 < 4; ++d0) cbuf[crow(r, hi) * 128 + d0 * 32 + r32] = -lam * o[d0][r] * rli[r];
    }
    __syncthreads();
    if (map == 0) {
        bf16* mix = WSP(bf16, WS_MIX) + (size_t)(b * SEQ + qw0) * DM + h * 128;
        float sg[4];
#pragma unroll
        for (int d0 = 0; d0 < 4; ++d0) sg[d0] = F.subln[d0 * 32 + r32] * 0.8f;
#pragma unroll
        for (int r = 0; r < 16; ++r) { float v[4], ss = 0.f;
#pragma unroll
            for (int d0 = 0; d0 < 4; ++d0) { v[d0] = o[d0][r] * rli[r] + cbuf[crow(r, hi) * 128 + d0 * 32 + r32]; ss += v[d0] * v[d0]; }
#pragma unroll
            for (int s = 1; s < 32; s <<= 1) ss += __shfl_xor(ss, s);
            const float rstd = rsqrtf(ss * (1.f / VD) + EPS);
#pragma unroll
            for (int d0 = 0; d0 < 4; ++d0) mix[(size_t)crow(r, hi) * DM + d0 * 32 + r32] = (bf16)f2bf(v[d0] * rstd * sg[d0]); }
    }
#undef SLOAD
#undef SWRITE
#undef SWAIT
#undef RESC
#undef PSM
}
}

__device__ __forceinline__ void p5_router(Frame& F, bool dry = false) {
    const float* mod = WSP(float, WS_MOD); const bf16* x1 = WSP(bf16, WS_X1); bf16* h2 = WSP(bf16, WS_H2);
    int* list = (int*)(F.ws + WS_ROUTE + RT_LIST); float* sw = (float*)(F.ws + WS_ROUTE + RT_SW); int* toke = (int*)(F.ws + WS_ROUTE + RT_TOKE); int* tokr = (int*)(F.ws + WS_ROUTE + RT_TOKR);
    constexpr int RS = 4096 + 16;
    LAS unsigned char* Ahi = F.lds; LAS unsigned char* Alo = F.lds + 16 * RS; LAS float* Pl = (LAS float*)(F.lds + 32 * RS);
    const unsigned char* wrf = WSP(unsigned char, WS_WRF);
    for (int tb = F.vcu; tb < T / 16; tb += F.G) {
        const int b = (tb * 16) / SEQ;
        __syncthreads();
#pragma unroll 1
        for (int rr = 0; rr < 2; ++rr) {
            const int tl = 2 * F.wave + rr, row = tb * 16 + tl;
            const GAS u32x2* xr = (const GAS u32x2*)(x1 + (size_t)row * DM) + F.lane;
            f32x4 v[8]; float s = 0.f;
#pragma unroll
            for (int j = 0; j < 8; ++j) { const u32x2 xx = xr[64 * j]; v[j] = (f32x4){bf2f(xx.x & 0xffffu), bf2f(xx.x >> 16), bf2f(xx.y & 0xffffu), bf2f(xx.y >> 16)}; s += (v[j].x * v[j].x + v[j].y * v[j].y) + (v[j].z * v[j].z + v[j].w * v[j].w); }
            const float rstd = rsqrtf(wave_sum(s) * (1.f / DM) + EPS);
            GAS u32x2* o8 = (GAS u32x2*)(h2 + (size_t)row * DM) + F.lane;
#pragma unroll
            for (int j = 0; j < 8; ++j) { const int k = 4 * F.lane + 256 * j;
                const f32x4 g = *(const GAS f32x4*)(F.g2 + k), sc = *(const GAS f32x4*)(mod + (size_t)b * 6 * DM + 4 * DM + k), sf = *(const GAS f32x4*)(mod + (size_t)b * 6 * DM + 3 * DM + k);
                float hv[4]; unsigned hb[4], lb[4];
#pragma unroll
                for (int q = 0; q < 4; ++q) { hv[q] = v[j][q] * rstd * g[q] * (1.f + sc[q]) + sf[q]; hb[q] = f2bf(hv[q]); lb[q] = f2bf(hv[q] - bf2f(hb[q])); }
                u32x2 wh, wl; wh.x = hb[0] | (hb[1] << 16); wh.y = hb[2] | (hb[3] << 16); wl.x = lb[0] | (lb[1] << 16); wl.y = lb[2] | (lb[3] << 16);
                o8[64 * j] = wh; *(LAS u32x2*)(Ahi + tl * RS + k * 2) = wh; *(LAS u32x2*)(Alo + tl * RS + k * 2) = wl; }
        }
        __syncthreads();
        { f32x4 acc0 = {0.f, 0.f, 0.f, 0.f}, acc1 = {0.f, 0.f, 0.f, 0.f};
#pragma unroll 2
          for (int ks = 0; ks < 8; ++ks) { const int s = 8 * F.wave + ks, k0 = 32 * s + 8 * (F.lane >> 4);
            const bf16x8 ah = *(const LAS bf16x8*)(Ahi + (F.lane & 15) * RS + k0 * 2), al = *(const LAS bf16x8*)(Alo + (F.lane & 15) * RS + k0 * 2);
            const bf16x8 bh0 = *(const GAS bf16x8*)(wrf + ((size_t)(s * 2 + 0) * 64 + F.lane) * 16), bh1 = *(const GAS bf16x8*)(wrf + ((size_t)(s * 2 + 1) * 64 + F.lane) * 16);
            const bf16x8 bl0 = *(const GAS bf16x8*)(wrf + 131072 + ((size_t)(s * 2 + 0) * 64 + F.lane) * 16), bl1 = *(const GAS bf16x8*)(wrf + 131072 + ((size_t)(s * 2 + 1) * 64 + F.lane) * 16);
            acc0 = __builtin_amdgcn_mfma_f32_16x16x32_bf16(ah, bh0, acc0, 0, 0, 0); acc0 = __builtin_amdgcn_mfma_f32_16x16x32_bf16(ah, bl0, acc0, 0, 0, 0); acc0 = __builtin_amdgcn_mfma_f32_16x16x32_bf16(al, bh0, acc0, 0, 0, 0);
            acc1 = __builtin_amdgcn_mfma_f32_16x16x32_bf16(ah, bh1, acc1, 0, 0, 0); acc1 = __builtin_amdgcn_mfma_f32_16x16x32_bf16(ah, bl1, acc1, 0, 0, 0); acc1 = __builtin_amdgcn_mfma_f32_16x16x32_bf16(al, bh1, acc1, 0, 0, 0); }
#pragma unroll
          for (int r = 0; r < 4; ++r) { const int tk = 4 * (F.lane >> 4) + r; Pl[(F.wave * 16 + tk) * 32 + (F.lane & 15)] = acc0[r]; Pl[(F.wave * 16 + tk) * 32 + 16 + (F.lane & 15)] = acc1[r]; }
        }
        __syncthreads();
        { const int tl = F.tid >> 5, e = F.tid & 31, tok = tb * 16 + tl;
          float v = F.b_r[e];
#pragma unroll
          for (int w = 0; w < 8; ++w) v += Pl[(w * 16 + tl) * 32 + e];
          float tv[4]; int ti[4];
#pragma unroll
          for (int r = 0; r < 4; ++r) { float bv = v; int bi = e;
#pragma unroll
              for (int o = 16; o > 0; o >>= 1) { const float ov = __shfl_xor(bv, o); const int oi = __shfl_xor(bi, o); if (ov > bv || (ov == bv && oi < bi)) { bv = ov; bi = oi; } }
              tv[r] = bv; ti[r] = bi; if (e == bi) v = -3.0e38f; }
          float den = 0.f, w[4];
#pragma unroll
          for (int r = 0; r < 4; ++r) { w[r] = __expf(tv[r] - tv[0]); den += w[r]; }
#pragma unroll
          for (int r = 0; r < 4; ++r) if (e == ti[r] && !dry) { const int rank = (int)atomicAdd(F.ctl + CW_CNT + e, 1u);
              list[e * T + rank] = tok; sw[e * T + rank] = w[r] / den; toke[tok * 4 + r] = e; tokr[tok * 4 + r] = rank; }
        }
    }
}

__device__ __forceinline__ void p8_final(Frame& F) {
    const float* mod = WSP(float, WS_MOD); const bf16* x1 = WSP(bf16, WS_X1); const bf16* y = WSP(bf16, WS_Y);
    const int* toke = (const int*)(F.ws + WS_ROUTE + RT_TOKE); const int* tokr = (const int*)(F.ws + WS_ROUTE + RT_TOKR);
    moe_tables(F);
    const LAS int* off = (const LAS int*)(F.lds + TAB_OFF) + 40;
    for (int row = F.vcu * NWAVES + F.wave; row < T; row += F.G * NWAVES) {
        const int b = row / SEQ;
        size_t so[4];
#pragma unroll
        for (int r = 0; r < 4; ++r) so[r] = (size_t)(off[toke[row * 4 + r]] + tokr[row * 4 + r]) * DM;
        const GAS u32x2* xr = (const GAS u32x2*)(x1 + (size_t)row * DM) + F.lane;
        f32x4 v[8]; float s = 0.f;
#pragma unroll
        for (int j = 0; j < 8; ++j) { const int k = 4 * F.lane + 256 * j; f32x4 m = {0.f, 0.f, 0.f, 0.f};
#pragma unroll
            for (int r = 0; r < 4; ++r) { const u32x2 yy = *(const GAS u32x2*)(y + so[r] + k); m[0] += bf2f(yy.x & 0xffffu); m[1] += bf2f(yy.x >> 16); m[2] += bf2f(yy.y & 0xffffu); m[3] += bf2f(yy.y >> 16); }
            const f32x4 g = *(const GAS f32x4*)(mod + (size_t)b * 6 * DM + 5 * DM + k);
            const u32x2 xx = xr[64 * j]; v[j] = (f32x4){bf2f(xx.x & 0xffffu), bf2f(xx.x >> 16), bf2f(xx.y & 0xffffu), bf2f(xx.y >> 16)} + g * m; s += (v[j].x * v[j].x + v[j].y * v[j].y) + (v[j].z * v[j].z + v[j].w * v[j].w); }
        const float rstd = rsqrtf(wave_sum(s) * (1.f / DM) + EPS);
        GAS f32x4* orow = (GAS f32x4*)(F.out + (size_t)row * DM) + F.lane;
#pragma unroll
        for (int j = 0; j < 8; ++j) { const f32x4 g = *(const GAS f32x4*)(F.fg + 4 * F.lane + 256 * j); orow[64 * j] = v[j] * rstd * g; }
    }
}

struct Args { const float* in[25]; float* out; unsigned char* ws; int ph_lo, ph_hi, li, pad; };
__global__ void __launch_bounds__(NTHR, 2) mega_fwd(Args args) {
    extern __shared__ __attribute__((aligned(16))) unsigned char lds[];
    Frame F;
    F.lds = (LAS unsigned char*)lds; F.MISC = (volatile LAS unsigned*)(F.lds + MISC_OFF);
    F.tid = threadIdx.x; F.lane = F.tid & 63; F.wave = __builtin_amdgcn_readfirstlane(F.tid >> 6);
    F.G = gridDim.x; { const int bx = blockIdx.x; F.vcu = (F.G % 8 == 0) ? (bx % 8) * (F.G / 8) + bx / 8 : bx; }
    F.ws = args.ws; F.ctl = (unsigned*)(args.ws + WS_CTL); F.out = args.out;
    F.x = args.in[0]; F.c = args.in[1]; F.w_ada = args.in[2]; F.b_ada = args.in[3]; F.g1 = args.in[4]; F.w_in = args.in[5]; F.lq1 = args.in[6]; F.lk1 = args.in[7]; F.lq2 = args.in[8]; F.lk2 = args.in[9];
    F.subln = args.in[10]; F.relb = args.in[11]; F.cw = args.in[12]; F.cb = args.in[13]; F.clg = args.in[14]; F.clb = args.in[15]; F.w_out = args.in[16]; F.g2 = args.in[17]; F.w_r = args.in[18]; F.b_r = args.in[19];
    F.w_gu = args.in[20]; F.b_gu = args.in[21]; F.w_d = args.in[22]; F.b_d = args.in[23]; F.fg = args.in[24];
    for (int u = F.tid; u < 64; u += NTHR) ((LAS unsigned*)(F.lds + MISC_OFF))[u] = 0u;
    __syncthreads();
    XcdBarrier bar = xcd_barrier_post(F.ctl + CW_BAR + args.li * XCD_BAR_WORDS, F.MISC + 8);
    const int lo = args.ph_lo, hi = args.ph_hi;
#ifndef PH_MASK
#define PH_MASK 0x1ff
#endif
#define IN(k) (((PH_MASK >> (k)) & 1) && lo <= (k) && (k) < hi)
#define SEAM(k) do { if (IN(k) && IN((k) + 1)) { xcd_barrier(bar); if constexpr (((REP_MASK >> 14) & 1) != 0) xcd_barrier(bar); } } while (0)
#define REP2(k, ...) do { { __VA_ARGS__ } if constexpr (((REP_MASK >> (k)) & 1) != 0) { __VA_ARGS__ } } while (0)
    if (IN(0)) { REP2(0, __syncthreads(); p0_prologue(F);); } SEAM(0);
    if (IN(0) && IN(1)) F.vcu = xcd_virtual_cu(bar);
    if (IN(1)) { REP2(1, __syncthreads(); p1_norm1(F);); } SEAM(1);
    if (IN(2)) { REP2(2, { InProjT<false> P{WSP(bf16, WS_H), WSP(bf16, WS_WIN), WSP(bf16, WS_PROJ), {}}; P.ord.init(T, INC, F.G, F.vcu, false, true); __syncthreads(); pg8::gemm_run(F.lds, P); }
        { InProjT<true> P{WSP(bf16, WS_H), WSP(bf16, WS_WIN), WSP(bf16, WS_PROJ), {}}; P.ord.init(T, INC, F.G, F.vcu, true, true); __syncthreads(); pg8::gemm_run<InProjT<true>, true>(F.lds, P); }); } SEAM(2);
    if (IN(3)) { REP2(3,
        for (int ct = F.vcu; ct < T / 32; ct += F.G) conv_unit(F, ct);
        if constexpr (((REP_MASK >> 9) & 1) != 0) { for (int ct = F.vcu; ct < T / 32; ct += F.G) conv_unit(F, ct); }
        for (int u = F.vcu; u < NB * AH * 16 * (1 + ((REP_MASK >> 10) & 1)); u += F.G) att::attn_unit(F, u % (NB * AH * 16));
    ); } SEAM(3);
    if (IN(4)) { REP2(4, OutProj P{WSP(bf16, WS_MIX), WSP(bf16, WS_WOUT), F.x, WSP(float, WS_MOD), WSP(bf16, WS_X1), {}}; P.ord.init(T, DM, F.G, F.vcu); __syncthreads(); pg8::gemm_run(F.lds, P);); } SEAM(4);
    if (IN(5)) { p5_router(F); if constexpr (((REP_MASK >> 13) & 1) != 0) { __syncthreads(); p5_router(F, true); } } SEAM(5);
    if (IN(6)) { REP2(6, moe_tables(F); const LAS int* tab = (const LAS int*)(F.lds + TAB_OFF);
        MoeGU P{WSP(bf16, WS_H2), F.w_gu, F.b_gu, (const int*)(F.ws + WS_ROUTE + RT_LIST), WSP(bf16, WS_ACT), {tab, tab + 40, tab + 80}, F.G, F.vcu}; pg8::gemm_run_bf32(F.lds, P);); } SEAM(6);
    if (IN(7)) { REP2(7, moe_tables(F); const LAS int* tab = (const LAS int*)(F.lds + TAB_OFF);
        { MoeDownT<1> P{WSP(bf16, WS_ACT), F.w_d, F.b_d, (const float*)(F.ws + WS_ROUTE + RT_SW), WSP(bf16, WS_Y), {tab, tab + 40, tab + 80}, F.G, F.vcu}; pg8::gemm_run_bf32(F.lds, P); }
        { MoeDownT<2> P{WSP(bf16, WS_ACT), F.w_d, F.b_d, (const float*)(F.ws + WS_ROUTE + RT_SW), WSP(bf16, WS_Y), {tab, tab + 40, tab + 80}, F.G, F.vcu}; pg8::gemm_run_bf32<MoeDownT<2>, true>(F.lds, P); }); } SEAM(7);
    if (IN(8)) { REP2(8, p8_final(F);); }
#undef IN
#undef SEAM
}

extern "C" void kernel_launch(void* const* d_in, const int* in_sizes, int n_in, void* d_out, int out_size, void* d_ws, size_t ws_size, hipStream_t stream) {
    static int grid = 0;
    if (grid == 0) {
        if (n_in != 25 || ws_size < WS_END || out_size != T * DM) { fprintf(stderr, "kernel_launch: n_in %d out %d ws %zu (need %zu); nothing launched\n", n_in, out_size, ws_size, (size_t)WS_END); grid = -1; return; }
        int dev = 0, cus = 0, per_cu = 0;
        if (hipGetDevice(&dev) != hipSuccess || hipDeviceGetAttribute(&cus, hipDeviceAttributeMultiprocessorCount, dev) != hipSuccess) { grid = -1; return; }
        if (hipFuncSetAttribute((const void*)mega_fwd, hipFuncAttributeMaxDynamicSharedMemorySize, LDS_BYTES) != hipSuccess) { fprintf(stderr, "kernel_launch: hipFuncSetAttribute failed\n"); grid = -1; return; }
        if (hipOccupancyMaxActiveBlocksPerMultiprocessor(&per_cu, (const void*)mega_fwd, NTHR, LDS_BYTES) != hipSuccess || per_cu < 1) { fprintf(stderr, "kernel_launch: occupancy query says %d blocks per CU\n", per_cu); }
        (void)hipGetLastError();
        grid = cus;
    }
    if (grid < 0) return;
    unsigned char* ws = (unsigned char*)d_ws;
    (void)hipMemsetAsync(ws + WS_CTL, 0, CTL_ZERO_BYTES, stream);
    Args a{};
    for (int i = 0; i < 25; ++i) a.in[i] = (const float*)d_in[i];
    a.out = (float*)d_out; a.ws = ws; a.ph_lo = 0; a.ph_hi = 9; a.li = 0; a.pad = 0;
    hipLaunchKernelGGL(mega_fwd, dim3(grid), dim3(NTHR), LDS_BYTES, stream, a);
}
```

```cpp
#include <hip/hip_runtime.h>
#include <cstdio>
#include <cstdint>

#ifndef REP_MASK
#define REP_MASK 0
#endif

constexpr int DM = 2048, NB = 4, SEQ = 2048, T = NB * SEQ;
constexpr int AH = 8, HD = 64, VD = 128, CCH = 1024, CK = 31;
constexpr int INC = 5120;
constexpr int NE = 32, TOPK = 4, DFF = 2048, NSLOT = T * TOPK;
constexpr float EPS = 1e-6f;
constexpr float LOG2E = 1.4426950408889634f;

typedef unsigned short bf16;
typedef short bf16x8 __attribute__((ext_vector_type(8)));
typedef short s16x4 __attribute__((ext_vector_type(4)));
typedef float f32x4 __attribute__((ext_vector_type(4)));
typedef float f32x16 __attribute__((ext_vector_type(16)));
typedef unsigned u32x4 __attribute__((ext_vector_type(4)));
typedef unsigned u32x2 __attribute__((ext_vector_type(2)));
#define GAS __attribute__((address_space(1)))
#define LAS __attribute__((address_space(3)))
typedef GAS unsigned gu32;

constexpr size_t MiB = 1u << 20;
constexpr size_t WS_CTL = 0, CTL_ZERO_BYTES = 64 * 1024;
constexpr size_t WS_MODP = 1 * MiB;
constexpr size_t WS_MOD = 3 * MiB;
constexpr size_t WS_BIAST = 4 * MiB;
constexpr size_t WS_WRF = 5 * MiB;
constexpr size_t WS_ROUTE = 6 * MiB;
constexpr size_t RT_LIST = 0;
constexpr size_t RT_SW = 1 * MiB;
constexpr size_t RT_TOKE = 2 * MiB;
constexpr size_t RT_TOKR = RT_TOKE + 128 * 1024;
constexpr size_t WS_WIN = 16 * MiB;
constexpr size_t WS_WOUT = WS_WIN + 20 * MiB;
constexpr size_t WS_H = WS_WOUT + 8 * MiB;
constexpr size_t WS_PROJ = WS_H + 32 * MiB;
constexpr size_t WS_MIX = WS_PROJ + 80 * MiB;
constexpr size_t WS_X1 = WS_MIX + 32 * MiB;
constexpr size_t WS_H2 = WS_X1 + 64 * MiB;
constexpr size_t WS_ACT = WS_H2 + 32 * MiB;
constexpr size_t WS_Y = WS_ACT + 130 * MiB;
constexpr size_t WS_END = WS_Y + 130 * MiB;
constexpr int CW_CNT = 0;
constexpr int CW_BAR = 1024;

__device__ __forceinline__ unsigned f2bf(float f) { unsigned u = __builtin_bit_cast(unsigned, f); return (u + 0x7fffu + ((u >> 16) & 1u)) >> 16; }
__device__ __forceinline__ float bf2f(unsigned h) { return __builtin_bit_cast(float, h << 16); }
__device__ __forceinline__ unsigned pk2(float lo, float hi) { return f2bf(lo) | (f2bf(hi) << 16); }
__device__ __forceinline__ unsigned cvt_pk_bf16(float lo, float hi) { unsigned r; asm volatile("v_cvt_pk_bf16_f32 %0, %1, %2" : "=v"(r) : "v"(lo), "v"(hi)); return r; }
__device__ __forceinline__ float silu_f(float v) { return v / (1.f + __expf(-v)); }
__device__ __forceinline__ float wave_sum(float v) {
#pragma unroll
    for (int o = 1; o < 64; o <<= 1) v += __shfl_xor(v, o);
    return v;
}
__host__ __device__ inline int t5_bucket(int rel) {
    int ret = rel > 0 ? 16 : 0; int n = rel < 0 ? -rel : rel;
    if (n < 8) return ret + n;
    int lg = n >= 91 ? 15 : n >= 64 ? 14 : n >= 46 ? 13 : n >= 32 ? 12 : n >= 23 ? 11 : n >= 16 ? 10 : n >= 12 ? 9 : 8;
    return ret + lg;
}
#define LDS_WAIT() asm volatile("s_waitcnt lgkmcnt(0)" ::: "memory")
#define VM_WAIT() asm volatile("s_waitcnt vmcnt(0)" ::: "memory")

#define XB_TMO      128
#define XB_XCNT(j)  (256  + 64 * (j))
#define XB_XSUB(j)  (1280 + 64 * (j))
#define XB_XGEN(j)  (2304 + 64 * (j))
#define XB_TOP      3328
#define XB_TOPGEN   3392
#define XCD_BAR_WORDS 3456
#define XB_SPIN_CAP (1u << 18)
__device__ __forceinline__ unsigned xb_ld(unsigned* p)              { return __hip_atomic_load(p, __ATOMIC_RELAXED, __HIP_MEMORY_SCOPE_AGENT); }
__device__ __forceinline__ unsigned xb_add(unsigned* p, unsigned v) { return __hip_atomic_fetch_add(p, v, __ATOMIC_RELAXED, __HIP_MEMORY_SCOPE_AGENT); }
__device__ __forceinline__ unsigned xb_xcc_id() { return (unsigned)__builtin_amdgcn_s_getreg((3 << 11) | 20) & 0xFu; }
#define XB_SPIN(cond, bar) do { unsigned _sp = 0; while (cond) { __builtin_amdgcn_s_sleep(1); \
    if ((++_sp & 255u) == 0u) { if (xb_ld(&(bar)[XB_TMO])) break; if (_sp > XB_SPIN_CAP) { atomicAdd(&(bar)[XB_TMO], 1u); break; } } } } while (0)
struct XcdBarrier { unsigned* bar; unsigned x; volatile LAS unsigned* st; };
__device__ __forceinline__ XcdBarrier xcd_barrier_post(unsigned* bar, volatile LAS unsigned* st) {
    XcdBarrier b; b.bar = bar; b.x = xb_xcc_id(); b.st = st;
    if (threadIdx.x == 0) st[2] = xb_add(&bar[XB_XCNT(b.x)], 1u);
    return b;
}
__device__ __forceinline__ int xcd_virtual_cu(const XcdBarrier& b) {
    if (threadIdx.x == 0) { unsigned pre = 0u; for (unsigned j = 0; j < 16; ++j) { const unsigned c = xb_ld(&b.bar[XB_XCNT(j)]); pre += (j < b.x) ? c : 0u; } b.st[3] = pre + b.st[2]; }
    __syncthreads();
    const int v = (int)b.st[3];
    __syncthreads();
    return __builtin_amdgcn_readfirstlane(v);
}
__device__ __forceinline__ void xcd_barrier_complete(unsigned* bar, unsigned x, unsigned& nloc, unsigned& nx) {
    const unsigned G = gridDim.x * gridDim.y * gridDim.z;
    unsigned sum, cnt, mine, sp = 0u;
    for (;;) {
        sum = 0u; cnt = 0u; mine = 0u;
#pragma unroll
        for (unsigned j = 0; j < 16; ++j) { const unsigned c = xb_ld(&bar[XB_XCNT(j)]); sum += c; cnt += (c > 0u) ? 1u : 0u; mine = (j == x) ? c : mine; }
        if (sum == G) break;
        __builtin_amdgcn_s_sleep(1);
        if ((++sp & 255u) == 0u) { if (xb_ld(&bar[XB_TMO])) break; if (sp > XB_SPIN_CAP) { atomicAdd(&bar[XB_TMO], 1u); break; } }
    }
    nloc = mine > 0u ? mine : 1u; nx = cnt > 0u ? cnt : 1u;
}
__device__ __forceinline__ void xcd_barrier(const XcdBarrier& b) {
    asm volatile("s_waitcnt vmcnt(0)" ::: "memory");
    __syncthreads();
    if (threadIdx.x == 0) {
        unsigned* bar = b.bar;
        __builtin_amdgcn_s_waitcnt(0);
        unsigned nloc = b.st[0], nx = b.st[1];
        if (nloc == 0u) { xcd_barrier_complete(bar, b.x, nloc, nx); b.st[0] = nloc; b.st[1] = nx; }
        const unsigned old = xb_add(&bar[XB_XSUB(b.x)], 1u);
        const unsigned gen = old / nloc;
        if (old + 1u == (gen + 1u) * nloc) {
            __builtin_amdgcn_fence(__ATOMIC_RELEASE, "agent");
            asm volatile("s_waitcnt vmcnt(0)" ::: "memory");
            const unsigned og = xb_add(&bar[XB_TOP], 1u);
            const unsigned tg = og / nx;
            if (og + 1u == (tg + 1u) * nx) xb_add(&bar[XB_TOPGEN], 1u);
            else XB_SPIN(xb_ld(&bar[XB_TOPGEN]) == tg, bar);
            __builtin_amdgcn_fence(__ATOMIC_ACQUIRE, "agent");
            xb_add(&bar[XB_XGEN(b.x)], 1u);
            asm volatile("s_waitcnt vmcnt(0)" ::: "memory");
        } else {
            XB_SPIN(xb_ld(&bar[XB_XGEN(b.x)]) == gen, bar);
            __builtin_amdgcn_fence(__ATOMIC_ACQUIRE, "agent");
            asm volatile("s_waitcnt vmcnt(0)" ::: "memory");
        }
    }
    __syncthreads();
}

namespace pg8 {
constexpr int BM = 256, BK = 64, HALF = 128, HTB = HALF * BK * 2, STAGE_BYTES = 8 * HTB, KD = 2048;
__host__ __device__ __forceinline__ int lds_byte(int r, int c) { const int st = (r >> 4) * 2 + (c >> 5), rr = r & 15, cc = c & 31, ob = rr * 64 + cc * 2; return st * 1024 + (ob ^ (((ob >> 9) & 1) << 5)); }
__host__ __device__ __forceinline__ void stage_rc(int b, int& R, int& C) { const int st = b / 1024, sb = b % 1024, swz = sb ^ (((sb >> 9) & 1) << 5); R = (st >> 1) * 16 + swz / 64; C = (st & 1) * 32 + (swz % 64) / 2; }
__host__ __device__ __forceinline__ int perm32(int rho) { const int n = rho >> 4, i = rho & 15; return 8 * (i >> 2) + 4 * n + (i & 3); }
struct Unit { int pm, pn, e, rows, hs; };

struct DenseOrder {
    int nM, nN, nwg, nfull, G, c; bool half;
    __device__ void init(int M, int N, int G_, int c_, bool half_ = false, bool split_tail = false) { nM = M / BM; nN = N / BM; nwg = nM * nN; G = G_; c = c_; half = half_; nfull = split_tail ? (nwg / G_) * G_ : nwg; }
    __device__ bool next(int i, Unit& u) const {
        long L = (long)i * G + c; int hsel = 0;
        if (half) { if (L >= 2L * (nwg - nfull)) return false; hsel = (int)(L & 1); L = nfull + (L >> 1); }
        else if (L >= nfull) return false;
        const int wgid = (int)L;
        const int nig = 8 * nN, gid = wgid / nig, fm = gid * 8, gsz = (nM - fm) < 8 ? (nM - fm) : 8;
        u.pm = fm + ((wgid % nig) % gsz); u.pn = (wgid % nig) / gsz; u.e = 0; u.hs = 0; u.rows = 256; if (half) { u.pm = 2 * u.pm + hsel; u.rows = 128; } return true;
    }
};

template <class P, bool HM = false>
__device__ __forceinline__ void gemm_run(LAS unsigned char* lds, const P& prob) {
    const int tid = threadIdx.x, wid = __builtin_amdgcn_readfirstlane(tid >> 6), lane = tid & 63, wr = wid >> 2, wc = wid & 3, fr = lane & 15, fq = lane >> 4;
    constexpr int K = KD, nt = K / BK;
    int Rr[2], Cc[2]; unsigned voffB[2];
#pragma unroll
    for (int i = 0; i < 2; ++i) { int R, C; stage_rc(tid * 16 + i * 8192, R, C); Rr[i] = R; Cc[i] = C; const int Rb = P::PERM ? ((R & ~31) + perm32(R & 31)) : R; voffB[i] = (unsigned)(Rb * K + C) * 2u; }
    constexpr size_t kstep = (size_t)(BK * 2), hstep = (size_t)HALF * K * 2;
    const unsigned ldsw = (unsigned)wid * 1024u;
    const int aoff = lds_byte(wr * 64 + fr, fq * 8), boff = lds_byte(wc * 32 + fr, fq * 8);
#define PG8_SA(b, h) (((b) * 2 + (h)) * HTB)
#define PG8_SB(b, h) ((4 + (b) * 2 + (h)) * HTB)
#define PG8_STAGE(bufoff, gbase, voff) do { _Pragma("unroll") for (int _i = 0; _i < 2; ++_i) \
        __builtin_amdgcn_global_load_lds((const unsigned*)((const char*)(gbase) + (voff)[_i]), (LAS unsigned*)(lds + (bufoff) + ldsw + _i * 8192), 16, 0, 0); } while (0)
#define PG8_LDA(dst, b, h) do { _Pragma("unroll") for (int m = 0; m < 4; ++m) _Pragma("unroll") for (int k = 0; k < 2; ++k) dst[m][k] = *(const LAS bf16x8*)(lds + PG8_SA(b, h) + aoff + m * 2048 + k * 1024); } while (0)
#define PG8_LDB(dst, b, h) do { _Pragma("unroll") for (int n = 0; n < 2; ++n) _Pragma("unroll") for (int k = 0; k < 2; ++k) dst[n][k] = *(const LAS bf16x8*)(lds + PG8_SB(b, h) + boff + n * 2048 + k * 1024); } while (0)
#define PG8_MMA(ai, bj, At, Bt) do { __builtin_amdgcn_s_setprio(1); _Pragma("unroll") for (int m = 0; m < 4; ++m) _Pragma("unroll") for (int n = 0; n < 2; ++n) _Pragma("unroll") for (int k = 0; k < 2; ++k) \
        acc[ai][bj][m][n] = __builtin_amdgcn_mfma_f32_16x16x32_bf16(Bt[n][k], At[m][k], acc[ai][bj][m][n], 0, 0, 0); __builtin_amdgcn_s_setprio(0); } while (0)
#define PG8_WAIT_V(n) asm volatile("s_waitcnt vmcnt(" #n ")" ::: "memory")
#define PG8_WAIT_L(n) asm volatile("s_waitcnt lgkmcnt(" #n ")" ::: "memory")
#define PG8_BAR __builtin_amdgcn_s_barrier()
#define PG8_SCHED __builtin_amdgcn_sched_barrier(0)
    Unit cur, nxt; int ui = 0;
    if (!prob.next(0, cur)) return;
    f32x4 acc[2][2][4][2];
#pragma unroll
    for (int a = 0; a < 2; ++a)
#pragma unroll
        for (int b = 0; b < 2; ++b)
#pragma unroll
            for (int m = 0; m < 4; ++m)
#pragma unroll
                for (int n = 0; n < 2; ++n) acc[a][b][m][n] = (f32x4){0.f, 0.f, 0.f, 0.f};
    bf16x8 At[4][2], B0[2][2], B1[2][2];
    unsigned vC0[2], vC1[2], vN0[2], vN1[2];
    prob.a_off(cur, Rr, Cc, vC0, vC1);
    const char* const Ab = prob.a_base();
    const char* cB = prob.b_base(cur);
    PG8_STAGE(PG8_SB(0, 0), cB, voffB); PG8_STAGE(PG8_SB(0, 1), cB + hstep, voffB); PG8_STAGE(PG8_SA(0, 0), Ab, vC0); if constexpr (!HM) PG8_STAGE(PG8_SA(0, 1), Ab, vC1);
    if (wr == 1) PG8_BAR;
    if constexpr (HM) PG8_WAIT_V(0); else PG8_WAIT_V(2);
    PG8_BAR;
    PG8_STAGE(PG8_SB(1, 0), cB + kstep, voffB); PG8_STAGE(PG8_SA(1, 0), Ab + kstep, vC0); PG8_STAGE(PG8_SB(1, 1), cB + hstep + kstep, voffB);
    PG8_WAIT_V(6); PG8_BAR;
    for (;;) {
        const bool has_next = prob.next(ui + 1, nxt);
        if (has_next) prob.a_off(nxt, Rr, Cc, vN0, vN1); else { vN0[0] = vC0[0]; vN0[1] = vC0[1]; vN1[0] = vC1[0]; vN1[1] = vC1[1]; }
        const char* nB = has_next ? prob.b_base(nxt) : cB;
        for (int t = 0; t < nt; t += 2) {
            const bool last = (t == nt - 2);
            const char* a1 = Ab + (size_t)(t + 1) * kstep;
            const char* a2 = last ? Ab : Ab + (size_t)(t + 2) * kstep; const char* b2 = last ? nB : cB + (size_t)(t + 2) * kstep;
            const char* a3 = a2 + kstep; const char* b3 = b2 + kstep;
            unsigned v20[2], v21[2];
            v20[0] = last ? vN0[0] : vC0[0]; v20[1] = last ? vN0[1] : vC0[1]; v21[0] = last ? vN1[0] : vC1[0]; v21[1] = last ? vN1[1] : vC1[1];
            PG8_LDB(B0, 0, 0); PG8_LDB(B1, 0, 1); PG8_SCHED; PG8_LDA(At, 0, 0); if constexpr (!HM) PG8_STAGE(PG8_SA(1, 1), a1, vC1);
            if constexpr (HM) PG8_WAIT_V(6); else PG8_WAIT_V(8); PG8_WAIT_L(0); PG8_BAR; PG8_MMA(0, 0, At, B0); PG8_MMA(0, 1, At, B1); PG8_BAR; PG8_SCHED;
            if constexpr (!HM) PG8_LDA(At, 0, 1); PG8_STAGE(PG8_SB(0, 0), b2, voffB); PG8_STAGE(PG8_SB(0, 1), b2 + hstep, voffB); PG8_STAGE(PG8_SA(0, 0), a2, v20);
            if constexpr (HM) PG8_WAIT_V(6); else PG8_WAIT_V(8);
            PG8_WAIT_L(0); PG8_BAR; if constexpr (!HM) { PG8_MMA(1, 0, At, B0); PG8_MMA(1, 1, At, B1); } PG8_BAR; PG8_SCHED;
            PG8_LDB(B0, 1, 0); PG8_LDB(B1, 1, 1); PG8_SCHED; PG8_LDA(At, 1, 0); if constexpr (!HM) PG8_STAGE(PG8_SA(0, 1), a2, v21);
            if constexpr (HM) PG8_WAIT_V(6); else PG8_WAIT_V(8); PG8_WAIT_L(0); PG8_BAR; PG8_MMA(0, 0, At, B0); PG8_MMA(0, 1, At, B1); PG8_BAR; PG8_SCHED;
            if constexpr (!HM) PG8_LDA(At, 1, 1); PG8_STAGE(PG8_SB(1, 0), b3, voffB); PG8_STAGE(PG8_SB(1, 1), b3 + hstep, voffB); PG8_STAGE(PG8_SA(1, 0), a3, v20);
            if constexpr (HM) PG8_WAIT_V(6); else PG8_WAIT_V(8);
            PG8_WAIT_L(0); PG8_BAR; if constexpr (!HM) { PG8_MMA(1, 0, At, B0); PG8_MMA(1, 1, At, B1); } PG8_BAR; PG8_SCHED;
        }
        if (wr == 0) PG8_BAR;
        prob.epi(acc, cur, wr, wc, fr, fq);
        if (!has_next) break;
#pragma unroll
        for (int a = 0; a < 2; ++a)
#pragma unroll
            for (int b = 0; b < 2; ++b)
#pragma unroll
                for (int m = 0; m < 4; ++m)
#pragma unroll
                    for (int n = 0; n < 2; ++n) acc[a][b][m][n] = (f32x4){0.f, 0.f, 0.f, 0.f};
        cur = nxt; cB = nB; ++ui; vC0[0] = vN0[0]; vC0[1] = vN0[1]; vC1[0] = vN1[0]; vC1[1] = vN1[1];
        if (wr == 1) PG8_BAR;
    }
    PG8_WAIT_V(0);
    PG8_BAR;
#undef PG8_SA
#undef PG8_SB
#undef PG8_STAGE
#undef PG8_LDA
#undef PG8_LDB
#undef PG8_MMA
#undef PG8_WAIT_V
#undef PG8_WAIT_L
#undef PG8_BAR
#undef PG8_SCHED
}

template <class P, bool HN = false>
__device__ __forceinline__ void gemm_run_bf32(LAS unsigned char* lds, const P& prob) {
    const int tid = threadIdx.x, wid = __builtin_amdgcn_readfirstlane(tid >> 6), lane = tid & 63, wr = wid >> 2, wc = wid & 3, fr = lane & 15, fq = lane >> 4;
    constexpr int K = KD, nt = K / BK;
    constexpr size_t kstep = (size_t)(BK * 2);
    constexpr size_t ldwB = (size_t)P::LDW_BYTES;
    const unsigned ldsw = (unsigned)wid * 1024u;
    const int aoff = lds_byte(wr * 64 + fr, fq * 8), boff = lds_byte(wc * 32 + fr, fq * 8);
    const int wbo0 = lds_byte(32 * (lane >> 4) + (((lane >> 1) & 1) | (((lane >> 3) & 1) << 2) | (((lane >> 2) & 1) << 3)), 8 * wid + 4 * (lane & 1));
#define PG8_SA(b, h) (((b) * 2 + (h)) * HTB)
#define PG8_SB(b, h) ((4 + (b) * 2 + (h)) * HTB)
#define PG8_STAGE(bufoff, gbase, voff) do { _Pragma("unroll") for (int _i = 0; _i < 2; ++_i) \
        __builtin_amdgcn_global_load_lds((const unsigned*)((const char*)(gbase) + (voff)[_i]), (LAS unsigned*)(lds + (bufoff) + ldsw + _i * 8192), 16, 0, 0); } while (0)
#define PG8_LDA(dst, b, h) do { _Pragma("unroll") for (int m = 0; m < 4; ++m) _Pragma("unroll") for (int k = 0; k < 2; ++k) dst[m][k] = *(const LAS bf16x8*)(lds + PG8_SA(b, h) + aoff + m * 2048 + k * 1024); } while (0)
#define PG8_LDB(dst, b, h) do { _Pragma("unroll") for (int n = 0; n < 2; ++n) _Pragma("unroll") for (int k = 0; k < 2; ++k) dst[n][k] = *(const LAS bf16x8*)(lds + PG8_SB(b, h) + boff + n * 2048 + k * 1024); } while (0)
#define PG8_MMA(ai, bj, At, Bt) do { __builtin_amdgcn_s_setprio(1); _Pragma("unroll") for (int m = 0; m < 4; ++m) _Pragma("unroll") for (int n = 0; n < 2; ++n) _Pragma("unroll") for (int k = 0; k < 2; ++k) \
        acc[ai][bj][m][n] = __builtin_amdgcn_mfma_f32_16x16x32_bf16(Bt[n][k], At[m][k], acc[ai][bj][m][n], 0, 0, 0); __builtin_amdgcn_s_setprio(0); } while (0)
#define PG8_WAIT_V(n) asm volatile("s_waitcnt vmcnt(" #n ")" ::: "memory")
#define PG8_WAIT_L(n) asm volatile("s_waitcnt lgkmcnt(" #n ")" ::: "memory")
#define PG8_BAR __builtin_amdgcn_s_barrier()
#define PG8_SCHED __builtin_amdgcn_sched_barrier(0)
#define PG8_BLOAD(kk, h) do { const bool nx_ = (kk) >= nt; const unsigned so_ = (nx_ ? nBo : cBo) + (unsigned)((nx_ ? (kk) - nt : (kk)) * BK + 8 * wid) * (unsigned)ldwB + (unsigned)(h) * (unsigned)P::HALF_BYTES; \
        const unsigned co_ = nx_ ? nCol : cCol; \
        asm volatile("s_nop 4" ::: "memory"); \
        _Pragma("unroll") for (int j_ = 0; j_ < 4; ++j_) asm volatile("buffer_load_dwordx4 %0, %1, %2, %3 offen" : "=v"(bv[j_]) : "v"(co_), "s"(wrs), "s"(so_ + (unsigned)j_ * (unsigned)ldwB) : "memory"); } while (0)
#define PG8_BWAIT(n) asm volatile("s_waitcnt vmcnt(" #n ")" : "+v"(bv[0]), "+v"(bv[1]), "+v"(bv[2]), "+v"(bv[3]) :: "memory")
#define PG8_BWRITE(b, h) do { _Pragma("unroll") for (int i_ = 0; i_ < 4; ++i_) { u32x2 o_; o_.x = cvt_pk_bf16(bv[0][i_], bv[1][i_]); o_.y = cvt_pk_bf16(bv[2][i_], bv[3][i_]); \
        *(LAS u32x2*)(lds + PG8_SB(b, h) + wbo0 + 128 * (i_ & 1) + 2048 * (i_ >> 1)) = o_; } } while (0)
    typedef float f32x2v __attribute__((ext_vector_type(2)));
    Unit cur, nxt; int ui = 0;
    if (!prob.next(0, cur)) return;
    f32x4 acc[2][2][4][2];
    bf16x8 At[4][2], B0[2][2], B1[2][2];
    f32x4 bv[4];
    unsigned vC0[2], vC1[2], vN0[2], vN1[2];
    prob.a_off(cur, vC0, vC1);
    const char* const Ab = prob.a_base();
    const __amdgpu_buffer_rsrc_t wrs = __builtin_amdgcn_make_buffer_rsrc((void*)prob.W, 0, (unsigned)NE * (unsigned)P::W_BYTES, 0x00020000);
    unsigned cBo = (unsigned)cur.e * (unsigned)P::W_BYTES, cCol = prob.b_col(cur, lane & ~1) + (unsigned)(lane & 1) * 4u * (unsigned)ldwB;
    unsigned nBo = cBo, nCol = cCol;
#define PG8_BLOADX(R, kk, h) do { const unsigned so_ = cBo + (unsigned)((kk) * BK + 8 * wid) * (unsigned)ldwB + (unsigned)(h) * (unsigned)P::HALF_BYTES; \
        _Pragma("unroll") for (int j_ = 0; j_ < 4; ++j_) asm volatile("buffer_load_dwordx4 %0, %1, %2, %3 offen" : "=v"(R[j_]) : "v"(cCol), "s"(wrs), "s"(so_ + (unsigned)j_ * (unsigned)ldwB) : "memory"); } while (0)
#define PG8_BWAITX(R, n) asm volatile("s_waitcnt vmcnt(" #n ")" : "+v"(R[0]), "+v"(R[1]), "+v"(R[2]), "+v"(R[3]) :: "memory")
#define PG8_BWRITEX(R, b, h) do { _Pragma("unroll") for (int i_ = 0; i_ < 4; ++i_) { u32x2 o_; o_.x = cvt_pk_bf16(R[0][i_], R[1][i_]); o_.y = cvt_pk_bf16(R[2][i_], R[3][i_]); \
        *(LAS u32x2*)(lds + PG8_SB(b, h) + wbo0 + 128 * (i_ & 1) + 2048 * (i_ >> 1)) = o_; } } while (0)
    { f32x4 bw[4], bx[4];
      asm volatile("s_nop 4" ::: "memory");
      PG8_BLOADX(bv, 0, 0); if constexpr (!HN) PG8_BLOADX(bw, 0, 1); PG8_BLOADX(bx, 1, 0);
      PG8_STAGE(PG8_SA(0, 0), Ab, vC0); PG8_STAGE(PG8_SA(0, 1), Ab, vC1);
      if constexpr (!HN) { PG8_BWAITX(bv, 12); PG8_BWRITEX(bv, 0, 0); PG8_BWAITX(bw, 8); PG8_BWRITEX(bw, 0, 1); }
      else { PG8_BWAITX(bv, 8); PG8_BWRITEX(bv, 0, 0); }
      PG8_BWAITX(bx, 4); PG8_BWRITEX(bx, 1, 0); }
    if constexpr (!HN) PG8_BLOAD(1, 1);
    if (wr == 1) PG8_BAR;
    if constexpr (!HN) PG8_WAIT_V(4); else PG8_WAIT_V(0);
    PG8_WAIT_L(0); PG8_BAR;
    PG8_STAGE(PG8_SA(1, 0), Ab + kstep, vC0);
    { f32x4 bini[2][2]; prob.bias_load(cur, wc, fq, bini);
#pragma unroll
      for (int a = 0; a < 2; ++a)
#pragma unroll
        for (int b = 0; b < 2; ++b)
#pragma unroll
            for (int m = 0; m < 4; ++m)
#pragma unroll
                for (int n = 0; n < 2; ++n) acc[a][b][m][n] = bini[b][n]; }
    PG8_WAIT_V(0); PG8_BAR;
    for (;;) {
        const bool has_next = prob.next(ui + 1, nxt);
        if (has_next) { prob.a_off(nxt, vN0, vN1); nBo = (unsigned)nxt.e * (unsigned)P::W_BYTES; nCol = prob.b_col(nxt, lane & ~1) + (unsigned)(lane & 1) * 4u * (unsigned)ldwB; }
        else { vN0[0] = vC0[0]; vN0[1] = vC0[1]; vN1[0] = vC1[0]; vN1[1] = vC1[1]; nBo = cBo; nCol = cCol; }
        for (int t = 0; t < nt; t += 2) {
            const bool last = (t == nt - 2);
            const char* a1 = Ab + (size_t)(t + 1) * kstep;
            const char* a2 = last ? Ab : Ab + (size_t)(t + 2) * kstep;
            const char* a3 = a2 + kstep;
            unsigned v20[2], v21[2];
            v20[0] = last ? vN0[0] : vC0[0]; v20[1] = last ? vN0[1] : vC0[1]; v21[0] = last ? vN1[0] : vC1[0]; v21[1] = last ? vN1[1] : vC1[1];
            PG8_LDB(B0, 0, 0); if constexpr (!HN) PG8_LDB(B1, 0, 1); PG8_SCHED; PG8_LDA(At, 0, 0); if constexpr (!HN) { PG8_BWAIT(2); PG8_BWRITE(1, 1); } PG8_BLOAD(t + 2, 0); PG8_STAGE(PG8_SA(1, 1), a1, vC1);
            if constexpr (HN) PG8_WAIT_V(8); else PG8_WAIT_V(12);
            PG8_WAIT_L(0); PG8_BAR; PG8_MMA(0, 0, At, B0); if constexpr (!HN) PG8_MMA(0, 1, At, B1); PG8_BAR; PG8_SCHED;
            PG8_LDA(At, 0, 1); PG8_BWAIT(2); PG8_BWRITE(0, 0); if constexpr (!HN) PG8_BLOAD(t + 2, 1); PG8_STAGE(PG8_SA(0, 0), a2, v20);
            if constexpr (HN) PG8_WAIT_V(8); else PG8_WAIT_V(12);
            PG8_WAIT_L(0); PG8_BAR; PG8_MMA(1, 0, At, B0); if constexpr (!HN) PG8_MMA(1, 1, At, B1); PG8_BAR; PG8_SCHED;
            PG8_LDB(B0, 1, 0); if constexpr (!HN) PG8_LDB(B1, 1, 1); PG8_SCHED; PG8_LDA(At, 1, 0); if constexpr (!HN) { PG8_BWAIT(2); PG8_BWRITE(0, 1); } PG8_BLOAD(t + 3, 0); PG8_STAGE(PG8_SA(0, 1), a2, v21);
            if constexpr (HN) PG8_WAIT_V(8); else PG8_WAIT_V(12);
            PG8_WAIT_L(0); PG8_BAR; PG8_MMA(0, 0, At, B0); if constexpr (!HN) PG8_MMA(0, 1, At, B1); PG8_BAR; PG8_SCHED;
            PG8_LDA(At, 1, 1); PG8_BWAIT(2); PG8_BWRITE(1, 0); if constexpr (!HN) PG8_BLOAD(t + 3, 1); PG8_STAGE(PG8_SA(1, 0), a3, v20);
            if constexpr (HN) PG8_WAIT_V(8); else PG8_WAIT_V(12);
            PG8_WAIT_L(0); PG8_BAR; PG8_MMA(1, 0, At, B0); if constexpr (!HN) PG8_MMA(1, 1, At, B1); PG8_BAR; PG8_SCHED;
        }
        if (wr == 0) PG8_BAR;
        prob.epi(acc, cur, wr, wc, fr, fq, 0);
        if (has_next) { f32x4 bini[2][2]; prob.bias_load(nxt, wc, fq, bini);
#pragma unroll
            for (int b = 0; b < 2; ++b)
#pragma unroll
                for (int m = 0; m < 4; ++m)
#pragma unroll
                    for (int n = 0; n < 2; ++n) acc[0][b][m][n] = bini[b][n]; }
        prob.epi(acc, cur, wr, wc, fr, fq, 1);
        if (!has_next) break;
#pragma unroll
        for (int b = 0; b < 2; ++b)
#pragma unroll
            for (int m = 0; m < 4; ++m)
#pragma unroll
                for (int n = 0; n < 2; ++n) acc[1][b][m][n] = acc[0][b][m][n];
        cur = nxt; cBo = nBo; cCol = nCol; ++ui; vC0[0] = vN0[0]; vC0[1] = vN0[1]; vC1[0] = vN1[0]; vC1[1] = vN1[1];
        if (wr == 1) PG8_BAR;
    }
    PG8_BWAIT(0);
    PG8_BAR;
#undef PG8_SA
#undef PG8_SB
#undef PG8_STAGE
#undef PG8_LDA
#undef PG8_LDB
#undef PG8_MMA
#undef PG8_WAIT_V
#undef PG8_WAIT_L
#undef PG8_BAR
#undef PG8_SCHED
#undef PG8_BLOAD
#undef PG8_BWAIT
#undef PG8_BWRITE
#undef PG8_BLOADX
#undef PG8_BWAITX
#undef PG8_BWRITEX
}
}

constexpr int NWAVES = 8, NTHR = 512;
constexpr int RING_BYTES = 131072;
constexpr int TAB_OFF = 147968;
constexpr int MISC_OFF = 163840 - 256;
constexpr int LDS_BYTES = 163840;

struct Frame {
    LAS unsigned char* lds; volatile LAS unsigned* MISC; unsigned* ctl;
    int tid, lane, wave, vcu, G;
    const float *x, *c, *w_ada, *b_ada, *g1, *w_in, *lq1, *lk1, *lq2, *lk2, *subln, *relb, *cw, *cb, *clg, *clb, *w_out, *g2, *w_r, *b_r, *w_gu, *b_gu, *w_d, *b_d, *fg;
    float* out; unsigned char* ws;
};
#define WSP(T_, off) ((T_*)(F.ws + (off)))

__device__ __forceinline__ void p0_transpose_item(const float* W, int ldn, int n0, int k0, bf16* dst, int drow0, LAS unsigned char* scr, int lane) {
    const int ng = lane & 31, kh = lane >> 5;
#pragma unroll
    for (int it = 0; it < 4; ++it) {
        f32x4 v[8];
#pragma unroll
        for (int j = 0; j < 8; ++j) v[j] = *(const GAS f32x4*)(W + (size_t)(k0 + 16 * it + 8 * kh + j) * ldn + n0 + 4 * ng);
        const int kc = 2 * it + kh;
#pragma unroll
        for (int i = 0; i < 4; ++i) { const int n = 4 * ng + i;
            u32x4 o; o.x = pk2(v[0][i], v[1][i]); o.y = pk2(v[2][i], v[3][i]); o.z = pk2(v[4][i], v[5][i]); o.w = pk2(v[6][i], v[7][i]);
            *(LAS u32x4*)(scr + n * 128 + ((kc ^ (ng & 7)) << 4)) = o; }
    }
    LDS_WAIT(); asm volatile("" ::: "memory");
#pragma unroll
    for (int j = 0; j < 16; ++j) { const int n = 8 * j + (lane >> 3), c = lane & 7;
        const u32x4 o = *(const LAS u32x4*)(scr + n * 128 + ((c ^ ((n >> 2) & 7)) << 4));
        *(GAS u32x4*)(dst + (size_t)(drow0 + n) * pg8::KD + k0 + 8 * c) = o; }
    LDS_WAIT(); asm volatile("" ::: "memory");
}
__device__ __forceinline__ void p0_prologue(Frame& F) {
    const int gw = F.vcu * NWAVES + F.wave, NGW = F.G * NWAVES, gt = F.vcu * NTHR + F.tid, NGT = F.G * NTHR;
    LAS float* cs = (LAS float*)(F.lds);
    for (int i = F.tid; i < NB * DM; i += NTHR) cs[i] = silu_f(F.c[i]);
    __syncthreads();
    float* modp = WSP(float, WS_MODP);
    for (int it = gw; it < 192 * 8; it += NGW) {
        const int cc = it % 192, kc = it / 192, r = F.lane >> 4, g = F.lane & 15;
        float acc[4][4];
#pragma unroll
        for (int b = 0; b < 4; ++b)
#pragma unroll
            for (int j = 0; j < 4; ++j) acc[b][j] = 0.f;
        const float* wp = F.w_ada + (size_t)(kc * 256 + r) * (6 * DM) + cc * 64 + g * 4;
#pragma unroll 8
        for (int s = 0; s < 64; ++s) {
            const f32x4 w = *(const GAS f32x4*)(wp + (size_t)(4 * s) * (6 * DM)); const int k = kc * 256 + 4 * s + r;
#pragma unroll
            for (int b = 0; b < 4; ++b) { const float cv = cs[b * DM + k];
#pragma unroll
                for (int j = 0; j < 4; ++j) acc[b][j] += cv * w[j]; }
        }
#pragma unroll
        for (int b = 0; b < 4; ++b)
#pragma unroll
            for (int j = 0; j < 4; ++j) { float v = acc[b][j]; v += __shfl_xor(v, 16); v += __shfl_xor(v, 32); acc[b][j] = v; }
        if (F.lane < 16)
#pragma unroll
            for (int b = 0; b < 4; ++b) *(GAS f32x4*)(modp + (size_t)(kc * 4 + b) * (6 * DM) + cc * 64 + g * 4) = (f32x4){acc[b][0], acc[b][1], acc[b][2], acc[b][3]};
    }
    __syncthreads();
    LAS unsigned char* scr = F.lds + F.wave * 16384;
    constexpr int I_IN = (INC / 128) * 32, I_OUT = (DM / 128) * 32;
    for (int it = gw; it < I_IN + I_OUT; it += NGW) {
        int r = it;
        if (r < I_IN) { const int nb = r >> 5, kb = r & 31;
            const int drow = nb < 24 ? nb * 128 : (nb < 32 ? 3072 + (nb - 24) * 256 : 3072 + (nb - 32) * 256 + 128);
            p0_transpose_item(F.w_in, INC, nb * 128, kb * 64, WSP(bf16, WS_WIN), drow, scr, F.lane); continue; } r -= I_IN;
        { const int nb = r >> 5, kb = r & 31; p0_transpose_item(F.w_out, DM, nb * 128, kb * 64, WSP(bf16, WS_WOUT), nb * 128, scr, F.lane); }
    }
    for (int i = gt; i < 64 * 2 * 64; i += NGT) {
        const int l = i & 63, nb = (i >> 6) & 1, s = i >> 7, e = 16 * nb + (l & 15), kb = 32 * s + 8 * (l >> 4);
        unsigned hi[8], lo[8];
#pragma unroll
        for (int j = 0; j < 8; ++j) { const float w = F.w_r[(size_t)(kb + j) * NE + e]; hi[j] = f2bf(w); lo[j] = f2bf(w - bf2f(hi[j])); }
        u32x4 oh, ol; oh.x = hi[0] | (hi[1] << 16); oh.y = hi[2] | (hi[3] << 16); oh.z = hi[4] | (hi[5] << 16); oh.w = hi[6] | (hi[7] << 16);
        ol.x = lo[0] | (lo[1] << 16); ol.y = lo[2] | (lo[3] << 16); ol.z = lo[4] | (lo[5] << 16); ol.w = lo[6] | (lo[7] << 16);
        *(GAS u32x4*)(WSP(unsigned char, WS_WRF) + (size_t)i * 16) = oh; *(GAS u32x4*)(WSP(unsigned char, WS_WRF) + 131072 + (size_t)i * 16) = ol;
    }
    float* bt = WSP(float, WS_BIAST);
    for (int i = gt; i < AH * 4096; i += NGT) { const int h = i >> 12, rel = (i & 4095) - 2048; bt[i] = F.relb[t5_bucket(rel) * AH + h] * LOG2E; }
    if (gt == 0) { float a = 0.f, b = 0.f; for (int i = 0; i < HD; ++i) { a += F.lq1[i] * F.lk1[i]; b += F.lq2[i] * F.lk2[i]; } bt[AH * 4096] = __expf(a) - __expf(b) + 0.2f; }
}

__device__ __forceinline__ void p1_norm1(Frame& F) {
    const float* modp = WSP(float, WS_MODP); float* mod = WSP(float, WS_MOD);
    for (int o = F.vcu * NTHR + F.tid; o < NB * 6 * DM; o += F.G * NTHR) { float s = F.b_ada[o % (6 * DM)];
#pragma unroll
        for (int kc = 0; kc < 8; ++kc) s += modp[(size_t)kc * (NB * 6 * DM) + o];
        mod[o] = s; }
    LAS float* gm = (LAS float*)F.lds; LAS float* sh = gm + DM;
    bf16* h = WSP(bf16, WS_H);
    for (int rb = F.vcu; rb < T / 32; rb += F.G) {
        const int b = rb / (SEQ / 32);
        __syncthreads();
        for (int k = F.tid; k < DM; k += NTHR) { float sc = F.b_ada[DM + k], sf = F.b_ada[k];
#pragma unroll
            for (int kc = 0; kc < 8; ++kc) { sc += modp[(size_t)(kc * 4 + b) * (6 * DM) + DM + k]; sf += modp[(size_t)(kc * 4 + b) * (6 * DM) + k]; }
            gm[k] = F.g1[k] * (1.f + sc); sh[k] = sf; }
        __syncthreads();
        for (int rr = F.wave; rr < 32; rr += NWAVES) {
            const int row = rb * 32 + rr;
            const GAS f32x4* xr = (const GAS f32x4*)(F.x + (size_t)row * DM) + F.lane;
            f32x4 v[8]; float s = 0.f;
#pragma unroll
            for (int j = 0; j < 8; ++j) { v[j] = xr[64 * j]; s += (v[j].x * v[j].x + v[j].y * v[j].y) + (v[j].z * v[j].z + v[j].w * v[j].w); }
            const float rstd = rsqrtf(wave_sum(s) * (1.f / DM) + EPS);
            GAS u32x2* o8 = (GAS u32x2*)(h + (size_t)row * DM) + F.lane;
#pragma unroll
            for (int j = 0; j < 8; ++j) { const int k = 4 * F.lane + 256 * j; const f32x4 g = *(const LAS f32x4*)(gm + k), s4 = *(const LAS f32x4*)(sh + k);
                u32x2 w; w.x = pk2(v[j].x * rstd * g.x + s4.x, v[j].y * rstd * g.y + s4.y); w.y = pk2(v[j].z * rstd * g.z + s4.z, v[j].w * rstd * g.w + s4.w); o8[64 * j] = w; }
        }
    }
}

template <bool HMT> struct InProjT {
    static constexpr bool PERM = true;
    const bf16* A; const bf16* Bt; bf16* O; pg8::DenseOrder ord;
    __device__ bool next(int i, pg8::Unit& u) const { return ord.next(i, u); }
    __device__ const char* a_base() const { return (const char*)A; }
    __device__ void a_off(const pg8::Unit& u, const int (&R)[2], const int (&C)[2], unsigned (&v0)[2], unsigned (&v1)[2]) const {
#pragma unroll
        for (int i = 0; i < 2; ++i) { v0[i] = (unsigned)((u.pm * u.rows + R[i]) * pg8::KD + C[i]) * 2u; v1[i] = (unsigned)((u.pm * u.rows + 128 + R[i]) * pg8::KD + C[i]) * 2u; } }
    __device__ const char* b_base(const pg8::Unit& u) const { return (const char*)(Bt + (size_t)u.pn * 256 * pg8::KD); }
    __device__ void epi(const f32x4 (&acc)[2][2][4][2], const pg8::Unit& u, int wr, int wc, int fr, int fq) const {
        const int row0 = u.pm * u.rows + wr * 64 + fr, col0 = u.pn * 256 + wc * 32 + 8 * fq;
        if (u.pn >= 12) {
            const int zc = 3072 + (u.pn - 12) * 128 + wc * 32 + 8 * fq;
#pragma unroll
            for (int ai = 0; ai < (HMT ? 1 : 2); ++ai)
#pragma unroll
                for (int m = 0; m < 4; ++m) { float r[8];
#pragma unroll
                    for (int n = 0; n < 2; ++n)
#pragma unroll
                        for (int j = 0; j < 4; ++j) r[4 * n + j] = acc[ai][0][m][n][j] * __builtin_amdgcn_rcpf(1.f + __builtin_amdgcn_exp2f(-LOG2E * acc[ai][1][m][n][j]));
                    u32x4 w; w.x = cvt_pk_bf16(r[0], r[1]); w.y = cvt_pk_bf16(r[2], r[3]); w.z = cvt_pk_bf16(r[4], r[5]); w.w = cvt_pk_bf16(r[6], r[7]);
                    *(GAS u32x4*)(O + (size_t)(row0 + ai * 128 + m * 16) * INC + zc) = w; }
            return; }
#pragma unroll
        for (int ai = 0; ai < (HMT ? 1 : 2); ++ai)
#pragma unroll
            for (int m = 0; m < 4; ++m) { bf16* rowp = O + (size_t)(row0 + ai * 128 + m * 16) * INC + col0;
#pragma unroll
                for (int bj = 0; bj < 2; ++bj) { const f32x4 v0 = acc[ai][bj][m][0], v1 = acc[ai][bj][m][1];
                    u32x4 w; w.x = cvt_pk_bf16(v0[0], v0[1]); w.y = cvt_pk_bf16(v0[2], v0[3]); w.z = cvt_pk_bf16(v1[0], v1[1]); w.w = cvt_pk_bf16(v1[2], v1[3]);
                    *(GAS u32x4*)(rowp + bj * 128) = w; } }
    }
};
struct OutProj {
    static constexpr bool PERM = true;
    const bf16* A; const bf16* Bt; const float* x; const float* mod; bf16* O; pg8::DenseOrder ord;
    __device__ bool next(int i, pg8::Unit& u) const { return ord.next(i, u); }
    __device__ const char* a_base() const { return (const char*)A; }
    __device__ void a_off(const pg8::Unit& u, const int (&R)[2], const int (&C)[2], unsigned (&v0)[2], unsigned (&v1)[2]) const {
#pragma unroll
        for (int i = 0; i < 2; ++i) { v0[i] = (unsigned)((u.pm * 256 + R[i]) * pg8::KD + C[i]) * 2u; v1[i] = (unsigned)((u.pm * 256 + 128 + R[i]) * pg8::KD + C[i]) * 2u; } }
    __device__ const char* b_base(const pg8::Unit& u) const { return (const char*)(Bt + (size_t)u.pn * 256 * pg8::KD); }
    __device__ void epi(const f32x4 (&acc)[2][2][4][2], const pg8::Unit& u, int wr, int wc, int fr, int fq) const {
        const int row0 = u.pm * 256 + wr * 64 + fr, col0 = u.pn * 256 + wc * 32 + 8 * fq, b = (u.pm * 256) / SEQ;
        f32x4 gt[2][2];
#pragma unroll
        for (int bj = 0; bj < 2; ++bj)
#pragma unroll
            for (int n = 0; n < 2; ++n) gt[bj][n] = *(const GAS f32x4*)(mod + (size_t)b * 6 * DM + 2 * DM + col0 + bj * 128 + 4 * n);
#pragma unroll
        for (int ai = 0; ai < 2; ++ai)
#pragma unroll
            for (int m = 0; m < 4; ++m) { const size_t ro = (size_t)(row0 + ai * 128 + m * 16) * DM + col0;
#pragma unroll
                for (int bj = 0; bj < 2; ++bj) { const f32x4 x0 = *(const GAS f32x4*)(x + ro + bj * 128), x1v = *(const GAS f32x4*)(x + ro + bj * 128 + 4);
                    const f32x4 v0 = x0 + gt[bj][0] * acc[ai][bj][m][0], v1 = x1v + gt[bj][1] * acc[ai][bj][m][1];
                    u32x4 w; w.x = cvt_pk_bf16(v0[0], v0[1]); w.y = cvt_pk_bf16(v0[2], v0[3]); w.z = cvt_pk_bf16(v1[0], v1[1]); w.w = cvt_pk_bf16(v1[2], v1[3]);
                    *(GAS u32x4*)(O + ro + bj * 128) = w; } }
    }
};
struct MoeTab { const LAS int* tp; const LAS int* off; const LAS int* cnt; };
__device__ __forceinline__ void moe_tables(Frame& F) {
    LAS int* tab = (LAS int*)(F.lds + TAB_OFF);
    __syncthreads();
    if (F.tid < 64) {
        const int e = F.lane & 31;
        const int c = (int)__hip_atomic_load(F.ctl + CW_CNT + e, __ATOMIC_RELAXED, __HIP_MEMORY_SCOPE_AGENT);
        const int t0 = (c + 255) >> 8; int t = t0, o = c;
#pragma unroll
        for (int d = 1; d < 32; d <<= 1) { const int t2 = __shfl_up(t, d, 32), o2 = __shfl_up(o, d, 32); if (e >= d) { t += t2; o += o2; } }
        if (F.lane < NE) { tab[e] = t - t0; tab[40 + e] = o - c; tab[80 + e] = c; }
        if (F.lane == NE - 1) { tab[NE] = t; tab[40 + NE] = o; }
    }
    __syncthreads();
}
template <int NTN, int REPF, int SPLIT>
__device__ __forceinline__ bool moe_next(const MoeTab& tb, int G, int c, int i, pg8::Unit& u) {
    int L = i * G + c; const int total = NTN * __builtin_amdgcn_readfirstlane(tb.tp[NE]); int hs = 0;
    if (SPLIT != 0) {
        const int nrem = total % G, nful = (2 * nrem <= G) ? total - nrem : total;
        if (SPLIT == 1) { if (L >= nful) return false; }
        else { if (L >= 2 * (total - nful)) return false; hs = L & 1; L = nful + (L >> 1); }
    } else { if (L >= total * REPF) return false; if (REPF > 1 && L >= total) L -= total; }
    int e = 0;
#pragma unroll
    for (int j = 1; j < NE; ++j) e += (L >= NTN * tb.tp[j]) ? 1 : 0;
    e = __builtin_amdgcn_readfirstlane(e);
    const int tpe = __builtin_amdgcn_readfirstlane(tb.tp[e]), tpe1 = __builtin_amdgcn_readfirstlane(tb.tp[e + 1]);
    const int local = L - NTN * tpe, nte = tpe1 - tpe;
    u.e = e; u.hs = hs; u.pn = __builtin_amdgcn_readfirstlane(local / nte); u.pm = local - u.pn * nte; u.rows = __builtin_amdgcn_readfirstlane(tb.cnt[e]) - 256 * u.pm; return true;
}
struct MoeGU {
    static constexpr bool PERM = true;
    const bf16* A; const float* W; const float* bias; const int* list; bf16* O; MoeTab tb; int G, c;
    __device__ bool next(int i, pg8::Unit& u) const { return moe_next<16, 1 + ((REP_MASK >> 11) & 1), 0>(tb, G, c, i, u); }
    __device__ const char* a_base() const { return (const char*)A; }
    __device__ void a_off(const pg8::Unit& u, unsigned (&v0)[2], unsigned (&v1)[2]) const {
        const int* lp = list + u.e * T + 256 * u.pm;
        int tb16 = (int)threadIdx.x * 16; asm volatile("" : "+v"(tb16));
#pragma unroll
        for (int i = 0; i < 2; ++i) { int R, C; pg8::stage_rc(tb16 + i * 8192, R, C);
            const int r0 = R < u.rows ? R : u.rows - 1, r1 = (128 + R) < u.rows ? (128 + R) : u.rows - 1;
            v0[i] = (unsigned)(lp[r0] * pg8::KD + C) * 2u; v1[i] = (unsigned)(lp[r1] * pg8::KD + C) * 2u; } }
    __device__ void bias_load(const pg8::Unit& u, int wc, int fq, f32x4 (&bi)[2][2]) const {
        int cb = wc * 32 + 8 * ((fq >> 1) + 2 * (fq & 1)); asm volatile("" : "+v"(cb));
        const float* bp = bias + (size_t)u.e * 2 * DFF + u.pn * 128 + cb;
#pragma unroll
        for (int bj = 0; bj < 2; ++bj)
            { const f32x4 t0 = *(const GAS f32x4*)(bp + bj * DFF), t1 = *(const GAS f32x4*)(bp + bj * DFF + 4); bi[bj][0] = (f32x4){t0[0], t1[0], t0[1], t1[1]}; bi[bj][1] = (f32x4){t0[2], t1[2], t0[3], t1[3]}; } }
    static constexpr int LDW_BYTES = 2 * DFF * 4, W_BYTES = DM * 2 * DFF * 4;
    __device__ const char* b_ptr(const pg8::Unit& u) const { return (const char*)(W + (size_t)u.e * DM * 2 * DFF); }
    static constexpr int HALF_BYTES = DFF * 4;
    __device__ unsigned b_col(const pg8::Unit& u, int lane) const { return (unsigned)(u.pn * 128 + 2 * lane) * 4u; }
    __device__ void epi(const f32x4 (&acc)[2][2][4][2], const pg8::Unit& u, int wr, int wc, int fr, int fq, const int ai) const {
        int rt0 = wr * 64 + fr, colt = u.pn * 128 + wc * 32 + 8 * ((fq >> 1) + 2 * (fq & 1)); asm volatile("" : "+v"(rt0), "+v"(colt)); const size_t slot0 = (size_t)__builtin_amdgcn_readfirstlane(tb.off[u.e]) + 256 * u.pm;
#pragma unroll
            for (int m = 0; m < 4; ++m) { const int rt = rt0 + ai * 128 + m * 16; float r[8];
#pragma unroll
                for (int n = 0; n < 2; ++n)
#pragma unroll
                    for (int j = 0; j < 4; ++j) { const int o = (j >> 1) + 2 * n + 4 * (j & 1);
                        float g = acc[ai][0][m][n][j], up = acc[ai][1][m][n][j];
                        g = fminf(g, 7.f); up = fminf(fmaxf(up, -7.f), 7.f);
                        r[o] = (up + 1.f) * g * __builtin_amdgcn_rcpf(1.f + __builtin_amdgcn_exp2f(-1.702f * LOG2E * g)); }
                if (rt < u.rows) { u32x4 w; w.x = cvt_pk_bf16(r[0], r[1]); w.y = cvt_pk_bf16(r[2], r[3]); w.z = cvt_pk_bf16(r[4], r[5]); w.w = cvt_pk_bf16(r[6], r[7]);
                    *(GAS u32x4*)(O + (slot0 + rt) * DFF + colt) = w; } }
    }
};
template <int SPLIT> struct MoeDownT {
    static constexpr bool PERM = true;
    const bf16* A; const float* W; const float* bias; const float* sw; bf16* O; MoeTab tb; int G, c;
    __device__ bool next(int i, pg8::Unit& u) const { return moe_next<8, 1 + ((REP_MASK >> 12) & 1), SPLIT>(tb, G, c, i, u); }
    __device__ const char* a_base() const { return (const char*)A; }
    __device__ void a_off(const pg8::Unit& u, unsigned (&v0)[2], unsigned (&v1)[2]) const {
        const int s0 = __builtin_amdgcn_readfirstlane(tb.off[u.e]) + 256 * u.pm;
        int tb16 = (int)threadIdx.x * 16; asm volatile("" : "+v"(tb16));
#pragma unroll
        for (int i = 0; i < 2; ++i) { int R, C; pg8::stage_rc(tb16 + i * 8192, R, C);
            v0[i] = (unsigned)((s0 + R) * pg8::KD + C) * 2u; v1[i] = (unsigned)((s0 + 128 + R) * pg8::KD + C) * 2u; } }
    __device__ void bias_load(const pg8::Unit& u, int wc, int fq, f32x4 (&bi)[2][2]) const {
        int cb = wc * 32 + 8 * ((fq >> 1) + 2 * (fq & 1)); asm volatile("" : "+v"(cb));
        const float* bp = bias + (size_t)u.e * DM + u.pn * 256 + u.hs * 128 + cb;
#pragma unroll
        for (int bj = 0; bj < (SPLIT == 2 ? 1 : 2); ++bj)
            { const f32x4 t0 = *(const GAS f32x4*)(bp + bj * 128), t1 = *(const GAS f32x4*)(bp + bj * 128 + 4); bi[bj][0] = (f32x4){t0[0], t1[0], t0[1], t1[1]}; bi[bj][1] = (f32x4){t0[2], t1[2], t0[3], t1[3]}; } }
    static constexpr int LDW_BYTES = DM * 4, W_BYTES = DFF * DM * 4;
    __device__ const char* b_ptr(const pg8::Unit& u) const { return (const char*)(W + (size_t)u.e * DFF * DM); }
    static constexpr int HALF_BYTES = 128 * 4;
    __device__ unsigned b_col(const pg8::Unit& u, int lane) const { return (unsigned)(u.pn * 256 + u.hs * 128 + 2 * lane) * 4u; }
    __device__ void epi(const f32x4 (&acc)[2][2][4][2], const pg8::Unit& u, int wr, int wc, int fr, int fq, const int ai) const {
        int rt0 = wr * 64 + fr, col0 = u.pn * 256 + u.hs * 128 + wc * 32 + 8 * ((fq >> 1) + 2 * (fq & 1)); asm volatile("" : "+v"(rt0), "+v"(col0)); const size_t slot0 = (size_t)__builtin_amdgcn_readfirstlane(tb.off[u.e]) + 256 * u.pm;
#pragma unroll
            for (int m = 0; m < 4; ++m) { const int rt = rt0 + ai * 128 + m * 16;
                if (rt < u.rows) { const float wgt = sw[(size_t)u.e * T + 256 * u.pm + rt]; bf16* rowp = O + (slot0 + rt) * DM + col0;
#pragma unroll
                    for (int bj = 0; bj < (SPLIT == 2 ? 1 : 2); ++bj) { float r[8];
#pragma unroll
                        for (int n = 0; n < 2; ++n)
#pragma unroll
                            for (int j = 0; j < 4; ++j) { const int o = (j >> 1) + 2 * n + 4 * (j & 1); r[o] = acc[ai][bj][m][n][j] * wgt; }
                        u32x4 w; w.x = cvt_pk_bf16(r[0], r[1]); w.y = cvt_pk_bf16(r[2], r[3]); w.z = cvt_pk_bf16(r[4], r[5]); w.w = cvt_pk_bf16(r[6], r[7]);
                        *(GAS u32x4*)(rowp + bj * 128) = w; } } }
    }
};

__device__ __forceinline__ void conv_unit(Frame& F, int ct) {
    const int b = ct / (SEQ / 32), s0 = (ct % (SEQ / 32)) * 32, tid = F.tid;
    const bf16* proj = WSP(bf16, WS_PROJ); bf16* mix = WSP(bf16, WS_MIX);
    LAS unsigned* z = (LAS unsigned*)F.lds;
    LAS float* st = (LAS float*)(F.lds + 126976);
    __syncthreads();
#pragma unroll 8
    for (int r = 0; r < 62; ++r) { const int s = s0 - 15 + r; const bool ok = (s >= 0 && s < SEQ); const int sc = ok ? s : 0;
        const unsigned zz = *(const GAS unsigned*)(proj + (size_t)(b * SEQ + sc) * INC + 3072 + 2 * tid);
        z[r * 512 + tid] = ok ? zz : 0u; }
    typedef float f32x2c __attribute__((ext_vector_type(2)));
    float w0[CK], w1[CK];
#pragma unroll
    for (int j = 0; j < CK; ++j) { const f32x2c w = *(const GAS f32x2c*)(F.cw + j * CCH + 2 * tid); w0[j] = w.x; w1[j] = w.y; }
    const f32x2c cbv = *(const GAS f32x2c*)(F.cb + 2 * tid), lg = *(const GAS f32x2c*)(F.clg + 2 * tid), lb = *(const GAS f32x2c*)(F.clb + 2 * tid);
    __syncthreads();
#pragma unroll 1
    for (int hf = 0; hf < 2; ++hf) {
        float c0[16], c1[16];
#pragma unroll
        for (int g = 0; g < 4; ++g) {
            float zl[34], zh[34];
#pragma unroll
            for (int r = 0; r < 34; ++r) { const unsigned zz = z[(16 * hf + 4 * g + r) * 512 + tid]; zl[r] = __builtin_bit_cast(float, zz << 16); zh[r] = __builtin_bit_cast(float, zz & 0xffff0000u); }
#pragma unroll
            for (int t = 0; t < 4; ++t) { float a0 = cbv.x, a1 = cbv.y;
#pragma unroll
                for (int j = 0; j < CK; ++j) { a0 = fmaf(w0[j], zl[t + j], a0); a1 = fmaf(w1[j], zh[t + j], a1); }
                c0[4 * g + t] = a0; c1[4 * g + t] = a1; }
        }
#pragma unroll
        for (int t = 0; t < 16; ++t) { const float sm = wave_sum(c0[t] + c1[t]), q = wave_sum(c0[t] * c0[t] + c1[t] * c1[t]);
            if (F.lane == 0) { st[(F.wave * 16 + t) * 2] = sm; st[(F.wave * 16 + t) * 2 + 1] = q; } }
        __syncthreads();
        if (tid < 16) { float sm = 0.f, q = 0.f;
#pragma unroll
            for (int w = 0; w < 8; ++w) { sm += st[(w * 16 + tid) * 2]; q += st[(w * 16 + tid) * 2 + 1]; }
            const float mu = sm * (1.f / CCH), var = q * (1.f / CCH) - mu * mu; st[512 + tid * 2] = mu; st[512 + tid * 2 + 1] = rsqrtf(fmaxf(var, 0.f) + EPS); }
        __syncthreads();
#pragma unroll
        for (int t = 0; t < 16; ++t) { const float mu = st[512 + t * 2], rs = st[512 + t * 2 + 1];
            const float y0 = (c0[t] - mu) * rs * lg.x + lb.x, y1 = (c1[t] - mu) * rs * lg.y + lb.y;
            const float o0 = y0 * __builtin_amdgcn_rcpf(1.f + __builtin_amdgcn_exp2f(-LOG2E * y0)), o1 = y1 * __builtin_amdgcn_rcpf(1.f + __builtin_amdgcn_exp2f(-LOG2E * y1));
            *(GAS unsigned*)(mix + (size_t)(b * SEQ + s0 + 16 * hf + t) * DM + 1024 + 2 * tid) = cvt_pk_bf16(o0, o1); }
        __syncthreads();
    }
}

namespace att {
constexpr int KVBLK = 64; constexpr size_t SHM_V = KVBLK * 128 * 2, SHM_K = KVBLK * 128 * 2;
constexpr float C = 0.125f * LOG2E, THR2 = 8.f * LOG2E;
#define KSWZ(row, colB) ((row) * 256 + ((colB) ^ (((row) & 7) << 4)))
#define SBAR() __builtin_amdgcn_sched_barrier(0)
__device__ __forceinline__ int crow(int r, int hi) { return (r & 3) + 8 * (r >> 2) + 4 * hi; }
__device__ __forceinline__ int v_st(int k, int c) { const int kk = (k & ~0xC) | ((k & 4) << 1) | ((k & 8) >> 1); return ((kk >> 3) * 4 + (c >> 5)) * 512 + ((kk & 7) * 32 + (c & 31)) * 2; }
__device__ __forceinline__ int v_rd_base(int lane) { return ((lane & 3) << 3) | (((lane >> 2) & 3) << 6) | (((lane >> 4) & 1) << 5) | (((lane >> 5) & 1) << 8); }
constexpr int v_rd_off(int d0, int ks, int half) { return d0 * 512 + ks * 4096 + half * 2048; }
template <int OFF> __device__ __forceinline__ s16x4 tr_read(int vb) { s16x4 r; asm volatile("ds_read_b64_tr_b16 %0, %1 offset:%2" : "=&v"(r) : "v"(vb), "i"(OFF) : "memory"); return r; }
template <int D0> __device__ __forceinline__ void pv_one(f32x16& od, int vb, bf16x8 pa0, bf16x8 pa1, bf16x8 pa2, bf16x8 pa3) {
    const s16x4 l0 = tr_read<v_rd_off(D0, 0, 0)>(vb), h0 = tr_read<v_rd_off(D0, 0, 1)>(vb), l1 = tr_read<v_rd_off(D0, 1, 0)>(vb), h1 = tr_read<v_rd_off(D0, 1, 1)>(vb);
    const s16x4 l2 = tr_read<v_rd_off(D0, 2, 0)>(vb), h2 = tr_read<v_rd_off(D0, 2, 1)>(vb), l3 = tr_read<v_rd_off(D0, 3, 0)>(vb), h3 = tr_read<v_rd_off(D0, 3, 1)>(vb);
    asm volatile("s_waitcnt lgkmcnt(0)" ::: "memory"); SBAR();
#define PK(L, H) (bf16x8){L[0], L[1], L[2], L[3], H[0], H[1], H[2], H[3]}
    od = __builtin_amdgcn_mfma_f32_32x32x16_bf16(pa0, PK(l0, h0), od, 0, 0, 0);
    od = __builtin_amdgcn_mfma_f32_32x32x16_bf16(pa1, PK(l1, h1), od, 0, 0, 0);
    od = __builtin_amdgcn_mfma_f32_32x32x16_bf16(pa2, PK(l2, h2), od, 0, 0, 0);
    od = __builtin_amdgcn_mfma_f32_32x32x16_bf16(pa3, PK(l3, h3), od, 0, 0, 0);
#undef PK
}
__device__ __forceinline__ void pv_d0(f32x16* o, int vb, bf16x8 pa0, bf16x8 pa1, bf16x8 pa2, bf16x8 pa3) {
    pv_one<0>(o[0], vb, pa0, pa1, pa2, pa3); pv_one<1>(o[1], vb, pa0, pa1, pa2, pa3); pv_one<2>(o[2], vb, pa0, pa1, pa2, pa3); pv_one<3>(o[3], vb, pa0, pa1, pa2, pa3);
}
__device__ __forceinline__ void qkt(f32x16& p0, f32x16& p1, const LAS char* Ks, const bf16x8* qr, int r32, int hi, int map) {
    p0 = f32x16{}; p1 = f32x16{};
#pragma unroll
    for (int d0 = 0; d0 < 4; ++d0) { const int cb = ((map * 4 + d0) * 16 + hi * 8) * 2;
        const bf16x8 b0 = *(const LAS bf16x8*)(Ks + KSWZ(r32, cb)); const bf16x8 b1 = *(const LAS bf16x8*)(Ks + KSWZ(32 + r32, cb));
        p0 = __builtin_amdgcn_mfma_f32_32x32x16_bf16(b0, qr[d0], p0, 0, 0, 0);
        p1 = __builtin_amdgcn_mfma_f32_32x32x16_bf16(b1, qr[d0], p1, 0, 0, 0); }
}
__device__ __forceinline__ void partialSM(f32x16& p0, f32x16& p1, float& m_reg, float& mn, float& alpha, int relw, int relb, int hi, const LAS float* btab, float bneg, float bpos) {
    if (relw - 31 >= 91 || relw + 63 <= -91) {
        const float bc = (relw > 0) ? bpos : bneg;
        float pmax = p0[0];
#pragma unroll
        for (int r = 1; r < 16; ++r) pmax = fmaxf(pmax, p0[r]);
#pragma unroll
        for (int r = 0; r < 16; ++r) pmax = fmaxf(pmax, p1[r]);
        { auto rr = __builtin_amdgcn_permlane32_swap(__float_as_uint(pmax), __float_as_uint(pmax), false, false); pmax = fmaxf(__uint_as_float(rr[0]), __uint_as_float(rr[1])); }
        const float tmax = fmaf(pmax, C, bc);
        if (__builtin_expect(__all(tmax - m_reg <= THR2), 1)) { mn = m_reg; alpha = 1.f; }
        else { mn = fmaxf(m_reg, tmax); alpha = __builtin_amdgcn_exp2f(m_reg - mn); m_reg = mn; }
        const float off = bc - mn;
#pragma unroll
        for (int r = 0; r < 16; ++r) p0[r] = fmaf(p0[r], C, off);
#pragma unroll
        for (int r = 0; r < 16; ++r) p1[r] = fmaf(p1[r], C, off);
    } else {
#pragma unroll
        for (int r = 0; r < 16; ++r) { const int idx = relb + crow(r, hi) + 256; p0[r] = fmaf(p0[r], C, btab[idx]); p1[r] = fmaf(p1[r], C, btab[idx + 32]); }
        float pmax = p0[0];
#pragma unroll
        for (int r = 1; r < 16; ++r) pmax = fmaxf(pmax, p0[r]);
#pragma unroll
        for (int r = 0; r < 16; ++r) pmax = fmaxf(pmax, p1[r]);
        { auto rr = __builtin_amdgcn_permlane32_swap(__float_as_uint(pmax), __float_as_uint(pmax), false, false); pmax = fmaxf(__uint_as_float(rr[0]), __uint_as_float(rr[1])); }
        if (__builtin_expect(__all(pmax - m_reg <= THR2), 1)) { mn = m_reg; alpha = 1.f; }
        else { mn = fmaxf(m_reg, pmax); alpha = __builtin_amdgcn_exp2f(m_reg - mn); m_reg = mn; }
#pragma unroll
        for (int r = 0; r < 16; ++r) p0[r] -= mn;
#pragma unroll
        for (int r = 0; r < 16; ++r) p1[r] -= mn;
    }
#pragma unroll
    for (int r = 0; r < 16; ++r) p0[r] = __builtin_amdgcn_exp2f(p0[r]);
}
__device__ __forceinline__ void finishSM(f32x16& p0, f32x16& p1, float alpha, float& l_reg, bf16x8& pa0, bf16x8& pa1, bf16x8& pa2, bf16x8& pa3) {
#pragma unroll
    for (int r = 0; r < 16; ++r) p1[r] = __builtin_amdgcn_exp2f(p1[r]);
    float ps = 0;
#pragma unroll
    for (int r = 0; r < 16; ++r) ps += p0[r];
#pragma unroll
    for (int r = 0; r < 16; ++r) ps += p1[r];
    { auto rr = __builtin_amdgcn_permlane32_swap(__float_as_uint(ps), __float_as_uint(ps), false, false); ps = __uint_as_float(rr[0]) + __uint_as_float(rr[1]); }
    l_reg = l_reg * alpha + ps;
#define PK4(P, BASE, OUT) do { unsigned a0 = cvt_pk_bf16(P[BASE + 0], P[BASE + 1]), a1 = cvt_pk_bf16(P[BASE + 2], P[BASE + 3]);   \
    unsigned b0 = cvt_pk_bf16(P[BASE + 4], P[BASE + 5]), b1 = cvt_pk_bf16(P[BASE + 6], P[BASE + 7]);                              \
    auto r0 = __builtin_amdgcn_permlane32_swap(a0, b0, false, false); auto r1 = __builtin_amdgcn_permlane32_swap(a1, b1, false, false); \
    u32x4 w = {r0[0], r1[0], r0[1], r1[1]}; OUT = __builtin_bit_cast(bf16x8, w); } while (0)
    PK4(p0, 0, pa0); PK4(p0, 8, pa1); PK4(p1, 0, pa2); PK4(p1, 8, pa3);
#undef PK4
}
constexpr int L_V = 0, L_K = 32768, L_WS = 65536, L_BT = 67584, L_CB = 69632;
__device__ __forceinline__ void attn_unit(Frame& F, int unit) {
    const int bh = unit >> 4, qb = unit & 15, b = bh >> 3, h = bh & 7, q0 = qb * 128;
    const int tid = F.tid, wid = F.wave, lane = F.lane, r32 = lane & 31, hi = lane >> 5, rg = wid & 3, map = wid >> 2;
    const bf16* proj = WSP(bf16, WS_PROJ);
    const bf16* Kh = proj + (size_t)(b * SEQ) * INC + 1024 + h * 128; const bf16* Vh = proj + (size_t)(b * SEQ) * INC + 2048 + h * 128;
    LAS char* lds = (LAS char*)F.lds; LAS char* V_lds = lds + L_V; LAS char* K_lds = lds + L_K;
    LAS float* wsf = (LAS float*)(lds + L_WS) + wid * 64; LAS float* li_l = wsf; LAS float* al_l = wsf + 32;
    LAS float* btab = (LAS float*)(lds + L_BT);
    const float* bt = WSP(float, WS_BIAST) + h * 4096;
    __syncthreads();
    btab[tid] = bt[2048 - 256 + tid];
    const float bneg = bt[2048 - 200], bpos = bt[2048 + 200], lam = WSP(float, WS_BIAST)[AH * 4096];
    float m_reg = -1e30f, l_reg = 0; f32x16 o[4] = {}; bf16x8 qr[4];
    const int qw0 = q0 + 32 * rg;
    const bf16* Qw = proj + (size_t)(b * SEQ + qw0 + r32) * INC + h * 128 + map * 64 + hi * 8;
#pragma unroll
    for (int d0 = 0; d0 < 4; ++d0) qr[d0] = *(const GAS bf16x8*)(Qw + d0 * 16);
    const int sr = tid >> 4, sc = (tid & 15) * 8, vst0 = v_st(sr, sc), vst1 = v_st(32 + sr, sc);
    const int vb0 = (int)(uintptr_t)V_lds + v_rd_base(lane);
    struct { bf16x8 vs0, vs1, ks0, ks1; } sr_[2];
#define SLOAD(i, k0) do { sr_[i].vs0 = *(const GAS bf16x8*)&Vh[(size_t)((k0) + sr) * INC + sc]; sr_[i].vs1 = *(const GAS bf16x8*)&Vh[(size_t)((k0) + 32 + sr) * INC + sc]; \
    sr_[i].ks0 = *(const GAS bf16x8*)&Kh[(size_t)((k0) + sr) * INC + sc]; sr_[i].ks1 = *(const GAS bf16x8*)&Kh[(size_t)((k0) + 32 + sr) * INC + sc]; } while (0)
#define SWRITE(bb, i) do { *(LAS bf16x8*)(V_lds + (bb) * SHM_V + vst0) = sr_[i].vs0; *(LAS bf16x8*)(V_lds + (bb) * SHM_V + vst1) = sr_[i].vs1; const int kc = sc * 2; \
    *(LAS bf16x8*)(K_lds + (bb) * SHM_K + KSWZ(sr, kc)) = sr_[i].ks0; *(LAS bf16x8*)(K_lds + (bb) * SHM_K + KSWZ(32 + sr, kc)) = sr_[i].ks1; } while (0)
#define SWAIT() asm volatile("s_waitcnt vmcnt(4)" ::: "memory")
#define RESC(a) do { if (__any((a) < 1.f)) { if (hi == 0) al_l[r32] = (a); asm volatile("s_waitcnt lgkmcnt(0)" ::: "memory"); \
    _Pragma("unroll") for (int d = 0; d < 4; ++d) _Pragma("unroll") for (int r = 0; r < 16; ++r) o[d][r] *= al_l[crow(r, hi)]; } } while (0)
#define PSM(P0, P1, MN, AL, k0) partialSM(P0, P1, m_reg, MN, AL, (k0) - qw0, (k0) - qw0 - r32, hi, btab, bneg, bpos)
    f32x16 pA0, pA1, pB0, pB1; float mnA, mnB, alA, alB; bf16x8 pa0, pa1, pa2, pa3; constexpr int NT = SEQ / KVBLK;
    constexpr int SE = 0, SO = 1;
    SLOAD(SE, 0); asm volatile("s_waitcnt vmcnt(0)" ::: "memory"); SWRITE(0, SE); __syncthreads();
    qkt(pA0, pA1, K_lds, qr, r32, hi, map); PSM(pA0, pA1, mnA, alA, 0);
    SLOAD(SO, KVBLK); SLOAD(SE, 2 * KVBLK);
    SWAIT(); SWRITE(1, SO); __syncthreads();
    for (int j = 1; j + 1 < NT; j += 2) {
        SBAR(); qkt(pB0, pB1, K_lds + SHM_K, qr, r32, hi, map);
        finishSM(pA0, pA1, alA, l_reg, pa0, pa1, pa2, pa3); SBAR();
        SLOAD(SO, (j + 2) * KVBLK); SBAR();
        pv_d0(o, vb0, pa0, pa1, pa2, pa3); PSM(pB0, pB1, mnB, alB, j * KVBLK);
        __syncthreads(); SWAIT(); SWRITE(0, SE);
        RESC(alB); __syncthreads();
        SBAR(); qkt(pA0, pA1, K_lds, qr, r32, hi, map);
        finishSM(pB0, pB1, alB, l_reg, pa0, pa1, pa2, pa3); SBAR();
        if (j + 3 < NT) SLOAD(SE, (j + 3) * KVBLK); SBAR();
        pv_d0(o, vb0 + (int)SHM_V, pa0, pa1, pa2, pa3); PSM(pA0, pA1, mnA, alA, (j + 1) * KVBLK);
        __syncthreads(); SWAIT(); SWRITE(1, SO);
        RESC(alA); __syncthreads();
    }
    SBAR(); qkt(pB0, pB1, K_lds + SHM_K, qr, r32, hi, map);
    finishSM(pA0, pA1, alA, l_reg, pa0, pa1, pa2, pa3); SBAR();
    pv_d0(o, vb0, pa0, pa1, pa2, pa3); PSM(pB0, pB1, mnB, alB, (NT - 1) * KVBLK);
    __syncthreads(); RESC(alB);
    finishSM(pB0, pB1, alB, l_reg, pa0, pa1, pa2, pa3); SBAR();
    pv_d0(o, vb0 + (int)SHM_V, pa0, pa1, pa2, pa3);
    if (hi == 0) li_l[r32] = l_reg; asm volatile("s_waitcnt lgkmcnt(0)" ::: "memory");
    float rli[16];
#pragma unroll
    for (int r = 0; r < 16; ++r) rli[r] = __builtin_amdgcn_rcpf(li_l[crow(r, hi)]);
    LAS float* cbuf = (LAS float*)(lds + L_CB) + rg * 32 * 128;
    if (map == 1) {
#pragma unroll
        for (int r = 0; r < 16; ++r)
#pragma unroll
            for (int d0 = 0; d0 < 4; ++d0) cbuf[crow(r, hi) * 128 + d0 * 32 + r32] = -lam * o[d0][r] * rli[r];
    }
    __syncthreads();
    if (map == 0) {
        bf16* mix = WSP(bf16, WS_MIX) + (size_t)(b * SEQ + qw0) * DM + h * 128;
        float sg[4];
#pragma unroll
        for (int d0 = 0; d0 < 4; ++d0) sg[d0] = F.subln[d0 * 32 + r32] * 0.8f;
#pragma unroll
        for (int r = 0; r < 16; ++r) { float v[4], ss = 0.f;
#pragma unroll
            for (int d0 = 0; d0 < 4; ++d0) { v[d0] = o[d0][r] * rli[r] + cbuf[crow(r, hi) * 128 + d0 * 32 + r32]; ss += v[d0] * v[d0]; }
#pragma unroll
            for (int s = 1; s < 32; s <<= 1) ss += __shfl_xor(ss, s);
            const float rstd = rsqrtf(ss * (1.f / VD) + EPS);
#pragma unroll
            for (int d0 = 0; d0 < 4; ++d0) mix[(size_t)crow(r, hi) * DM + d0 * 32 + r32] = (bf16)f2bf(v[d0] * rstd * sg[d0]); }
    }
#undef SLOAD
#undef SWRITE
#undef SWAIT
#undef RESC
#undef PSM
}
}

__device__ __forceinline__ void p5_router(Frame& F, bool dry = false) {
    const float* mod = WSP(float, WS_MOD); const bf16* x1 = WSP(bf16, WS_X1); bf16* h2 = WSP(bf16, WS_H2);
    int* list = (int*)(F.ws + WS_ROUTE + RT_LIST); float* sw = (float*)(F.ws + WS_ROUTE + RT_SW); int* toke = (int*)(F.ws + WS_ROUTE + RT_TOKE); int* tokr = (int*)(F.ws + WS_ROUTE + RT_TOKR);
    constexpr int RS = 4096 + 16;
    LAS unsigned char* Ahi = F.lds; LAS unsigned char* Alo = F.lds + 16 * RS; LAS float* Pl = (LAS float*)(F.lds + 32 * RS);
    const unsigned char* wrf = WSP(unsigned char, WS_WRF);
    for (int tb = F.vcu; tb < T / 16; tb += F.G) {
        const int b = (tb * 16) / SEQ;
        __syncthreads();
#pragma unroll 1
        for (int rr = 0; rr < 2; ++rr) {
            const int tl = 2 * F.wave + rr, row = tb * 16 + tl;
            const GAS u32x2* xr = (const GAS u32x2*)(x1 + (size_t)row * DM) + F.lane;
            f32x4 v[8]; float s = 0.f;
#pragma unroll
            for (int j = 0; j < 8; ++j) { const u32x2 xx = xr[64 * j]; v[j] = (f32x4){bf2f(xx.x & 0xffffu), bf2f(xx.x >> 16), bf2f(xx.y & 0xffffu), bf2f(xx.y >> 16)}; s += (v[j].x * v[j].x + v[j].y * v[j].y) + (v[j].z * v[j].z + v[j].w * v[j].w); }
            const float rstd = rsqrtf(wave_sum(s) * (1.f / DM) + EPS);
            GAS u32x2* o8 = (GAS u32x2*)(h2 + (size_t)row * DM) + F.lane;
#pragma unroll
            for (int j = 0; j < 8; ++j) { const int k = 4 * F.lane + 256 * j;
                const f32x4 g = *(const GAS f32x4*)(F.g2 + k), sc = *(const GAS f32x4*)(mod + (size_t)b * 6 * DM + 4 * DM + k), sf = *(const GAS f32x4*)(mod + (size_t)b * 6 * DM + 3 * DM + k);
                float hv[4]; unsigned hb[4], lb[4];
#pragma unroll
                for (int q = 0; q < 4; ++q) { hv[q] = v[j][q] * rstd * g[q] * (1.f + sc[q]) + sf[q]; hb[q] = f2bf(hv[q]); lb[q] = f2bf(hv[q] - bf2f(hb[q])); }
                u32x2 wh, wl; wh.x = hb[0] | (hb[1] << 16); wh.y = hb[2] | (hb[3] << 16); wl.x = lb[0] | (lb[1] << 16); wl.y = lb[2] | (lb[3] << 16);
                o8[64 * j] = wh; *(LAS u32x2*)(Ahi + tl * RS + k * 2) = wh; *(LAS u32x2*)(Alo + tl * RS + k * 2) = wl; }
        }
        __syncthreads();
        { f32x4 acc0 = {0.f, 0.f, 0.f, 0.f}, acc1 = {0.f, 0.f, 0.f, 0.f};
#pragma unroll 2
          for (int ks = 0; ks < 8; ++ks) { const int s = 8 * F.wave + ks, k0 = 32 * s + 8 * (F.lane >> 4);
            const bf16x8 ah = *(const LAS bf16x8*)(Ahi + (F.lane & 15) * RS + k0 * 2), al = *(const LAS bf16x8*)(Alo + (F.lane & 15) * RS + k0 * 2);
            const bf16x8 bh0 = *(const GAS bf16x8*)(wrf + ((size_t)(s * 2 + 0) * 64 + F.lane) * 16), bh1 = *(const GAS bf16x8*)(wrf + ((size_t)(s * 2 + 1) * 64 + F.lane) * 16);
            const bf16x8 bl0 = *(const GAS bf16x8*)(wrf + 131072 + ((size_t)(s * 2 + 0) * 64 + F.lane) * 16), bl1 = *(const GAS bf16x8*)(wrf + 131072 + ((size_t)(s * 2 + 1) * 64 + F.lane) * 16);
            acc0 = __builtin_amdgcn_mfma_f32_16x16x32_bf16(ah, bh0, acc0, 0, 0, 0); acc0 = __builtin_amdgcn_mfma_f32_16x16x32_bf16(ah, bl0, acc0, 0, 0, 0); acc0 = __builtin_amdgcn_mfma_f32_16x16x32_bf16(al, bh0, acc0, 0, 0, 0);
            acc1 = __builtin_amdgcn_mfma_f32_16x16x32_bf16(ah, bh1, acc1, 0, 0, 0); acc1 = __builtin_amdgcn_mfma_f32_16x16x32_bf16(ah, bl1, acc1, 0, 0, 0); acc1 = __builtin_amdgcn_mfma_f32_16x16x32_bf16(al, bh1, acc1, 0, 0, 0); }
#pragma unroll
          for (int r = 0; r < 4; ++r) { const int tk = 4 * (F.lane >> 4) + r; Pl[(F.wave * 16 + tk) * 32 + (F.lane & 15)] = acc0[r]; Pl[(F.wave * 16 + tk) * 32 + 16 + (F.lane & 15)] = acc1[r]; }
        }
        __syncthreads();
        { const int tl = F.tid >> 5, e = F.tid & 31, tok = tb * 16 + tl;
          float v = F.b_r[e];
#pragma unroll
          for (int w = 0; w < 8; ++w) v += Pl[(w * 16 + tl) * 32 + e];
          float tv[4]; int ti[4];
#pragma unroll
          for (int r = 0; r < 4; ++r) { float bv = v; int bi = e;
#pragma unroll
              for (int o = 16; o > 0; o >>= 1) { const float ov = __shfl_xor(bv, o); const int oi = __shfl_xor(bi, o); if (ov > bv || (ov == bv && oi < bi)) { bv = ov; bi = oi; } }
              tv[r] = bv; ti[r] = bi; if (e == bi) v = -3.0e38f; }
          float den = 0.f, w[4];
#pragma unroll
          for (int r = 0; r < 4; ++r) { w[r] = __expf(tv[r] - tv[0]); den += w[r]; }
#pragma unroll
          for (int r = 0; r < 4; ++r) if (e == ti[r] && !dry) { const int rank = (int)atomicAdd(F.ctl + CW_CNT + e, 1u);
              list[e * T + rank] = tok; sw[e * T + rank] = w[r] / den; toke[tok * 4 + r] = e; tokr[tok * 4 + r] = rank; }
        }
    }
}

__device__ __forceinline__ void p8_final(Frame& F) {
    const float* mod = WSP(float, WS_MOD); const bf16* x1 = WSP(bf16, WS_X1); const bf16* y = WSP(bf16, WS_Y);
    const int* toke = (const int*)(F.ws + WS_ROUTE + RT_TOKE); const int* tokr = (const int*)(F.ws + WS_ROUTE + RT_TOKR);
    moe_tables(F);
    const LAS int* off = (const LAS int*)(F.lds + TAB_OFF) + 40;
    for (int row = F.vcu * NWAVES + F.wave; row < T; row += F.G * NWAVES) {
        const int b = row / SEQ;
        size_t so[4];
#pragma unroll
        for (int r = 0; r < 4; ++r) so[r] = (size_t)(off[toke[row * 4 + r]] + tokr[row * 4 + r]) * DM;
        const GAS u32x2* xr = (const GAS u32x2*)(x1 + (size_t)row * DM) + F.lane;
        f32x4 v[8]; float s = 0.f;
#pragma unroll
        for (int j = 0; j < 8; ++j) { const int k = 4 * F.lane + 256 * j; f32x4 m = {0.f, 0.f, 0.f, 0.f};
#pragma unroll
            for (int r = 0; r < 4; ++r) { const u32x2 yy = *(const GAS u32x2*)(y + so[r] + k); m[0] += bf2f(yy.x & 0xffffu); m[1] += bf2f(yy.x >> 16); m[2] += bf2f(yy.y & 0xffffu); m[3] += bf2f(yy.y >> 16); }
            const f32x4 g = *(const GAS f32x4*)(mod + (size_t)b * 6 * DM + 5 * DM + k);
            const u32x2 xx = xr[64 * j]; v[j] = (f32x4){bf2f(xx.x & 0xffffu), bf2f(xx.x >> 16), bf2f(xx.y & 0xffffu), bf2f(xx.y >> 16)} + g * m; s += (v[j].x * v[j].x + v[j].y * v[j].y) + (v[j].z * v[j].z + v[j].w * v[j].w); }
        const float rstd = rsqrtf(wave_sum(s) * (1.f / DM) + EPS);
        GAS f32x4* orow = (GAS f32x4*)(F.out + (size_t)row * DM) + F.lane;
#pragma unroll
        for (int j = 0; j < 8; ++j) { const f32x4 g = *(const GAS f32x4*)(F.fg + 4 * F.lane + 256 * j); orow[64 * j] = v[j] * rstd * g; }
    }
}

struct Args { const float* in[25]; float* out; unsigned char* ws; int ph_lo, ph_hi, li, pad; };
__global__ void __launch_bounds__(NTHR, 2) mega_fwd(Args args) {
    extern __shared__ __attribute__((aligned(16))) unsigned char lds[];
    Frame F;
    F.lds = (LAS unsigned char*)lds; F.MISC = (volatile LAS unsigned*)(F.lds + MISC_OFF);
    F.tid = threadIdx.x; F.lane = F.tid & 63; F.wave = __builtin_amdgcn_readfirstlane(F.tid >> 6);
    F.G = gridDim.x; { const int bx = blockIdx.x; F.vcu = (F.G % 8 == 0) ? (bx % 8) * (F.G / 8) + bx / 8 : bx; }
    F.ws = args.ws; F.ctl = (unsigned*)(args.ws + WS_CTL); F.out = args.out;
    F.x = args.in[0]; F.c = args.in[1]; F.w_ada = args.in[2]; F.b_ada = args.in[3]; F.g1 = args.in[4]; F.w_in = args.in[5]; F.lq1 = args.in[6]; F.lk1 = args.in[7]; F.lq2 = args.in[8]; F.lk2 = args.in[9];
    F.subln = args.in[10]; F.relb = args.in[11]; F.cw = args.in[12]; F.cb = args.in[13]; F.clg = args.in[14]; F.clb = args.in[15]; F.w_out = args.in[16]; F.g2 = args.in[17]; F.w_r = args.in[18]; F.b_r = args.in[19];
    F.w_gu = args.in[20]; F.b_gu = args.in[21]; F.w_d = args.in[22]; F.b_d = args.in[23]; F.fg = args.in[24];
    for (int u = F.tid; u < 64; u += NTHR) ((LAS unsigned*)(F.lds + MISC_OFF))[u] = 0u;
    __syncthreads();
    XcdBarrier bar = xcd_barrier_post(F.ctl + CW_BAR + args.li * XCD_BAR_WORDS, F.MISC + 8);
    const int lo = args.ph_lo, hi = args.ph_hi;
#ifndef PH_MASK
#define PH_MASK 0x1ff
#endif
#define IN(k) (((PH_MASK >> (k)) & 1) && lo <= (k) && (k) < hi)
#define SEAM(k) do { if (IN(k) && IN((k) + 1)) { xcd_barrier(bar); if constexpr (((REP_MASK >> 14) & 1) != 0) xcd_barrier(bar); } } while (0)
#define REP2(k, ...) do { { __VA_ARGS__ } if constexpr (((REP_MASK >> (k)) & 1) != 0) { __VA_ARGS__ } } while (0)
    if (IN(0)) { REP2(0, __syncthreads(); p0_prologue(F);); } SEAM(0);
    if (IN(0) && IN(1)) F.vcu = xcd_virtual_cu(bar);
    if (IN(1)) { REP2(1, __syncthreads(); p1_norm1(F);); } SEAM(1);
    if (IN(2)) { REP2(2, { InProjT<false> P{WSP(bf16, WS_H), WSP(bf16, WS_WIN), WSP(bf16, WS_PROJ), {}}; P.ord.init(T, INC, F.G, F.vcu, false, true); __syncthreads(); pg8::gemm_run(F.lds, P); }
        { InProjT<true> P{WSP(bf16, WS_H), WSP(bf16, WS_WIN), WSP(bf16, WS_PROJ), {}}; P.ord.init(T, INC, F.G, F.vcu, true, true); __syncthreads(); pg8::gemm_run<InProjT<true>, true>(F.lds, P); }); } SEAM(2);
    if (IN(3)) { REP2(3,
        for (int ct = F.vcu; ct < T / 32; ct += F.G) conv_unit(F, ct);
        if constexpr (((REP_MASK >> 9) & 1) != 0) { for (int ct = F.vcu; ct < T / 32; ct += F.G) conv_unit(F, ct); }
        for (int u = F.vcu; u < NB * AH * 16 * (1 + ((REP_MASK >> 10) & 1)); u += F.G) att::attn_unit(F, u % (NB * AH * 16));
    ); } SEAM(3);
    if (IN(4)) { REP2(4, OutProj P{WSP(bf16, WS_MIX), WSP(bf16, WS_WOUT), F.x, WSP(float, WS_MOD), WSP(bf16, WS_X1), {}}; P.ord.init(T, DM, F.G, F.vcu); __syncthreads(); pg8::gemm_run(F.lds, P);); } SEAM(4);
    if (IN(5)) { p5_router(F); if constexpr (((REP_MASK >> 13) & 1) != 0) { __syncthreads(); p5_router(F, true); } } SEAM(5);
    if (IN(6)) { REP2(6, moe_tables(F); const LAS int* tab = (const LAS int*)(F.lds + TAB_OFF);
        MoeGU P{WSP(bf16, WS_H2), F.w_gu, F.b_gu, (const int*)(F.ws + WS_ROUTE + RT_LIST), WSP(bf16, WS_ACT), {tab, tab + 40, tab + 80}, F.G, F.vcu}; pg8::gemm_run_bf32(F.lds, P);); } SEAM(6);
    if (IN(7)) { REP2(7, moe_tables(F); const LAS int* tab = (const LAS int*)(F.lds + TAB_OFF);
        { MoeDownT<1> P{WSP(bf16, WS_ACT), F.w_d, F.b_d, (const float*)(F.ws + WS_ROUTE + RT_SW), WSP(bf16, WS_Y), {tab, tab + 40, tab + 80}, F.G, F.vcu}; pg8::gemm_run_bf32(F.lds, P); }
        { MoeDownT<2> P{WSP(bf16, WS_ACT), F.w_d, F.b_d, (const float*)(F.ws + WS_ROUTE + RT_SW), WSP(bf16, WS_Y), {tab, tab + 40, tab + 80}, F.G, F.vcu}; pg8::gemm_run_bf32<MoeDownT<2>, true>(F.lds, P); }); } SEAM(7);
    if (IN(8)) { REP2(8, p8_final(F);); }
#undef IN
#undef SEAM
}

extern "C" void kernel_launch(void* const* d_in, const int* in_sizes, int n_in, void* d_out, int out_size, void* d_ws, size_t ws_size, hipStream_t stream) {
    static int grid = 0;
    if (grid == 0) {
        if (n_in != 25 || ws_size < WS_END || out_size != T * DM) { fprintf(stderr, "kernel_launch: n_in %d out %d ws %zu (need %zu); nothing launched\n", n_in, out_size, ws_size, (size_t)WS_END); grid = -1; return; }
        int dev = 0, cus = 0, per_cu = 0;
        if (hipGetDevice(&dev) != hipSuccess || hipDeviceGetAttribute(&cus, hipDeviceAttributeMultiprocessorCount, dev) != hipSuccess) { grid = -1; return; }
        if (hipFuncSetAttribute((const void*)mega_fwd, hipFuncAttributeMaxDynamicSharedMemorySize, LDS_BYTES) != hipSuccess) { fprintf(stderr, "kernel_launch: hipFuncSetAttribute failed\n"); grid = -1; return; }
        if (hipOccupancyMaxActiveBlocksPerMultiprocessor(&per_cu, (const void*)mega_fwd, NTHR, LDS_BYTES) != hipSuccess || per_cu < 1) { fprintf(stderr, "kernel_launch: occupancy query says %d blocks per CU\n", per_cu); }
        (void)hipGetLastError();
        grid = cus;
    }
    if (grid < 0) return;
    unsigned char* ws = (unsigned char*)d_ws;
    (void)hipMemsetAsync(ws + WS_CTL, 0, CTL_ZERO_BYTES, stream);
    Args a{};
    for (int i = 0; i < 25; ++i) a.in[i] = (const float*)d_in[i];
    a.out = (float*)d_out; a.ws = ws; a.ph_lo = 0; a.ph_hi = 9; a.li = 0; a.pad = 0;
    hipLaunchKernelGGL(mega_fwd, dim3(grid), dim3(NTHR), LDS_BYTES, stream, a);
}
```

```cpp
#include <hip/hip_runtime.h>
#include <cstdio>
#include <cstdint>

#ifndef REP_MASK
#define REP_MASK 0
#endif

constexpr int DM = 2048, NB = 4, SEQ = 2048, T = NB * SEQ;
constexpr int AH = 8, HD = 64, VD = 128, CCH = 1024, CK = 31;
constexpr int INC = 5120;
constexpr int NE = 32, TOPK = 4, DFF = 2048, NSLOT = T * TOPK;
constexpr float EPS = 1e-6f;
constexpr float LOG2E = 1.4426950408889634f;

typedef unsigned short bf16;
typedef short bf16x8 __attribute__((ext_vector_type(8)));
typedef short s16x4 __attribute__((ext_vector_type(4)));
typedef float f32x4 __attribute__((ext_vector_type(4)));
typedef float f32x16 __attribute__((ext_vector_type(16)));
typedef unsigned u32x4 __attribute__((ext_vector_type(4)));
typedef unsigned u32x2 __attribute__((ext_vector_type(2)));
#define GAS __attribute__((address_space(1)))
#define LAS __attribute__((address_space(3)))
typedef GAS unsigned gu32;

constexpr size_t MiB = 1u << 20;
constexpr size_t WS_CTL = 0, CTL_ZERO_BYTES = 64 * 1024;
constexpr size_t WS_MODP = 1 * MiB;
constexpr size_t WS_MOD = 3 * MiB;
constexpr size_t WS_BIAST = 4 * MiB;
constexpr size_t WS_WRF = 5 * MiB;
constexpr size_t WS_ROUTE = 6 * MiB;
constexpr size_t RT_LIST = 0;
constexpr size_t RT_SW = 1 * MiB;
constexpr size_t RT_TOKE = 2 * MiB;
constexpr size_t RT_TOKR = RT_TOKE + 128 * 1024;
constexpr size_t WS_WIN = 16 * MiB;
constexpr size_t WS_WOUT = WS_WIN + 20 * MiB;
constexpr size_t WS_H = WS_WOUT + 8 * MiB;
constexpr size_t WS_PROJ = WS_H + 32 * MiB;
constexpr size_t WS_MIX = WS_PROJ + 80 * MiB;
constexpr size_t WS_X1 = WS_MIX + 32 * MiB;
constexpr size_t WS_H2 = WS_X1 + 64 * MiB;
constexpr size_t WS_ACT = WS_H2 + 32 * MiB;
constexpr size_t WS_Y = WS_ACT + 130 * MiB;
constexpr size_t WS_END = WS_Y + 130 * MiB;
constexpr int CW_CNT = 5120, CNT_STRIDE = 64;
constexpr int CW_BAR = 1024;

__device__ __forceinline__ unsigned f2bf(float f) { unsigned u = __builtin_bit_cast(unsigned, f); return (u + 0x7fffu + ((u >> 16) & 1u)) >> 16; }
__device__ __forceinline__ float bf2f(unsigned h) { return __builtin_bit_cast(float, h << 16); }
__device__ __forceinline__ unsigned pk2(float lo, float hi) { return f2bf(lo) | (f2bf(hi) << 16); }
__device__ __forceinline__ unsigned cvt_pk_bf16(float lo, float hi) { unsigned r; asm volatile("v_cvt_pk_bf16_f32 %0, %1, %2" : "=v"(r) : "v"(lo), "v"(hi)); return r; }
__device__ __forceinline__ float silu_f(float v) { return v / (1.f + __expf(-v)); }
__device__ __forceinline__ float wave_sum(float v) {
#pragma unroll
    for (int o = 1; o < 64; o <<= 1) v += __shfl_xor(v, o);
    return v;
}
__host__ __device__ inline int t5_bucket(int rel) {
    int ret = rel > 0 ? 16 : 0; int n = rel < 0 ? -rel : rel;
    if (n < 8) return ret + n;
    int lg = n >= 91 ? 15 : n >= 64 ? 14 : n >= 46 ? 13 : n >= 32 ? 12 : n >= 23 ? 11 : n >= 16 ? 10 : n >= 12 ? 9 : 8;
    return ret + lg;
}
#define LDS_WAIT() asm volatile("s_waitcnt lgkmcnt(0)" ::: "memory")
#define VM_WAIT() asm volatile("s_waitcnt vmcnt(0)" ::: "memory")

#define XB_TMO      128
#define XB_XCNT(j)  (256  + 64 * (j))
#define XB_XSUB(j)  (1280 + 64 * (j))
#define XB_XGEN(j)  (2304 + 64 * (j))
#define XB_TOP      3328
#define XB_TOPGEN   3392
#define XCD_BAR_WORDS 3456
#define XB_SPIN_CAP (1u << 18)
__device__ __forceinline__ unsigned xb_ld(unsigned* p)              { return __hip_atomic_load(p, __ATOMIC_RELAXED, __HIP_MEMORY_SCOPE_AGENT); }
__device__ __forceinline__ unsigned xb_add(unsigned* p, unsigned v) { return __hip_atomic_fetch_add(p, v, __ATOMIC_RELAXED, __HIP_MEMORY_SCOPE_AGENT); }
__device__ __forceinline__ unsigned xb_xcc_id() { return (unsigned)__builtin_amdgcn_s_getreg((3 << 11) | 20) & 0xFu; }
#define XB_SPIN(cond, bar) do { unsigned _sp = 0; while (cond) { __builtin_amdgcn_s_sleep(1); \
    if ((++_sp & 255u) == 0u) { if (xb_ld(&(bar)[XB_TMO])) break; if (_sp > XB_SPIN_CAP) { atomicAdd(&(bar)[XB_TMO], 1u); break; } } } } while (0)
struct XcdBarrier { unsigned* bar; unsigned x; volatile LAS unsigned* st; };
__device__ __forceinline__ XcdBarrier xcd_barrier_post(unsigned* bar, volatile LAS unsigned* st) {
    XcdBarrier b; b.bar = bar; b.x = xb_xcc_id(); b.st = st;
    if (threadIdx.x == 0) st[2] = xb_add(&bar[XB_XCNT(b.x)], 1u);
    return b;
}
__device__ __forceinline__ int xcd_virtual_cu(const XcdBarrier& b) {
    if (threadIdx.x == 0) { unsigned pre = 0u; for (unsigned j = 0; j < 16; ++j) { const unsigned c = xb_ld(&b.bar[XB_XCNT(j)]); pre += (j < b.x) ? c : 0u; } b.st[3] = pre + b.st[2]; }
    __syncthreads();
    const int v = (int)b.st[3];
    __syncthreads();
    return __builtin_amdgcn_readfirstlane(v);
}
__device__ __forceinline__ void xcd_barrier_complete(unsigned* bar, unsigned x, unsigned& nloc, unsigned& nx) {
    const unsigned G = gridDim.x * gridDim.y * gridDim.z;
    unsigned sum, cnt, mine, sp = 0u;
    for (;;) {
        sum = 0u; cnt = 0u; mine = 0u;
#pragma unroll
        for (unsigned j = 0; j < 16; ++j) { const unsigned c = xb_ld(&bar[XB_XCNT(j)]); sum += c; cnt += (c > 0u) ? 1u : 0u; mine = (j == x) ? c : mine; }
        if (sum == G) break;
        __builtin_amdgcn_s_sleep(1);
        if ((++sp & 255u) == 0u) { if (xb_ld(&bar[XB_TMO])) break; if (sp > XB_SPIN_CAP) { atomicAdd(&bar[XB_TMO], 1u); break; } }
    }
    nloc = mine > 0u ? mine : 1u; nx = cnt > 0u ? cnt : 1u;
}
__device__ __forceinline__ void xcd_barrier(const XcdBarrier& b) {
    asm volatile("s_waitcnt vmcnt(0)" ::: "memory");
    __syncthreads();
    if (threadIdx.x == 0) {
        unsigned* bar = b.bar;
        __builtin_amdgcn_s_waitcnt(0);
        unsigned nloc = b.st[0], nx = b.st[1];
        if (nloc == 0u) { xcd_barrier_complete(bar, b.x, nloc, nx); b.st[0] = nloc; b.st[1] = nx; }
        const unsigned old = xb_add(&bar[XB_XSUB(b.x)], 1u);
        const unsigned gen = old / nloc;
        if (old + 1u == (gen + 1u) * nloc) {
            __builtin_amdgcn_fence(__ATOMIC_RELEASE, "agent");
            asm volatile("s_waitcnt vmcnt(0)" ::: "memory");
            const unsigned og = xb_add(&bar[XB_TOP], 1u);
            const unsigned tg = og / nx;
            if (og + 1u == (tg + 1u) * nx) xb_add(&bar[XB_TOPGEN], 1u);
            else XB_SPIN(xb_ld(&bar[XB_TOPGEN]) == tg, bar);
            __builtin_amdgcn_fence(__ATOMIC_ACQUIRE, "agent");
            xb_add(&bar[XB_XGEN(b.x)], 1u);
            asm volatile("s_waitcnt vmcnt(0)" ::: "memory");
        } else {
            XB_SPIN(xb_ld(&bar[XB_XGEN(b.x)]) == gen, bar);
            __builtin_amdgcn_fence(__ATOMIC_ACQUIRE, "agent");
            asm volatile("s_waitcnt vmcnt(0)" ::: "memory");
        }
    }
    __syncthreads();
}

namespace pg8 {
constexpr int BM = 256, BK = 64, HALF = 128, HTB = HALF * BK * 2, STAGE_BYTES = 8 * HTB, KD = 2048;
__host__ __device__ __forceinline__ int lds_byte(int r, int c) { const int st = (r >> 4) * 2 + (c >> 5), rr = r & 15, cc = c & 31, ob = rr * 64 + cc * 2; return st * 1024 + (ob ^ (((ob >> 9) & 1) << 5)); }
__host__ __device__ __forceinline__ void stage_rc(int b, int& R, int& C) { const int st = b / 1024, sb = b % 1024, swz = sb ^ (((sb >> 9) & 1) << 5); R = (st >> 1) * 16 + swz / 64; C = (st & 1) * 32 + (swz % 64) / 2; }
__host__ __device__ __forceinline__ int perm32(int rho) { const int n = rho >> 4, i = rho & 15; return 8 * (i >> 2) + 4 * n + (i & 3); }
struct Unit { int pm, pn, e, rows, hs; };

struct DenseOrder {
    int nM, nN, nwg, nfull, G, c, rep = 1; bool half;
    __device__ void init(int M, int N, int G_, int c_, bool half_ = false, bool split_tail = false) { nM = M / BM; nN = N / BM; nwg = nM * nN; G = G_; c = c_; half = half_; nfull = split_tail ? (nwg / G_) * G_ : nwg; }
    __device__ bool next(int i, Unit& u) const {
        long L = (long)i * G + c; int hsel = 0;
        if (half) { if (L >= 2L * (nwg - nfull)) return false; hsel = (int)(L & 1); L = nfull + (L >> 1); }
        else { if (L >= (long)nfull * rep) return false; if (rep > 1 && L >= nfull) L -= nfull; }
        const int wgid = (int)L;
        const int nig = 8 * nN, gid = wgid / nig, fm = gid * 8, gsz = (nM - fm) < 8 ? (nM - fm) : 8;
        u.pm = fm + ((wgid % nig) % gsz); u.pn = (wgid % nig) / gsz; u.e = 0; u.hs = 0; u.rows = 256; if (half) { u.pm = 2 * u.pm + hsel; u.rows = 128; } return true;
    }
};

template <class P, bool HM = false>
__device__ __forceinline__ void gemm_run(LAS unsigned char* lds, const P& prob) {
    const int tid = threadIdx.x, wid = __builtin_amdgcn_readfirstlane(tid >> 6), lane = tid & 63, wr = wid >> 2, wc = wid & 3, fr = lane & 15, fq = lane >> 4;
    constexpr int K = KD, nt = K / BK;
    int Rr[2], Cc[2]; unsigned voffB[2];
#pragma unroll
    for (int i = 0; i < 2; ++i) { int R, C; stage_rc(tid * 16 + i * 8192, R, C); Rr[i] = R; Cc[i] = C; const int Rb = P::PERM ? ((R & ~31) + perm32(R & 31)) : R; voffB[i] = (unsigned)(Rb * K + C) * 2u; }
    constexpr size_t kstep = (size_t)(BK * 2), hstep = (size_t)HALF * K * 2;
    const unsigned ldsw = (unsigned)wid * 1024u;
    const int aoff = lds_byte(wr * 64 + fr, fq * 8), boff = lds_byte(wc * 32 + fr, fq * 8);
#define PG8_SA(b, h) (((b) * 2 + (h)) * HTB)
#define PG8_SB(b, h) ((4 + (b) * 2 + (h)) * HTB)
#define PG8_STAGE(bufoff, gbase, voff) do { _Pragma("unroll") for (int _i = 0; _i < 2; ++_i) \
        __builtin_amdgcn_global_load_lds((const unsigned*)((const char*)(gbase) + (voff)[_i]), (LAS unsigned*)(lds + (bufoff) + ldsw + _i * 8192), 16, 0, 0); } while (0)
#define PG8_LDA(dst, b, h) do { _Pragma("unroll") for (int m = 0; m < 4; ++m) _Pragma("unroll") for (int k = 0; k < 2; ++k) dst[m][k] = *(const LAS bf16x8*)(lds + PG8_SA(b, h) + aoff + m * 2048 + k * 1024); } while (0)
#define PG8_LDB(dst, b, h) do { _Pragma("unroll") for (int n = 0; n < 2; ++n) _Pragma("unroll") for (int k = 0; k < 2; ++k) dst[n][k] = *(const LAS bf16x8*)(lds + PG8_SB(b, h) + boff + n * 2048 + k * 1024); } while (0)
#define PG8_MMA(ai, bj, At, Bt) do { __builtin_amdgcn_s_setprio(1); _Pragma("unroll") for (int m = 0; m < 4; ++m) _Pragma("unroll") for (int n = 0; n < 2; ++n) _Pragma("unroll") for (int k = 0; k < 2; ++k) \
        acc[ai][bj][m][n] = __builtin_amdgcn_mfma_f32_16x16x32_bf16(Bt[n][k], At[m][k], acc[ai][bj][m][n], 0, 0, 0); __builtin_amdgcn_s_setprio(0); } while (0)
#define PG8_WAIT_V(n) asm volatile("s_waitcnt vmcnt(" #n ")" ::: "memory")
#define PG8_WAIT_L(n) asm volatile("s_waitcnt lgkmcnt(" #n ")" ::: "memory")
#define PG8_BAR __builtin_amdgcn_s_barrier()
#define PG8_SCHED __builtin_amdgcn_sched_barrier(0)
    Unit cur, nxt; int ui = 0;
    if (!prob.next(0, cur)) return;
    f32x4 acc[2][2][4][2];
#pragma unroll
    for (int a = 0; a < 2; ++a)
#pragma unroll
        for (int b = 0; b < 2; ++b)
#pragma unroll
            for (int m = 0; m < 4; ++m)
#pragma unroll
                for (int n = 0; n < 2; ++n) acc[a][b][m][n] = (f32x4){0.f, 0.f, 0.f, 0.f};
    bf16x8 At[4][2], B0[2][2], B1[2][2];
    unsigned vC0[2], vC1[2], vN0[2], vN1[2];
    prob.a_off(cur, Rr, Cc, vC0, vC1);
    const char* const Ab = prob.a_base();
    const char* cB = prob.b_base(cur);
    PG8_STAGE(PG8_SB(0, 0), cB, voffB); PG8_STAGE(PG8_SB(0, 1), cB + hstep, voffB); PG8_STAGE(PG8_SA(0, 0), Ab, vC0); if constexpr (!HM) PG8_STAGE(PG8_SA(0, 1), Ab, vC1);
    if (wr == 1) PG8_BAR;
    if constexpr (HM) PG8_WAIT_V(0); else PG8_WAIT_V(2);
    PG8_BAR;
    PG8_STAGE(PG8_SB(1, 0), cB + kstep, voffB); PG8_STAGE(PG8_SA(1, 0), Ab + kstep, vC0); PG8_STAGE(PG8_SB(1, 1), cB + hstep + kstep, voffB);
    PG8_WAIT_V(6); PG8_BAR;
    for (;;) {
        const bool has_next = prob.next(ui + 1, nxt);
        if (has_next) prob.a_off(nxt, Rr, Cc, vN0, vN1); else { vN0[0] = vC0[0]; vN0[1] = vC0[1]; vN1[0] = vC1[0]; vN1[1] = vC1[1]; }
        const char* nB = has_next ? prob.b_base(nxt) : cB;
        for (int t = 0; t < nt; t += 2) {
            const bool last = (t == nt - 2);
            const char* a1 = Ab + (size_t)(t + 1) * kstep;
            const char* a2 = last ? Ab : Ab + (size_t)(t + 2) * kstep; const char* b2 = last ? nB : cB + (size_t)(t + 2) * kstep;
            const char* a3 = a2 + kstep; const char* b3 = b2 + kstep;
            unsigned v20[2], v21[2];
            v20[0] = last ? vN0[0] : vC0[0]; v20[1] = last ? vN0[1] : vC0[1]; v21[0] = last ? vN1[0] : vC1[0]; v21[1] = last ? vN1[1] : vC1[1];
            PG8_LDB(B0, 0, 0); PG8_LDB(B1, 0, 1); PG8_SCHED; PG8_LDA(At, 0, 0); if constexpr (!HM) PG8_STAGE(PG8_SA(1, 1), a1, vC1);
            if constexpr (HM) PG8_WAIT_V(6); else PG8_WAIT_V(8); PG8_WAIT_L(0); PG8_BAR; PG8_MMA(0, 0, At, B0); PG8_MMA(0, 1, At, B1); PG8_BAR; PG8_SCHED;
            if constexpr (!HM) PG8_LDA(At, 0, 1); PG8_STAGE(PG8_SB(0, 0), b2, voffB); PG8_STAGE(PG8_SB(0, 1), b2 + hstep, voffB); PG8_STAGE(PG8_SA(0, 0), a2, v20);
            if constexpr (HM) PG8_WAIT_V(6); else PG8_WAIT_V(8);
            PG8_WAIT_L(0); PG8_BAR; if constexpr (!HM) { PG8_MMA(1, 0, At, B0); PG8_MMA(1, 1, At, B1); } PG8_BAR; PG8_SCHED;
            PG8_LDB(B0, 1, 0); PG8_LDB(B1, 1, 1); PG8_SCHED; PG8_LDA(At, 1, 0); if constexpr (!HM) PG8_STAGE(PG8_SA(0, 1), a2, v21);
            if constexpr (HM) PG8_WAIT_V(6); else PG8_WAIT_V(8); PG8_WAIT_L(0); PG8_BAR; PG8_MMA(0, 0, At, B0); PG8_MMA(0, 1, At, B1); PG8_BAR; PG8_SCHED;
            if constexpr (!HM) PG8_LDA(At, 1, 1); PG8_STAGE(PG8_SB(1, 0), b3, voffB); PG8_STAGE(PG8_SB(1, 1), b3 + hstep, voffB); PG8_STAGE(PG8_SA(1, 0), a3, v20);
            if constexpr (HM) PG8_WAIT_V(6); else PG8_WAIT_V(8);
            PG8_WAIT_L(0); PG8_BAR; if constexpr (!HM) { PG8_MMA(1, 0, At, B0); PG8_MMA(1, 1, At, B1); } PG8_BAR; PG8_SCHED;
        }
        if (wr == 0) PG8_BAR;
        prob.epi(acc, cur, wr, wc, fr, fq);
        if (!has_next) break;
#pragma unroll
        for (int a = 0; a < 2; ++a)
#pragma unroll
            for (int b = 0; b < 2; ++b)
#pragma unroll
                for (int m = 0; m < 4; ++m)
#pragma unroll
                    for (int n = 0; n < 2; ++n) acc[a][b][m][n] = (f32x4){0.f, 0.f, 0.f, 0.f};
        cur = nxt; cB = nB; ++ui; vC0[0] = vN0[0]; vC0[1] = vN0[1]; vC1[0] = vN1[0]; vC1[1] = vN1[1];
        if (wr == 1) PG8_BAR;
    }
    PG8_WAIT_V(0);
    PG8_BAR;
#undef PG8_SA
#undef PG8_SB
#undef PG8_STAGE
#undef PG8_LDA
#undef PG8_LDB
#undef PG8_MMA
#undef PG8_WAIT_V
#undef PG8_WAIT_L
#undef PG8_BAR
#undef PG8_SCHED
}

template <class P, bool HN = false>
__device__ __forceinline__ void gemm_run_bf32(LAS unsigned char* lds, const P& prob) {
    const int tid = threadIdx.x, wid = __builtin_amdgcn_readfirstlane(tid >> 6), lane = tid & 63, wr = wid >> 2, wc = wid & 3, fr = lane & 15, fq = lane >> 4;
    constexpr int K = KD, nt = K / BK;
    constexpr size_t kstep = (size_t)(BK * 2);
    constexpr size_t ldwB = (size_t)P::LDW_BYTES;
    const unsigned ldsw = (unsigned)wid * 1024u;
    const int aoff = lds_byte(wr * 64 + fr, fq * 8), boff = lds_byte(wc * 32 + fr, fq * 8);
    const int wbo0 = lds_byte(32 * (lane >> 4) + (((lane >> 1) & 1) | (((lane >> 3) & 1) << 2) | (((lane >> 2) & 1) << 3)), 8 * wid + 4 * (lane & 1));
#define PG8_SA(b, h) (((b) * 2 + (h)) * HTB)
#define PG8_SB(b, h) ((4 + (b) * 2 + (h)) * HTB)
#define PG8_STAGE(bufoff, gbase, voff) do { _Pragma("unroll") for (int _i = 0; _i < 2; ++_i) \
        __builtin_amdgcn_global_load_lds((const unsigned*)((const char*)(gbase) + (voff)[_i]), (LAS unsigned*)(lds + (bufoff) + ldsw + _i * 8192), 16, 0, 0); } while (0)
#define PG8_LDA(dst, b, h) do { _Pragma("unroll") for (int m = 0; m < 4; ++m) _Pragma("unroll") for (int k = 0; k < 2; ++k) dst[m][k] = *(const LAS bf16x8*)(lds + PG8_SA(b, h) + aoff + m * 2048 + k * 1024); } while (0)
#define PG8_LDB(dst, b, h) do { _Pragma("unroll") for (int n = 0; n < 2; ++n) _Pragma("unroll") for (int k = 0; k < 2; ++k) dst[n][k] = *(const LAS bf16x8*)(lds + PG8_SB(b, h) + boff + n * 2048 + k * 1024); } while (0)
#define PG8_MMA(ai, bj, At, Bt) do { __builtin_amdgcn_s_setprio(1); _Pragma("unroll") for (int m = 0; m < 4; ++m) _Pragma("unroll") for (int n = 0; n < 2; ++n) _Pragma("unroll") for (int k = 0; k < 2; ++k) \
        acc[ai][bj][m][n] = __builtin_amdgcn_mfma_f32_16x16x32_bf16(Bt[n][k], At[m][k], acc[ai][bj][m][n], 0, 0, 0); __builtin_amdgcn_s_setprio(0); } while (0)
#define PG8_WAIT_V(n) asm volatile("s_waitcnt vmcnt(" #n ")" ::: "memory")
#define PG8_WAIT_L(n) asm volatile("s_waitcnt lgkmcnt(" #n ")" ::: "memory")
#define PG8_BAR __builtin_amdgcn_s_barrier()
#define PG8_SCHED __builtin_amdgcn_sched_barrier(0)
#define PG8_BLOAD(kk, h) do { const bool nx_ = (kk) >= nt; const unsigned so_ = (nx_ ? nBo : cBo) + (unsigned)((nx_ ? (kk) - nt : (kk)) * BK + 8 * wid) * (unsigned)ldwB + (unsigned)(h) * (unsigned)P::HALF_BYTES; \
        const unsigned co_ = nx_ ? nCol : cCol; \
        asm volatile("s_nop 4" ::: "memory"); \
        _Pragma("unroll") for (int j_ = 0; j_ < 4; ++j_) asm volatile("buffer_load_dwordx4 %0, %1, %2, %3 offen" : "=v"(bv[j_]) : "v"(co_), "s"(wrs), "s"(so_ + (unsigned)j_ * (unsigned)ldwB) : "memory"); } while (0)
#define PG8_BWAIT(n) asm volatile("s_waitcnt vmcnt(" #n ")" : "+v"(bv[0]), "+v"(bv[1]), "+v"(bv[2]), "+v"(bv[3]) :: "memory")
#define PG8_BWRITE(b, h) do { _Pragma("unroll") for (int i_ = 0; i_ < 4; ++i_) { u32x2 o_; o_.x = cvt_pk_bf16(bv[0][i_], bv[1][i_]); o_.y = cvt_pk_bf16(bv[2][i_], bv[3][i_]); \
        *(LAS u32x2*)(lds + PG8_SB(b, h) + wbo0 + 128 * (i_ & 1) + 2048 * (i_ >> 1)) = o_; } } while (0)
    typedef float f32x2v __attribute__((ext_vector_type(2)));
    Unit cur, nxt; int ui = 0;
    if (!prob.next(0, cur)) return;
    f32x4 acc[2][2][4][2];
    bf16x8 At[4][2], B0[2][2], B1[2][2];
    f32x4 bv[4];
    unsigned vC0[2], vC1[2], vN0[2], vN1[2];
    prob.a_off(cur, vC0, vC1);
    const char* const Ab = prob.a_base();
    const __amdgpu_buffer_rsrc_t wrs = __builtin_amdgcn_make_buffer_rsrc((void*)prob.W, 0, (unsigned)NE * (unsigned)P::W_BYTES, 0x00020000);
    unsigned cBo = (unsigned)cur.e * (unsigned)P::W_BYTES, cCol = prob.b_col(cur, lane & ~1) + (unsigned)(lane & 1) * 4u * (unsigned)ldwB;
    unsigned nBo = cBo, nCol = cCol;
#define PG8_BLOADX(R, kk, h) do { const unsigned so_ = cBo + (unsigned)((kk) * BK + 8 * wid) * (unsigned)ldwB + (unsigned)(h) * (unsigned)P::HALF_BYTES; \
        _Pragma("unroll") for (int j_ = 0; j_ < 4; ++j_) asm volatile("buffer_load_dwordx4 %0, %1, %2, %3 offen" : "=v"(R[j_]) : "v"(cCol), "s"(wrs), "s"(so_ + (unsigned)j_ * (unsigned)ldwB) : "memory"); } while (0)
#define PG8_BWAITX(R, n) asm volatile("s_waitcnt vmcnt(" #n ")" : "+v"(R[0]), "+v"(R[1]), "+v"(R[2]), "+v"(R[3]) :: "memory")
#define PG8_BWRITEX(R, b, h) do { _Pragma("unroll") for (int i_ = 0; i_ < 4; ++i_) { u32x2 o_; o_.x = cvt_pk_bf16(R[0][i_], R[1][i_]); o_.y = cvt_pk_bf16(R[2][i_], R[3][i_]); \
        *(LAS u32x2*)(lds + PG8_SB(b, h) + wbo0 + 128 * (i_ & 1) + 2048 * (i_ >> 1)) = o_; } } while (0)
    { f32x4 bw[4], bx[4];
      asm volatile("s_nop 4" ::: "memory");
      PG8_BLOADX(bv, 0, 0); if constexpr (!HN) PG8_BLOADX(bw, 0, 1); PG8_BLOADX(bx, 1, 0);
      PG8_STAGE(PG8_SA(0, 0), Ab, vC0); PG8_STAGE(PG8_SA(0, 1), Ab, vC1);
      if constexpr (!HN) { PG8_BWAITX(bv, 12); PG8_BWRITEX(bv, 0, 0); PG8_BWAITX(bw, 8); PG8_BWRITEX(bw, 0, 1); }
      else { PG8_BWAITX(bv, 8); PG8_BWRITEX(bv, 0, 0); }
      PG8_BWAITX(bx, 4); PG8_BWRITEX(bx, 1, 0); }
    if constexpr (!HN) PG8_BLOAD(1, 1);
    if (wr == 1) PG8_BAR;
    if constexpr (!HN) PG8_WAIT_V(4); else PG8_WAIT_V(0);
    PG8_WAIT_L(0); PG8_BAR;
    PG8_STAGE(PG8_SA(1, 0), Ab + kstep, vC0);
    { f32x4 bini[2][2]; prob.bias_load(cur, wc, fq, bini);
#pragma unroll
      for (int a = 0; a < 2; ++a)
#pragma unroll
        for (int b = 0; b < 2; ++b)
#pragma unroll
            for (int m = 0; m < 4; ++m)
#pragma unroll
                for (int n = 0; n < 2; ++n) acc[a][b][m][n] = bini[b][n]; }
    PG8_WAIT_V(0); PG8_BAR;
    for (;;) {
        const bool has_next = prob.next(ui + 1, nxt);
        if (has_next) { prob.a_off(nxt, vN0, vN1); nBo = (unsigned)nxt.e * (unsigned)P::W_BYTES; nCol = prob.b_col(nxt, lane & ~1) + (unsigned)(lane & 1) * 4u * (unsigned)ldwB; }
        else { vN0[0] = vC0[0]; vN0[1] = vC0[1]; vN1[0] = vC1[0]; vN1[1] = vC1[1]; nBo = cBo; nCol = cCol; }
        for (int t = 0; t < nt; t += 2) {
            const bool last = (t == nt - 2);
            const char* a1 = Ab + (size_t)(t + 1) * kstep;
            const char* a2 = last ? Ab : Ab + (size_t)(t + 2) * kstep;
            const char* a3 = a2 + kstep;
            unsigned v20[2], v21[2];
            v20[0] = last ? vN0[0] : vC0[0]; v20[1] = last ? vN0[1] : vC0[1]; v21[0] = last ? vN1[0] : vC1[0]; v21[1] = last ? vN1[1] : vC1[1];
            PG8_LDB(B0, 0, 0); if constexpr (!HN) PG8_LDB(B1, 0, 1); PG8_SCHED; PG8_LDA(At, 0, 0); if constexpr (!HN) { PG8_BWAIT(2); PG8_BWRITE(1, 1); } PG8_BLOAD(t + 2, 0); PG8_STAGE(PG8_SA(1, 1), a1, vC1);
            if constexpr (HN) PG8_WAIT_V(8); else PG8_WAIT_V(12);
            PG8_WAIT_L(0); PG8_BAR; PG8_MMA(0, 0, At, B0); if constexpr (!HN) PG8_MMA(0, 1, At, B1); PG8_BAR; PG8_SCHED;
            PG8_LDA(At, 0, 1); PG8_BWAIT(2); PG8_BWRITE(0, 0); if constexpr (!HN) PG8_BLOAD(t + 2, 1); PG8_STAGE(PG8_SA(0, 0), a2, v20);
            if constexpr (HN) PG8_WAIT_V(8); else PG8_WAIT_V(12);
            PG8_WAIT_L(0); PG8_BAR; PG8_MMA(1, 0, At, B0); if constexpr (!HN) PG8_MMA(1, 1, At, B1); PG8_BAR; PG8_SCHED;
            PG8_LDB(B0, 1, 0); if constexpr (!HN) PG8_LDB(B1, 1, 1); PG8_SCHED; PG8_LDA(At, 1, 0); if constexpr (!HN) { PG8_BWAIT(2); PG8_BWRITE(0, 1); } PG8_BLOAD(t + 3, 0); PG8_STAGE(PG8_SA(0, 1), a2, v21);
            if constexpr (HN) PG8_WAIT_V(8); else PG8_WAIT_V(12);
            PG8_WAIT_L(0); PG8_BAR; PG8_MMA(0, 0, At, B0); if constexpr (!HN) PG8_MMA(0, 1, At, B1); PG8_BAR; PG8_SCHED;
            PG8_LDA(At, 1, 1); PG8_BWAIT(2); PG8_BWRITE(1, 0); if constexpr (!HN) PG8_BLOAD(t + 3, 1); PG8_STAGE(PG8_SA(1, 0), a3, v20);
            if constexpr (HN) PG8_WAIT_V(8); else PG8_WAIT_V(12);
            PG8_WAIT_L(0); PG8_BAR; PG8_MMA(1, 0, At, B0); if constexpr (!HN) PG8_MMA(1, 1, At, B1); PG8_BAR; PG8_SCHED;
        }
        if (wr == 0) PG8_BAR;
        prob.epi(acc, cur, wr, wc, fr, fq, 0);
        if (has_next) { f32x4 bini[2][2]; prob.bias_load(nxt, wc, fq, bini);
#pragma unroll
            for (int b = 0; b < 2; ++b)
#pragma unroll
                for (int m = 0; m < 4; ++m)
#pragma unroll
                    for (int n = 0; n < 2; ++n) acc[0][b][m][n] = bini[b][n]; }
        prob.epi(acc, cur, wr, wc, fr, fq, 1);
        if (!has_next) break;
#pragma unroll
        for (int b = 0; b < 2; ++b)
#pragma unroll
            for (int m = 0; m < 4; ++m)
#pragma unroll
                for (int n = 0; n < 2; ++n) acc[1][b][m][n] = acc[0][b][m][n];
        cur = nxt; cBo = nBo; cCol = nCol; ++ui; vC0[0] = vN0[0]; vC0[1] = vN0[1]; vC1[0] = vN1[0]; vC1[1] = vN1[1];
        if (wr == 1) PG8_BAR;
    }
    PG8_BWAIT(0);
    PG8_BAR;
#undef PG8_SA
#undef PG8_SB
#undef PG8_STAGE
#undef PG8_LDA
#undef PG8_LDB
#undef PG8_MMA
#undef PG8_WAIT_V
#undef PG8_WAIT_L
#undef PG8_BAR
#undef PG8_SCHED
#undef PG8_BLOAD
#undef PG8_BWAIT
#undef PG8_BWRITE
#undef PG8_BLOADX
#undef PG8_BWAITX
#undef PG8_BWRITEX
}
}

constexpr int NWAVES = 8, NTHR = 512;
constexpr int RING_BYTES = 131072;
constexpr int TAB_OFF = 147968;
constexpr int MISC_OFF = 163840 - 256;
constexpr int LDS_BYTES = 163840;

struct Frame {
    LAS unsigned char* lds; volatile LAS unsigned* MISC; unsigned* ctl;
    int tid, lane, wave, vcu, G;
    const float *x, *c, *w_ada, *b_ada, *g1, *w_in, *lq1, *lk1, *lq2, *lk2, *subln, *relb, *cw, *cb, *clg, *clb, *w_out, *g2, *w_r, *b_r, *w_gu, *b_gu, *w_d, *b_d, *fg;
    float* out; unsigned char* ws;
};
#define WSP(T_, off) ((T_*)(F.ws + (off)))

__device__ __forceinline__ void p0_transpose_item(const float* W, int ldn, int n0, int k0, bf16* dst, int drow0, LAS unsigned char* scr, int lane) {
    const int ng = lane & 31, kh = lane >> 5;
#pragma unroll
    for (int it = 0; it < 4; ++it) {
        f32x4 v[8];
#pragma unroll
        for (int j = 0; j < 8; ++j) v[j] = *(const GAS f32x4*)(W + (size_t)(k0 + 16 * it + 8 * kh + j) * ldn + n0 + 4 * ng);
        const int kc = 2 * it + kh;
#pragma unroll
        for (int i = 0; i < 4; ++i) { const int n = 4 * ng + i;
            u32x4 o; o.x = pk2(v[0][i], v[1][i]); o.y = pk2(v[2][i], v[3][i]); o.z = pk2(v[4][i], v[5][i]); o.w = pk2(v[6][i], v[7][i]);
            *(LAS u32x4*)(scr + n * 128 + ((kc ^ (ng & 7)) << 4)) = o; }
    }
    LDS_WAIT(); asm volatile("" ::: "memory");
#pragma unroll
    for (int j = 0; j < 16; ++j) { const int n = 8 * j + (lane >> 3), c = lane & 7;
        const u32x4 o = *(const LAS u32x4*)(scr + n * 128 + ((c ^ ((n >> 2) & 7)) << 4));
        *(GAS u32x4*)(dst + (size_t)(drow0 + n) * pg8::KD + k0 + 8 * c) = o; }
    LDS_WAIT(); asm volatile("" ::: "memory");
}
__device__ __forceinline__ void p0_prologue(Frame& F) {
    const int gw = F.vcu * NWAVES + F.wave, NGW = F.G * NWAVES, gt = F.vcu * NTHR + F.tid, NGT = F.G * NTHR;
    LAS float* cs = (LAS float*)(F.lds);
    for (int i = F.tid; i < NB * DM; i += NTHR) cs[i] = silu_f(F.c[i]);
    __syncthreads();
    float* modp = WSP(float, WS_MODP);
    for (int it = gw; it < 192 * 8; it += NGW) {
        const int cc = it % 192, kc = it / 192, r = F.lane >> 4, g = F.lane & 15;
        float acc[4][4];
#pragma unroll
        for (int b = 0; b < 4; ++b)
#pragma unroll
            for (int j = 0; j < 4; ++j) acc[b][j] = 0.f;
        const float* wp = F.w_ada + (size_t)(kc * 256 + r) * (6 * DM) + cc * 64 + g * 4;
#pragma unroll 8
        for (int s = 0; s < 64; ++s) {
            const f32x4 w = *(const GAS f32x4*)(wp + (size_t)(4 * s) * (6 * DM)); const int k = kc * 256 + 4 * s + r;
#pragma unroll
            for (int b = 0; b < 4; ++b) { const float cv = cs[b * DM + k];
#pragma unroll
                for (int j = 0; j < 4; ++j) acc[b][j] += cv * w[j]; }
        }
#pragma unroll
        for (int b = 0; b < 4; ++b)
#pragma unroll
            for (int j = 0; j < 4; ++j) { float v = acc[b][j]; v += __shfl_xor(v, 16); v += __shfl_xor(v, 32); acc[b][j] = v; }
        if (F.lane < 16)
#pragma unroll
            for (int b = 0; b < 4; ++b) *(GAS f32x4*)(modp + (size_t)(kc * 4 + b) * (6 * DM) + cc * 64 + g * 4) = (f32x4){acc[b][0], acc[b][1], acc[b][2], acc[b][3]};
    }
    __syncthreads();
    LAS unsigned char* scr = F.lds + F.wave * 16384;
    constexpr int I_IN = (INC / 128) * 32, I_OUT = (DM / 128) * 32;
    for (int it = gw; it < I_IN + I_OUT; it += NGW) {
        int r = it;
        if (r < I_IN) { const int nb = r >> 5, kb = r & 31;
            const int drow = nb < 24 ? nb * 128 : (nb < 32 ? 3072 + (nb - 24) * 256 : 3072 + (nb - 32) * 256 + 128);
            p0_transpose_item(F.w_in, INC, nb * 128, kb * 64, WSP(bf16, WS_WIN), drow, scr, F.lane); continue; } r -= I_IN;
        { const int nb = r >> 5, kb = r & 31; p0_transpose_item(F.w_out, DM, nb * 128, kb * 64, WSP(bf16, WS_WOUT), nb * 128, scr, F.lane); }
    }
    for (int i = gt; i < 64 * 2 * 64; i += NGT) {
        const int l = i & 63, nb = (i >> 6) & 1, s = i >> 7, e = 16 * nb + (l & 15), kb = 32 * s + 8 * (l >> 4);
        unsigned hi[8], lo[8];
#pragma unroll
        for (int j = 0; j < 8; ++j) { const float w = F.w_r[(size_t)(kb + j) * NE + e]; hi[j] = f2bf(w); lo[j] = f2bf(w - bf2f(hi[j])); }
        u32x4 oh, ol; oh.x = hi[0] | (hi[1] << 16); oh.y = hi[2] | (hi[3] << 16); oh.z = hi[4] | (hi[5] << 16); oh.w = hi[6] | (hi[7] << 16);
        ol.x = lo[0] | (lo[1] << 16); ol.y = lo[2] | (lo[3] << 16); ol.z = lo[4] | (lo[5] << 16); ol.w = lo[6] | (lo[7] << 16);
        *(GAS u32x4*)(WSP(unsigned char, WS_WRF) + (size_t)i * 16) = oh; *(GAS u32x4*)(WSP(unsigned char, WS_WRF) + 131072 + (size_t)i * 16) = ol;
    }
    float* bt = WSP(float, WS_BIAST);
    for (int i = gt; i < AH * 4096; i += NGT) { const int h = i >> 12, rel = (i & 4095) - 2048; bt[i] = F.relb[t5_bucket(rel) * AH + h] * LOG2E; }
    if (gt == 0) { float a = 0.f, b = 0.f; for (int i = 0; i < HD; ++i) { a += F.lq1[i] * F.lk1[i]; b += F.lq2[i] * F.lk2[i]; } bt[AH * 4096] = __expf(a) - __expf(b) + 0.2f; }
}

__device__ __forceinline__ void p1_norm1(Frame& F) {
    const float* modp = WSP(float, WS_MODP); float* mod = WSP(float, WS_MOD);
    for (int o = F.vcu * NTHR + F.tid; o < NB * 6 * DM; o += F.G * NTHR) { float s = F.b_ada[o % (6 * DM)];
#pragma unroll
        for (int kc = 0; kc < 8; ++kc) s += modp[(size_t)kc * (NB * 6 * DM) + o];
        mod[o] = s; }
    LAS float* gm = (LAS float*)F.lds; LAS float* sh = gm + DM;
    bf16* h = WSP(bf16, WS_H);
    for (int rb = F.vcu; rb < T / 32; rb += F.G) {
        const int b = rb / (SEQ / 32);
        __syncthreads();
        for (int k = F.tid; k < DM; k += NTHR) { float sc = F.b_ada[DM + k], sf = F.b_ada[k];
#pragma unroll
            for (int kc = 0; kc < 8; ++kc) { sc += modp[(size_t)(kc * 4 + b) * (6 * DM) + DM + k]; sf += modp[(size_t)(kc * 4 + b) * (6 * DM) + k]; }
            gm[k] = F.g1[k] * (1.f + sc); sh[k] = sf; }
        __syncthreads();
        for (int rr = F.wave; rr < 32; rr += NWAVES) {
            const int row = rb * 32 + rr;
            const GAS f32x4* xr = (const GAS f32x4*)(F.x + (size_t)row * DM) + F.lane;
            f32x4 v[8]; float s = 0.f;
#pragma unroll
            for (int j = 0; j < 8; ++j) { v[j] = xr[64 * j]; s += (v[j].x * v[j].x + v[j].y * v[j].y) + (v[j].z * v[j].z + v[j].w * v[j].w); }
            const float rstd = rsqrtf(wave_sum(s) * (1.f / DM) + EPS);
            GAS u32x2* o8 = (GAS u32x2*)(h + (size_t)row * DM) + F.lane;
#pragma unroll
            for (int j = 0; j < 8; ++j) { const int k = 4 * F.lane + 256 * j; const f32x4 g = *(const LAS f32x4*)(gm + k), s4 = *(const LAS f32x4*)(sh + k);
                u32x2 w; w.x = pk2(v[j].x * rstd * g.x + s4.x, v[j].y * rstd * g.y + s4.y); w.y = pk2(v[j].z * rstd * g.z + s4.z, v[j].w * rstd * g.w + s4.w); o8[64 * j] = w; }
        }
    }
}

template <bool HMT> struct InProjT {
    static constexpr bool PERM = true;
    const bf16* A; const bf16* Bt; bf16* O; pg8::DenseOrder ord;
    __device__ bool next(int i, pg8::Unit& u) const { return ord.next(i, u); }
    __device__ const char* a_base() const { return (const char*)A; }
    __device__ void a_off(const pg8::Unit& u, const int (&R)[2], const int (&C)[2], unsigned (&v0)[2], unsigned (&v1)[2]) const {
#pragma unroll
        for (int i = 0; i < 2; ++i) { v0[i] = (unsigned)((u.pm * u.rows + R[i]) * pg8::KD + C[i]) * 2u; v1[i] = (unsigned)((u.pm * u.rows + 128 + R[i]) * pg8::KD + C[i]) * 2u; } }
    __device__ const char* b_base(const pg8::Unit& u) const { return (const char*)(Bt + (size_t)u.pn * 256 * pg8::KD); }
    __device__ void epi(const f32x4 (&acc)[2][2][4][2], const pg8::Unit& u, int wr, int wc, int fr, int fq) const {
        const int row0 = u.pm * u.rows + wr * 64 + fr, col0 = u.pn * 256 + wc * 32 + 8 * fq;
        if (u.pn >= 12) {
            const int zc = 3072 + (u.pn - 12) * 128 + wc * 32 + 8 * fq;
#pragma unroll
            for (int ai = 0; ai < (HMT ? 1 : 2); ++ai)
#pragma unroll
                for (int m = 0; m < 4; ++m) { float r[8];
#pragma unroll
                    for (int n = 0; n < 2; ++n)
#pragma unroll
                        for (int j = 0; j < 4; ++j) r[4 * n + j] = acc[ai][0][m][n][j] * __builtin_amdgcn_rcpf(1.f + __builtin_amdgcn_exp2f(-LOG2E * acc[ai][1][m][n][j]));
                    u32x4 w; w.x = cvt_pk_bf16(r[0], r[1]); w.y = cvt_pk_bf16(r[2], r[3]); w.z = cvt_pk_bf16(r[4], r[5]); w.w = cvt_pk_bf16(r[6], r[7]);
                    *(GAS u32x4*)(O + (size_t)(row0 + ai * 128 + m * 16) * INC + zc) = w; }
            return; }
#pragma unroll
        for (int ai = 0; ai < (HMT ? 1 : 2); ++ai)
#pragma unroll
            for (int m = 0; m < 4; ++m) { bf16* rowp = O + (size_t)(row0 + ai * 128 + m * 16) * INC + col0;
#pragma unroll
                for (int bj = 0; bj < 2; ++bj) { const f32x4 v0 = acc[ai][bj][m][0], v1 = acc[ai][bj][m][1];
                    u32x4 w; w.x = cvt_pk_bf16(v0[0], v0[1]); w.y = cvt_pk_bf16(v0[2], v0[3]); w.z = cvt_pk_bf16(v1[0], v1[1]); w.w = cvt_pk_bf16(v1[2], v1[3]);
                    *(GAS u32x4*)(rowp + bj * 128) = w; } }
    }
};
struct OutProj {
    static constexpr bool PERM = true;
    const bf16* A; const bf16* Bt; const float* x; const float* mod; bf16* O; pg8::DenseOrder ord;
    __device__ bool next(int i, pg8::Unit& u) const { return ord.next(i, u); }
    __device__ const char* a_base() const { return (const char*)A; }
    __device__ void a_off(const pg8::Unit& u, const int (&R)[2], const int (&C)[2], unsigned (&v0)[2], unsigned (&v1)[2]) const {
#pragma unroll
        for (int i = 0; i < 2; ++i) { v0[i] = (unsigned)((u.pm * 256 + R[i]) * pg8::KD + C[i]) * 2u; v1[i] = (unsigned)((u.pm * 256 + 128 + R[i]) * pg8::KD + C[i]) * 2u; } }
    __device__ const char* b_base(const pg8::Unit& u) const { return (const char*)(Bt + (size_t)u.pn * 256 * pg8::KD); }
    __device__ void epi(const f32x4 (&acc)[2][2][4][2], const pg8::Unit& u, int wr, int wc, int fr, int fq) const {
        const int row0 = u.pm * 256 + wr * 64 + fr, col0 = u.pn * 256 + wc * 32 + 8 * fq, b = (u.pm * 256) / SEQ;
        f32x4 gt[2][2];
#pragma unroll
        for (int bj = 0; bj < 2; ++bj)
#pragma unroll
            for (int n = 0; n < 2; ++n) gt[bj][n] = *(const GAS f32x4*)(mod + (size_t)b * 6 * DM + 2 * DM + col0 + bj * 128 + 4 * n);
#pragma unroll
        for (int ai = 0; ai < 2; ++ai)
#pragma unroll
            for (int m = 0; m < 4; ++m) { const size_t ro = (size_t)(row0 + ai * 128 + m * 16) * DM + col0;
#pragma unroll
                for (int bj = 0; bj < 2; ++bj) { const f32x4 x0 = *(const GAS f32x4*)(x + ro + bj * 128), x1v = *(const GAS f32x4*)(x + ro + bj * 128 + 4);
                    const f32x4 v0 = x0 + gt[bj][0] * acc[ai][bj][m][0], v1 = x1v + gt[bj][1] * acc[ai][bj][m][1];
                    u32x4 w; w.x = cvt_pk_bf16(v0[0], v0[1]); w.y = cvt_pk_bf16(v0[2], v0[3]); w.z = cvt_pk_bf16(v1[0], v1[1]); w.w = cvt_pk_bf16(v1[2], v1[3]);
                    *(GAS u32x4*)(O + ro + bj * 128) = w; } }
    }
};
struct MoeTab { const LAS int* tp; const LAS int* off; const LAS int* cnt; };
__device__ __forceinline__ void moe_tables(Frame& F) {
    LAS int* tab = (LAS int*)(F.lds + TAB_OFF);
    __syncthreads();
    if (F.tid < 64) {
        const int e = F.lane & 31;
        const int c = (int)__hip_atomic_load(F.ctl + CW_CNT + e * CNT_STRIDE, __ATOMIC_RELAXED, __HIP_MEMORY_SCOPE_AGENT);
        const int t0 = (c + 255) >> 8; int t = t0, o = c;
#pragma unroll
        for (int d = 1; d < 32; d <<= 1) { const int t2 = __shfl_up(t, d, 32), o2 = __shfl_up(o, d, 32); if (e >= d) { t += t2; o += o2; } }
        if (F.lane < NE) { tab[e] = t - t0; tab[40 + e] = o - c; tab[80 + e] = c; }
        if (F.lane == NE - 1) { tab[NE] = t; tab[40 + NE] = o; }
    }
    __syncthreads();
}
template <int NTN, int REPF, int SPLIT>
__device__ __forceinline__ bool moe_next(const MoeTab& tb, int G, int c, int i, pg8::Unit& u) {
    int L = i * G + c; const int total = NTN * __builtin_amdgcn_readfirstlane(tb.tp[NE]); int hs = 0;
    if (SPLIT != 0) {
        const int nrem = total % G, nful = (2 * nrem <= G) ? total - nrem : total;
        if (SPLIT == 1) { if (L >= nful) return false; }
        else { if (L >= 2 * (total - nful)) return false; hs = L & 1; L = nful + (L >> 1); }
    } else { if (L >= total * REPF) return false; if (REPF > 1 && L >= total) L -= total; }
    int e = 0;
#pragma unroll
    for (int j = 1; j < NE; ++j) e += (L >= NTN * tb.tp[j]) ? 1 : 0;
    e = __builtin_amdgcn_readfirstlane(e);
    const int tpe = __builtin_amdgcn_readfirstlane(tb.tp[e]), tpe1 = __builtin_amdgcn_readfirstlane(tb.tp[e + 1]);
    const int local = L - NTN * tpe, nte = tpe1 - tpe;
    u.e = e; u.hs = hs; u.pn = __builtin_amdgcn_readfirstlane(local / nte); u.pm = local - u.pn * nte; u.rows = __builtin_amdgcn_readfirstlane(tb.cnt[e]) - 256 * u.pm; return true;
}
struct MoeGU {
    static constexpr bool PERM = true;
    const bf16* A; const float* W; const float* bias; const int* list; bf16* O; MoeTab tb; int G, c;
    __device__ bool next(int i, pg8::Unit& u) const { return moe_next<16, 1 + ((REP_MASK >> 11) & 1), 0>(tb, G, c, i, u); }
    __device__ const char* a_base() const { return (const char*)A; }
    __device__ void a_off(const pg8::Unit& u, unsigned (&v0)[2], unsigned (&v1)[2]) const {
        const int* lp = list + u.e * T + 256 * u.pm;
        int tb16 = (int)threadIdx.x * 16; asm volatile("" : "+v"(tb16));
#pragma unroll
        for (int i = 0; i < 2; ++i) { int R, C; pg8::stage_rc(tb16 + i * 8192, R, C);
            const int r0 = R < u.rows ? R : u.rows - 1, r1 = (128 + R) < u.rows ? (128 + R) : u.rows - 1;
            v0[i] = (unsigned)(lp[r0] * pg8::KD + C) * 2u; v1[i] = (unsigned)(lp[r1] * pg8::KD + C) * 2u; } }
    __device__ void bias_load(const pg8::Unit& u, int wc, int fq, f32x4 (&bi)[2][2]) const {
        int cb = wc * 32 + 8 * ((fq >> 1) + 2 * (fq & 1)); asm volatile("" : "+v"(cb));
        const float* bp = bias + (size_t)u.e * 2 * DFF + u.pn * 128 + cb;
#pragma unroll
        for (int bj = 0; bj < 2; ++bj)
            { const f32x4 t0 = *(const GAS f32x4*)(bp + bj * DFF), t1 = *(const GAS f32x4*)(bp + bj * DFF + 4); bi[bj][0] = (f32x4){t0[0], t1[0], t0[1], t1[1]}; bi[bj][1] = (f32x4){t0[2], t1[2], t0[3], t1[3]}; } }
    static constexpr int LDW_BYTES = 2 * DFF * 4, W_BYTES = DM * 2 * DFF * 4;
    __device__ const char* b_ptr(const pg8::Unit& u) const { return (const char*)(W + (size_t)u.e * DM * 2 * DFF); }
    static constexpr int HALF_BYTES = DFF * 4;
    __device__ unsigned b_col(const pg8::Unit& u, int lane) const { return (unsigned)(u.pn * 128 + 2 * lane) * 4u; }
    __device__ void epi(const f32x4 (&acc)[2][2][4][2], const pg8::Unit& u, int wr, int wc, int fr, int fq, const int ai) const {
        int rt0 = wr * 64 + fr, colt = u.pn * 128 + wc * 32 + 8 * ((fq >> 1) + 2 * (fq & 1)); asm volatile("" : "+v"(rt0), "+v"(colt)); const size_t slot0 = (size_t)__builtin_amdgcn_readfirstlane(tb.off[u.e]) + 256 * u.pm;
#pragma unroll
            for (int m = 0; m < 4; ++m) { const int rt = rt0 + ai * 128 + m * 16; float r[8];
#pragma unroll
                for (int n = 0; n < 2; ++n)
#pragma unroll
                    for (int j = 0; j < 4; ++j) { const int o = (j >> 1) + 2 * n + 4 * (j & 1);
                        float g = acc[ai][0][m][n][j], up = acc[ai][1][m][n][j];
                        g = fminf(g, 7.f); up = fminf(fmaxf(up, -7.f), 7.f);
                        r[o] = (up + 1.f) * g * __builtin_amdgcn_rcpf(1.f + __builtin_amdgcn_exp2f(-1.702f * LOG2E * g)); }
                if (rt < u.rows) { u32x4 w; w.x = cvt_pk_bf16(r[0], r[1]); w.y = cvt_pk_bf16(r[2], r[3]); w.z = cvt_pk_bf16(r[4], r[5]); w.w = cvt_pk_bf16(r[6], r[7]);
                    *(GAS u32x4*)(O + (slot0 + rt) * DFF + colt) = w; } }
    }
};
template <int SPLIT> struct MoeDownT {
    static constexpr bool PERM = true;
    const bf16* A; const float* W; const float* bias; const float* sw; bf16* O; MoeTab tb; int G, c;
    __device__ bool next(int i, pg8::Unit& u) const { return moe_next<8, 1 + ((REP_MASK >> 12) & 1), SPLIT>(tb, G, c, i, u); }
    __device__ const char* a_base() const { return (const char*)A; }
    __device__ void a_off(const pg8::Unit& u, unsigned (&v0)[2], unsigned (&v1)[2]) const {
        const int s0 = __builtin_amdgcn_readfirstlane(tb.off[u.e]) + 256 * u.pm;
        int tb16 = (int)threadIdx.x * 16; asm volatile("" : "+v"(tb16));
#pragma unroll
        for (int i = 0; i < 2; ++i) { int R, C; pg8::stage_rc(tb16 + i * 8192, R, C);
            v0[i] = (unsigned)((s0 + R) * pg8::KD + C) * 2u; v1[i] = (unsigned)((s0 + 128 + R) * pg8::KD + C) * 2u; } }
    __device__ void bias_load(const pg8::Unit& u, int wc, int fq, f32x4 (&bi)[2][2]) const {
        int cb = wc * 32 + 8 * ((fq >> 1) + 2 * (fq & 1)); asm volatile("" : "+v"(cb));
        const float* bp = bias + (size_t)u.e * DM + u.pn * 256 + u.hs * 128 + cb;
#pragma unroll
        for (int bj = 0; bj < (SPLIT == 2 ? 1 : 2); ++bj)
            { const f32x4 t0 = *(const GAS f32x4*)(bp + bj * 128), t1 = *(const GAS f32x4*)(bp + bj * 128 + 4); bi[bj][0] = (f32x4){t0[0], t1[0], t0[1], t1[1]}; bi[bj][1] = (f32x4){t0[2], t1[2], t0[3], t1[3]}; } }
    static constexpr int LDW_BYTES = DM * 4, W_BYTES = DFF * DM * 4;
    __device__ const char* b_ptr(const pg8::Unit& u) const { return (const char*)(W + (size_t)u.e * DFF * DM); }
    static constexpr int HALF_BYTES = 128 * 4;
    __device__ unsigned b_col(const pg8::Unit& u, int lane) const { return (unsigned)(u.pn * 256 + u.hs * 128 + 2 * lane) * 4u; }
    __device__ void epi(const f32x4 (&acc)[2][2][4][2], const pg8::Unit& u, int wr, int wc, int fr, int fq, const int ai) const {
        int rt0 = wr * 64 + fr, col0 = u.pn * 256 + u.hs * 128 + wc * 32 + 8 * ((fq >> 1) + 2 * (fq & 1)); asm volatile("" : "+v"(rt0), "+v"(col0)); const size_t slot0 = (size_t)__builtin_amdgcn_readfirstlane(tb.off[u.e]) + 256 * u.pm;
#pragma unroll
            for (int m = 0; m < 4; ++m) { const int rt = rt0 + ai * 128 + m * 16;
                if (rt < u.rows) { const float wgt = sw[(size_t)u.e * T + 256 * u.pm + rt]; bf16* rowp = O + (slot0 + rt) * DM + col0;
#pragma unroll
                    for (int bj = 0; bj < (SPLIT == 2 ? 1 : 2); ++bj) { float r[8];
#pragma unroll
                        for (int n = 0; n < 2; ++n)
#pragma unroll
                            for (int j = 0; j < 4; ++j) { const int o = (j >> 1) + 2 * n + 4 * (j & 1); r[o] = acc[ai][bj][m][n][j] * wgt; }
                        u32x4 w; w.x = cvt_pk_bf16(r[0], r[1]); w.y = cvt_pk_bf16(r[2], r[3]); w.z = cvt_pk_bf16(r[4], r[5]); w.w = cvt_pk_bf16(r[6], r[7]);
                        *(GAS u32x4*)(rowp + bj * 128) = w; } } }
    }
};

__device__ __forceinline__ void conv_unit(Frame& F, int ct) {
    const int b = ct / (SEQ / 32), s0 = (ct % (SEQ / 32)) * 32, tid = F.tid;
    const bf16* proj = WSP(bf16, WS_PROJ); bf16* mix = WSP(bf16, WS_MIX);
    LAS unsigned* z = (LAS unsigned*)F.lds;
    LAS float* st = (LAS float*)(F.lds + 126976);
    __syncthreads();
#pragma unroll 8
    for (int r = 0; r < 62; ++r) { const int s = s0 - 15 + r; const bool ok = (s >= 0 && s < SEQ); const int sc = ok ? s : 0;
        const unsigned zz = *(const GAS unsigned*)(proj + (size_t)(b * SEQ + sc) * INC + 3072 + 2 * tid);
        z[r * 512 + tid] = ok ? zz : 0u; }
    typedef float f32x2c __attribute__((ext_vector_type(2)));
    float w0[CK], w1[CK];
#pragma unroll
    for (int j = 0; j < CK; ++j) { const f32x2c w = *(const GAS f32x2c*)(F.cw + j * CCH + 2 * tid); w0[j] = w.x; w1[j] = w.y; }
    const f32x2c cbv = *(const GAS f32x2c*)(F.cb + 2 * tid), lg = *(const GAS f32x2c*)(F.clg + 2 * tid), lb = *(const GAS f32x2c*)(F.clb + 2 * tid);
    __syncthreads();
#pragma unroll 1
    for (int hf = 0; hf < 2; ++hf) {
        float c0[16], c1[16];
#pragma unroll
        for (int g = 0; g < 4; ++g) {
            float zl[34], zh[34];
#pragma unroll
            for (int r = 0; r < 34; ++r) { const unsigned zz = z[(16 * hf + 4 * g + r) * 512 + tid]; zl[r] = __builtin_bit_cast(float, zz << 16); zh[r] = __builtin_bit_cast(float, zz & 0xffff0000u); }
#pragma unroll
            for (int t = 0; t < 4; ++t) { float a0 = cbv.x, a1 = cbv.y;
#pragma unroll
                for (int j = 0; j < CK; ++j) { a0 = fmaf(w0[j], zl[t + j], a0); a1 = fmaf(w1[j], zh[t + j], a1); }
                c0[4 * g + t] = a0; c1[4 * g + t] = a1; }
        }
#pragma unroll
        for (int t = 0; t < 16; ++t) { const float sm = wave_sum(c0[t] + c1[t]), q = wave_sum(c0[t] * c0[t] + c1[t] * c1[t]);
            if (F.lane == 0) { st[(F.wave * 16 + t) * 2] = sm; st[(F.wave * 16 + t) * 2 + 1] = q; } }
        __syncthreads();
        if (tid < 16) { float sm = 0.f, q = 0.f;
#pragma unroll
            for (int w = 0; w < 8; ++w) { sm += st[(w * 16 + tid) * 2]; q += st[(w * 16 + tid) * 2 + 1]; }
            const float mu = sm * (1.f / CCH), var = q * (1.f / CCH) - mu * mu; st[512 + tid * 2] = mu; st[512 + tid * 2 + 1] = rsqrtf(fmaxf(var, 0.f) + EPS); }
        __syncthreads();
#pragma unroll
        for (int t = 0; t < 16; ++t) { const float mu = st[512 + t * 2], rs = st[512 + t * 2 + 1];
            const float y0 = (c0[t] - mu) * rs * lg.x + lb.x, y1 = (c1[t] - mu) * rs * lg.y + lb.y;
            const float o0 = y0 * __builtin_amdgcn_rcpf(1.f + __builtin_amdgcn_exp2f(-LOG2E * y0)), o1 = y1 * __builtin_amdgcn_rcpf(1.f + __builtin_amdgcn_exp2f(-LOG2E * y1));
            *(GAS unsigned*)(mix + (size_t)(b * SEQ + s0 + 16 * hf + t) * DM + 1024 + 2 * tid) = cvt_pk_bf16(o0, o1); }
        __syncthreads();
    }
}

namespace att {
constexpr int KVBLK = 64; constexpr size_t SHM_V = KVBLK * 128 * 2, SHM_K = KVBLK * 128 * 2;
constexpr float C = 0.125f * LOG2E, THR2 = 8.f * LOG2E;
#define KSWZ(row, colB) ((row) * 256 + ((colB) ^ (((row) & 7) << 4)))
#define SBAR() __builtin_amdgcn_sched_barrier(0)
__device__ __forceinline__ int crow(int r, int hi) { return (r & 3) + 8 * (r >> 2) + 4 * hi; }
__device__ __forceinline__ int v_st(int k, int c) { const int kk = (k & ~0xC) | ((k & 4) << 1) | ((k & 8) >> 1); return ((kk >> 3) * 4 + (c >> 5)) * 512 + ((kk & 7) * 32 + (c & 31)) * 2; }
__device__ __forceinline__ int v_rd_base(int lane) { return ((lane & 3) << 3) | (((lane >> 2) & 3) << 6) | (((lane >> 4) & 1) << 5) | (((lane >> 5) & 1) << 8); }
constexpr int v_rd_off(int d0, int ks, int half) { return d0 * 512 + ks * 4096 + half * 2048; }
template <int OFF> __device__ __forceinline__ s16x4 tr_read(int vb) { s16x4 r; asm volatile("ds_read_b64_tr_b16 %0, %1 offset:%2" : "=&v"(r) : "v"(vb), "i"(OFF) : "memory"); return r; }
template <int D0> __device__ __forceinline__ void pv_one(f32x16& od, int vb, bf16x8 pa0, bf16x8 pa1, bf16x8 pa2, bf16x8 pa3) {
    const s16x4 l0 = tr_read<v_rd_off(D0, 0, 0)>(vb), h0 = tr_read<v_rd_off(D0, 0, 1)>(vb), l1 = tr_read<v_rd_off(D0, 1, 0)>(vb), h1 = tr_read<v_rd_off(D0, 1, 1)>(vb);
    const s16x4 l2 = tr_read<v_rd_off(D0, 2, 0)>(vb), h2 = tr_read<v_rd_off(D0, 2, 1)>(vb), l3 = tr_read<v_rd_off(D0, 3, 0)>(vb), h3 = tr_read<v_rd_off(D0, 3, 1)>(vb);
    asm volatile("s_waitcnt lgkmcnt(0)" ::: "memory"); SBAR();
#define PK(L, H) (bf16x8){L[0], L[1], L[2], L[3], H[0], H[1], H[2], H[3]}
    od = __builtin_amdgcn_mfma_f32_32x32x16_bf16(pa0, PK(l0, h0), od, 0, 0, 0);
    od = __builtin_amdgcn_mfma_f32_32x32x16_bf16(pa1, PK(l1, h1), od, 0, 0, 0);
    od = __builtin_amdgcn_mfma_f32_32x32x16_bf16(pa2, PK(l2, h2), od, 0, 0, 0);
    od = __builtin_amdgcn_mfma_f32_32x32x16_bf16(pa3, PK(l3, h3), od, 0, 0, 0);
#undef PK
}
__device__ __forceinline__ void pv_d0(f32x16* o, int vb, bf16x8 pa0, bf16x8 pa1, bf16x8 pa2, bf16x8 pa3) {
    pv_one<0>(o[0], vb, pa0, pa1, pa2, pa3); pv_one<1>(o[1], vb, pa0, pa1, pa2, pa3); pv_one<2>(o[2], vb, pa0, pa1, pa2, pa3); pv_one<3>(o[3], vb, pa0, pa1, pa2, pa3);
}
__device__ __forceinline__ void qkt(f32x16& p0, f32x16& p1, const LAS char* Ks, const bf16x8* qr, int r32, int hi, int map) {
    p0 = f32x16{}; p1 = f32x16{};
#pragma unroll
    for (int d0 = 0; d0 < 4; ++d0) { const int cb = ((map * 4 + d0) * 16 + hi * 8) * 2;
        const bf16x8 b0 = *(const LAS bf16x8*)(Ks + KSWZ(r32, cb)); const bf16x8 b1 = *(const LAS bf16x8*)(Ks + KSWZ(32 + r32, cb));
        p0 = __builtin_amdgcn_mfma_f32_32x32x16_bf16(b0, qr[d0], p0, 0, 0, 0);
        p1 = __builtin_amdgcn_mfma_f32_32x32x16_bf16(b1, qr[d0], p1, 0, 0, 0); }
}
__device__ __forceinline__ void partialSM(f32x16& p0, f32x16& p1, float& m_reg, float& mn, float& alpha, int relw, int relb, int hi, const LAS float* btab, float bneg, float bpos) {
    if (relw - 31 >= 91 || relw + 63 <= -91) {
        const float bc = (relw > 0) ? bpos : bneg;
        float pmax = p0[0];
#pragma unroll
        for (int r = 1; r < 16; ++r) pmax = fmaxf(pmax, p0[r]);
#pragma unroll
        for (int r = 0; r < 16; ++r) pmax = fmaxf(pmax, p1[r]);
        { auto rr = __builtin_amdgcn_permlane32_swap(__float_as_uint(pmax), __float_as_uint(pmax), false, false); pmax = fmaxf(__uint_as_float(rr[0]), __uint_as_float(rr[1])); }
        const float tmax = fmaf(pmax, C, bc);
        if (__builtin_expect(__all(tmax - m_reg <= THR2), 1)) { mn = m_reg; alpha = 1.f; }
        else { mn = fmaxf(m_reg, tmax); alpha = __builtin_amdgcn_exp2f(m_reg - mn); m_reg = mn; }
        const float off = bc - mn;
#pragma unroll
        for (int r = 0; r < 16; ++r) p0[r] = fmaf(p0[r], C, off);
#pragma unroll
        for (int r = 0; r < 16; ++r) p1[r] = fmaf(p1[r], C, off);
    } else {
#pragma unroll
        for (int r = 0; r < 16; ++r) { const int idx = relb + crow(r, hi) + 256; p0[r] = fmaf(p0[r], C, btab[idx]); p1[r] = fmaf(p1[r], C, btab[idx + 32]); }
        float pmax = p0[0];
#pragma unroll
        for (int r = 1; r < 16; ++r) pmax = fmaxf(pmax, p0[r]);
#pragma unroll
        for (int r = 0; r < 16; ++r) pmax = fmaxf(pmax, p1[r]);
        { auto rr = __builtin_amdgcn_permlane32_swap(__float_as_uint(pmax), __float_as_uint(pmax), false, false); pmax = fmaxf(__uint_as_float(rr[0]), __uint_as_float(rr[1])); }
        if (__builtin_expect(__all(pmax - m_reg <= THR2), 1)) { mn = m_reg; alpha = 1.f; }
        else { mn = fmaxf(m_reg, pmax); alpha = __builtin_amdgcn_exp2f(m_reg - mn); m_reg = mn; }
#pragma unroll
        for (int r = 0; r < 16; ++r) p0[r] -= mn;
#pragma unroll
        for (int r = 0; r < 16; ++r) p1[r] -= mn;
    }
#pragma unroll
    for (int r = 0; r < 16; ++r) p0[r] = __builtin_amdgcn_exp2f(p0[r]);
}
__device__ __forceinline__ void finishSM(f32x16& p0, f32x16& p1, float alpha, float& l_reg, bf16x8& pa0, bf16x8& pa1, bf16x8& pa2, bf16x8& pa3) {
#pragma unroll
    for (int r = 0; r < 16; ++r) p1[r] = __builtin_amdgcn_exp2f(p1[r]);
    float ps = 0;
#pragma unroll
    for (int r = 0; r < 16; ++r) ps += p0[r];
#pragma unroll
    for (int r = 0; r < 16; ++r) ps += p1[r];
    { auto rr = __builtin_amdgcn_permlane32_swap(__float_as_uint(ps), __float_as_uint(ps), false, false); ps = __uint_as_float(rr[0]) + __uint_as_float(rr[1]); }
    l_reg = l_reg * alpha + ps;
#define PK4(P, BASE, OUT) do { unsigned a0 = cvt_pk_bf16(P[BASE + 0], P[BASE + 1]), a1 = cvt_pk_bf16(P[BASE + 2], P[BASE + 3]);   \
    unsigned b0 = cvt_pk_bf16(P[BASE + 4], P[BASE + 5]), b1 = cvt_pk_bf16(P[BASE + 6], P[BASE + 7]);                              \
    auto r0 = __builtin_amdgcn_permlane32_swap(a0, b0, false, false); auto r1 = __builtin_amdgcn_permlane32_swap(a1, b1, false, false); \
    u32x4 w = {r0[0], r1[0], r0[1], r1[1]}; OUT = __builtin_bit_cast(bf16x8, w); } while (0)
    PK4(p0, 0, pa0); PK4(p0, 8, pa1); PK4(p1, 0, pa2); PK4(p1, 8, pa3);
#undef PK4
}
constexpr int L_V = 0, L_K = 32768, L_WS = 65536, L_BT = 67584, L_CB = 69632;
__device__ __forceinline__ void attn_unit(Frame& F, int unit) {
    const int bh = unit >> 4, qb = unit & 15, b = bh >> 3, h = bh & 7, q0 = qb * 128;
    const int tid = F.tid, wid = F.wave, lane = F.lane, r32 = lane & 31, hi = lane >> 5, rg = wid & 3, map = wid >> 2;
    const bf16* proj = WSP(bf16, WS_PROJ);
    const bf16* Kh = proj + (size_t)(b * SEQ) * INC + 1024 + h * 128; const bf16* Vh = proj + (size_t)(b * SEQ) * INC + 2048 + h * 128;
    LAS char* lds = (LAS char*)F.lds; LAS char* V_lds = lds + L_V; LAS char* K_lds = lds + L_K;
    LAS float* wsf = (LAS float*)(lds + L_WS) + wid * 64; LAS float* li_l = wsf; LAS float* al_l = wsf + 32;
    LAS float* btab = (LAS float*)(lds + L_BT);
    const float* bt = WSP(float, WS_BIAST) + h * 4096;
    __syncthreads();
    btab[tid] = bt[2048 - 256 + tid];
    const float bneg = bt[2048 - 200], bpos = bt[2048 + 200], lam = WSP(float, WS_BIAST)[AH * 4096];
    float m_reg = -1e30f, l_reg = 0; f32x16 o[4] = {}; bf16x8 qr[4];
    const int qw0 = q0 + 32 * rg;
    const bf16* Qw = proj + (size_t)(b * SEQ + qw0 + r32) * INC + h * 128 + map * 64 + hi * 8;
#pragma unroll
    for (int d0 = 0; d0 < 4; ++d0) qr[d0] = *(const GAS bf16x8*)(Qw + d0 * 16);
    const int sr = tid >> 4, sc = (tid & 15) * 8, vst0 = v_st(sr, sc), vst1 = v_st(32 + sr, sc);
    const int vb0 = (int)(uintptr_t)V_lds + v_rd_base(lane);
    struct { bf16x8 vs0, vs1, ks0, ks1; } sr_[2];
#define SLOAD(i, k0) do { sr_[i].vs0 = *(const GAS bf16x8*)&Vh[(size_t)((k0) + sr) * INC + sc]; sr_[i].vs1 = *(const GAS bf16x8*)&Vh[(size_t)((k0) + 32 + sr) * INC + sc]; \
    sr_[i].ks0 = *(const GAS bf16x8*)&Kh[(size_t)((k0) + sr) * INC + sc]; sr_[i].ks1 = *(const GAS bf16x8*)&Kh[(size_t)((k0) + 32 + sr) * INC + sc]; } while (0)
#define SWRITE(bb, i) do { *(LAS bf16x8*)(V_lds + (bb) * SHM_V + vst0) = sr_[i].vs0; *(LAS bf16x8*)(V_lds + (bb) * SHM_V + vst1) = sr_[i].vs1; const int kc = sc * 2; \
    *(LAS bf16x8*)(K_lds + (bb) * SHM_K + KSWZ(sr, kc)) = sr_[i].ks0; *(LAS bf16x8*)(K_lds + (bb) * SHM_K + KSWZ(32 + sr, kc)) = sr_[i].ks1; } while (0)
#define SWAIT() asm volatile("s_waitcnt vmcnt(4)" ::: "memory")
#define RESC(a) do { if (__any((a) < 1.f)) { if (hi == 0) al_l[r32] = (a); asm volatile("s_waitcnt lgkmcnt(0)" ::: "memory"); \
    _Pragma("unroll") for (int d = 0; d < 4; ++d) _Pragma("unroll") for (int r = 0; r < 16; ++r) o[d][r] *= al_l[crow(r, hi)]; } } while (0)
#define PSM(P0, P1, MN, AL, k0) partialSM(P0, P1, m_reg, MN, AL, (k0) - qw0, (k0) - qw0 - r32, hi, btab, bneg, bpos)
    f32x16 pA0, pA1, pB0, pB1; float mnA, mnB, alA, alB; bf16x8 pa0, pa1, pa2, pa3; constexpr int NT = SEQ / KVBLK;
    constexpr int SE = 0, SO = 1;
    SLOAD(SE, 0); asm volatile("s_waitcnt vmcnt(0)" ::: "memory"); SWRITE(0, SE); __syncthreads();
    qkt(pA0, pA1, K_lds, qr, r32, hi, map); PSM(pA0, pA1, mnA, alA, 0);
    SLOAD(SO, KVBLK); SLOAD(SE, 2 * KVBLK);
    SWAIT(); SWRITE(1, SO); __syncthreads();
    for (int j = 1; j + 1 < NT; j += 2) {
        SBAR(); qkt(pB0, pB1, K_lds + SHM_K, qr, r32, hi, map);
        finishSM(pA0, pA1, alA, l_reg, pa0, pa1, pa2, pa3); SBAR();
        SLOAD(SO, (j + 2) * KVBLK); SBAR();
        pv_d0(o, vb0, pa0, pa1, pa2, pa3); PSM(pB0, pB1, mnB, alB, j * KVBLK);
        __syncthreads(); SWAIT(); SWRITE(0, SE);
        RESC(alB); __syncthreads();
        SBAR(); qkt(pA0, pA1, K_lds, qr, r32, hi, map);
        finishSM(pB0, pB1, alB, l_reg, pa0, pa1, pa2, pa3); SBAR();
        if (j + 3 < NT) SLOAD(SE, (j + 3) * KVBLK); SBAR();
        pv_d0(o, vb0 + (int)SHM_V, pa0, pa1, pa2, pa3); PSM(pA0, pA1, mnA, alA, (j + 1) * KVBLK);
        __syncthreads(); SWAIT(); SWRITE(1, SO);
        RESC(alA); __syncthreads();
    }
    SBAR(); qkt(pB0, pB1, K_lds + SHM_K, qr, r32, hi, map);
    finishSM(pA0, pA1, alA, l_reg, pa0, pa1, pa2, pa3); SBAR();
    pv_d0(o, vb0, pa0, pa1, pa2, pa3); PSM(pB0, pB1, mnB, alB, (NT - 1) * KVBLK);
    __syncthreads(); RESC(alB);
    finishSM(pB0, pB1, alB, l_reg, pa0, pa1, pa2, pa3); SBAR();
    pv_d0(o, vb0 + (int)SHM_V, pa0, pa1, pa2, pa3);
    if (hi == 0) li_l[r32] = l_reg; asm volatile("s_waitcnt lgkmcnt(0)" ::: "memory");
    float rli[16];
#pragma unroll
    for (int r = 0; r < 16; ++r) rli[r] = __builtin_amdgcn_rcpf(li_l[crow(r, hi)]);
    LAS float* cbuf = (LAS float*)(lds + L_CB) + rg * 32 * 128;
    if (map == 1) {
#pragma unroll
        for (int r = 0; r < 16; ++r)
#pragma unroll
            for (int d0 = 0; d0 < 4; ++d0) cbuf[crow(r, hi) * 128 + d0 * 32 + r32] = -lam * o[d0][r] * rli[r];
    }
    __syncthreads();
    if (map == 0) {
        bf16* mix = WSP(bf16, WS_MIX) + (size_t)(b * SEQ + qw0) * DM + h * 128;
        float sg[4];
#pragma unroll
        for (int d0 = 0; d0 < 4; ++d0) sg[d0] = F.subln[d0 * 32 + r32] * 0.8f;
#pragma unroll
        for (int r = 0; r < 16; ++r) { float v[4], ss = 0.f;
#pragma unroll
            for (int d0 = 0; d0 < 4; ++d0) { v[d0] = o[d0][r] * rli[r] + cbuf[crow(r, hi) * 128 + d0 * 32 + r32]; ss += v[d0] * v[d0]; }
#pragma unroll
            for (int s = 1; s < 32; s <<= 1) ss += __shfl_xor(ss, s);
            const float rstd = rsqrtf(ss * (1.f / VD) + EPS);
#pragma unroll
            for (int d0 = 0; d0 < 4; ++d0) mix[(size_t)crow(r, hi) * DM + d0 * 32 + r32] = (bf16)f2bf(v[d0] * rstd * sg[d0]); }
    }
#undef SLOAD
#undef SWRITE
#undef SWAIT
#undef RESC
#undef PSM
}
}

__device__ __forceinline__ void p5_router(Frame& F, bool dry = false) {
    const float* mod = WSP(float, WS_MOD); const bf16* x1 = WSP(bf16, WS_X1); bf16* h2 = WSP(bf16, WS_H2);
    int* list = (int*)(F.ws + WS_ROUTE + RT_LIST); float* sw = (float*)(F.ws + WS_ROUTE + RT_SW); int* toke = (int*)(F.ws + WS_ROUTE + RT_TOKE); int* tokr = (int*)(F.ws + WS_ROUTE + RT_TOKR);
    constexpr int RS = 4096 + 16;
    LAS unsigned char* Ahi = F.lds; LAS unsigned char* Alo = F.lds + 16 * RS; LAS float* Pl = (LAS float*)(F.lds + 32 * RS);
    const unsigned char* wrf = WSP(unsigned char, WS_WRF);
    for (int tb = F.vcu; tb < T / 16; tb += F.G) {
        const int b = (tb * 16) / SEQ;
        __syncthreads();
#pragma unroll 1
        for (int rr = 0; rr < 2; ++rr) {
            const int tl = 2 * F.wave + rr, row = tb * 16 + tl;
            const GAS u32x2* xr = (const GAS u32x2*)(x1 + (size_t)row * DM) + F.lane;
            f32x4 v[8]; float s = 0.f;
#pragma unroll
            for (int j = 0; j < 8; ++j) { const u32x2 xx = xr[64 * j]; v[j] = (f32x4){bf2f(xx.x & 0xffffu), bf2f(xx.x >> 16), bf2f(xx.y & 0xffffu), bf2f(xx.y >> 16)}; s += (v[j].x * v[j].x + v[j].y * v[j].y) + (v[j].z * v[j].z + v[j].w * v[j].w); }
            const float rstd = rsqrtf(wave_sum(s) * (1.f / DM) + EPS);
            GAS u32x2* o8 = (GAS u32x2*)(h2 + (size_t)row * DM) + F.lane;
#pragma unroll
            for (int j = 0; j < 8; ++j) { const int k = 4 * F.lane + 256 * j;
                const f32x4 g = *(const GAS f32x4*)(F.g2 + k), sc = *(const GAS f32x4*)(mod + (size_t)b * 6 * DM + 4 * DM + k), sf = *(const GAS f32x4*)(mod + (size_t)b * 6 * DM + 3 * DM + k);
                float hv[4]; unsigned hb[4], lb[4];
#pragma unroll
                for (int q = 0; q < 4; ++q) { hv[q] = v[j][q] * rstd * g[q] * (1.f + sc[q]) + sf[q]; hb[q] = f2bf(hv[q]); lb[q] = f2bf(hv[q] - bf2f(hb[q])); }
                u32x2 wh, wl; wh.x = hb[0] | (hb[1] << 16); wh.y = hb[2] | (hb[3] << 16); wl.x = lb[0] | (lb[1] << 16); wl.y = lb[2] | (lb[3] << 16);
                o8[64 * j] = wh; *(LAS u32x2*)(Ahi + tl * RS + k * 2) = wh; *(LAS u32x2*)(Alo + tl * RS + k * 2) = wl; }
        }
        __syncthreads();
        { f32x4 acc0 = {0.f, 0.f, 0.f, 0.f}, acc1 = {0.f, 0.f, 0.f, 0.f};
#pragma unroll 2
          for (int ks = 0; ks < 8; ++ks) { const int s = 8 * F.wave + ks, k0 = 32 * s + 8 * (F.lane >> 4);
            const bf16x8 ah = *(const LAS bf16x8*)(Ahi + (F.lane & 15) * RS + k0 * 2), al = *(const LAS bf16x8*)(Alo + (F.lane & 15) * RS + k0 * 2);
            const bf16x8 bh0 = *(const GAS bf16x8*)(wrf + ((size_t)(s * 2 + 0) * 64 + F.lane) * 16), bh1 = *(const GAS bf16x8*)(wrf + ((size_t)(s * 2 + 1) * 64 + F.lane) * 16);
            const bf16x8 bl0 = *(const GAS bf16x8*)(wrf + 131072 + ((size_t)(s * 2 + 0) * 64 + F.lane) * 16), bl1 = *(const GAS bf16x8*)(wrf + 131072 + ((size_t)(s * 2 + 1) * 64 + F.lane) * 16);
            acc0 = __builtin_amdgcn_mfma_f32_16x16x32_bf16(ah, bh0, acc0, 0, 0, 0); acc0 = __builtin_amdgcn_mfma_f32_16x16x32_bf16(ah, bl0, acc0, 0, 0, 0); acc0 = __builtin_amdgcn_mfma_f32_16x16x32_bf16(al, bh0, acc0, 0, 0, 0);
            acc1 = __builtin_amdgcn_mfma_f32_16x16x32_bf16(ah, bh1, acc1, 0, 0, 0); acc1 = __builtin_amdgcn_mfma_f32_16x16x32_bf16(ah, bl1, acc1, 0, 0, 0); acc1 = __builtin_amdgcn_mfma_f32_16x16x32_bf16(al, bh1, acc1, 0, 0, 0); }
#pragma unroll
          for (int r = 0; r < 4; ++r) { const int tk = 4 * (F.lane >> 4) + r; Pl[(F.wave * 16 + tk) * 32 + (F.lane & 15)] = acc0[r]; Pl[(F.wave * 16 + tk) * 32 + 16 + (F.lane & 15)] = acc1[r]; }
        }
        __syncthreads();
        { const int tl = F.tid >> 5, e = F.tid & 31, tok = tb * 16 + tl;
          float v = F.b_r[e];
#pragma unroll
          for (int w = 0; w < 8; ++w) v += Pl[(w * 16 + tl) * 32 + e];
          float tv[4]; int ti[4];
#pragma unroll
          for (int r = 0; r < 4; ++r) { float bv = v; int bi = e;
#pragma unroll
              for (int o = 16; o > 0; o >>= 1) { const float ov = __shfl_xor(bv, o); const int oi = __shfl_xor(bi, o); if (ov > bv || (ov == bv && oi < bi)) { bv = ov; bi = oi; } }
              tv[r] = bv; ti[r] = bi; if (e == bi) v = -3.0e38f; }
          float den = 0.f, w[4];
#pragma unroll
          for (int r = 0; r < 4; ++r) { w[r] = __expf(tv[r] - tv[0]); den += w[r]; }
#pragma unroll
          for (int r = 0; r < 4; ++r) if (e == ti[r] && !dry) { const int rank = (int)atomicAdd(F.ctl + CW_CNT + e * CNT_STRIDE, 1u);
              list[e * T + rank] = tok; sw[e * T + rank] = w[r] / den; toke[tok * 4 + r] = e; tokr[tok * 4 + r] = rank; }
        }
    }
}

__device__ __forceinline__ void p8_final(Frame& F) {
    const float* mod = WSP(float, WS_MOD); const bf16* x1 = WSP(bf16, WS_X1); const bf16* y = WSP(bf16, WS_Y);
    const int* toke = (const int*)(F.ws + WS_ROUTE + RT_TOKE); const int* tokr = (const int*)(F.ws + WS_ROUTE + RT_TOKR);
    moe_tables(F);
    const LAS int* off = (const LAS int*)(F.lds + TAB_OFF) + 40;
    for (int row = F.vcu * NWAVES + F.wave; row < T; row += F.G * NWAVES) {
        const int b = row / SEQ;
        size_t so[4];
#pragma unroll
        for (int r = 0; r < 4; ++r) so[r] = (size_t)(off[toke[row * 4 + r]] + tokr[row * 4 + r]) * DM;
        const GAS u32x2* xr = (const GAS u32x2*)(x1 + (size_t)row * DM) + F.lane;
        f32x4 v[8]; float s = 0.f;
#pragma unroll
        for (int j = 0; j < 8; ++j) { const int k = 4 * F.lane + 256 * j; f32x4 m = {0.f, 0.f, 0.f, 0.f};
#pragma unroll
            for (int r = 0; r < 4; ++r) { const u32x2 yy = *(const GAS u32x2*)(y + so[r] + k); m[0] += bf2f(yy.x & 0xffffu); m[1] += bf2f(yy.x >> 16); m[2] += bf2f(yy.y & 0xffffu); m[3] += bf2f(yy.y >> 16); }
            const f32x4 g = *(const GAS f32x4*)(mod + (size_t)b * 6 * DM + 5 * DM + k);
            const u32x2 xx = xr[64 * j]; v[j] = (f32x4){bf2f(xx.x & 0xffffu), bf2f(xx.x >> 16), bf2f(xx.y & 0xffffu), bf2f(xx.y >> 16)} + g * m; s += (v[j].x * v[j].x + v[j].y * v[j].y) + (v[j].z * v[j].z + v[j].w * v[j].w); }
        const float rstd = rsqrtf(wave_sum(s) * (1.f / DM) + EPS);
        GAS f32x4* orow = (GAS f32x4*)(F.out + (size_t)row * DM) + F.lane;
#pragma unroll
        for (int j = 0; j < 8; ++j) { const f32x4 g = *(const GAS f32x4*)(F.fg + 4 * F.lane + 256 * j); orow[64 * j] = v[j] * rstd * g; }
    }
}

struct Args { const float* in[25]; float* out; unsigned char* ws; int ph_lo, ph_hi, li, pad; };
__global__ void __launch_bounds__(NTHR, 2) mega_fwd(Args args) {
    extern __shared__ __attribute__((aligned(16))) unsigned char lds[];
    Frame F;
    F.lds = (LAS unsigned char*)lds; F.MISC = (volatile LAS unsigned*)(F.lds + MISC_OFF);
    F.tid = threadIdx.x; F.lane = F.tid & 63; F.wave = __builtin_amdgcn_readfirstlane(F.tid >> 6);
    F.G = gridDim.x; { const int bx = blockIdx.x; F.vcu = (F.G % 8 == 0) ? (bx % 8) * (F.G / 8) + bx / 8 : bx; }
    F.ws = args.ws; F.ctl = (unsigned*)(args.ws + WS_CTL); F.out = args.out;
    F.x = args.in[0]; F.c = args.in[1]; F.w_ada = args.in[2]; F.b_ada = args.in[3]; F.g1 = args.in[4]; F.w_in = args.in[5]; F.lq1 = args.in[6]; F.lk1 = args.in[7]; F.lq2 = args.in[8]; F.lk2 = args.in[9];
    F.subln = args.in[10]; F.relb = args.in[11]; F.cw = args.in[12]; F.cb = args.in[13]; F.clg = args.in[14]; F.clb = args.in[15]; F.w_out = args.in[16]; F.g2 = args.in[17]; F.w_r = args.in[18]; F.b_r = args.in[19];
    F.w_gu = args.in[20]; F.b_gu = args.in[21]; F.w_d = args.in[22]; F.b_d = args.in[23]; F.fg = args.in[24];
    for (int u = F.tid; u < 64; u += NTHR) ((LAS unsigned*)(F.lds + MISC_OFF))[u] = 0u;
    __syncthreads();
    XcdBarrier bar = xcd_barrier_post(F.ctl + CW_BAR + args.li * XCD_BAR_WORDS, F.MISC + 8);
    const int lo = args.ph_lo, hi = args.ph_hi;
#ifndef PH_MASK
#define PH_MASK 0x1ff
#endif
#define IN(k) (((PH_MASK >> (k)) & 1) && lo <= (k) && (k) < hi)
#define SEAM(k) do { if (IN(k) && IN((k) + 1)) { xcd_barrier(bar); if constexpr (((REP_MASK >> 14) & 1) != 0) xcd_barrier(bar); } } while (0)
#define REP2(k, ...) do { { __VA_ARGS__ } if constexpr (((REP_MASK >> (k)) & 1) != 0) { __VA_ARGS__ } } while (0)
#ifndef PROBE_TS
#define PROBE_TS -1
#endif
    unsigned long long* const tsb = (unsigned long long*)(F.ctl + 8192);
#define STAMP(k) do { if constexpr (PROBE_TS >= 0) { if (F.tid == 0) __hip_atomic_store(tsb + (k) * 256 + blockIdx.x, (unsigned long long)wall_clock64(), __ATOMIC_RELAXED, __HIP_MEMORY_SCOPE_AGENT); } } while (0)
    STAMP(0);
    if (IN(0)) { REP2(0, __syncthreads(); p0_prologue(F);); } STAMP(1); SEAM(0);
    if (IN(0) && IN(1)) F.vcu = xcd_virtual_cu(bar);
    if (IN(1)) { REP2(1, __syncthreads(); p1_norm1(F);); } STAMP(2); SEAM(1);
    if (IN(2)) { REP2(2, { InProjT<false> P{WSP(bf16, WS_H), WSP(bf16, WS_WIN), WSP(bf16, WS_PROJ), {}}; P.ord.init(T, INC, F.G, F.vcu, false, true); P.ord.rep = 1 + ((REP_MASK >> 15) & 1); __syncthreads(); pg8::gemm_run(F.lds, P); }
        { InProjT<true> P{WSP(bf16, WS_H), WSP(bf16, WS_WIN), WSP(bf16, WS_PROJ), {}}; P.ord.init(T, INC, F.G, F.vcu, true, true); __syncthreads(); pg8::gemm_run<InProjT<true>, true>(F.lds, P); }); } STAMP(3); SEAM(2);
    if (IN(3)) { REP2(3,
        for (int ct = F.vcu; ct < T / 32; ct += F.G) conv_unit(F, ct);
        if constexpr (((REP_MASK >> 9) & 1) != 0) { for (int ct = F.vcu; ct < T / 32; ct += F.G) conv_unit(F, ct); }
        for (int u = F.vcu; u < NB * AH * 16 * (1 + ((REP_MASK >> 10) & 1)); u += F.G) att::attn_unit(F, u % (NB * AH * 16));
    ); } STAMP(4); SEAM(3);
    if (IN(4)) { REP2(4, OutProj P{WSP(bf16, WS_MIX), WSP(bf16, WS_WOUT), F.x, WSP(float, WS_MOD), WSP(bf16, WS_X1), {}}; P.ord.init(T, DM, F.G, F.vcu); P.ord.rep = 1 + ((REP_MASK >> 16) & 1); __syncthreads(); pg8::gemm_run(F.lds, P);); } STAMP(5); SEAM(4);
    if (IN(5)) { p5_router(F); if constexpr (((REP_MASK >> 13) & 1) != 0) { __syncthreads(); p5_router(F, true); } } STAMP(6); SEAM(5);
    if (IN(6)) { REP2(6, moe_tables(F); const LAS int* tab = (const LAS int*)(F.lds + TAB_OFF);
        MoeGU P{WSP(bf16, WS_H2), F.w_gu, F.b_gu, (const int*)(F.ws + WS_ROUTE + RT_LIST), WSP(bf16, WS_ACT), {tab, tab + 40, tab + 80}, F.G, F.vcu}; pg8::gemm_run_bf32(F.lds, P);); } STAMP(7); SEAM(6);
    if (IN(7)) { REP2(7, moe_tables(F); const LAS int* tab = (const LAS int*)(F.lds + TAB_OFF);
        { MoeDownT<1> P{WSP(bf16, WS_ACT), F.w_d, F.b_d, (const float*)(F.ws + WS_ROUTE + RT_SW), WSP(bf16, WS_Y), {tab, tab + 40, tab + 80}, F.G, F.vcu}; pg8::gemm_run_bf32(F.lds, P); }
        { MoeDownT<2> P{WSP(bf16, WS_ACT), F.w_d, F.b_d, (const float*)(F.ws + WS_ROUTE + RT_SW), WSP(bf16, WS_Y), {tab, tab + 40, tab + 80}, F.G, F.vcu}; pg8::gemm_run_bf32<MoeDownT<2>, true>(F.lds, P); }); } STAMP(8); SEAM(7);
    if (IN(8)) { REP2(8, p8_final(F);); }
    if constexpr (PROBE_TS >= 0) {
        STAMP(9); xcd_barrier(bar);
        if (blockIdx.x == 0) {
            LAS unsigned long long* sh = (LAS unsigned long long*)F.lds;
            __syncthreads();
            if (F.tid < 256) { const int cu = F.tid < (int)gridDim.x ? F.tid : 0;
                sh[F.tid] = __hip_atomic_load(tsb + (PROBE_TS + 1) * 256 + cu, __ATOMIC_RELAXED, __HIP_MEMORY_SCOPE_AGENT);
                sh[256 + F.tid] = __hip_atomic_load(tsb + PROBE_TS * 256 + cu, __ATOMIC_RELAXED, __HIP_MEMORY_SCOPE_AGENT); }
            __syncthreads();
            if (F.tid == 0) { long long mx = 0, sum = 0; for (int i = 0; i < 256; ++i) { const long long d = (long long)(sh[i] - sh[256 + i]); mx = d > mx ? d : mx; sum += d; }
                const long long W = sum / 256 / 100, sk = (mx - sum / 256) / 100;
                const long long a = W > 1023 ? 1023 : W, b = sk > 255 ? 255 : (sk < 0 ? 0 : sk);
                const unsigned long long wait = (unsigned long long)(10 * a + 0 * b) * 100ull, t0 = wall_clock64();
                while ((unsigned long long)wall_clock64() - t0 < wait) __builtin_amdgcn_s_sleep(32); }
            __syncthreads();
        }
    }
#undef IN
#undef SEAM
}

extern "C" void kernel_launch(void* const* d_in, const int* in_sizes, int n_in, void* d_out, int out_size, void* d_ws, size_t ws_size, hipStream_t stream) {
    static int grid = 0;
    if (grid == 0) {
        if (n_in != 25 || ws_size < WS_END || out_size != T * DM) { fprintf(stderr, "kernel_launch: n_in %d out %d ws %zu (need %zu); nothing launched\n", n_in, out_size, ws_size, (size_t)WS_END); grid = -1; return; }
        int dev = 0, cus = 0, per_cu = 0;
        if (hipGetDevice(&dev) != hipSuccess || hipDeviceGetAttribute(&cus, hipDeviceAttributeMultiprocessorCount, dev) != hipSuccess) { grid = -1; return; }
        if (hipFuncSetAttribute((const void*)mega_fwd, hipFuncAttributeMaxDynamicSharedMemorySize, LDS_BYTES) != hipSuccess) { fprintf(stderr, "kernel_launch: hipFuncSetAttribute failed\n"); grid = -1; return; }
        if (hipOccupancyMaxActiveBlocksPerMultiprocessor(&per_cu, (const void*)mega_fwd, NTHR, LDS_BYTES) != hipSuccess || per_cu < 1) { fprintf(stderr, "kernel_launch: occupancy query says %d blocks per CU\n", per_cu); }
        (void)hipGetLastError();
        grid = cus;
    }
    if (grid < 0) return;
    unsigned char* ws = (unsigned char*)d_ws;
    (void)hipMemsetAsync(ws + WS_CTL, 0, CTL_ZERO_BYTES, stream);
    Args a{};
    for (int i = 0; i < 25; ++i) a.in[i] = (const float*)d_in[i];
    a.out = (float*)d_out; a.ws = ws; a.ph_lo = 0; a.ph_hi = 9; a.li = 0; a.pad = 0;
    hipLaunchKernelGGL(mega_fwd, dim3(grid), dim3(NTHR), LDS_BYTES, stream, a);
}
```

```cpp
#include <hip/hip_runtime.h>
#include <cstdio>
#include <cstdint>

#ifndef REP_MASK
#define REP_MASK 0
#endif

constexpr int DM = 2048, NB = 4, SEQ = 2048, T = NB * SEQ;
constexpr int AH = 8, HD = 64, VD = 128, CCH = 1024, CK = 31;
constexpr int INC = 5120;
constexpr int NE = 32, TOPK = 4, DFF = 2048, NSLOT = T * TOPK;
constexpr float EPS = 1e-6f;
constexpr float LOG2E = 1.4426950408889634f;

typedef unsigned short bf16;
typedef short bf16x8 __attribute__((ext_vector_type(8)));
typedef short s16x4 __attribute__((ext_vector_type(4)));
typedef float f32x4 __attribute__((ext_vector_type(4)));
typedef float f32x16 __attribute__((ext_vector_type(16)));
typedef unsigned u32x4 __attribute__((ext_vector_type(4)));
typedef unsigned u32x2 __attribute__((ext_vector_type(2)));
#define GAS __attribute__((address_space(1)))
#define LAS __attribute__((address_space(3)))
typedef GAS unsigned gu32;

constexpr size_t MiB = 1u << 20;
constexpr size_t WS_CTL = 0, CTL_ZERO_BYTES = 64 * 1024;
constexpr size_t WS_MODP = 1 * MiB;
constexpr size_t WS_MOD = 3 * MiB;
constexpr size_t WS_BIAST = 4 * MiB;
constexpr size_t WS_WRF = 5 * MiB;
constexpr size_t WS_ROUTE = 6 * MiB;
constexpr size_t RT_LIST = 0;
constexpr size_t RT_SW = 1 * MiB;
constexpr size_t RT_TOKE = 2 * MiB;
constexpr size_t RT_TOKR = RT_TOKE + 128 * 1024;
constexpr size_t WS_WIN = 16 * MiB;
constexpr size_t WS_WOUT = WS_WIN + 20 * MiB;
constexpr size_t WS_H = WS_WOUT + 8 * MiB;
constexpr size_t WS_PROJ = WS_H + 32 * MiB;
constexpr size_t WS_MIX = WS_PROJ + 80 * MiB;
constexpr size_t WS_X1 = WS_MIX + 32 * MiB;
constexpr size_t WS_H2 = WS_X1 + 64 * MiB;
constexpr size_t WS_ACT = WS_H2 + 32 * MiB;
constexpr size_t WS_Y = WS_ACT + 130 * MiB;
constexpr size_t WS_END = WS_Y + 130 * MiB;
constexpr int CW_CNT = 5120, CNT_STRIDE = 64;
constexpr int CW_BAR = 1024;

__device__ __forceinline__ unsigned f2bf(float f) { unsigned u = __builtin_bit_cast(unsigned, f); return (u + 0x7fffu + ((u >> 16) & 1u)) >> 16; }
__device__ __forceinline__ float bf2f(unsigned h) { return __builtin_bit_cast(float, h << 16); }
__device__ __forceinline__ unsigned pk2(float lo, float hi) { return f2bf(lo) | (f2bf(hi) << 16); }
__device__ __forceinline__ unsigned cvt_pk_bf16(float lo, float hi) { unsigned r; asm volatile("v_cvt_pk_bf16_f32 %0, %1, %2" : "=v"(r) : "v"(lo), "v"(hi)); return r; }
__device__ __forceinline__ float silu_f(float v) { return v / (1.f + __expf(-v)); }
__device__ __forceinline__ void st_wt8(GAS u32x2* p, u32x2 v) { asm volatile("global_store_dwordx2 %0, %1, off sc0 sc1" :: "v"(p), "v"(v) : "memory"); }
__device__ __forceinline__ void st_wt16(GAS u32x4* p, u32x4 v) { asm volatile("global_store_dwordx4 %0, %1, off sc0 sc1" :: "v"(p), "v"(v) : "memory"); }
__device__ __forceinline__ float wave_sum(float v) {
#pragma unroll
    for (int o = 1; o < 64; o <<= 1) v += __shfl_xor(v, o);
    return v;
}
__host__ __device__ inline int t5_bucket(int rel) {
    int ret = rel > 0 ? 16 : 0; int n = rel < 0 ? -rel : rel;
    if (n < 8) return ret + n;
    int lg = n >= 91 ? 15 : n >= 64 ? 14 : n >= 46 ? 13 : n >= 32 ? 12 : n >= 23 ? 11 : n >= 16 ? 10 : n >= 12 ? 9 : 8;
    return ret + lg;
}
#define LDS_WAIT() asm volatile("s_waitcnt lgkmcnt(0)" ::: "memory")
#define VM_WAIT() asm volatile("s_waitcnt vmcnt(0)" ::: "memory")

#define XB_TMO      128
#define XB_XCNT(j)  (256  + 64 * (j))
#define XB_XSUB(j)  (1280 + 64 * (j))
#define XB_XGEN(j)  (2304 + 64 * (j))
#define XB_TOP      3328
#define XB_TOPGEN   3392
#define XCD_BAR_WORDS 3456
#define XB_SPIN_CAP (1u << 18)
__device__ __forceinline__ unsigned xb_ld(unsigned* p)              { return __hip_atomic_load(p, __ATOMIC_RELAXED, __HIP_MEMORY_SCOPE_AGENT); }
__device__ __forceinline__ unsigned xb_add(unsigned* p, unsigned v) { return __hip_atomic_fetch_add(p, v, __ATOMIC_RELAXED, __HIP_MEMORY_SCOPE_AGENT); }
__device__ __forceinline__ unsigned xb_xcc_id() { return (unsigned)__builtin_amdgcn_s_getreg((3 << 11) | 20) & 0xFu; }
#define XB_SPIN(cond, bar) do { unsigned _sp = 0; while (cond) { __builtin_amdgcn_s_sleep(1); \
    if ((++_sp & 255u) == 0u) { if (xb_ld(&(bar)[XB_TMO])) break; if (_sp > XB_SPIN_CAP) { atomicAdd(&(bar)[XB_TMO], 1u); break; } } } } while (0)
struct XcdBarrier { unsigned* bar; unsigned x; volatile LAS unsigned* st; };
__device__ __forceinline__ XcdBarrier xcd_barrier_post(unsigned* bar, volatile LAS unsigned* st) {
    XcdBarrier b; b.bar = bar; b.x = xb_xcc_id(); b.st = st;
    if (threadIdx.x == 0) st[2] = xb_add(&bar[XB_XCNT(b.x)], 1u);
    return b;
}
__device__ __forceinline__ int xcd_virtual_cu(const XcdBarrier& b) {
    if (threadIdx.x == 0) { unsigned pre = 0u; for (unsigned j = 0; j < 16; ++j) { const unsigned c = xb_ld(&b.bar[XB_XCNT(j)]); pre += (j < b.x) ? c : 0u; } b.st[3] = pre + b.st[2]; }
    __syncthreads();
    const int v = (int)b.st[3];
    __syncthreads();
    return __builtin_amdgcn_readfirstlane(v);
}
__device__ __forceinline__ void xcd_barrier_complete(unsigned* bar, unsigned x, unsigned& nloc, unsigned& nx) {
    const unsigned G = gridDim.x * gridDim.y * gridDim.z;
    unsigned sum, cnt, mine, sp = 0u;
    for (;;) {
        sum = 0u; cnt = 0u; mine = 0u;
#pragma unroll
        for (unsigned j = 0; j < 16; ++j) { const unsigned c = xb_ld(&bar[XB_XCNT(j)]); sum += c; cnt += (c > 0u) ? 1u : 0u; mine = (j == x) ? c : mine; }
        if (sum == G) break;
        __builtin_amdgcn_s_sleep(1);
        if ((++sp & 255u) == 0u) { if (xb_ld(&bar[XB_TMO])) break; if (sp > XB_SPIN_CAP) { atomicAdd(&bar[XB_TMO], 1u); break; } }
    }
    nloc = mine > 0u ? mine : 1u; nx = cnt > 0u ? cnt : 1u;
}
__device__ __forceinline__ void xcd_barrier(const XcdBarrier& b) {
    asm volatile("s_waitcnt vmcnt(0)" ::: "memory");
    __syncthreads();
    if (threadIdx.x == 0) {
        unsigned* bar = b.bar;
        __builtin_amdgcn_s_waitcnt(0);
        unsigned nloc = b.st[0], nx = b.st[1];
        if (nloc == 0u) { xcd_barrier_complete(bar, b.x, nloc, nx); b.st[0] = nloc; b.st[1] = nx; }
        const unsigned old = xb_add(&bar[XB_XSUB(b.x)], 1u);
        const unsigned gen = old / nloc;
        if (old + 1u == (gen + 1u) * nloc) {
            __builtin_amdgcn_fence(__ATOMIC_RELEASE, "agent");
            asm volatile("s_waitcnt vmcnt(0)" ::: "memory");
            const unsigned og = xb_add(&bar[XB_TOP], 1u);
            const unsigned tg = og / nx;
            if (og + 1u == (tg + 1u) * nx) xb_add(&bar[XB_TOPGEN], 1u);
            else XB_SPIN(xb_ld(&bar[XB_TOPGEN]) == tg, bar);
            __builtin_amdgcn_fence(__ATOMIC_ACQUIRE, "agent");
            xb_add(&bar[XB_XGEN(b.x)], 1u);
            asm volatile("s_waitcnt vmcnt(0)" ::: "memory");
        } else {
            XB_SPIN(xb_ld(&bar[XB_XGEN(b.x)]) == gen, bar);
            __builtin_amdgcn_fence(__ATOMIC_ACQUIRE, "agent");
            asm volatile("s_waitcnt vmcnt(0)" ::: "memory");
        }
    }
    __syncthreads();
}

namespace pg8 {
constexpr int BM = 256, BK = 64, HALF = 128, HTB = HALF * BK * 2, STAGE_BYTES = 8 * HTB, KD = 2048;
__host__ __device__ __forceinline__ int lds_byte(int r, int c) { const int st = (r >> 4) * 2 + (c >> 5), rr = r & 15, cc = c & 31, ob = rr * 64 + cc * 2; return st * 1024 + (ob ^ (((ob >> 9) & 1) << 5)); }
__host__ __device__ __forceinline__ void stage_rc(int b, int& R, int& C) { const int st = b / 1024, sb = b % 1024, swz = sb ^ (((sb >> 9) & 1) << 5); R = (st >> 1) * 16 + swz / 64; C = (st & 1) * 32 + (swz % 64) / 2; }
__host__ __device__ __forceinline__ int perm32(int rho) { const int n = rho >> 4, i = rho & 15; return 8 * (i >> 2) + 4 * n + (i & 3); }
struct Unit { int pm, pn, e, rows, hs; };

struct DenseOrder {
    int nM, nN, nwg, nfull, G, c, rep = 1; bool half;
    __device__ void init(int M, int N, int G_, int c_, bool half_ = false, bool split_tail = false) { nM = M / BM; nN = N / BM; nwg = nM * nN; G = G_; c = c_; half = half_; nfull = split_tail ? (nwg / G_) * G_ : nwg; }
    __device__ bool next(int i, Unit& u) const {
        long L = (long)i * G + c; int hsel = 0;
        if (half) { if (L >= 2L * (nwg - nfull)) return false; hsel = (int)(L & 1); L = nfull + (L >> 1); }
        else { if (L >= (long)nfull * rep) return false; if (rep > 1 && L >= nfull) L -= nfull; }
        const int wgid = (int)L;
        const int nig = 8 * nN, gid = wgid / nig, fm = gid * 8, gsz = (nM - fm) < 8 ? (nM - fm) : 8;
        u.pm = fm + ((wgid % nig) % gsz); u.pn = (wgid % nig) / gsz; u.e = 0; u.hs = 0; u.rows = 256; if (half) { u.pm = 2 * u.pm + hsel; u.rows = 128; } return true;
    }
};

template <class P, bool HM = false>
__device__ __forceinline__ void gemm_run(LAS unsigned char* lds, const P& prob) {
    const int tid = threadIdx.x, wid = __builtin_amdgcn_readfirstlane(tid >> 6), lane = tid & 63, wr = wid >> 2, wc = wid & 3, fr = lane & 15, fq = lane >> 4;
    constexpr int K = KD, nt = K / BK;
    int Rr[2], Cc[2]; unsigned voffB[2];
#pragma unroll
    for (int i = 0; i < 2; ++i) { int R, C; stage_rc(tid * 16 + i * 8192, R, C); Rr[i] = R; Cc[i] = C; const int Rb = P::PERM ? ((R & ~31) + perm32(R & 31)) : R; voffB[i] = (unsigned)(Rb * K + C) * 2u; }
    constexpr size_t kstep = (size_t)(BK * 2), hstep = (size_t)HALF * K * 2;
    const unsigned ldsw = (unsigned)wid * 1024u;
    const int aoff = lds_byte(wr * 64 + fr, fq * 8), boff = lds_byte(wc * 32 + fr, fq * 8);
#define PG8_SA(b, h) (((b) * 2 + (h)) * HTB)
#define PG8_SB(b, h) ((4 + (b) * 2 + (h)) * HTB)
#define PG8_STAGE(bufoff, gbase, voff) do { _Pragma("unroll") for (int _i = 0; _i < 2; ++_i) \
        __builtin_amdgcn_global_load_lds((const unsigned*)((const char*)(gbase) + (voff)[_i]), (LAS unsigned*)(lds + (bufoff) + ldsw + _i * 8192), 16, 0, 0); } while (0)
#define PG8_LDA(dst, b, h) do { _Pragma("unroll") for (int m = 0; m < 4; ++m) _Pragma("unroll") for (int k = 0; k < 2; ++k) dst[m][k] = *(const LAS bf16x8*)(lds + PG8_SA(b, h) + aoff + m * 2048 + k * 1024); } while (0)
#define PG8_LDB(dst, b, h) do { _Pragma("unroll") for (int n = 0; n < 2; ++n) _Pragma("unroll") for (int k = 0; k < 2; ++k) dst[n][k] = *(const LAS bf16x8*)(lds + PG8_SB(b, h) + boff + n * 2048 + k * 1024); } while (0)
#define PG8_MMA(ai, bj, At, Bt) do { __builtin_amdgcn_s_setprio(1); _Pragma("unroll") for (int m = 0; m < 4; ++m) _Pragma("unroll") for (int n = 0; n < 2; ++n) _Pragma("unroll") for (int k = 0; k < 2; ++k) \
        acc[ai][bj][m][n] = __builtin_amdgcn_mfma_f32_16x16x32_bf16(Bt[n][k], At[m][k], acc[ai][bj][m][n], 0, 0, 0); __builtin_amdgcn_s_setprio(0); } while (0)
#define PG8_WAIT_V(n) asm volatile("s_waitcnt vmcnt(" #n ")" ::: "memory")
#define PG8_WAIT_L(n) asm volatile("s_waitcnt lgkmcnt(" #n ")" ::: "memory")
#define PG8_BAR __builtin_amdgcn_s_barrier()
#define PG8_SCHED __builtin_amdgcn_sched_barrier(0)
    Unit cur, nxt; int ui = 0;
    if (!prob.next(0, cur)) return;
    f32x4 acc[2][2][4][2];
#pragma unroll
    for (int a = 0; a < 2; ++a)
#pragma unroll
        for (int b = 0; b < 2; ++b)
#pragma unroll
            for (int m = 0; m < 4; ++m)
#pragma unroll
                for (int n = 0; n < 2; ++n) acc[a][b][m][n] = (f32x4){0.f, 0.f, 0.f, 0.f};
    bf16x8 At[4][2], B0[2][2], B1[2][2];
    unsigned vC0[2], vC1[2], vN0[2], vN1[2];
    prob.a_off(cur, Rr, Cc, vC0, vC1);
    const char* const Ab = prob.a_base();
    const char* cB = prob.b_base(cur);
    PG8_STAGE(PG8_SB(0, 0), cB, voffB); PG8_STAGE(PG8_SB(0, 1), cB + hstep, voffB); PG8_STAGE(PG8_SA(0, 0), Ab, vC0); if constexpr (!HM) PG8_STAGE(PG8_SA(0, 1), Ab, vC1);
    if (wr == 1) PG8_BAR;
    if constexpr (HM) PG8_WAIT_V(0); else PG8_WAIT_V(2);
    PG8_BAR;
    PG8_STAGE(PG8_SB(1, 0), cB + kstep, voffB); PG8_STAGE(PG8_SA(1, 0), Ab + kstep, vC0); PG8_STAGE(PG8_SB(1, 1), cB + hstep + kstep, voffB);
    PG8_WAIT_V(6); PG8_BAR;
    for (;;) {
        const bool has_next = prob.next(ui + 1, nxt);
        if (has_next) prob.a_off(nxt, Rr, Cc, vN0, vN1); else { vN0[0] = vC0[0]; vN0[1] = vC0[1]; vN1[0] = vC1[0]; vN1[1] = vC1[1]; }
        const char* nB = has_next ? prob.b_base(nxt) : cB;
        for (int t = 0; t < nt; t += 2) {
            const bool last = (t == nt - 2);
            const char* a1 = Ab + (size_t)(t + 1) * kstep;
            const char* a2 = last ? Ab : Ab + (size_t)(t + 2) * kstep; const char* b2 = last ? nB : cB + (size_t)(t + 2) * kstep;
            const char* a3 = a2 + kstep; const char* b3 = b2 + kstep;
            unsigned v20[2], v21[2];
            v20[0] = last ? vN0[0] : vC0[0]; v20[1] = last ? vN0[1] : vC0[1]; v21[0] = last ? vN1[0] : vC1[0]; v21[1] = last ? vN1[1] : vC1[1];
            PG8_LDB(B0, 0, 0); PG8_LDB(B1, 0, 1); PG8_SCHED; PG8_LDA(At, 0, 0); if constexpr (!HM) PG8_STAGE(PG8_SA(1, 1), a1, vC1);
            if constexpr (HM) PG8_WAIT_V(6); else PG8_WAIT_V(8); PG8_WAIT_L(0); PG8_BAR; PG8_MMA(0, 0, At, B0); PG8_MMA(0, 1, At, B1); PG8_BAR; PG8_SCHED;
            if constexpr (!HM) PG8_LDA(At, 0, 1); PG8_STAGE(PG8_SB(0, 0), b2, voffB); PG8_STAGE(PG8_SB(0, 1), b2 + hstep, voffB); PG8_STAGE(PG8_SA(0, 0), a2, v20);
            if constexpr (HM) PG8_WAIT_V(6); else PG8_WAIT_V(8);
            PG8_WAIT_L(0); PG8_BAR; if constexpr (!HM) { PG8_MMA(1, 0, At, B0); PG8_MMA(1, 1, At, B1); } PG8_BAR; PG8_SCHED;
            PG8_LDB(B0, 1, 0); PG8_LDB(B1, 1, 1); PG8_SCHED; PG8_LDA(At, 1, 0); if constexpr (!HM) PG8_STAGE(PG8_SA(0, 1), a2, v21);
            if constexpr (HM) PG8_WAIT_V(6); else PG8_WAIT_V(8); PG8_WAIT_L(0); PG8_BAR; PG8_MMA(0, 0, At, B0); PG8_MMA(0, 1, At, B1); PG8_BAR; PG8_SCHED;
            if constexpr (!HM) PG8_LDA(At, 1, 1); PG8_STAGE(PG8_SB(1, 0), b3, voffB); PG8_STAGE(PG8_SB(1, 1), b3 + hstep, voffB); PG8_STAGE(PG8_SA(1, 0), a3, v20);
            if constexpr (HM) PG8_WAIT_V(6); else PG8_WAIT_V(8);
            PG8_WAIT_L(0); PG8_BAR; if constexpr (!HM) { PG8_MMA(1, 0, At, B0); PG8_MMA(1, 1, At, B1); } PG8_BAR; PG8_SCHED;
        }
        if (wr == 0) PG8_BAR;
        prob.epi(acc, cur, wr, wc, fr, fq);
        if (!has_next) break;
#pragma unroll
        for (int a = 0; a < 2; ++a)
#pragma unroll
            for (int b = 0; b < 2; ++b)
#pragma unroll
                for (int m = 0; m < 4; ++m)
#pragma unroll
                    for (int n = 0; n < 2; ++n) acc[a][b][m][n] = (f32x4){0.f, 0.f, 0.f, 0.f};
        cur = nxt; cB = nB; ++ui; vC0[0] = vN0[0]; vC0[1] = vN0[1]; vC1[0] = vN1[0]; vC1[1] = vN1[1];
        if (wr == 1) PG8_BAR;
    }
    PG8_WAIT_V(0);
    PG8_BAR;
#undef PG8_SA
#undef PG8_SB
#undef PG8_STAGE
#undef PG8_LDA
#undef PG8_LDB
#undef PG8_MMA
#undef PG8_WAIT_V
#undef PG8_WAIT_L
#undef PG8_BAR
#undef PG8_SCHED
}

template <class P, bool HN = false>
__device__ __forceinline__ void gemm_run_bf32(LAS unsigned char* lds, const P& prob) {
    const int tid = threadIdx.x, wid = __builtin_amdgcn_readfirstlane(tid >> 6), lane = tid & 63, wr = wid >> 2, wc = wid & 3, fr = lane & 15, fq = lane >> 4;
    constexpr int K = KD, nt = K / BK;
    constexpr size_t kstep = (size_t)(BK * 2);
    constexpr size_t ldwB = (size_t)P::LDW_BYTES;
    const unsigned ldsw = (unsigned)wid * 1024u;
    const int aoff = lds_byte(wr * 64 + fr, fq * 8), boff = lds_byte(wc * 32 + fr, fq * 8);
    const int wbo0 = lds_byte(32 * (lane >> 4) + (((lane >> 1) & 1) | (((lane >> 3) & 1) << 2) | (((lane >> 2) & 1) << 3)), 8 * wid + 4 * (lane & 1));
#define PG8_SA(b, h) (((b) * 2 + (h)) * HTB)
#define PG8_SB(b, h) ((4 + (b) * 2 + (h)) * HTB)
#define PG8_STAGE(bufoff, gbase, voff) do { _Pragma("unroll") for (int _i = 0; _i < 2; ++_i) \
        __builtin_amdgcn_global_load_lds((const unsigned*)((const char*)(gbase) + (voff)[_i]), (LAS unsigned*)(lds + (bufoff) + ldsw + _i * 8192), 16, 0, 0); } while (0)
#define PG8_LDA(dst, b, h) do { _Pragma("unroll") for (int m = 0; m < 4; ++m) _Pragma("unroll") for (int k = 0; k < 2; ++k) dst[m][k] = *(const LAS bf16x8*)(lds + PG8_SA(b, h) + aoff + m * 2048 + k * 1024); } while (0)
#define PG8_LDB(dst, b, h) do { _Pragma("unroll") for (int n = 0; n < 2; ++n) _Pragma("unroll") for (int k = 0; k < 2; ++k) dst[n][k] = *(const LAS bf16x8*)(lds + PG8_SB(b, h) + boff + n * 2048 + k * 1024); } while (0)
#define PG8_MMA(ai, bj, At, Bt) do { __builtin_amdgcn_s_setprio(1); _Pragma("unroll") for (int m = 0; m < 4; ++m) _Pragma("unroll") for (int n = 0; n < 2; ++n) _Pragma("unroll") for (int k = 0; k < 2; ++k) \
        acc[ai][bj][m][n] = __builtin_amdgcn_mfma_f32_16x16x32_bf16(Bt[n][k], At[m][k], acc[ai][bj][m][n], 0, 0, 0); __builtin_amdgcn_s_setprio(0); } while (0)
#define PG8_WAIT_V(n) asm volatile("s_waitcnt vmcnt(" #n ")" ::: "memory")
#define PG8_WAIT_L(n) asm volatile("s_waitcnt lgkmcnt(" #n ")" ::: "memory")
#define PG8_BAR __builtin_amdgcn_s_barrier()
#define PG8_SCHED __builtin_amdgcn_sched_barrier(0)
#define PG8_BLOAD(kk, h) do { const bool nx_ = (kk) >= nt; const unsigned so_ = (nx_ ? nBo : cBo) + (unsigned)((nx_ ? (kk) - nt : (kk)) * BK + 8 * wid) * (unsigned)ldwB + (unsigned)(h) * (unsigned)P::HALF_BYTES; \
        const unsigned co_ = nx_ ? nCol : cCol; \
        asm volatile("s_nop 4" ::: "memory"); \
        _Pragma("unroll") for (int j_ = 0; j_ < 4; ++j_) asm volatile("buffer_load_dwordx4 %0, %1, %2, %3 offen" : "=v"(bv[j_]) : "v"(co_), "s"(wrs), "s"(so_ + (unsigned)j_ * (unsigned)ldwB) : "memory"); } while (0)
#define PG8_BWAIT(n) asm volatile("s_waitcnt vmcnt(" #n ")" : "+v"(bv[0]), "+v"(bv[1]), "+v"(bv[2]), "+v"(bv[3]) :: "memory")
#define PG8_BWRITE(b, h) do { _Pragma("unroll") for (int i_ = 0; i_ < 4; ++i_) { u32x2 o_; o_.x = cvt_pk_bf16(bv[0][i_], bv[1][i_]); o_.y = cvt_pk_bf16(bv[2][i_], bv[3][i_]); \
        *(LAS u32x2*)(lds + PG8_SB(b, h) + wbo0 + 128 * (i_ & 1) + 2048 * (i_ >> 1)) = o_; } } while (0)
    typedef float f32x2v __attribute__((ext_vector_type(2)));
    Unit cur, nxt; int ui = 0;
    if (!prob.next(0, cur)) return;
    f32x4 acc[2][2][4][2];
    bf16x8 At[4][2], B0[2][2], B1[2][2];
    f32x4 bv[4];
    unsigned vC0[2], vC1[2], vN0[2], vN1[2];
    prob.a_off(cur, vC0, vC1);
    const char* const Ab = prob.a_base();
    const __amdgpu_buffer_rsrc_t wrs = __builtin_amdgcn_make_buffer_rsrc((void*)prob.W, 0, (unsigned)NE * (unsigned)P::W_BYTES, 0x00020000);
    unsigned cBo = (unsigned)cur.e * (unsigned)P::W_BYTES, cCol = prob.b_col(cur, lane & ~1) + (unsigned)(lane & 1) * 4u * (unsigned)ldwB;
    unsigned nBo = cBo, nCol = cCol;
#define PG8_BLOADX(R, kk, h) do { const unsigned so_ = cBo + (unsigned)((kk) * BK + 8 * wid) * (unsigned)ldwB + (unsigned)(h) * (unsigned)P::HALF_BYTES; \
        _Pragma("unroll") for (int j_ = 0; j_ < 4; ++j_) asm volatile("buffer_load_dwordx4 %0, %1, %2, %3 offen" : "=v"(R[j_]) : "v"(cCol), "s"(wrs), "s"(so_ + (unsigned)j_ * (unsigned)ldwB) : "memory"); } while (0)
#define PG8_BWAITX(R, n) asm volatile("s_waitcnt vmcnt(" #n ")" : "+v"(R[0]), "+v"(R[1]), "+v"(R[2]), "+v"(R[3]) :: "memory")
#define PG8_BWRITEX(R, b, h) do { _Pragma("unroll") for (int i_ = 0; i_ < 4; ++i_) { u32x2 o_; o_.x = cvt_pk_bf16(R[0][i_], R[1][i_]); o_.y = cvt_pk_bf16(R[2][i_], R[3][i_]); \
        *(LAS u32x2*)(lds + PG8_SB(b, h) + wbo0 + 128 * (i_ & 1) + 2048 * (i_ >> 1)) = o_; } } while (0)
    { f32x4 bw[4], bx[4];
      asm volatile("s_nop 4" ::: "memory");
      PG8_BLOADX(bv, 0, 0); if constexpr (!HN) PG8_BLOADX(bw, 0, 1); PG8_BLOADX(bx, 1, 0);
      PG8_STAGE(PG8_SA(0, 0), Ab, vC0); PG8_STAGE(PG8_SA(0, 1), Ab, vC1);
      if constexpr (!HN) { PG8_BWAITX(bv, 12); PG8_BWRITEX(bv, 0, 0); PG8_BWAITX(bw, 8); PG8_BWRITEX(bw, 0, 1); }
      else { PG8_BWAITX(bv, 8); PG8_BWRITEX(bv, 0, 0); }
      PG8_BWAITX(bx, 4); PG8_BWRITEX(bx, 1, 0); }
    if constexpr (!HN) PG8_BLOAD(1, 1);
    if (wr == 1) PG8_BAR;
    if constexpr (!HN) PG8_WAIT_V(4); else PG8_WAIT_V(0);
    PG8_WAIT_L(0); PG8_BAR;
    PG8_STAGE(PG8_SA(1, 0), Ab + kstep, vC0);
    { f32x4 bini[2][2]; prob.bias_load(cur, wc, fq, bini);
#pragma unroll
      for (int a = 0; a < 2; ++a)
#pragma unroll
        for (int b = 0; b < 2; ++b)
#pragma unroll
            for (int m = 0; m < 4; ++m)
#pragma unroll
                for (int n = 0; n < 2; ++n) acc[a][b][m][n] = bini[b][n]; }
    PG8_WAIT_V(0); PG8_BAR;
    for (;;) {
        const bool has_next = prob.next(ui + 1, nxt);
        if (has_next) { prob.a_off(nxt, vN0, vN1); nBo = (unsigned)nxt.e * (unsigned)P::W_BYTES; nCol = prob.b_col(nxt, lane & ~1) + (unsigned)(lane & 1) * 4u * (unsigned)ldwB; }
        else { vN0[0] = vC0[0]; vN0[1] = vC0[1]; vN1[0] = vC1[0]; vN1[1] = vC1[1]; nBo = cBo; nCol = cCol; }
        for (int t = 0; t < nt; t += 2) {
            const bool last = (t == nt - 2);
            const char* a1 = Ab + (size_t)(t + 1) * kstep;
            const char* a2 = last ? Ab : Ab + (size_t)(t + 2) * kstep;
            const char* a3 = a2 + kstep;
            unsigned v20[2], v21[2];
            v20[0] = last ? vN0[0] : vC0[0]; v20[1] = last ? vN0[1] : vC0[1]; v21[0] = last ? vN1[0] : vC1[0]; v21[1] = last ? vN1[1] : vC1[1];
            PG8_LDB(B0, 0, 0); if constexpr (!HN) PG8_LDB(B1, 0, 1); PG8_SCHED; PG8_LDA(At, 0, 0); if constexpr (!HN) { PG8_BWAIT(2); PG8_BWRITE(1, 1); } PG8_BLOAD(t + 2, 0); PG8_STAGE(PG8_SA(1, 1), a1, vC1);
            if constexpr (HN) PG8_WAIT_V(8); else PG8_WAIT_V(12);
            PG8_WAIT_L(0); PG8_BAR; PG8_MMA(0, 0, At, B0); if constexpr (!HN) PG8_MMA(0, 1, At, B1); PG8_BAR; PG8_SCHED;
            PG8_LDA(At, 0, 1); PG8_BWAIT(2); PG8_BWRITE(0, 0); if constexpr (!HN) PG8_BLOAD(t + 2, 1); PG8_STAGE(PG8_SA(0, 0), a2, v20);
            if constexpr (HN) PG8_WAIT_V(8); else PG8_WAIT_V(12);
            PG8_WAIT_L(0); PG8_BAR; PG8_MMA(1, 0, At, B0); if constexpr (!HN) PG8_MMA(1, 1, At, B1); PG8_BAR; PG8_SCHED;
            PG8_LDB(B0, 1, 0); if constexpr (!HN) PG8_LDB(B1, 1, 1); PG8_SCHED; PG8_LDA(At, 1, 0); if constexpr (!HN) { PG8_BWAIT(2); PG8_BWRITE(0, 1); } PG8_BLOAD(t + 3, 0); PG8_STAGE(PG8_SA(0, 1), a2, v21);
            if constexpr (HN) PG8_WAIT_V(8); else PG8_WAIT_V(12);
            PG8_WAIT_L(0); PG8_BAR; PG8_MMA(0, 0, At, B0); if constexpr (!HN) PG8_MMA(0, 1, At, B1); PG8_BAR; PG8_SCHED;
            PG8_LDA(At, 1, 1); PG8_BWAIT(2); PG8_BWRITE(1, 0); if constexpr (!HN) PG8_BLOAD(t + 3, 1); PG8_STAGE(PG8_SA(1, 0), a3, v20);
            if constexpr (HN) PG8_WAIT_V(8); else PG8_WAIT_V(12);
            PG8_WAIT_L(0); PG8_BAR; PG8_MMA(1, 0, At, B0); if constexpr (!HN) PG8_MMA(1, 1, At, B1); PG8_BAR; PG8_SCHED;
        }
        if (wr == 0) PG8_BAR;
        prob.epi(acc, cur, wr, wc, fr, fq, 0);
        if (has_next) { f32x4 bini[2][2]; prob.bias_load(nxt, wc, fq, bini);
#pragma unroll
            for (int b = 0; b < 2; ++b)
#pragma unroll
                for (int m = 0; m < 4; ++m)
#pragma unroll
                    for (int n = 0; n < 2; ++n) acc[0][b][m][n] = bini[b][n]; }
        prob.epi(acc, cur, wr, wc, fr, fq, 1);
        if (!has_next) break;
#pragma unroll
        for (int b = 0; b < 2; ++b)
#pragma unroll
            for (int m = 0; m < 4; ++m)
#pragma unroll
                for (int n = 0; n < 2; ++n) acc[1][b][m][n] = acc[0][b][m][n];
        cur = nxt; cBo = nBo; cCol = nCol; ++ui; vC0[0] = vN0[0]; vC0[1] = vN0[1]; vC1[0] = vN1[0]; vC1[1] = vN1[1];
        if (wr == 1) PG8_BAR;
    }
    PG8_BWAIT(0);
    PG8_BAR;
#undef PG8_SA
#undef PG8_SB
#undef PG8_STAGE
#undef PG8_LDA
#undef PG8_LDB
#undef PG8_MMA
#undef PG8_WAIT_V
#undef PG8_WAIT_L
#undef PG8_BAR
#undef PG8_SCHED
#undef PG8_BLOAD
#undef PG8_BWAIT
#undef PG8_BWRITE
#undef PG8_BLOADX
#undef PG8_BWAITX
#undef PG8_BWRITEX
}
}

constexpr int NWAVES = 8, NTHR = 512;
constexpr int RING_BYTES = 131072;
constexpr int TAB_OFF = 147968;
constexpr int MISC_OFF = 163840 - 256;
constexpr int LDS_BYTES = 163840;

struct Frame {
    LAS unsigned char* lds; volatile LAS unsigned* MISC; unsigned* ctl;
    int tid, lane, wave, vcu, G;
    const float *x, *c, *w_ada, *b_ada, *g1, *w_in, *lq1, *lk1, *lq2, *lk2, *subln, *relb, *cw, *cb, *clg, *clb, *w_out, *g2, *w_r, *b_r, *w_gu, *b_gu, *w_d, *b_d, *fg;
    float* out; unsigned char* ws;
};
#define WSP(T_, off) ((T_*)(F.ws + (off)))

__device__ __forceinline__ void p0_transpose_item(const float* W, int ldn, int n0, int k0, bf16* dst, int drow0, LAS unsigned char* scr, int lane) {
    const int ng = lane & 31, kh = lane >> 5;
#pragma unroll
    for (int it = 0; it < 4; ++it) {
        f32x4 v[8];
#pragma unroll
        for (int j = 0; j < 8; ++j) v[j] = *(const GAS f32x4*)(W + (size_t)(k0 + 16 * it + 8 * kh + j) * ldn + n0 + 4 * ng);
        const int kc = 2 * it + kh;
#pragma unroll
        for (int i = 0; i < 4; ++i) { const int n = 4 * ng + i;
            u32x4 o; o.x = pk2(v[0][i], v[1][i]); o.y = pk2(v[2][i], v[3][i]); o.z = pk2(v[4][i], v[5][i]); o.w = pk2(v[6][i], v[7][i]);
            *(LAS u32x4*)(scr + n * 128 + ((kc ^ (ng & 7)) << 4)) = o; }
    }
    LDS_WAIT(); asm volatile("" ::: "memory");
#pragma unroll
    for (int j = 0; j < 16; ++j) { const int n = 8 * j + (lane >> 3), c = lane & 7;
        const u32x4 o = *(const LAS u32x4*)(scr + n * 128 + ((c ^ ((n >> 2) & 7)) << 4));
        *(GAS u32x4*)(dst + (size_t)(drow0 + n) * pg8::KD + k0 + 8 * c) = o; }
    LDS_WAIT(); asm volatile("" ::: "memory");
}
__device__ __forceinline__ void p0_prologue(Frame& F) {
    const int gw = F.vcu * NWAVES + F.wave, NGW = F.G * NWAVES, gt = F.vcu * NTHR + F.tid, NGT = F.G * NTHR;
    LAS float* cs = (LAS float*)(F.lds);
    for (int i = F.tid; i < NB * DM; i += NTHR) cs[i] = silu_f(F.c[i]);
    __syncthreads();
    float* modp = WSP(float, WS_MODP);
    for (int it = gw; it < 192 * 8; it += NGW) {
        const int cc = it % 192, kc = it / 192, r = F.lane >> 4, g = F.lane & 15;
        float acc[4][4];
#pragma unroll
        for (int b = 0; b < 4; ++b)
#pragma unroll
            for (int j = 0; j < 4; ++j) acc[b][j] = 0.f;
        const float* wp = F.w_ada + (size_t)(kc * 256 + r) * (6 * DM) + cc * 64 + g * 4;
#pragma unroll 8
        for (int s = 0; s < 64; ++s) {
            const f32x4 w = *(const GAS f32x4*)(wp + (size_t)(4 * s) * (6 * DM)); const int k = kc * 256 + 4 * s + r;
#pragma unroll
            for (int b = 0; b < 4; ++b) { const float cv = cs[b * DM + k];
#pragma unroll
                for (int j = 0; j < 4; ++j) acc[b][j] += cv * w[j]; }
        }
#pragma unroll
        for (int b = 0; b < 4; ++b)
#pragma unroll
            for (int j = 0; j < 4; ++j) { float v = acc[b][j]; v += __shfl_xor(v, 16); v += __shfl_xor(v, 32); acc[b][j] = v; }
        if (F.lane < 16)
#pragma unroll
            for (int b = 0; b < 4; ++b) *(GAS f32x4*)(modp + (size_t)(kc * 4 + b) * (6 * DM) + cc * 64 + g * 4) = (f32x4){acc[b][0], acc[b][1], acc[b][2], acc[b][3]};
    }
    __syncthreads();
    LAS unsigned char* scr = F.lds + F.wave * 16384;
    constexpr int I_IN = (INC / 128) * 32, I_OUT = (DM / 128) * 32;
    for (int it = gw; it < I_IN + I_OUT; it += NGW) {
        int r = it;
        if (r < I_IN) { const int nb = r >> 5, kb = r & 31;
            const int drow = nb < 24 ? nb * 128 : (nb < 32 ? 3072 + (nb - 24) * 256 : 3072 + (nb - 32) * 256 + 128);
            p0_transpose_item(F.w_in, INC, nb * 128, kb * 64, WSP(bf16, WS_WIN), drow, scr, F.lane); continue; } r -= I_IN;
        { const int nb = r >> 5, kb = r & 31; p0_transpose_item(F.w_out, DM, nb * 128, kb * 64, WSP(bf16, WS_WOUT), nb * 128, scr, F.lane); }
    }
    for (int i = gt; i < 64 * 2 * 64; i += NGT) {
        const int l = i & 63, nb = (i >> 6) & 1, s = i >> 7, e = 16 * nb + (l & 15), kb = 32 * s + 8 * (l >> 4);
        unsigned hi[8], lo[8];
#pragma unroll
        for (int j = 0; j < 8; ++j) { const float w = F.w_r[(size_t)(kb + j) * NE + e]; hi[j] = f2bf(w); lo[j] = f2bf(w - bf2f(hi[j])); }
        u32x4 oh, ol; oh.x = hi[0] | (hi[1] << 16); oh.y = hi[2] | (hi[3] << 16); oh.z = hi[4] | (hi[5] << 16); oh.w = hi[6] | (hi[7] << 16);
        ol.x = lo[0] | (lo[1] << 16); ol.y = lo[2] | (lo[3] << 16); ol.z = lo[4] | (lo[5] << 16); ol.w = lo[6] | (lo[7] << 16);
        *(GAS u32x4*)(WSP(unsigned char, WS_WRF) + (size_t)i * 16) = oh; *(GAS u32x4*)(WSP(unsigned char, WS_WRF) + 131072 + (size_t)i * 16) = ol;
    }
    float* bt = WSP(float, WS_BIAST);
    for (int i = gt; i < AH * 4096; i += NGT) { const int h = i >> 12, rel = (i & 4095) - 2048; bt[i] = F.relb[t5_bucket(rel) * AH + h] * LOG2E; }
    if (gt == 0) { float a = 0.f, b = 0.f; for (int i = 0; i < HD; ++i) { a += F.lq1[i] * F.lk1[i]; b += F.lq2[i] * F.lk2[i]; } bt[AH * 4096] = __expf(a) - __expf(b) + 0.2f; }
}

__device__ __forceinline__ void p1_norm1(Frame& F) {
    const float* modp = WSP(float, WS_MODP); float* mod = WSP(float, WS_MOD);
    for (int o = F.vcu * NTHR + F.tid; o < NB * 6 * DM; o += F.G * NTHR) { float s = F.b_ada[o % (6 * DM)];
#pragma unroll
        for (int kc = 0; kc < 8; ++kc) s += modp[(size_t)kc * (NB * 6 * DM) + o];
        mod[o] = s; }
    LAS float* gm = (LAS float*)F.lds; LAS float* sh = gm + DM;
    bf16* h = WSP(bf16, WS_H);
    for (int rb = F.vcu; rb < T / 32; rb += F.G) {
        const int b = rb / (SEQ / 32);
        __syncthreads();
        for (int k = F.tid; k < DM; k += NTHR) { float sc = F.b_ada[DM + k], sf = F.b_ada[k];
#pragma unroll
            for (int kc = 0; kc < 8; ++kc) { sc += modp[(size_t)(kc * 4 + b) * (6 * DM) + DM + k]; sf += modp[(size_t)(kc * 4 + b) * (6 * DM) + k]; }
            gm[k] = F.g1[k] * (1.f + sc); sh[k] = sf; }
        __syncthreads();
        for (int rr = F.wave; rr < 32; rr += NWAVES) {
            const int row = rb * 32 + rr;
            const GAS f32x4* xr = (const GAS f32x4*)(F.x + (size_t)row * DM) + F.lane;
            f32x4 v[8]; float s = 0.f;
#pragma unroll
            for (int j = 0; j < 8; ++j) { v[j] = xr[64 * j]; s += (v[j].x * v[j].x + v[j].y * v[j].y) + (v[j].z * v[j].z + v[j].w * v[j].w); }
            const float rstd = rsqrtf(wave_sum(s) * (1.f / DM) + EPS);
            GAS u32x2* o8 = (GAS u32x2*)(h + (size_t)row * DM) + F.lane;
#pragma unroll
            for (int j = 0; j < 8; ++j) { const int k = 4 * F.lane + 256 * j; const f32x4 g = *(const LAS f32x4*)(gm + k), s4 = *(const LAS f32x4*)(sh + k);
                u32x2 w; w.x = pk2(v[j].x * rstd * g.x + s4.x, v[j].y * rstd * g.y + s4.y); w.y = pk2(v[j].z * rstd * g.z + s4.z, v[j].w * rstd * g.w + s4.w); st_wt8(o8 + 64 * j, w); }
        }
    }
}

template <bool HMT> struct InProjT {
    static constexpr bool PERM = true;
    const bf16* A; const bf16* Bt; bf16* O; pg8::DenseOrder ord;
    __device__ bool next(int i, pg8::Unit& u) const { return ord.next(i, u); }
    __device__ const char* a_base() const { return (const char*)A; }
    __device__ void a_off(const pg8::Unit& u, const int (&R)[2], const int (&C)[2], unsigned (&v0)[2], unsigned (&v1)[2]) const {
#pragma unroll
        for (int i = 0; i < 2; ++i) { v0[i] = (unsigned)((u.pm * u.rows + R[i]) * pg8::KD + C[i]) * 2u; v1[i] = (unsigned)((u.pm * u.rows + 128 + R[i]) * pg8::KD + C[i]) * 2u; } }
    __device__ const char* b_base(const pg8::Unit& u) const { return (const char*)(Bt + (size_t)u.pn * 256 * pg8::KD); }
    __device__ void epi(const f32x4 (&acc)[2][2][4][2], const pg8::Unit& u, int wr, int wc, int fr, int fq) const {
        const int row0 = u.pm * u.rows + wr * 64 + fr, col0 = u.pn * 256 + wc * 32 + 8 * fq;
        if (u.pn >= 12) {
            const int zc = 3072 + (u.pn - 12) * 128 + wc * 32 + 8 * fq;
#pragma unroll
            for (int ai = 0; ai < (HMT ? 1 : 2); ++ai)
#pragma unroll
                for (int m = 0; m < 4; ++m) { float r[8];
#pragma unroll
                    for (int n = 0; n < 2; ++n)
#pragma unroll
                        for (int j = 0; j < 4; ++j) r[4 * n + j] = acc[ai][0][m][n][j] * __builtin_amdgcn_rcpf(1.f + __builtin_amdgcn_exp2f(-LOG2E * acc[ai][1][m][n][j]));
                    u32x4 w; w.x = cvt_pk_bf16(r[0], r[1]); w.y = cvt_pk_bf16(r[2], r[3]); w.z = cvt_pk_bf16(r[4], r[5]); w.w = cvt_pk_bf16(r[6], r[7]);
                    *(GAS u32x4*)(O + (size_t)(row0 + ai * 128 + m * 16) * INC + zc) = w; }
            return; }
#pragma unroll
        for (int ai = 0; ai < (HMT ? 1 : 2); ++ai)
#pragma unroll
            for (int m = 0; m < 4; ++m) { bf16* rowp = O + (size_t)(row0 + ai * 128 + m * 16) * INC + col0;
#pragma unroll
                for (int bj = 0; bj < 2; ++bj) { const f32x4 v0 = acc[ai][bj][m][0], v1 = acc[ai][bj][m][1];
                    u32x4 w; w.x = cvt_pk_bf16(v0[0], v0[1]); w.y = cvt_pk_bf16(v0[2], v0[3]); w.z = cvt_pk_bf16(v1[0], v1[1]); w.w = cvt_pk_bf16(v1[2], v1[3]);
                    *(GAS u32x4*)(rowp + bj * 128) = w; } }
    }
};
struct OutProj {
    static constexpr bool PERM = true;
    const bf16* A; const bf16* Bt; const float* x; const float* mod; bf16* O; pg8::DenseOrder ord;
    __device__ bool next(int i, pg8::Unit& u) const { return ord.next(i, u); }
    __device__ const char* a_base() const { return (const char*)A; }
    __device__ void a_off(const pg8::Unit& u, const int (&R)[2], const int (&C)[2], unsigned (&v0)[2], unsigned (&v1)[2]) const {
#pragma unroll
        for (int i = 0; i < 2; ++i) { v0[i] = (unsigned)((u.pm * 256 + R[i]) * pg8::KD + C[i]) * 2u; v1[i] = (unsigned)((u.pm * 256 + 128 + R[i]) * pg8::KD + C[i]) * 2u; } }
    __device__ const char* b_base(const pg8::Unit& u) const { return (const char*)(Bt + (size_t)u.pn * 256 * pg8::KD); }
    __device__ void epi(const f32x4 (&acc)[2][2][4][2], const pg8::Unit& u, int wr, int wc, int fr, int fq) const {
        const int row0 = u.pm * 256 + wr * 64 + fr, col0 = u.pn * 256 + wc * 32 + 8 * fq, b = (u.pm * 256) / SEQ;
        f32x4 gt[2][2];
#pragma unroll
        for (int bj = 0; bj < 2; ++bj)
#pragma unroll
            for (int n = 0; n < 2; ++n) gt[bj][n] = *(const GAS f32x4*)(mod + (size_t)b * 6 * DM + 2 * DM + col0 + bj * 128 + 4 * n);
#pragma unroll
        for (int ai = 0; ai < 2; ++ai)
#pragma unroll
            for (int m = 0; m < 4; ++m) { const size_t ro = (size_t)(row0 + ai * 128 + m * 16) * DM + col0;
#pragma unroll
                for (int bj = 0; bj < 2; ++bj) { const f32x4 x0 = *(const GAS f32x4*)(x + ro + bj * 128), x1v = *(const GAS f32x4*)(x + ro + bj * 128 + 4);
                    const f32x4 v0 = x0 + gt[bj][0] * acc[ai][bj][m][0], v1 = x1v + gt[bj][1] * acc[ai][bj][m][1];
                    u32x4 w; w.x = cvt_pk_bf16(v0[0], v0[1]); w.y = cvt_pk_bf16(v0[2], v0[3]); w.z = cvt_pk_bf16(v1[0], v1[1]); w.w = cvt_pk_bf16(v1[2], v1[3]);
                    *(GAS u32x4*)(O + ro + bj * 128) = w; } }
    }
};
struct MoeTab { const LAS int* tp; const LAS int* off; const LAS int* cnt; };
__device__ __forceinline__ void moe_tables(Frame& F) {
    LAS int* tab = (LAS int*)(F.lds + TAB_OFF);
    __syncthreads();
    if (F.tid < 64) {
        const int e = F.lane & 31;
        const int c = (int)__hip_atomic_load(F.ctl + CW_CNT + e * CNT_STRIDE, __ATOMIC_RELAXED, __HIP_MEMORY_SCOPE_AGENT);
        const int t0 = (c + 255) >> 8; int t = t0, o = c;
#pragma unroll
        for (int d = 1; d < 32; d <<= 1) { const int t2 = __shfl_up(t, d, 32), o2 = __shfl_up(o, d, 32); if (e >= d) { t += t2; o += o2; } }
        if (F.lane < NE) { tab[e] = t - t0; tab[40 + e] = o - c; tab[80 + e] = c; }
        if (F.lane == NE - 1) { tab[NE] = t; tab[40 + NE] = o; }
    }
    __syncthreads();
}
template <int NTN, int REPF, int SPLIT>
__device__ __forceinline__ bool moe_next(const MoeTab& tb, int G, int c, int i, pg8::Unit& u) {
    int L = i * G + c; const int total = NTN * __builtin_amdgcn_readfirstlane(tb.tp[NE]); int hs = 0;
    if (SPLIT != 0) {
        const int nrem = total % G, nful = (2 * nrem <= G) ? total - nrem : total;
        if (SPLIT == 1) { if (L >= nful) return false; }
        else { if (L >= 2 * (total - nful)) return false; hs = L & 1; L = nful + (L >> 1); }
    } else { if (L >= total * REPF) return false; if (REPF > 1 && L >= total) L -= total; }
    int e = 0;
#pragma unroll
    for (int j = 1; j < NE; ++j) e += (L >= NTN * tb.tp[j]) ? 1 : 0;
    e = __builtin_amdgcn_readfirstlane(e);
    const int tpe = __builtin_amdgcn_readfirstlane(tb.tp[e]), tpe1 = __builtin_amdgcn_readfirstlane(tb.tp[e + 1]);
    const int local = L - NTN * tpe, nte = tpe1 - tpe;
    u.e = e; u.hs = hs; u.pn = __builtin_amdgcn_readfirstlane(local / nte); u.pm = local - u.pn * nte; u.rows = __builtin_amdgcn_readfirstlane(tb.cnt[e]) - 256 * u.pm; return true;
}
struct MoeGU {
    static constexpr bool PERM = true;
    const bf16* A; const float* W; const float* bias; const int* list; bf16* O; MoeTab tb; int G, c;
    __device__ bool next(int i, pg8::Unit& u) const { return moe_next<16, 1 + ((REP_MASK >> 11) & 1), 0>(tb, G, c, i, u); }
    __device__ const char* a_base() const { return (const char*)A; }
    __device__ void a_off(const pg8::Unit& u, unsigned (&v0)[2], unsigned (&v1)[2]) const {
        const int* lp = list + u.e * T + 256 * u.pm;
        int tb16 = (int)threadIdx.x * 16; asm volatile("" : "+v"(tb16));
#pragma unroll
        for (int i = 0; i < 2; ++i) { int R, C; pg8::stage_rc(tb16 + i * 8192, R, C);
            const int r0 = R < u.rows ? R : u.rows - 1, r1 = (128 + R) < u.rows ? (128 + R) : u.rows - 1;
            v0[i] = (unsigned)(lp[r0] * pg8::KD + C) * 2u; v1[i] = (unsigned)(lp[r1] * pg8::KD + C) * 2u; } }
    __device__ void bias_load(const pg8::Unit& u, int wc, int fq, f32x4 (&bi)[2][2]) const {
        int cb = wc * 32 + 8 * ((fq >> 1) + 2 * (fq & 1)); asm volatile("" : "+v"(cb));
        const float* bp = bias + (size_t)u.e * 2 * DFF + u.pn * 128 + cb;
#pragma unroll
        for (int bj = 0; bj < 2; ++bj)
            { const f32x4 t0 = *(const GAS f32x4*)(bp + bj * DFF), t1 = *(const GAS f32x4*)(bp + bj * DFF + 4); bi[bj][0] = (f32x4){t0[0], t1[0], t0[1], t1[1]}; bi[bj][1] = (f32x4){t0[2], t1[2], t0[3], t1[3]}; } }
    static constexpr int LDW_BYTES = 2 * DFF * 4, W_BYTES = DM * 2 * DFF * 4;
    __device__ const char* b_ptr(const pg8::Unit& u) const { return (const char*)(W + (size_t)u.e * DM * 2 * DFF); }
    static constexpr int HALF_BYTES = DFF * 4;
    __device__ unsigned b_col(const pg8::Unit& u, int lane) const { return (unsigned)(u.pn * 128 + 2 * lane) * 4u; }
    __device__ void epi(const f32x4 (&acc)[2][2][4][2], const pg8::Unit& u, int wr, int wc, int fr, int fq, const int ai) const {
        int rt0 = wr * 64 + fr, colt = u.pn * 128 + wc * 32 + 8 * ((fq >> 1) + 2 * (fq & 1)); asm volatile("" : "+v"(rt0), "+v"(colt)); const size_t slot0 = (size_t)__builtin_amdgcn_readfirstlane(tb.off[u.e]) + 256 * u.pm;
#pragma unroll
            for (int m = 0; m < 4; ++m) { const int rt = rt0 + ai * 128 + m * 16; float r[8];
#pragma unroll
                for (int n = 0; n < 2; ++n)
#pragma unroll
                    for (int j = 0; j < 4; ++j) { const int o = (j >> 1) + 2 * n + 4 * (j & 1);
                        float g = acc[ai][0][m][n][j], up = acc[ai][1][m][n][j];
                        g = fminf(g, 7.f); up = fminf(fmaxf(up, -7.f), 7.f);
                        r[o] = (up + 1.f) * g * __builtin_amdgcn_rcpf(1.f + __builtin_amdgcn_exp2f(-1.702f * LOG2E * g)); }
                if (rt < u.rows) { u32x4 w; w.x = cvt_pk_bf16(r[0], r[1]); w.y = cvt_pk_bf16(r[2], r[3]); w.z = cvt_pk_bf16(r[4], r[5]); w.w = cvt_pk_bf16(r[6], r[7]);
                    *(GAS u32x4*)(O + (slot0 + rt) * DFF + colt) = w; } }
    }
};
template <int SPLIT> struct MoeDownT {
    static constexpr bool PERM = true;
    const bf16* A; const float* W; const float* bias; const float* sw; bf16* O; MoeTab tb; int G, c;
    __device__ bool next(int i, pg8::Unit& u) const { return moe_next<8, 1 + ((REP_MASK >> 12) & 1), SPLIT>(tb, G, c, i, u); }
    __device__ const char* a_base() const { return (const char*)A; }
    __device__ void a_off(const pg8::Unit& u, unsigned (&v0)[2], unsigned (&v1)[2]) const {
        const int s0 = __builtin_amdgcn_readfirstlane(tb.off[u.e]) + 256 * u.pm;
        int tb16 = (int)threadIdx.x * 16; asm volatile("" : "+v"(tb16));
#pragma unroll
        for (int i = 0; i < 2; ++i) { int R, C; pg8::stage_rc(tb16 + i * 8192, R, C);
            v0[i] = (unsigned)((s0 + R) * pg8::KD + C) * 2u; v1[i] = (unsigned)((s0 + 128 + R) * pg8::KD + C) * 2u; } }
    __device__ void bias_load(const pg8::Unit& u, int wc, int fq, f32x4 (&bi)[2][2]) const {
        int cb = wc * 32 + 8 * ((fq >> 1) + 2 * (fq & 1)); asm volatile("" : "+v"(cb));
        const float* bp = bias + (size_t)u.e * DM + u.pn * 256 + u.hs * 128 + cb;
#pragma unroll
        for (int bj = 0; bj < (SPLIT == 2 ? 1 : 2); ++bj)
            { const f32x4 t0 = *(const GAS f32x4*)(bp + bj * 128), t1 = *(const GAS f32x4*)(bp + bj * 128 + 4); bi[bj][0] = (f32x4){t0[0], t1[0], t0[1], t1[1]}; bi[bj][1] = (f32x4){t0[2], t1[2], t0[3], t1[3]}; } }
    static constexpr int LDW_BYTES = DM * 4, W_BYTES = DFF * DM * 4;
    __device__ const char* b_ptr(const pg8::Unit& u) const { return (const char*)(W + (size_t)u.e * DFF * DM); }
    static constexpr int HALF_BYTES = 128 * 4;
    __device__ unsigned b_col(const pg8::Unit& u, int lane) const { return (unsigned)(u.pn * 256 + u.hs * 128 + 2 * lane) * 4u; }
    __device__ void epi(const f32x4 (&acc)[2][2][4][2], const pg8::Unit& u, int wr, int wc, int fr, int fq, const int ai) const {
        int rt0 = wr * 64 + fr, col0 = u.pn * 256 + u.hs * 128 + wc * 32 + 8 * ((fq >> 1) + 2 * (fq & 1)); asm volatile("" : "+v"(rt0), "+v"(col0)); const size_t slot0 = (size_t)__builtin_amdgcn_readfirstlane(tb.off[u.e]) + 256 * u.pm;
#pragma unroll
            for (int m = 0; m < 4; ++m) { const int rt = rt0 + ai * 128 + m * 16;
                if (rt < u.rows) { const float wgt = sw[(size_t)u.e * T + 256 * u.pm + rt]; bf16* rowp = O + (slot0 + rt) * DM + col0;
#pragma unroll
                    for (int bj = 0; bj < (SPLIT == 2 ? 1 : 2); ++bj) { float r[8];
#pragma unroll
                        for (int n = 0; n < 2; ++n)
#pragma unroll
                            for (int j = 0; j < 4; ++j) { const int o = (j >> 1) + 2 * n + 4 * (j & 1); r[o] = acc[ai][bj][m][n][j] * wgt; }
                        u32x4 w; w.x = cvt_pk_bf16(r[0], r[1]); w.y = cvt_pk_bf16(r[2], r[3]); w.z = cvt_pk_bf16(r[4], r[5]); w.w = cvt_pk_bf16(r[6], r[7]);
                        *(GAS u32x4*)(rowp + bj * 128) = w; } } }
    }
};

__device__ __forceinline__ void conv_unit(Frame& F, int ct) {
    const int b = ct / (SEQ / 32), s0 = (ct % (SEQ / 32)) * 32, tid = F.tid;
    const bf16* proj = WSP(bf16, WS_PROJ); bf16* mix = WSP(bf16, WS_MIX);
    LAS unsigned* z = (LAS unsigned*)F.lds;
    LAS float* st = (LAS float*)(F.lds + 126976);
    __syncthreads();
#pragma unroll 8
    for (int r = 0; r < 62; ++r) { const int s = s0 - 15 + r; const bool ok = (s >= 0 && s < SEQ); const int sc = ok ? s : 0;
        const unsigned zz = *(const GAS unsigned*)(proj + (size_t)(b * SEQ + sc) * INC + 3072 + 2 * tid);
        z[r * 512 + tid] = ok ? zz : 0u; }
    typedef float f32x2c __attribute__((ext_vector_type(2)));
    float w0[CK], w1[CK];
#pragma unroll
    for (int j = 0; j < CK; ++j) { const f32x2c w = *(const GAS f32x2c*)(F.cw + j * CCH + 2 * tid); w0[j] = w.x; w1[j] = w.y; }
    const f32x2c cbv = *(const GAS f32x2c*)(F.cb + 2 * tid), lg = *(const GAS f32x2c*)(F.clg + 2 * tid), lb = *(const GAS f32x2c*)(F.clb + 2 * tid);
    __syncthreads();
#pragma unroll 1
    for (int hf = 0; hf < 2; ++hf) {
        float c0[16], c1[16];
#pragma unroll
        for (int g = 0; g < 4; ++g) {
            float zl[34], zh[34];
#pragma unroll
            for (int r = 0; r < 34; ++r) { const unsigned zz = z[(16 * hf + 4 * g + r) * 512 + tid]; zl[r] = __builtin_bit_cast(float, zz << 16); zh[r] = __builtin_bit_cast(float, zz & 0xffff0000u); }
#pragma unroll
            for (int t = 0; t < 4; ++t) { float a0 = cbv.x, a1 = cbv.y;
#pragma unroll
                for (int j = 0; j < CK; ++j) { a0 = fmaf(w0[j], zl[t + j], a0); a1 = fmaf(w1[j], zh[t + j], a1); }
                c0[4 * g + t] = a0; c1[4 * g + t] = a1; }
        }
#pragma unroll
        for (int t = 0; t < 16; ++t) { const float sm = wave_sum(c0[t] + c1[t]), q = wave_sum(c0[t] * c0[t] + c1[t] * c1[t]);
            if (F.lane == 0) { st[(F.wave * 16 + t) * 2] = sm; st[(F.wave * 16 + t) * 2 + 1] = q; } }
        __syncthreads();
        if (tid < 16) { float sm = 0.f, q = 0.f;
#pragma unroll
            for (int w = 0; w < 8; ++w) { sm += st[(w * 16 + tid) * 2]; q += st[(w * 16 + tid) * 2 + 1]; }
            const float mu = sm * (1.f / CCH), var = q * (1.f / CCH) - mu * mu; st[512 + tid * 2] = mu; st[512 + tid * 2 + 1] = rsqrtf(fmaxf(var, 0.f) + EPS); }
        __syncthreads();
#pragma unroll
        for (int t = 0; t < 16; ++t) { const float mu = st[512 + t * 2], rs = st[512 + t * 2 + 1];
            const float y0 = (c0[t] - mu) * rs * lg.x + lb.x, y1 = (c1[t] - mu) * rs * lg.y + lb.y;
            const float o0 = y0 * __builtin_amdgcn_rcpf(1.f + __builtin_amdgcn_exp2f(-LOG2E * y0)), o1 = y1 * __builtin_amdgcn_rcpf(1.f + __builtin_amdgcn_exp2f(-LOG2E * y1));
            *(GAS unsigned*)(mix + (size_t)(b * SEQ + s0 + 16 * hf + t) * DM + 1024 + 2 * tid) = cvt_pk_bf16(o0, o1); }
        __syncthreads();
    }
}

namespace att {
constexpr int KVBLK = 64; constexpr size_t SHM_V = KVBLK * 128 * 2, SHM_K = KVBLK * 128 * 2;
constexpr float C = 0.125f * LOG2E, THR2 = 8.f * LOG2E;
#define KSWZ(row, colB) ((row) * 256 + ((colB) ^ (((row) & 7) << 4)))
#define SBAR() __builtin_amdgcn_sched_barrier(0)
__device__ __forceinline__ int crow(int r, int hi) { return (r & 3) + 8 * (r >> 2) + 4 * hi; }
__device__ __forceinline__ int v_st(int k, int c) { const int kk = (k & ~0xC) | ((k & 4) << 1) | ((k & 8) >> 1); return ((kk >> 3) * 4 + (c >> 5)) * 512 + ((kk & 7) * 32 + (c & 31)) * 2; }
__device__ __forceinline__ int v_rd_base(int lane) { return ((lane & 3) << 3) | (((lane >> 2) & 3) << 6) | (((lane >> 4) & 1) << 5) | (((lane >> 5) & 1) << 8); }
constexpr int v_rd_off(int d0, int ks, int half) { return d0 * 512 + ks * 4096 + half * 2048; }
template <int OFF> __device__ __forceinline__ s16x4 tr_read(int vb) { s16x4 r; asm volatile("ds_read_b64_tr_b16 %0, %1 offset:%2" : "=&v"(r) : "v"(vb), "i"(OFF) : "memory"); return r; }
template <int D0> __device__ __forceinline__ void pv_one(f32x16& od, int vb, bf16x8 pa0, bf16x8 pa1, bf16x8 pa2, bf16x8 pa3) {
    const s16x4 l0 = tr_read<v_rd_off(D0, 0, 0)>(vb), h0 = tr_read<v_rd_off(D0, 0, 1)>(vb), l1 = tr_read<v_rd_off(D0, 1, 0)>(vb), h1 = tr_read<v_rd_off(D0, 1, 1)>(vb);
    const s16x4 l2 = tr_read<v_rd_off(D0, 2, 0)>(vb), h2 = tr_read<v_rd_off(D0, 2, 1)>(vb), l3 = tr_read<v_rd_off(D0, 3, 0)>(vb), h3 = tr_read<v_rd_off(D0, 3, 1)>(vb);
    asm volatile("s_waitcnt lgkmcnt(0)" ::: "memory"); SBAR();
#define PK(L, H) (bf16x8){L[0], L[1], L[2], L[3], H[0], H[1], H[2], H[3]}
    od = __builtin_amdgcn_mfma_f32_32x32x16_bf16(pa0, PK(l0, h0), od, 0, 0, 0);
    od = __builtin_amdgcn_mfma_f32_32x32x16_bf16(pa1, PK(l1, h1), od, 0, 0, 0);
    od = __builtin_amdgcn_mfma_f32_32x32x16_bf16(pa2, PK(l2, h2), od, 0, 0, 0);
    od = __builtin_amdgcn_mfma_f32_32x32x16_bf16(pa3, PK(l3, h3), od, 0, 0, 0);
#undef PK
}
__device__ __forceinline__ void pv_d0(f32x16* o, int vb, bf16x8 pa0, bf16x8 pa1, bf16x8 pa2, bf16x8 pa3) {
    pv_one<0>(o[0], vb, pa0, pa1, pa2, pa3); pv_one<1>(o[1], vb, pa0, pa1, pa2, pa3); pv_one<2>(o[2], vb, pa0, pa1, pa2, pa3); pv_one<3>(o[3], vb, pa0, pa1, pa2, pa3);
}
__device__ __forceinline__ void qkt(f32x16& p0, f32x16& p1, const LAS char* Ks, const bf16x8* qr, int r32, int hi, int map) {
    p0 = f32x16{}; p1 = f32x16{};
#pragma unroll
    for (int d0 = 0; d0 < 4; ++d0) { const int cb = ((map * 4 + d0) * 16 + hi * 8) * 2;
        const bf16x8 b0 = *(const LAS bf16x8*)(Ks + KSWZ(r32, cb)); const bf16x8 b1 = *(const LAS bf16x8*)(Ks + KSWZ(32 + r32, cb));
        p0 = __builtin_amdgcn_mfma_f32_32x32x16_bf16(b0, qr[d0], p0, 0, 0, 0);
        p1 = __builtin_amdgcn_mfma_f32_32x32x16_bf16(b1, qr[d0], p1, 0, 0, 0); }
}
__device__ __forceinline__ void partialSM(f32x16& p0, f32x16& p1, float& m_reg, float& mn, float& alpha, int relw, int relb, int hi, const LAS float* btab, float bneg, float bpos) {
    if (relw - 31 >= 91 || relw + 63 <= -91) {
        const float bc = (relw > 0) ? bpos : bneg;
        float pmax = p0[0];
#pragma unroll
        for (int r = 1; r < 16; ++r) pmax = fmaxf(pmax, p0[r]);
#pragma unroll
        for (int r = 0; r < 16; ++r) pmax = fmaxf(pmax, p1[r]);
        { auto rr = __builtin_amdgcn_permlane32_swap(__float_as_uint(pmax), __float_as_uint(pmax), false, false); pmax = fmaxf(__uint_as_float(rr[0]), __uint_as_float(rr[1])); }
        const float tmax = fmaf(pmax, C, bc);
        if (__builtin_expect(__all(tmax - m_reg <= THR2), 1)) { mn = m_reg; alpha = 1.f; }
        else { mn = fmaxf(m_reg, tmax); alpha = __builtin_amdgcn_exp2f(m_reg - mn); m_reg = mn; }
        const float off = bc - mn;
#pragma unroll
        for (int r = 0; r < 16; ++r) p0[r] = fmaf(p0[r], C, off);
#pragma unroll
        for (int r = 0; r < 16; ++r) p1[r] = fmaf(p1[r], C, off);
    } else {
#pragma unroll
        for (int r = 0; r < 16; ++r) { const int idx = relb + crow(r, hi) + 256; p0[r] = fmaf(p0[r], C, btab[idx]); p1[r] = fmaf(p1[r], C, btab[idx + 32]); }
        float pmax = p0[0];
#pragma unroll
        for (int r = 1; r < 16; ++r) pmax = fmaxf(pmax, p0[r]);
#pragma unroll
        for (int r = 0; r < 16; ++r) pmax = fmaxf(pmax, p1[r]);
        { auto rr = __builtin_amdgcn_permlane32_swap(__float_as_uint(pmax), __float_as_uint(pmax), false, false); pmax = fmaxf(__uint_as_float(rr[0]), __uint_as_float(rr[1])); }
        if (__builtin_expect(__all(pmax - m_reg <= THR2), 1)) { mn = m_reg; alpha = 1.f; }
        else { mn = fmaxf(m_reg, pmax); alpha = __builtin_amdgcn_exp2f(m_reg - mn); m_reg = mn; }
#pragma unroll
        for (int r = 0; r < 16; ++r) p0[r] -= mn;
#pragma unroll
        for (int r = 0; r < 16; ++r) p1[r] -= mn;
    }
#pragma unroll
    for (int r = 0; r < 16; ++r) p0[r] = __builtin_amdgcn_exp2f(p0[r]);
}
__device__ __forceinline__ void finishSM(f32x16& p0, f32x16& p1, float alpha, float& l_reg, bf16x8& pa0, bf16x8& pa1, bf16x8& pa2, bf16x8& pa3) {
#pragma unroll
    for (int r = 0; r < 16; ++r) p1[r] = __builtin_amdgcn_exp2f(p1[r]);
    float ps = 0;
#pragma unroll
    for (int r = 0; r < 16; ++r) ps += p0[r];
#pragma unroll
    for (int r = 0; r < 16; ++r) ps += p1[r];
    { auto rr = __builtin_amdgcn_permlane32_swap(__float_as_uint(ps), __float_as_uint(ps), false, false); ps = __uint_as_float(rr[0]) + __uint_as_float(rr[1]); }
    l_reg = l_reg * alpha + ps;
#define PK4(P, BASE, OUT) do { unsigned a0 = cvt_pk_bf16(P[BASE + 0], P[BASE + 1]), a1 = cvt_pk_bf16(P[BASE + 2], P[BASE + 3]);   \
    unsigned b0 = cvt_pk_bf16(P[BASE + 4], P[BASE + 5]), b1 = cvt_pk_bf16(P[BASE + 6], P[BASE + 7]);                              \
    auto r0 = __builtin_amdgcn_permlane32_swap(a0, b0, false, false); auto r1 = __builtin_amdgcn_permlane32_swap(a1, b1, false, false); \
    u32x4 w = {r0[0], r1[0], r0[1], r1[1]}; OUT = __builtin_bit_cast(bf16x8, w); } while (0)
    PK4(p0, 0, pa0); PK4(p0, 8, pa1); PK4(p1, 0, pa2); PK4(p1, 8, pa3);
#undef PK4
}
constexpr int L_V = 0, L_K = 32768, L_WS = 65536, L_BT = 67584, L_CB = 69632;
__device__ __forceinline__ void attn_unit(Frame& F, int unit) {
    const int bh = unit >> 4, qb = unit & 15, b = bh >> 3, h = bh & 7, q0 = qb * 128;
    const int tid = F.tid, wid = F.wave, lane = F.lane, r32 = lane & 31, hi = lane >> 5, rg = wid & 3, map = wid >> 2;
    const bf16* proj = WSP(bf16, WS_PROJ);
    const bf16* Kh = proj + (size_t)(b * SEQ) * INC + 1024 + h * 128; const bf16* Vh = proj + (size_t)(b * SEQ) * INC + 2048 + h * 128;
    LAS char* lds = (LAS char*)F.lds; LAS char* V_lds = lds + L_V; LAS char* K_lds = lds + L_K;
    LAS float* wsf = (LAS float*)(lds + L_WS) + wid * 64; LAS float* li_l = wsf; LAS float* al_l = wsf + 32;
    LAS float* btab = (LAS float*)(lds + L_BT);
    const float* bt = WSP(float, WS_BIAST) + h * 4096;
    __syncthreads();
    btab[tid] = bt[2048 - 256 + tid];
    const float bneg = bt[2048 - 200], bpos = bt[2048 + 200], lam = WSP(float, WS_BIAST)[AH * 4096];
    float m_reg = -1e30f, l_reg = 0; f32x16 o[4] = {}; bf16x8 qr[4];
    const int qw0 = q0 + 32 * rg;
    const bf16* Qw = proj + (size_t)(b * SEQ + qw0 + r32) * INC + h * 128 + map * 64 + hi * 8;
#pragma unroll
    for (int d0 = 0; d0 < 4; ++d0) qr[d0] = *(const GAS bf16x8*)(Qw + d0 * 16);
    const int sr = tid >> 4, sc = (tid & 15) * 8, vst0 = v_st(sr, sc), vst1 = v_st(32 + sr, sc);
    const int vb0 = (int)(uintptr_t)V_lds + v_rd_base(lane);
    struct { bf16x8 vs0, vs1, ks0, ks1; } sr_[2];
#define SLOAD(i, k0) do { sr_[i].vs0 = *(const GAS bf16x8*)&Vh[(size_t)((k0) + sr) * INC + sc]; sr_[i].vs1 = *(const GAS bf16x8*)&Vh[(size_t)((k0) + 32 + sr) * INC + sc]; \
    sr_[i].ks0 = *(const GAS bf16x8*)&Kh[(size_t)((k0) + sr) * INC + sc]; sr_[i].ks1 = *(const GAS bf16x8*)&Kh[(size_t)((k0) + 32 + sr) * INC + sc]; } while (0)
#define SWRITE(bb, i) do { *(LAS bf16x8*)(V_lds + (bb) * SHM_V + vst0) = sr_[i].vs0; *(LAS bf16x8*)(V_lds + (bb) * SHM_V + vst1) = sr_[i].vs1; const int kc = sc * 2; \
    *(LAS bf16x8*)(K_lds + (bb) * SHM_K + KSWZ(sr, kc)) = sr_[i].ks0; *(LAS bf16x8*)(K_lds + (bb) * SHM_K + KSWZ(32 + sr, kc)) = sr_[i].ks1; } while (0)
#define SWAIT() asm volatile("s_waitcnt vmcnt(4)" ::: "memory")
#define RESC(a) do { if (__any((a) < 1.f)) { if (hi == 0) al_l[r32] = (a); asm volatile("s_waitcnt lgkmcnt(0)" ::: "memory"); \
    _Pragma("unroll") for (int d = 0; d < 4; ++d) _Pragma("unroll") for (int r = 0; r < 16; ++r) o[d][r] *= al_l[crow(r, hi)]; } } while (0)
#define PSM(P0, P1, MN, AL, k0) partialSM(P0, P1, m_reg, MN, AL, (k0) - qw0, (k0) - qw0 - r32, hi, btab, bneg, bpos)
    f32x16 pA0, pA1, pB0, pB1; float mnA, mnB, alA, alB; bf16x8 pa0, pa1, pa2, pa3; constexpr int NT = SEQ / KVBLK;
    constexpr int SE = 0, SO = 1;
    SLOAD(SE, 0); asm volatile("s_waitcnt vmcnt(0)" ::: "memory"); SWRITE(0, SE); __syncthreads();
    qkt(pA0, pA1, K_lds, qr, r32, hi, map); PSM(pA0, pA1, mnA, alA, 0);
    SLOAD(SO, KVBLK); SLOAD(SE, 2 * KVBLK);
    SWAIT(); SWRITE(1, SO); __syncthreads();
    for (int j = 1; j + 1 < NT; j += 2) {
        SBAR(); qkt(pB0, pB1, K_lds + SHM_K, qr, r32, hi, map);
        finishSM(pA0, pA1, alA, l_reg, pa0, pa1, pa2, pa3); SBAR();
        SLOAD(SO, (j + 2) * KVBLK); SBAR();
        pv_d0(o, vb0, pa0, pa1, pa2, pa3); PSM(pB0, pB1, mnB, alB, j * KVBLK);
        __syncthreads(); SWAIT(); SWRITE(0, SE);
        RESC(alB); __syncthreads();
        SBAR(); qkt(pA0, pA1, K_lds, qr, r32, hi, map);
        finishSM(pB0, pB1, alB, l_reg, pa0, pa1, pa2, pa3); SBAR();
        if (j + 3 < NT) SLOAD(SE, (j + 3) * KVBLK); SBAR();
        pv_d0(o, vb0 + (int)SHM_V, pa0, pa1, pa2, pa3); PSM(pA0, pA1, mnA, alA, (j + 1) * KVBLK);
        __syncthreads(); SWAIT(); SWRITE(1, SO);
        RESC(alA); __syncthreads();
    }
    SBAR(); qkt(pB0, pB1, K_lds + SHM_K, qr, r32, hi, map);
    finishSM(pA0, pA1, alA, l_reg, pa0, pa1, pa2, pa3); SBAR();
    pv_d0(o, vb0, pa0, pa1, pa2, pa3); PSM(pB0, pB1, mnB, alB, (NT - 1) * KVBLK);
    __syncthreads(); RESC(alB);
    finishSM(pB0, pB1, alB, l_reg, pa0, pa1, pa2, pa3); SBAR();
    pv_d0(o, vb0 + (int)SHM_V, pa0, pa1, pa2, pa3);
    if (hi == 0) li_l[r32] = l_reg; asm volatile("s_waitcnt lgkmcnt(0)" ::: "memory");
    float rli[16];
#pragma unroll
    for (int r = 0; r < 16; ++r) rli[r] = __builtin_amdgcn_rcpf(li_l[crow(r, hi)]);
    LAS float* cbuf = (LAS float*)(lds + L_CB) + rg * 32 * 128;
    if (map == 1) {
#pragma unroll
        for (int r = 0; r < 16; ++r)
#pragma unroll
            for (int d0 = 0; d0 < 4; ++d0) cbuf[crow(r, hi) * 128 + d0 * 32 + r32] = -lam * o[d0][r] * rli[r];
    }
    __syncthreads();
    if (map == 0) {
        bf16* mix = WSP(bf16, WS_MIX) + (size_t)(b * SEQ + qw0) * DM + h * 128;
        float sg[4];
#pragma unroll
        for (int d0 = 0; d0 < 4; ++d0) sg[d0] = F.subln[d0 * 32 + r32] * 0.8f;
#pragma unroll
        for (int r = 0; r < 16; ++r) { float v[4], ss = 0.f;
#pragma unroll
            for (int d0 = 0; d0 < 4; ++d0) { v[d0] = o[d0][r] * rli[r] + cbuf[crow(r, hi) * 128 + d0 * 32 + r32]; ss += v[d0] * v[d0]; }
#pragma unroll
            for (int s = 1; s < 32; s <<= 1) ss += __shfl_xor(ss, s);
            const float rstd = rsqrtf(ss * (1.f / VD) + EPS);
#pragma unroll
            for (int d0 = 0; d0 < 4; ++d0) mix[(size_t)crow(r, hi) * DM + d0 * 32 + r32] = (bf16)f2bf(v[d0] * rstd * sg[d0]); }
    }
#undef SLOAD
#undef SWRITE
#undef SWAIT
#undef RESC
#undef PSM
}
}

__device__ __forceinline__ void p5_router(Frame& F, bool dry = false) {
    const float* mod = WSP(float, WS_MOD); const bf16* x1 = WSP(bf16, WS_X1); bf16* h2 = WSP(bf16, WS_H2);
    int* list = (int*)(F.ws + WS_ROUTE + RT_LIST); float* sw = (float*)(F.ws + WS_ROUTE + RT_SW); int* toke = (int*)(F.ws + WS_ROUTE + RT_TOKE); int* tokr = (int*)(F.ws + WS_ROUTE + RT_TOKR);
    constexpr int RS = 4096 + 16;
    LAS unsigned char* Ahi = F.lds; LAS unsigned char* Alo = F.lds + 16 * RS; LAS float* Pl = (LAS float*)(F.lds + 32 * RS);
    const unsigned char* wrf = WSP(unsigned char, WS_WRF);
    LAS int* lcnt = (LAS int*)(F.lds + TAB_OFF);
    LAS int* asg = lcnt + 64; LAS float* aw = (LAS float*)(asg + 1024);
    for (int tb0 = F.vcu; tb0 < T / 16; tb0 += 2 * F.G) {
      if (F.tid < 32) lcnt[F.tid] = 0;
#pragma unroll 1
      for (int it = 0; it < 2; ++it) {
        const int tb = tb0 + it * F.G;
        if (tb >= T / 16) { asg[it * 512 + F.tid] = -1; continue; }
        const int b = (tb * 16) / SEQ;
        __syncthreads();
        { f32x4 v[2][8]; float rstd[2];
#pragma unroll
          for (int rr = 0; rr < 2; ++rr) { const GAS u32x2* xr = (const GAS u32x2*)(x1 + (size_t)(tb * 16 + 2 * F.wave + rr) * DM) + F.lane;
#pragma unroll
              for (int j = 0; j < 8; ++j) { const u32x2 xx = xr[64 * j]; v[rr][j] = (f32x4){bf2f(xx.x & 0xffffu), bf2f(xx.x >> 16), bf2f(xx.y & 0xffffu), bf2f(xx.y >> 16)}; } }
#pragma unroll
          for (int rr = 0; rr < 2; ++rr) { float s = 0.f;
#pragma unroll
              for (int j = 0; j < 8; ++j) s += (v[rr][j].x * v[rr][j].x + v[rr][j].y * v[rr][j].y) + (v[rr][j].z * v[rr][j].z + v[rr][j].w * v[rr][j].w);
              rstd[rr] = rsqrtf(wave_sum(s) * (1.f / DM) + EPS); }
#pragma unroll
          for (int j = 0; j < 8; ++j) { const int k = 4 * F.lane + 256 * j;
              const f32x4 g = *(const GAS f32x4*)(F.g2 + k), sc = *(const GAS f32x4*)(mod + (size_t)b * 6 * DM + 4 * DM + k), sf = *(const GAS f32x4*)(mod + (size_t)b * 6 * DM + 3 * DM + k);
#pragma unroll
              for (int rr = 0; rr < 2; ++rr) { const int tl = 2 * F.wave + rr;
                  float hv[4]; unsigned hb[4], lb[4];
#pragma unroll
                  for (int q = 0; q < 4; ++q) { hv[q] = v[rr][j][q] * rstd[rr] * g[q] * (1.f + sc[q]) + sf[q]; hb[q] = f2bf(hv[q]); lb[q] = f2bf(hv[q] - bf2f(hb[q])); }
                  u32x2 wh, wl; wh.x = hb[0] | (hb[1] << 16); wh.y = hb[2] | (hb[3] << 16); wl.x = lb[0] | (lb[1] << 16); wl.y = lb[2] | (lb[3] << 16);
                  st_wt8((GAS u32x2*)(h2 + (size_t)(tb * 16 + tl) * DM) + F.lane + 64 * j, wh); *(LAS u32x2*)(Ahi + tl * RS + k * 2) = wh; *(LAS u32x2*)(Alo + tl * RS + k * 2) = wl; } }
        }
        __syncthreads();
        { f32x4 acc0 = {0.f, 0.f, 0.f, 0.f}, acc1 = {0.f, 0.f, 0.f, 0.f};
#pragma unroll 2
          for (int ks = 0; ks < 8; ++ks) { const int s = 8 * F.wave + ks, k0 = 32 * s + 8 * (F.lane >> 4);
            const bf16x8 ah = *(const LAS bf16x8*)(Ahi + (F.lane & 15) * RS + k0 * 2), al = *(const LAS bf16x8*)(Alo + (F.lane & 15) * RS + k0 * 2);
            const bf16x8 bh0 = *(const GAS bf16x8*)(wrf + ((size_t)(s * 2 + 0) * 64 + F.lane) * 16), bh1 = *(const GAS bf16x8*)(wrf + ((size_t)(s * 2 + 1) * 64 + F.lane) * 16);
            const bf16x8 bl0 = *(const GAS bf16x8*)(wrf + 131072 + ((size_t)(s * 2 + 0) * 64 + F.lane) * 16), bl1 = *(const GAS bf16x8*)(wrf + 131072 + ((size_t)(s * 2 + 1) * 64 + F.lane) * 16);
            acc0 = __builtin_amdgcn_mfma_f32_16x16x32_bf16(ah, bh0, acc0, 0, 0, 0); acc0 = __builtin_amdgcn_mfma_f32_16x16x32_bf16(ah, bl0, acc0, 0, 0, 0); acc0 = __builtin_amdgcn_mfma_f32_16x16x32_bf16(al, bh0, acc0, 0, 0, 0);
            acc1 = __builtin_amdgcn_mfma_f32_16x16x32_bf16(ah, bh1, acc1, 0, 0, 0); acc1 = __builtin_amdgcn_mfma_f32_16x16x32_bf16(ah, bl1, acc1, 0, 0, 0); acc1 = __builtin_amdgcn_mfma_f32_16x16x32_bf16(al, bh1, acc1, 0, 0, 0); }
#pragma unroll
          for (int r = 0; r < 4; ++r) { const int tk = 4 * (F.lane >> 4) + r; Pl[(F.wave * 16 + tk) * 32 + (F.lane & 15)] = acc0[r]; Pl[(F.wave * 16 + tk) * 32 + 16 + (F.lane & 15)] = acc1[r]; }
        }
        __syncthreads();
        { const int tl = F.tid >> 5, e = F.tid & 31, tok = tb * 16 + tl;
          float v = F.b_r[e];
#pragma unroll
          for (int w = 0; w < 8; ++w) v += Pl[(w * 16 + tl) * 32 + e];
          float tv[4]; int ti[4];
#pragma unroll
          for (int r = 0; r < 4; ++r) { float bv = v; int bi = e;
#pragma unroll
              for (int o = 16; o > 0; o >>= 1) { const float ov = __shfl_xor(bv, o); const int oi = __shfl_xor(bi, o); if (ov > bv || (ov == bv && oi < bi)) { bv = ov; bi = oi; } }
              tv[r] = bv; ti[r] = bi; if (e == bi) v = -3.0e38f; }
          float den = 0.f, w[4];
#pragma unroll
          for (int r = 0; r < 4; ++r) { w[r] = __expf(tv[r] - tv[0]); den += w[r]; }
          int sel = -1; float wsel = 0.f;
#pragma unroll
          for (int r = 0; r < 4; ++r) if (e == ti[r]) { sel = r; wsel = w[r]; }
          int code = -1;
          if (sel >= 0 && !dry) code = sel | (__hip_atomic_fetch_add(lcnt + e, 1, __ATOMIC_RELAXED, __HIP_MEMORY_SCOPE_WORKGROUP) << 8);
          asg[it * 512 + F.tid] = code; aw[it * 512 + F.tid] = wsel / den; (void)tok;
        }
      }
      __syncthreads();
      if (F.tid < 32) { const int n = lcnt[F.tid]; lcnt[32 + F.tid] = n > 0 ? (int)atomicAdd(F.ctl + CW_CNT + F.tid * CNT_STRIDE, (unsigned)n) : 0; }
      __syncthreads();
#pragma unroll
      for (int it = 0; it < 2; ++it) { const int code = asg[it * 512 + F.tid];
          if (code >= 0) { const int e = F.tid & 31, tok = (tb0 + it * F.G) * 16 + (F.tid >> 5), sel = code & 255, rank = lcnt[32 + e] + (code >> 8);
              list[e * T + rank] = tok; sw[e * T + rank] = aw[it * 512 + F.tid]; toke[tok * 4 + sel] = e; tokr[tok * 4 + sel] = rank; } }
      __syncthreads();
    }
}

__device__ __forceinline__ void p8_final(Frame& F) {
    const float* mod = WSP(float, WS_MOD); const bf16* x1 = WSP(bf16, WS_X1); const bf16* y = WSP(bf16, WS_Y);
    const int* toke = (const int*)(F.ws + WS_ROUTE + RT_TOKE); const int* tokr = (const int*)(F.ws + WS_ROUTE + RT_TOKR);
    moe_tables(F);
    const LAS int* off = (const LAS int*)(F.lds + TAB_OFF) + 40;
    for (int row = F.vcu * NWAVES + F.wave; row < T; row += F.G * NWAVES) {
        const int b = row / SEQ;
        size_t so[4];
#pragma unroll
        for (int r = 0; r < 4; ++r) so[r] = (size_t)(off[toke[row * 4 + r]] + tokr[row * 4 + r]) * DM;
        const GAS u32x2* xr = (const GAS u32x2*)(x1 + (size_t)row * DM) + F.lane;
        f32x4 v[8]; float s = 0.f;
#pragma unroll
        for (int j = 0; j < 8; ++j) { const int k = 4 * F.lane + 256 * j; f32x4 m = {0.f, 0.f, 0.f, 0.f};
#pragma unroll
            for (int r = 0; r < 4; ++r) { const u32x2 yy = *(const GAS u32x2*)(y + so[r] + k); m[0] += bf2f(yy.x & 0xffffu); m[1] += bf2f(yy.x >> 16); m[2] += bf2f(yy.y & 0xffffu); m[3] += bf2f(yy.y >> 16); }
            const f32x4 g = *(const GAS f32x4*)(mod + (size_t)b * 6 * DM + 5 * DM + k);
            const u32x2 xx = xr[64 * j]; v[j] = (f32x4){bf2f(xx.x & 0xffffu), bf2f(xx.x >> 16), bf2f(xx.y & 0xffffu), bf2f(xx.y >> 16)} + g * m; s += (v[j].x * v[j].x + v[j].y * v[j].y) + (v[j].z * v[j].z + v[j].w * v[j].w); }
        const float rstd = rsqrtf(wave_sum(s) * (1.f / DM) + EPS);
        GAS f32x4* orow = (GAS f32x4*)(F.out + (size_t)row * DM) + F.lane;
#pragma unroll
        for (int j = 0; j < 8; ++j) { const f32x4 g = *(const GAS f32x4*)(F.fg + 4 * F.lane + 256 * j); orow[64 * j] = v[j] * rstd * g; }
    }
}

struct Args { const float* in[25]; float* out; unsigned char* ws; int ph_lo, ph_hi, li, pad; };
__global__ void __launch_bounds__(NTHR, 2) mega_fwd(Args args) {
    extern __shared__ __attribute__((aligned(16))) unsigned char lds[];
    Frame F;
    F.lds = (LAS unsigned char*)lds; F.MISC = (volatile LAS unsigned*)(F.lds + MISC_OFF);
    F.tid = threadIdx.x; F.lane = F.tid & 63; F.wave = __builtin_amdgcn_readfirstlane(F.tid >> 6);
    F.G = gridDim.x; { const int bx = blockIdx.x; F.vcu = (F.G % 8 == 0) ? (bx % 8) * (F.G / 8) + bx / 8 : bx; }
    F.ws = args.ws; F.ctl = (unsigned*)(args.ws + WS_CTL); F.out = args.out;
    F.x = args.in[0]; F.c = args.in[1]; F.w_ada = args.in[2]; F.b_ada = args.in[3]; F.g1 = args.in[4]; F.w_in = args.in[5]; F.lq1 = args.in[6]; F.lk1 = args.in[7]; F.lq2 = args.in[8]; F.lk2 = args.in[9];
    F.subln = args.in[10]; F.relb = args.in[11]; F.cw = args.in[12]; F.cb = args.in[13]; F.clg = args.in[14]; F.clb = args.in[15]; F.w_out = args.in[16]; F.g2 = args.in[17]; F.w_r = args.in[18]; F.b_r = args.in[19];
    F.w_gu = args.in[20]; F.b_gu = args.in[21]; F.w_d = args.in[22]; F.b_d = args.in[23]; F.fg = args.in[24];
    for (int u = F.tid; u < 64; u += NTHR) ((LAS unsigned*)(F.lds + MISC_OFF))[u] = 0u;
    __syncthreads();
    XcdBarrier bar = xcd_barrier_post(F.ctl + CW_BAR + args.li * XCD_BAR_WORDS, F.MISC + 8);
    const int lo = args.ph_lo, hi = args.ph_hi;
#ifndef PH_MASK
#define PH_MASK 0x1ff
#endif
#define IN(k) (((PH_MASK >> (k)) & 1) && lo <= (k) && (k) < hi)
#define SEAM(k) do { if (IN(k) && IN((k) + 1)) { xcd_barrier(bar); if constexpr (((REP_MASK >> 14) & 1) != 0) xcd_barrier(bar); } } while (0)
#define REP2(k, ...) do { { __VA_ARGS__ } if constexpr (((REP_MASK >> (k)) & 1) != 0) { __VA_ARGS__ } } while (0)
#ifndef PROBE_TS
#define PROBE_TS -1
#endif
    unsigned long long* const tsb = (unsigned long long*)(F.ctl + 8192);
#define STAMP(k) do { if constexpr (PROBE_TS >= 0) { if (F.tid == 0) __hip_atomic_store(tsb + (k) * 256 + blockIdx.x, (unsigned long long)wall_clock64(), __ATOMIC_RELAXED, __HIP_MEMORY_SCOPE_AGENT); } } while (0)
    STAMP(0);
    if (IN(0)) { REP2(0, __syncthreads(); p0_prologue(F);); } STAMP(1); SEAM(0);
    if (IN(0) && IN(1)) F.vcu = xcd_virtual_cu(bar);
    if (IN(1)) { REP2(1, __syncthreads(); p1_norm1(F);); } STAMP(2); SEAM(1);
    if (IN(2)) { REP2(2, { InProjT<false> P{WSP(bf16, WS_H), WSP(bf16, WS_WIN), WSP(bf16, WS_PROJ), {}}; P.ord.init(T, INC, F.G, F.vcu, false, true); P.ord.rep = 1 + ((REP_MASK >> 15) & 1); __syncthreads(); pg8::gemm_run(F.lds, P); }
        { InProjT<true> P{WSP(bf16, WS_H), WSP(bf16, WS_WIN), WSP(bf16, WS_PROJ), {}}; P.ord.init(T, INC, F.G, F.vcu, true, true); __syncthreads(); pg8::gemm_run<InProjT<true>, true>(F.lds, P); }); } STAMP(3); SEAM(2);
    if (IN(3)) { REP2(3,
        for (int ct = F.vcu; ct < T / 32; ct += F.G) conv_unit(F, ct);
        if constexpr (((REP_MASK >> 9) & 1) != 0) { for (int ct = F.vcu; ct < T / 32; ct += F.G) conv_unit(F, ct); }
        for (int u = F.vcu; u < NB * AH * 16 * (1 + ((REP_MASK >> 10) & 1)); u += F.G) att::attn_unit(F, u % (NB * AH * 16));
    ); } STAMP(4); SEAM(3);
    if (IN(4)) { REP2(4, OutProj P{WSP(bf16, WS_MIX), WSP(bf16, WS_WOUT), F.x, WSP(float, WS_MOD), WSP(bf16, WS_X1), {}}; P.ord.init(T, DM, F.G, F.vcu); P.ord.rep = 1 + ((REP_MASK >> 16) & 1); __syncthreads(); pg8::gemm_run(F.lds, P);); } STAMP(5); SEAM(4);
    if (IN(5)) { p5_router(F); if constexpr (((REP_MASK >> 13) & 1) != 0) { __syncthreads(); p5_router(F, true); } } STAMP(6); SEAM(5);
    if (IN(6)) { REP2(6, moe_tables(F); const LAS int* tab = (const LAS int*)(F.lds + TAB_OFF);
        MoeGU P{WSP(bf16, WS_H2), F.w_gu, F.b_gu, (const int*)(F.ws + WS_ROUTE + RT_LIST), WSP(bf16, WS_ACT), {tab, tab + 40, tab + 80}, F.G, F.vcu}; pg8::gemm_run_bf32(F.lds, P);); } STAMP(7); SEAM(6);
    if (IN(7)) { REP2(7, moe_tables(F); const LAS int* tab = (const LAS int*)(F.lds + TAB_OFF);
        { MoeDownT<1> P{WSP(bf16, WS_ACT), F.w_d, F.b_d, (const float*)(F.ws + WS_ROUTE + RT_SW), WSP(bf16, WS_Y), {tab, tab + 40, tab + 80}, F.G, F.vcu}; pg8::gemm_run_bf32(F.lds, P); }
        { MoeDownT<2> P{WSP(bf16, WS_ACT), F.w_d, F.b_d, (const float*)(F.ws + WS_ROUTE + RT_SW), WSP(bf16, WS_Y), {tab, tab + 40, tab + 80}, F.G, F.vcu}; pg8::gemm_run_bf32<MoeDownT<2>, true>(F.lds, P); }); } STAMP(8); SEAM(7);
    if (IN(8)) { REP2(8, p8_final(F);); }
    if constexpr (PROBE_TS >= 0) {
        STAMP(9); xcd_barrier(bar);
        if (blockIdx.x == 0) {
            LAS unsigned long long* sh = (LAS unsigned long long*)F.lds;
            __syncthreads();
            if (F.tid < 256) { const int cu = F.tid < (int)gridDim.x ? F.tid : 0;
                sh[F.tid] = __hip_atomic_load(tsb + (PROBE_TS + 1) * 256 + cu, __ATOMIC_RELAXED, __HIP_MEMORY_SCOPE_AGENT);
                sh[256 + F.tid] = __hip_atomic_load(tsb + PROBE_TS * 256 + cu, __ATOMIC_RELAXED, __HIP_MEMORY_SCOPE_AGENT); }
            __syncthreads();
            if (F.tid == 0) { long long mx = 0, sum = 0; for (int i = 0; i < 256; ++i) { const long long d = (long long)(sh[i] - sh[256 + i]); mx = d > mx ? d : mx; sum += d; }
                const long long W = sum / 256 / 100, sk = (mx - sum / 256) / 100;
                const long long a = PROBE_TS == 9 ? 0 : W > 1023 ? 1023 : W, b = sk > 255 ? 255 : (sk < 0 ? 0 : sk);
                const unsigned long long wait = (unsigned long long)(10 * a + 0 * b) * 100ull, t0 = wall_clock64();
                while ((unsigned long long)wall_clock64() - t0 < wait) __builtin_amdgcn_s_sleep(32); }
            __syncthreads();
        }
    }
#undef IN
#undef SEAM
}

extern "C" void kernel_launch(void* const* d_in, const int* in_sizes, int n_in, void* d_out, int out_size, void* d_ws, size_t ws_size, hipStream_t stream) {
    static int grid = 0;
    if (grid == 0) {
        if (n_in != 25 || ws_size < WS_END || out_size != T * DM) { fprintf(stderr, "kernel_launch: n_in %d out %d ws %zu (need %zu); nothing launched\n", n_in, out_size, ws_size, (size_t)WS_END); grid = -1; return; }
        int dev = 0, cus = 0, per_cu = 0;
        if (hipGetDevice(&dev) != hipSuccess || hipDeviceGetAttribute(&cus, hipDeviceAttributeMultiprocessorCount, dev) != hipSuccess) { grid = -1; return; }
        if (hipFuncSetAttribute((const void*)mega_fwd, hipFuncAttributeMaxDynamicSharedMemorySize, LDS_BYTES) != hipSuccess) { fprintf(stderr, "kernel_launch: hipFuncSetAttribute failed\n"); grid = -1; return; }
        if (hipOccupancyMaxActiveBlocksPerMultiprocessor(&per_cu, (const void*)mega_fwd, NTHR, LDS_BYTES) != hipSuccess || per_cu < 1) { fprintf(stderr, "kernel_launch: occupancy query says %d blocks per CU\n", per_cu); }
        (void)hipGetLastError();
        grid = cus;
    }
    if (grid < 0) return;
    unsigned char* ws = (unsigned char*)d_ws;
    (void)hipMemsetAsync(ws + WS_CTL, 0, CTL_ZERO_BYTES, stream);
    Args a{};
    for (int i = 0; i < 25; ++i) a.in[i] = (const float*)d_in[i];
    a.out = (float*)d_out; a.ws = ws; a.ph_lo = 0; a.ph_hi = 9; a.li = 0; a.pad = 0;
    hipLaunchKernelGGL(mega_fwd, dim3(grid), dim3(NTHR), LDS_BYTES, stream, a);
}
```

```cpp
#include <hip/hip_runtime.h>
#include <cstdio>
#include <cstdint>

#ifndef REP_MASK
#define REP_MASK 0
#endif

constexpr int DM = 2048, NB = 4, SEQ = 2048, T = NB * SEQ;
constexpr int AH = 8, HD = 64, VD = 128, CCH = 1024, CK = 31;
constexpr int INC = 5120;
constexpr int NE = 32, TOPK = 4, DFF = 2048, NSLOT = T * TOPK;
constexpr float EPS = 1e-6f;
constexpr float LOG2E = 1.4426950408889634f;

typedef unsigned short bf16;
typedef short bf16x8 __attribute__((ext_vector_type(8)));
typedef short s16x4 __attribute__((ext_vector_type(4)));
typedef float f32x4 __attribute__((ext_vector_type(4)));
typedef float f32x16 __attribute__((ext_vector_type(16)));
typedef unsigned u32x4 __attribute__((ext_vector_type(4)));
typedef unsigned u32x2 __attribute__((ext_vector_type(2)));
#define GAS __attribute__((address_space(1)))
#define LAS __attribute__((address_space(3)))
typedef GAS unsigned gu32;

constexpr size_t MiB = 1u << 20;
constexpr size_t WS_CTL = 0, CTL_ZERO_BYTES = 64 * 1024;
constexpr size_t WS_MODP = 1 * MiB;
constexpr size_t WS_MOD = 3 * MiB;
constexpr size_t WS_BIAST = 4 * MiB;
constexpr size_t WS_WRF = 5 * MiB;
constexpr size_t WS_ROUTE = 6 * MiB;
constexpr size_t RT_LIST = 0;
constexpr size_t RT_SW = 1 * MiB;
constexpr size_t RT_TOKE = 2 * MiB;
constexpr size_t RT_TOKR = RT_TOKE + 128 * 1024;
constexpr size_t WS_WIN = 16 * MiB;
constexpr size_t WS_WOUT = WS_WIN + 20 * MiB;
constexpr size_t WS_H = WS_WOUT + 8 * MiB;
constexpr size_t WS_PROJ = WS_H + 32 * MiB;
constexpr size_t WS_MIX = WS_PROJ + 80 * MiB;
constexpr size_t WS_X1 = WS_MIX + 32 * MiB;
constexpr size_t WS_H2 = WS_X1 + 64 * MiB;
constexpr size_t WS_ACT = WS_H2 + 32 * MiB;
constexpr size_t WS_Y = WS_ACT + 130 * MiB;
constexpr size_t WS_END = WS_Y + 130 * MiB;
constexpr int CW_CNT = 5120, CNT_STRIDE = 64;
constexpr int CW_BAR = 1024;

__device__ __forceinline__ unsigned f2bf(float f) { unsigned u = __builtin_bit_cast(unsigned, f); return (u + 0x7fffu + ((u >> 16) & 1u)) >> 16; }
__device__ __forceinline__ float bf2f(unsigned h) { return __builtin_bit_cast(float, h << 16); }
__device__ __forceinline__ unsigned pk2(float lo, float hi) { return f2bf(lo) | (f2bf(hi) << 16); }
__device__ __forceinline__ unsigned cvt_pk_bf16(float lo, float hi) { unsigned r; asm volatile("v_cvt_pk_bf16_f32 %0, %1, %2" : "=v"(r) : "v"(lo), "v"(hi)); return r; }
__device__ __forceinline__ float silu_f(float v) { return v / (1.f + __expf(-v)); }
__device__ __forceinline__ void st_wt8(GAS u32x2* p, u32x2 v) { asm volatile("global_store_dwordx2 %0, %1, off sc0 sc1" :: "v"(p), "v"(v) : "memory"); }
__device__ __forceinline__ void st_wt16(GAS u32x4* p, u32x4 v) { asm volatile("global_store_dwordx4 %0, %1, off sc0 sc1" :: "v"(p), "v"(v) : "memory"); }
__device__ __forceinline__ float wave_sum(float v) {
#pragma unroll
    for (int o = 1; o < 64; o <<= 1) v += __shfl_xor(v, o);
    return v;
}
__host__ __device__ inline int t5_bucket(int rel) {
    int ret = rel > 0 ? 16 : 0; int n = rel < 0 ? -rel : rel;
    if (n < 8) return ret + n;
    int lg = n >= 91 ? 15 : n >= 64 ? 14 : n >= 46 ? 13 : n >= 32 ? 12 : n >= 23 ? 11 : n >= 16 ? 10 : n >= 12 ? 9 : 8;
    return ret + lg;
}
#define LDS_WAIT() asm volatile("s_waitcnt lgkmcnt(0)" ::: "memory")
#define VM_WAIT() asm volatile("s_waitcnt vmcnt(0)" ::: "memory")

#define XB_TMO      128
#define XB_XCNT(j)  (256  + 64 * (j))
#define XB_XSUB(j)  (1280 + 64 * (j))
#define XB_XGEN(j)  (2304 + 64 * (j))
#define XB_TOP      3328
#define XB_TOPGEN   3392
#define XCD_BAR_WORDS 3456
#define XB_SPIN_CAP (1u << 18)
__device__ __forceinline__ unsigned xb_ld(unsigned* p)              { return __hip_atomic_load(p, __ATOMIC_RELAXED, __HIP_MEMORY_SCOPE_AGENT); }
__device__ __forceinline__ unsigned xb_add(unsigned* p, unsigned v) { return __hip_atomic_fetch_add(p, v, __ATOMIC_RELAXED, __HIP_MEMORY_SCOPE_AGENT); }
__device__ __forceinline__ unsigned xb_xcc_id() { return (unsigned)__builtin_amdgcn_s_getreg((3 << 11) | 20) & 0xFu; }
#define XB_SPIN(cond, bar) do { unsigned _sp = 0; while (cond) { __builtin_amdgcn_s_sleep(1); \
    if ((++_sp & 255u) == 0u) { if (xb_ld(&(bar)[XB_TMO])) break; if (_sp > XB_SPIN_CAP) { atomicAdd(&(bar)[XB_TMO], 1u); break; } } } } while (0)
struct XcdBarrier { unsigned* bar; unsigned x; volatile LAS unsigned* st; };
__device__ __forceinline__ XcdBarrier xcd_barrier_post(unsigned* bar, volatile LAS unsigned* st) {
    XcdBarrier b; b.bar = bar; b.x = xb_xcc_id(); b.st = st;
    if (threadIdx.x == 0) st[2] = xb_add(&bar[XB_XCNT(b.x)], 1u);
    return b;
}
__device__ __forceinline__ int xcd_virtual_cu(const XcdBarrier& b) {
    if (threadIdx.x == 0) { unsigned pre = 0u; for (unsigned j = 0; j < 16; ++j) { const unsigned c = xb_ld(&b.bar[XB_XCNT(j)]); pre += (j < b.x) ? c : 0u; } b.st[3] = pre + b.st[2]; }
    __syncthreads();
    const int v = (int)b.st[3];
    __syncthreads();
    return __builtin_amdgcn_readfirstlane(v);
}
__device__ __forceinline__ void xcd_barrier_complete(unsigned* bar, unsigned x, unsigned& nloc, unsigned& nx) {
    const unsigned G = gridDim.x * gridDim.y * gridDim.z;
    unsigned sum, cnt, mine, sp = 0u;
    for (;;) {
        sum = 0u; cnt = 0u; mine = 0u;
#pragma unroll
        for (unsigned j = 0; j < 16; ++j) { const unsigned c = xb_ld(&bar[XB_XCNT(j)]); sum += c; cnt += (c > 0u) ? 1u : 0u; mine = (j == x) ? c : mine; }
        if (sum == G) break;
        __builtin_amdgcn_s_sleep(1);
        if ((++sp & 255u) == 0u) { if (xb_ld(&bar[XB_TMO])) break; if (sp > XB_SPIN_CAP) { atomicAdd(&bar[XB_TMO], 1u); break; } }
    }
    nloc = mine > 0u ? mine : 1u; nx = cnt > 0u ? cnt : 1u;
}
__device__ __forceinline__ void xcd_barrier(const XcdBarrier& b) {
    asm volatile("s_waitcnt vmcnt(0)" ::: "memory");
    __syncthreads();
    if (threadIdx.x == 0) {
        unsigned* bar = b.bar;
        __builtin_amdgcn_s_waitcnt(0);
        unsigned nloc = b.st[0], nx = b.st[1];
        if (nloc == 0u) { xcd_barrier_complete(bar, b.x, nloc, nx); b.st[0] = nloc; b.st[1] = nx; }
        const unsigned old = xb_add(&bar[XB_XSUB(b.x)], 1u);
        const unsigned gen = old / nloc;
        if (old + 1u == (gen + 1u) * nloc) {
            __builtin_amdgcn_fence(__ATOMIC_RELEASE, "agent");
            asm volatile("s_waitcnt vmcnt(0)" ::: "memory");
            const unsigned og = xb_add(&bar[XB_TOP], 1u);
            const unsigned tg = og / nx;
            if (og + 1u == (tg + 1u) * nx) xb_add(&bar[XB_TOPGEN], 1u);
            else XB_SPIN(xb_ld(&bar[XB_TOPGEN]) == tg, bar);
            __builtin_amdgcn_fence(__ATOMIC_ACQUIRE, "agent");
            xb_add(&bar[XB_XGEN(b.x)], 1u);
            asm volatile("s_waitcnt vmcnt(0)" ::: "memory");
        } else {
            XB_SPIN(xb_ld(&bar[XB_XGEN(b.x)]) == gen, bar);
            __builtin_amdgcn_fence(__ATOMIC_ACQUIRE, "agent");
            asm volatile("s_waitcnt vmcnt(0)" ::: "memory");
        }
    }
    __syncthreads();
}

namespace pg8 {
constexpr int BM = 256, BK = 64, HALF = 128, HTB = HALF * BK * 2, STAGE_BYTES = 8 * HTB, KD = 2048;
__host__ __device__ __forceinline__ int lds_byte(int r, int c) { const int st = (r >> 4) * 2 + (c >> 5), rr = r & 15, cc = c & 31, ob = rr * 64 + cc * 2; return st * 1024 + (ob ^ (((ob >> 9) & 1) << 5)); }
__host__ __device__ __forceinline__ void stage_rc(int b, int& R, int& C) { const int st = b / 1024, sb = b % 1024, swz = sb ^ (((sb >> 9) & 1) << 5); R = (st >> 1) * 16 + swz / 64; C = (st & 1) * 32 + (swz % 64) / 2; }
__host__ __device__ __forceinline__ int perm32(int rho) { const int n = rho >> 4, i = rho & 15; return 8 * (i >> 2) + 4 * n + (i & 3); }
struct Unit { int pm, pn, e, rows, hs; };

struct DenseOrder {
    int nM, nN, nwg, nfull, G, c, rep = 1; bool half;
    __device__ void init(int M, int N, int G_, int c_, bool half_ = false, bool split_tail = false) { nM = M / BM; nN = N / BM; nwg = nM * nN; G = G_; c = c_; half = half_; nfull = split_tail ? (nwg / G_) * G_ : nwg; }
    __device__ bool next(int i, Unit& u) const {
        long L = (long)i * G + c; int hsel = 0;
        if (half) { if (L >= 2L * (nwg - nfull)) return false; hsel = (int)(L & 1); L = nfull + (L >> 1); }
        else { if (L >= (long)nfull * rep) return false; if (rep > 1 && L >= nfull) L -= nfull; }
        const int wgid = (int)L;
        const int nig = 8 * nN, gid = wgid / nig, fm = gid * 8, gsz = (nM - fm) < 8 ? (nM - fm) : 8;
        u.pm = fm + ((wgid % nig) % gsz); u.pn = (wgid % nig) / gsz; u.e = 0; u.hs = 0; u.rows = 256; if (half) { u.pm = 2 * u.pm + hsel; u.rows = 128; } return true;
    }
};

template <class P, bool HM = false>
__device__ __forceinline__ void gemm_run(LAS unsigned char* lds, const P& prob) {
    const int tid = threadIdx.x, wid = __builtin_amdgcn_readfirstlane(tid >> 6), lane = tid & 63, wr = wid >> 2, wc = wid & 3, fr = lane & 15, fq = lane >> 4;
    constexpr int K = KD, nt = K / BK;
    int Rr[2], Cc[2]; unsigned voffB[2];
#pragma unroll
    for (int i = 0; i < 2; ++i) { int R, C; stage_rc(tid * 16 + i * 8192, R, C); Rr[i] = R; Cc[i] = C; const int Rb = P::PERM ? ((R & ~31) + perm32(R & 31)) : R; voffB[i] = (unsigned)(Rb * K + C) * 2u; }
    constexpr size_t kstep = (size_t)(BK * 2), hstep = (size_t)HALF * K * 2;
    const unsigned ldsw = (unsigned)wid * 1024u;
    const int aoff = lds_byte(wr * 64 + fr, fq * 8), boff = lds_byte(wc * 32 + fr, fq * 8);
#define PG8_SA(b, h) (((b) * 2 + (h)) * HTB)
#define PG8_SB(b, h) ((4 + (b) * 2 + (h)) * HTB)
#define PG8_STAGE(bufoff, gbase, voff) do { _Pragma("unroll") for (int _i = 0; _i < 2; ++_i) \
        __builtin_amdgcn_global_load_lds((const unsigned*)((const char*)(gbase) + (voff)[_i]), (LAS unsigned*)(lds + (bufoff) + ldsw + _i * 8192), 16, 0, 0); } while (0)
#define PG8_LDA(dst, b, h) do { _Pragma("unroll") for (int m = 0; m < 4; ++m) _Pragma("unroll") for (int k = 0; k < 2; ++k) dst[m][k] = *(const LAS bf16x8*)(lds + PG8_SA(b, h) + aoff + m * 2048 + k * 1024); } while (0)
#define PG8_LDB(dst, b, h) do { _Pragma("unroll") for (int n = 0; n < 2; ++n) _Pragma("unroll") for (int k = 0; k < 2; ++k) dst[n][k] = *(const LAS bf16x8*)(lds + PG8_SB(b, h) + boff + n * 2048 + k * 1024); } while (0)
#define PG8_MMA(ai, bj, At, Bt) do { __builtin_amdgcn_s_setprio(1); _Pragma("unroll") for (int m = 0; m < 4; ++m) _Pragma("unroll") for (int n = 0; n < 2; ++n) _Pragma("unroll") for (int k = 0; k < 2; ++k) \
        acc[ai][bj][m][n] = __builtin_amdgcn_mfma_f32_16x16x32_bf16(Bt[n][k], At[m][k], acc[ai][bj][m][n], 0, 0, 0); __builtin_amdgcn_s_setprio(0); } while (0)
#define PG8_WAIT_V(n) asm volatile("s_waitcnt vmcnt(" #n ")" ::: "memory")
#define PG8_WAIT_L(n) asm volatile("s_waitcnt lgkmcnt(" #n ")" ::: "memory")
#define PG8_BAR __builtin_amdgcn_s_barrier()
#define PG8_SCHED __builtin_amdgcn_sched_barrier(0)
    Unit cur, nxt; int ui = 0;
    if (!prob.next(0, cur)) return;
    f32x4 acc[2][2][4][2];
#pragma unroll
    for (int a = 0; a < 2; ++a)
#pragma unroll
        for (int b = 0; b < 2; ++b)
#pragma unroll
            for (int m = 0; m < 4; ++m)
#pragma unroll
                for (int n = 0; n < 2; ++n) acc[a][b][m][n] = (f32x4){0.f, 0.f, 0.f, 0.f};
    bf16x8 At[4][2], B0[2][2], B1[2][2];
    unsigned vC0[2], vC1[2], vN0[2], vN1[2];
    prob.a_off(cur, Rr, Cc, vC0, vC1);
    const char* const Ab = prob.a_base();
    const char* cB = prob.b_base(cur);
    PG8_STAGE(PG8_SB(0, 0), cB, voffB); PG8_STAGE(PG8_SB(0, 1), cB + hstep, voffB); PG8_STAGE(PG8_SA(0, 0), Ab, vC0); if constexpr (!HM) PG8_STAGE(PG8_SA(0, 1), Ab, vC1);
    if (wr == 1) PG8_BAR;
    if constexpr (HM) PG8_WAIT_V(0); else PG8_WAIT_V(2);
    PG8_BAR;
    PG8_STAGE(PG8_SB(1, 0), cB + kstep, voffB); PG8_STAGE(PG8_SA(1, 0), Ab + kstep, vC0); PG8_STAGE(PG8_SB(1, 1), cB + hstep + kstep, voffB);
    PG8_WAIT_V(6); PG8_BAR;
    for (;;) {
        const bool has_next = prob.next(ui + 1, nxt);
        if (has_next) prob.a_off(nxt, Rr, Cc, vN0, vN1); else { vN0[0] = vC0[0]; vN0[1] = vC0[1]; vN1[0] = vC1[0]; vN1[1] = vC1[1]; }
        const char* nB = has_next ? prob.b_base(nxt) : cB;
        for (int t = 0; t < nt; t += 2) {
            const bool last = (t == nt - 2);
            const char* a1 = Ab + (size_t)(t + 1) * kstep;
            const char* a2 = last ? Ab : Ab + (size_t)(t + 2) * kstep; const char* b2 = last ? nB : cB + (size_t)(t + 2) * kstep;
            const char* a3 = a2 + kstep; const char* b3 = b2 + kstep;
            unsigned v20[2], v21[2];
            v20[0] = last ? vN0[0] : vC0[0]; v20[1] = last ? vN0[1] : vC0[1]; v21[0] = last ? vN1[0] : vC1[0]; v21[1] = last ? vN1[1] : vC1[1];
            PG8_LDB(B0, 0, 0); PG8_LDB(B1, 0, 1); PG8_SCHED; PG8_LDA(At, 0, 0); if constexpr (!HM) PG8_STAGE(PG8_SA(1, 1), a1, vC1);
            if constexpr (HM) PG8_WAIT_V(6); else PG8_WAIT_V(8); PG8_WAIT_L(0); PG8_BAR; PG8_MMA(0, 0, At, B0); PG8_MMA(0, 1, At, B1); PG8_BAR; PG8_SCHED;
            if constexpr (!HM) PG8_LDA(At, 0, 1); PG8_STAGE(PG8_SB(0, 0), b2, voffB); PG8_STAGE(PG8_SB(0, 1), b2 + hstep, voffB); PG8_STAGE(PG8_SA(0, 0), a2, v20);
            if constexpr (HM) PG8_WAIT_V(6); else PG8_WAIT_V(8);
            PG8_WAIT_L(0); PG8_BAR; if constexpr (!HM) { PG8_MMA(1, 0, At, B0); PG8_MMA(1, 1, At, B1); } PG8_BAR; PG8_SCHED;
            PG8_LDB(B0, 1, 0); PG8_LDB(B1, 1, 1); PG8_SCHED; PG8_LDA(At, 1, 0); if constexpr (!HM) PG8_STAGE(PG8_SA(0, 1), a2, v21);
            if constexpr (HM) PG8_WAIT_V(6); else PG8_WAIT_V(8); PG8_WAIT_L(0); PG8_BAR; PG8_MMA(0, 0, At, B0); PG8_MMA(0, 1, At, B1); PG8_BAR; PG8_SCHED;
            if constexpr (!HM) PG8_LDA(At, 1, 1); PG8_STAGE(PG8_SB(1, 0), b3, voffB); PG8_STAGE(PG8_SB(1, 1), b3 + hstep, voffB); PG8_STAGE(PG8_SA(1, 0), a3, v20);
            if constexpr (HM) PG8_WAIT_V(6); else PG8_WAIT_V(8);
            PG8_WAIT_L(0); PG8_BAR; if constexpr (!HM) { PG8_MMA(1, 0, At, B0); PG8_MMA(1, 1, At, B1); } PG8_BAR; PG8_SCHED;
        }
        if (wr == 0) PG8_BAR;
        prob.epi(acc, cur, wr, wc, fr, fq);
        if (!has_next) break;
#pragma unroll
        for (int a = 0; a < 2; ++a)
#pragma unroll
            for (int b = 0; b < 2; ++b)
#pragma unroll
                for (int m = 0; m < 4; ++m)
#pragma unroll
                    for (int n = 0; n < 2; ++n) acc[a][b][m][n] = (f32x4){0.f, 0.f, 0.f, 0.f};
        cur = nxt; cB = nB; ++ui; vC0[0] = vN0[0]; vC0[1] = vN0[1]; vC1[0] = vN1[0]; vC1[1] = vN1[1];
        if (wr == 1) PG8_BAR;
    }
    PG8_WAIT_V(0);
    PG8_BAR;
#undef PG8_SA
#undef PG8_SB
#undef PG8_STAGE
#undef PG8_LDA
#undef PG8_LDB
#undef PG8_MMA
#undef PG8_WAIT_V
#undef PG8_WAIT_L
#undef PG8_BAR
#undef PG8_SCHED
}

template <class P, bool HN = false>
__device__ __forceinline__ void gemm_run_bf32(LAS unsigned char* lds, const P& prob) {
    const int tid = threadIdx.x, wid = __builtin_amdgcn_readfirstlane(tid >> 6), lane = tid & 63, wr = wid >> 2, wc = wid & 3, fr = lane & 15, fq = lane >> 4;
    constexpr int K = KD, nt = K / BK;
    constexpr size_t kstep = (size_t)(BK * 2);
    constexpr size_t ldwB = (size_t)P::LDW_BYTES;
    const unsigned ldsw = (unsigned)wid * 1024u;
    const int aoff = lds_byte(wr * 64 + fr, fq * 8), boff = lds_byte(wc * 32 + fr, fq * 8);
    const int wbo0 = lds_byte(32 * (lane >> 4) + (((lane >> 1) & 1) | (((lane >> 3) & 1) << 2) | (((lane >> 2) & 1) << 3)), 8 * wid + 4 * (lane & 1));
#define PG8_SA(b, h) (((b) * 2 + (h)) * HTB)
#define PG8_SB(b, h) ((4 + (b) * 2 + (h)) * HTB)
#define PG8_STAGE(bufoff, gbase, voff) do { _Pragma("unroll") for (int _i = 0; _i < 2; ++_i) \
        __builtin_amdgcn_global_load_lds((const unsigned*)((const char*)(gbase) + (voff)[_i]), (LAS unsigned*)(lds + (bufoff) + ldsw + _i * 8192), 16, 0, 0); } while (0)
#define PG8_LDA(dst, b, h) do { _Pragma("unroll") for (int m = 0; m < 4; ++m) _Pragma("unroll") for (int k = 0; k < 2; ++k) dst[m][k] = *(const LAS bf16x8*)(lds + PG8_SA(b, h) + aoff + m * 2048 + k * 1024); } while (0)
#define PG8_LDB(dst, b, h) do { _Pragma("unroll") for (int n = 0; n < 2; ++n) _Pragma("unroll") for (int k = 0; k < 2; ++k) dst[n][k] = *(const LAS bf16x8*)(lds + PG8_SB(b, h) + boff + n * 2048 + k * 1024); } while (0)
#define PG8_MMA(ai, bj, At, Bt) do { __builtin_amdgcn_s_setprio(1); _Pragma("unroll") for (int m = 0; m < 4; ++m) _Pragma("unroll") for (int n = 0; n < 2; ++n) _Pragma("unroll") for (int k = 0; k < 2; ++k) \
        acc[ai][bj][m][n] = __builtin_amdgcn_mfma_f32_16x16x32_bf16(Bt[n][k], At[m][k], acc[ai][bj][m][n], 0, 0, 0); __builtin_amdgcn_s_setprio(0); } while (0)
#define PG8_WAIT_V(n) asm volatile("s_waitcnt vmcnt(" #n ")" ::: "memory")
#define PG8_WAIT_L(n) asm volatile("s_waitcnt lgkmcnt(" #n ")" ::: "memory")
#define PG8_BAR __builtin_amdgcn_s_barrier()
#define PG8_SCHED __builtin_amdgcn_sched_barrier(0)
#define PG8_BLOAD(kk, h) do { const bool nx_ = (kk) >= nt; const unsigned so_ = (nx_ ? nBo : cBo) + (unsigned)((nx_ ? (kk) - nt : (kk)) * BK + 8 * wid) * (unsigned)ldwB + (unsigned)(h) * (unsigned)P::HALF_BYTES; \
        const unsigned co_ = nx_ ? nCol : cCol; \
        asm volatile("s_nop 4" ::: "memory"); \
        _Pragma("unroll") for (int j_ = 0; j_ < 4; ++j_) asm volatile("buffer_load_dwordx4 %0, %1, %2, %3 offen" : "=v"(bv[j_]) : "v"(co_), "s"(wrs), "s"(so_ + (unsigned)j_ * (unsigned)ldwB) : "memory"); } while (0)
#define PG8_BWAIT(n) asm volatile("s_waitcnt vmcnt(" #n ")" : "+v"(bv[0]), "+v"(bv[1]), "+v"(bv[2]), "+v"(bv[3]) :: "memory")
#define PG8_BWRITE(b, h) do { _Pragma("unroll") for (int i_ = 0; i_ < 4; ++i_) { u32x2 o_; o_.x = cvt_pk_bf16(bv[0][i_], bv[1][i_]); o_.y = cvt_pk_bf16(bv[2][i_], bv[3][i_]); \
        *(LAS u32x2*)(lds + PG8_SB(b, h) + wbo0 + 128 * (i_ & 1) + 2048 * (i_ >> 1)) = o_; } } while (0)
    typedef float f32x2v __attribute__((ext_vector_type(2)));
    Unit cur, nxt; int ui = 0;
    if (!prob.next(0, cur)) return;
    f32x4 acc[2][2][4][2];
    bf16x8 At[4][2], B0[2][2], B1[2][2];
    f32x4 bv[4];
    unsigned vC0[2], vC1[2], vN0[2], vN1[2];
    prob.a_off(cur, vC0, vC1);
    const char* const Ab = prob.a_base();
    const __amdgpu_buffer_rsrc_t wrs = __builtin_amdgcn_make_buffer_rsrc((void*)prob.W, 0, (unsigned)NE * (unsigned)P::W_BYTES, 0x00020000);
    unsigned cBo = (unsigned)cur.e * (unsigned)P::W_BYTES, cCol = prob.b_col(cur, lane & ~1) + (unsigned)(lane & 1) * 4u * (unsigned)ldwB;
    unsigned nBo = cBo, nCol = cCol;
#define PG8_BLOADX(R, kk, h) do { const unsigned so_ = cBo + (unsigned)((kk) * BK + 8 * wid) * (unsigned)ldwB + (unsigned)(h) * (unsigned)P::HALF_BYTES; \
        _Pragma("unroll") for (int j_ = 0; j_ < 4; ++j_) asm volatile("buffer_load_dwordx4 %0, %1, %2, %3 offen" : "=v"(R[j_]) : "v"(cCol), "s"(wrs), "s"(so_ + (unsigned)j_ * (unsigned)ldwB) : "memory"); } while (0)
#define PG8_BWAITX(R, n) asm volatile("s_waitcnt vmcnt(" #n ")" : "+v"(R[0]), "+v"(R[1]), "+v"(R[2]), "+v"(R[3]) :: "memory")
#define PG8_BWRITEX(R, b, h) do { _Pragma("unroll") for (int i_ = 0; i_ < 4; ++i_) { u32x2 o_; o_.x = cvt_pk_bf16(R[0][i_], R[1][i_]); o_.y = cvt_pk_bf16(R[2][i_], R[3][i_]); \
        *(LAS u32x2*)(lds + PG8_SB(b, h) + wbo0 + 128 * (i_ & 1) + 2048 * (i_ >> 1)) = o_; } } while (0)
    { f32x4 bw[4], bx[4];
      asm volatile("s_nop 4" ::: "memory");
      PG8_BLOADX(bv, 0, 0); if constexpr (!HN) PG8_BLOADX(bw, 0, 1); PG8_BLOADX(bx, 1, 0);
      PG8_STAGE(PG8_SA(0, 0), Ab, vC0); PG8_STAGE(PG8_SA(0, 1), Ab, vC1);
      if constexpr (!HN) { PG8_BWAITX(bv, 12); PG8_BWRITEX(bv, 0, 0); PG8_BWAITX(bw, 8); PG8_BWRITEX(bw, 0, 1); }
      else { PG8_BWAITX(bv, 8); PG8_BWRITEX(bv, 0, 0); }
      PG8_BWAITX(bx, 4); PG8_BWRITEX(bx, 1, 0); }
    if constexpr (!HN) PG8_BLOAD(1, 1);
    if (wr == 1) PG8_BAR;
    if constexpr (!HN) PG8_WAIT_V(4); else PG8_WAIT_V(0);
    PG8_WAIT_L(0); PG8_BAR;
    PG8_STAGE(PG8_SA(1, 0), Ab + kstep, vC0);
    { f32x4 bini[2][2]; prob.bias_load(cur, wc, fq, bini);
#pragma unroll
      for (int a = 0; a < 2; ++a)
#pragma unroll
        for (int b = 0; b < 2; ++b)
#pragma unroll
            for (int m = 0; m < 4; ++m)
#pragma unroll
                for (int n = 0; n < 2; ++n) acc[a][b][m][n] = bini[b][n]; }
    PG8_WAIT_V(0); PG8_BAR;
    for (;;) {
        const bool has_next = prob.next(ui + 1, nxt);
        if (has_next) { prob.a_off(nxt, vN0, vN1); nBo = (unsigned)nxt.e * (unsigned)P::W_BYTES; nCol = prob.b_col(nxt, lane & ~1) + (unsigned)(lane & 1) * 4u * (unsigned)ldwB; }
        else { vN0[0] = vC0[0]; vN0[1] = vC0[1]; vN1[0] = vC1[0]; vN1[1] = vC1[1]; nBo = cBo; nCol = cCol; }
        for (int t = 0; t < nt; t += 2) {
            const bool last = (t == nt - 2);
            const char* a1 = Ab + (size_t)(t + 1) * kstep;
            const char* a2 = last ? Ab : Ab + (size_t)(t + 2) * kstep;
            const char* a3 = a2 + kstep;
            unsigned v20[2], v21[2];
            v20[0] = last ? vN0[0] : vC0[0]; v20[1] = last ? vN0[1] : vC0[1]; v21[0] = last ? vN1[0] : vC1[0]; v21[1] = last ? vN1[1] : vC1[1];
            PG8_LDB(B0, 0, 0); if constexpr (!HN) PG8_LDB(B1, 0, 1); PG8_SCHED; PG8_LDA(At, 0, 0); if constexpr (!HN) { PG8_BWAIT(2); PG8_BWRITE(1, 1); } PG8_BLOAD(t + 2, 0); PG8_STAGE(PG8_SA(1, 1), a1, vC1);
            if constexpr (HN) PG8_WAIT_V(8); else PG8_WAIT_V(12);
            PG8_WAIT_L(0); PG8_BAR; PG8_MMA(0, 0, At, B0); if constexpr (!HN) PG8_MMA(0, 1, At, B1); PG8_BAR; PG8_SCHED;
            PG8_LDA(At, 0, 1); PG8_BWAIT(2); PG8_BWRITE(0, 0); if constexpr (!HN) PG8_BLOAD(t + 2, 1); PG8_STAGE(PG8_SA(0, 0), a2, v20);
            if constexpr (HN) PG8_WAIT_V(8); else PG8_WAIT_V(12);
            PG8_WAIT_L(0); PG8_BAR; PG8_MMA(1, 0, At, B0); if constexpr (!HN) PG8_MMA(1, 1, At, B1); PG8_BAR; PG8_SCHED;
            PG8_LDB(B0, 1, 0); if constexpr (!HN) PG8_LDB(B1, 1, 1); PG8_SCHED; PG8_LDA(At, 1, 0); if constexpr (!HN) { PG8_BWAIT(2); PG8_BWRITE(0, 1); } PG8_BLOAD(t + 3, 0); PG8_STAGE(PG8_SA(0, 1), a2, v21);
            if constexpr (HN) PG8_WAIT_V(8); else PG8_WAIT_V(12);
            PG8_WAIT_L(0); PG8_BAR; PG8_MMA(0, 0, At, B0); if constexpr (!HN) PG8_MMA(0, 1, At, B1); PG8_BAR; PG8_SCHED;
            PG8_LDA(At, 1, 1); PG8_BWAIT(2); PG8_BWRITE(1, 0); if constexpr (!HN) PG8_BLOAD(t + 3, 1); PG8_STAGE(PG8_SA(1, 0), a3, v20);
            if constexpr (HN) PG8_WAIT_V(8); else PG8_WAIT_V(12);
            PG8_WAIT_L(0); PG8_BAR; PG8_MMA(1, 0, At, B0); if constexpr (!HN) PG8_MMA(1, 1, At, B1); PG8_BAR; PG8_SCHED;
        }
        if (wr == 0) PG8_BAR;
        prob.epi(acc, cur, wr, wc, fr, fq, 0);
        if (has_next) { f32x4 bini[2][2]; prob.bias_load(nxt, wc, fq, bini);
#pragma unroll
            for (int b = 0; b < 2; ++b)
#pragma unroll
                for (int m = 0; m < 4; ++m)
#pragma unroll
                    for (int n = 0; n < 2; ++n) acc[0][b][m][n] = bini[b][n]; }
        prob.epi(acc, cur, wr, wc, fr, fq, 1);
        if (!has_next) break;
#pragma unroll
        for (int b = 0; b < 2; ++b)
#pragma unroll
            for (int m = 0; m < 4; ++m)
#pragma unroll
                for (int n = 0; n < 2; ++n) acc[1][b][m][n] = acc[0][b][m][n];
        cur = nxt; cBo = nBo; cCol = nCol; ++ui; vC0[0] = vN0[0]; vC0[1] = vN0[1]; vC1[0] = vN1[0]; vC1[1] = vN1[1];
        if (wr == 1) PG8_BAR;
    }
    PG8_BWAIT(0);
    PG8_BAR;
#undef PG8_SA
#undef PG8_SB
#undef PG8_STAGE
#undef PG8_LDA
#undef PG8_LDB
#undef PG8_MMA
#undef PG8_WAIT_V
#undef PG8_WAIT_L
#undef PG8_BAR
#undef PG8_SCHED
#undef PG8_BLOAD
#undef PG8_BWAIT
#undef PG8_BWRITE
#undef PG8_BLOADX
#undef PG8_BWAITX
#undef PG8_BWRITEX
}
}

constexpr int NWAVES = 8, NTHR = 512;
constexpr int RING_BYTES = 131072;
constexpr int TAB_OFF = 147968;
constexpr int MISC_OFF = 163840 - 256;
constexpr int LDS_BYTES = 163840;

struct Frame {
    LAS unsigned char* lds; volatile LAS unsigned* MISC; unsigned* ctl;
    int tid, lane, wave, vcu, G;
    const float *x, *c, *w_ada, *b_ada, *g1, *w_in, *lq1, *lk1, *lq2, *lk2, *subln, *relb, *cw, *cb, *clg, *clb, *w_out, *g2, *w_r, *b_r, *w_gu, *b_gu, *w_d, *b_d, *fg;
    float* out; unsigned char* ws;
};
#define WSP(T_, off) ((T_*)(F.ws + (off)))

__device__ __forceinline__ void p0_transpose_item(const float* W, int ldn, int n0, int k0, bf16* dst, int drow0, LAS unsigned char* scr, int lane) {
    const int ng = lane & 31, kh = lane >> 5;
#pragma unroll
    for (int it = 0; it < 4; ++it) {
        f32x4 v[8];
#pragma unroll
        for (int j = 0; j < 8; ++j) v[j] = *(const GAS f32x4*)(W + (size_t)(k0 + 16 * it + 8 * kh + j) * ldn + n0 + 4 * ng);
        const int kc = 2 * it + kh;
#pragma unroll
        for (int i = 0; i < 4; ++i) { const int n = 4 * ng + i;
            u32x4 o; o.x = pk2(v[0][i], v[1][i]); o.y = pk2(v[2][i], v[3][i]); o.z = pk2(v[4][i], v[5][i]); o.w = pk2(v[6][i], v[7][i]);
            *(LAS u32x4*)(scr + n * 128 + ((kc ^ (ng & 7)) << 4)) = o; }
    }
    LDS_WAIT(); asm volatile("" ::: "memory");
#pragma unroll
    for (int j = 0; j < 16; ++j) { const int n = 8 * j + (lane >> 3), c = lane & 7;
        const u32x4 o = *(const LAS u32x4*)(scr + n * 128 + ((c ^ ((n >> 2) & 7)) << 4));
        *(GAS u32x4*)(dst + (size_t)(drow0 + n) * pg8::KD + k0 + 8 * c) = o; }
    LDS_WAIT(); asm volatile("" ::: "memory");
}
__device__ __forceinline__ void p0_prologue(Frame& F) {
    const int gw = F.vcu * NWAVES + F.wave, NGW = F.G * NWAVES, gt = F.vcu * NTHR + F.tid, NGT = F.G * NTHR;
    LAS float* cs = (LAS float*)(F.lds);
    for (int i = F.tid; i < NB * DM; i += NTHR) cs[i] = silu_f(F.c[i]);
    __syncthreads();
    float* modp = WSP(float, WS_MODP);
    for (int it = gw; it < 192 * 8; it += NGW) {
        const int cc = it % 192, kc = it / 192, r = F.lane >> 4, g = F.lane & 15;
        float acc[4][4];
#pragma unroll
        for (int b = 0; b < 4; ++b)
#pragma unroll
            for (int j = 0; j < 4; ++j) acc[b][j] = 0.f;
        const float* wp = F.w_ada + (size_t)(kc * 256 + r) * (6 * DM) + cc * 64 + g * 4;
#pragma unroll 8
        for (int s = 0; s < 64; ++s) {
            const f32x4 w = *(const GAS f32x4*)(wp + (size_t)(4 * s) * (6 * DM)); const int k = kc * 256 + 4 * s + r;
#pragma unroll
            for (int b = 0; b < 4; ++b) { const float cv = cs[b * DM + k];
#pragma unroll
                for (int j = 0; j < 4; ++j) acc[b][j] += cv * w[j]; }
        }
#pragma unroll
        for (int b = 0; b < 4; ++b)
#pragma unroll
            for (int j = 0; j < 4; ++j) { float v = acc[b][j]; v += __shfl_xor(v, 16); v += __shfl_xor(v, 32); acc[b][j] = v; }
        if (F.lane < 16)
#pragma unroll
            for (int b = 0; b < 4; ++b) *(GAS f32x4*)(modp + (size_t)(kc * 4 + b) * (6 * DM) + cc * 64 + g * 4) = (f32x4){acc[b][0], acc[b][1], acc[b][2], acc[b][3]};
    }
    __syncthreads();
    LAS unsigned char* scr = F.lds + F.wave * 16384;
    constexpr int I_IN = (INC / 128) * 32, I_OUT = (DM / 128) * 32;
    for (int it = gw; it < I_IN + I_OUT; it += NGW) {
        int r = it;
        if (r < I_IN) { const int nb = r >> 5, kb = r & 31;
            const int drow = nb < 24 ? nb * 128 : (nb < 32 ? 3072 + (nb - 24) * 256 : 3072 + (nb - 32) * 256 + 128);
            p0_transpose_item(F.w_in, INC, nb * 128, kb * 64, WSP(bf16, WS_WIN), drow, scr, F.lane); continue; } r -= I_IN;
        { const int nb = r >> 5, kb = r & 31; p0_transpose_item(F.w_out, DM, nb * 128, kb * 64, WSP(bf16, WS_WOUT), nb * 128, scr, F.lane); }
    }
    for (int i = gt; i < 64 * 2 * 64; i += NGT) {
        const int l = i & 63, nb = (i >> 6) & 1, s = i >> 7, e = 16 * nb + (l & 15), kb = 32 * s + 8 * (l >> 4);
        unsigned hi[8], lo[8];
#pragma unroll
        for (int j = 0; j < 8; ++j) { const float w = F.w_r[(size_t)(kb + j) * NE + e]; hi[j] = f2bf(w); lo[j] = f2bf(w - bf2f(hi[j])); }
        u32x4 oh, ol; oh.x = hi[0] | (hi[1] << 16); oh.y = hi[2] | (hi[3] << 16); oh.z = hi[4] | (hi[5] << 16); oh.w = hi[6] | (hi[7] << 16);
        ol.x = lo[0] | (lo[1] << 16); ol.y = lo[2] | (lo[3] << 16); ol.z = lo[4] | (lo[5] << 16); ol.w = lo[6] | (lo[7] << 16);
        *(GAS u32x4*)(WSP(unsigned char, WS_WRF) + (size_t)i * 16) = oh; *(GAS u32x4*)(WSP(unsigned char, WS_WRF) + 131072 + (size_t)i * 16) = ol;
    }
    float* bt = WSP(float, WS_BIAST);
    for (int i = gt; i < AH * 4096; i += NGT) { const int h = i >> 12, rel = (i & 4095) - 2048; bt[i] = F.relb[t5_bucket(rel) * AH + h] * LOG2E; }
    if (gt == 0) { float a = 0.f, b = 0.f; for (int i = 0; i < HD; ++i) { a += F.lq1[i] * F.lk1[i]; b += F.lq2[i] * F.lk2[i]; } bt[AH * 4096] = __expf(a) - __expf(b) + 0.2f; }
}

__device__ __forceinline__ void p1_norm1(Frame& F) {
    const float* modp = WSP(float, WS_MODP); float* mod = WSP(float, WS_MOD);
    for (int o = F.vcu * NTHR + F.tid; o < NB * 6 * DM; o += F.G * NTHR) { float s = F.b_ada[o % (6 * DM)];
#pragma unroll
        for (int kc = 0; kc < 8; ++kc) s += modp[(size_t)kc * (NB * 6 * DM) + o];
        mod[o] = s; }
    LAS float* gm = (LAS float*)F.lds; LAS float* sh = gm + DM;
    bf16* h = WSP(bf16, WS_H);
    for (int rb = F.vcu; rb < T / 32; rb += F.G) {
        const int b = rb / (SEQ / 32);
        __syncthreads();
        for (int k = F.tid; k < DM; k += NTHR) { float sc = F.b_ada[DM + k], sf = F.b_ada[k];
#pragma unroll
            for (int kc = 0; kc < 8; ++kc) { sc += modp[(size_t)(kc * 4 + b) * (6 * DM) + DM + k]; sf += modp[(size_t)(kc * 4 + b) * (6 * DM) + k]; }
            gm[k] = F.g1[k] * (1.f + sc); sh[k] = sf; }
        __syncthreads();
        for (int rr = F.wave; rr < 32; rr += NWAVES) {
            const int row = rb * 32 + rr;
            const GAS f32x4* xr = (const GAS f32x4*)(F.x + (size_t)row * DM) + F.lane;
            f32x4 v[8]; float s = 0.f;
#pragma unroll
            for (int j = 0; j < 8; ++j) { v[j] = xr[64 * j]; s += (v[j].x * v[j].x + v[j].y * v[j].y) + (v[j].z * v[j].z + v[j].w * v[j].w); }
            const float rstd = rsqrtf(wave_sum(s) * (1.f / DM) + EPS);
            GAS u32x2* o8 = (GAS u32x2*)(h + (size_t)row * DM) + F.lane;
#pragma unroll
            for (int j = 0; j < 8; ++j) { const int k = 4 * F.lane + 256 * j; const f32x4 g = *(const LAS f32x4*)(gm + k), s4 = *(const LAS f32x4*)(sh + k);
                u32x2 w; w.x = pk2(v[j].x * rstd * g.x + s4.x, v[j].y * rstd * g.y + s4.y); w.y = pk2(v[j].z * rstd * g.z + s4.z, v[j].w * rstd * g.w + s4.w); st_wt8(o8 + 64 * j, w); }
        }
    }
}

template <bool HMT> struct InProjT {
    static constexpr bool PERM = true;
    const bf16* A; const bf16* Bt; bf16* O; pg8::DenseOrder ord;
    __device__ bool next(int i, pg8::Unit& u) const { return ord.next(i, u); }
    __device__ const char* a_base() const { return (const char*)A; }
    __device__ void a_off(const pg8::Unit& u, const int (&R)[2], const int (&C)[2], unsigned (&v0)[2], unsigned (&v1)[2]) const {
#pragma unroll
        for (int i = 0; i < 2; ++i) { v0[i] = (unsigned)((u.pm * u.rows + R[i]) * pg8::KD + C[i]) * 2u; v1[i] = (unsigned)((u.pm * u.rows + 128 + R[i]) * pg8::KD + C[i]) * 2u; } }
    __device__ const char* b_base(const pg8::Unit& u) const { return (const char*)(Bt + (size_t)u.pn * 256 * pg8::KD); }
    __device__ void epi(const f32x4 (&acc)[2][2][4][2], const pg8::Unit& u, int wr, int wc, int fr, int fq) const {
        const int row0 = u.pm * u.rows + wr * 64 + fr, col0 = u.pn * 256 + wc * 32 + 8 * fq;
        if (u.pn >= 12) {
            const int zc = 3072 + (u.pn - 12) * 128 + wc * 32 + 8 * fq;
#pragma unroll
            for (int ai = 0; ai < (HMT ? 1 : 2); ++ai)
#pragma unroll
                for (int m = 0; m < 4; ++m) { float r[8];
#pragma unroll
                    for (int n = 0; n < 2; ++n)
#pragma unroll
                        for (int j = 0; j < 4; ++j) r[4 * n + j] = acc[ai][0][m][n][j] * __builtin_amdgcn_rcpf(1.f + __builtin_amdgcn_exp2f(-LOG2E * acc[ai][1][m][n][j]));
                    u32x4 w; w.x = cvt_pk_bf16(r[0], r[1]); w.y = cvt_pk_bf16(r[2], r[3]); w.z = cvt_pk_bf16(r[4], r[5]); w.w = cvt_pk_bf16(r[6], r[7]);
                    *(GAS u32x4*)(O + (size_t)(row0 + ai * 128 + m * 16) * INC + zc) = w; }
            return; }
#pragma unroll
        for (int ai = 0; ai < (HMT ? 1 : 2); ++ai)
#pragma unroll
            for (int m = 0; m < 4; ++m) { bf16* rowp = O + (size_t)(row0 + ai * 128 + m * 16) * INC + col0;
#pragma unroll
                for (int bj = 0; bj < 2; ++bj) { const f32x4 v0 = acc[ai][bj][m][0], v1 = acc[ai][bj][m][1];
                    u32x4 w; w.x = cvt_pk_bf16(v0[0], v0[1]); w.y = cvt_pk_bf16(v0[2], v0[3]); w.z = cvt_pk_bf16(v1[0], v1[1]); w.w = cvt_pk_bf16(v1[2], v1[3]);
                    *(GAS u32x4*)(rowp + bj * 128) = w; } }
    }
};
struct OutProj {
    static constexpr bool PERM = true;
    const bf16* A; const bf16* Bt; const float* x; const float* mod; bf16* O; pg8::DenseOrder ord;
    __device__ bool next(int i, pg8::Unit& u) const { return ord.next(i, u); }
    __device__ const char* a_base() const { return (const char*)A; }
    __device__ void a_off(const pg8::Unit& u, const int (&R)[2], const int (&C)[2], unsigned (&v0)[2], unsigned (&v1)[2]) const {
#pragma unroll
        for (int i = 0; i < 2; ++i) { v0[i] = (unsigned)((u.pm * 256 + R[i]) * pg8::KD + C[i]) * 2u; v1[i] = (unsigned)((u.pm * 256 + 128 + R[i]) * pg8::KD + C[i]) * 2u; } }
    __device__ const char* b_base(const pg8::Unit& u) const { return (const char*)(Bt + (size_t)u.pn * 256 * pg8::KD); }
    __device__ void epi(const f32x4 (&acc)[2][2][4][2], const pg8::Unit& u, int wr, int wc, int fr, int fq) const {
        const int row0 = u.pm * 256 + wr * 64 + fr, col0 = u.pn * 256 + wc * 32 + 8 * fq, b = (u.pm * 256) / SEQ;
        f32x4 gt[2][2];
#pragma unroll
        for (int bj = 0; bj < 2; ++bj)
#pragma unroll
            for (int n = 0; n < 2; ++n) gt[bj][n] = *(const GAS f32x4*)(mod + (size_t)b * 6 * DM + 2 * DM + col0 + bj * 128 + 4 * n);
#pragma unroll
        for (int ai = 0; ai < 2; ++ai)
#pragma unroll
            for (int m = 0; m < 4; ++m) { const size_t ro = (size_t)(row0 + ai * 128 + m * 16) * DM + col0;
#pragma unroll
                for (int bj = 0; bj < 2; ++bj) { const f32x4 x0 = *(const GAS f32x4*)(x + ro + bj * 128), x1v = *(const GAS f32x4*)(x + ro + bj * 128 + 4);
                    const f32x4 v0 = x0 + gt[bj][0] * acc[ai][bj][m][0], v1 = x1v + gt[bj][1] * acc[ai][bj][m][1];
                    u32x4 w; w.x = cvt_pk_bf16(v0[0], v0[1]); w.y = cvt_pk_bf16(v0[2], v0[3]); w.z = cvt_pk_bf16(v1[0], v1[1]); w.w = cvt_pk_bf16(v1[2], v1[3]);
                    *(GAS u32x4*)(O + ro + bj * 128) = w; } }
    }
};
struct MoeTab { const LAS int* tp; const LAS int* off; const LAS int* cnt; };
__device__ __forceinline__ void moe_tables(Frame& F) {
    LAS int* tab = (LAS int*)(F.lds + TAB_OFF);
    __syncthreads();
    if (F.tid < 64) {
        const int e = F.lane & 31;
        const int c = (int)__hip_atomic_load(F.ctl + CW_CNT + e * CNT_STRIDE, __ATOMIC_RELAXED, __HIP_MEMORY_SCOPE_AGENT);
        const int t0 = (c + 255) >> 8; int t = t0, o = c;
#pragma unroll
        for (int d = 1; d < 32; d <<= 1) { const int t2 = __shfl_up(t, d, 32), o2 = __shfl_up(o, d, 32); if (e >= d) { t += t2; o += o2; } }
        if (F.lane < NE) { tab[e] = t - t0; tab[40 + e] = o - c; tab[80 + e] = c; }
        if (F.lane == NE - 1) { tab[NE] = t; tab[40 + NE] = o; }
    }
    __syncthreads();
}
template <int NTN, int REPF, int SPLIT>
__device__ __forceinline__ bool moe_next(const MoeTab& tb, int G, int c, int i, pg8::Unit& u) {
    int L = i * G + c; const int total = NTN * __builtin_amdgcn_readfirstlane(tb.tp[NE]); int hs = 0;
    if (SPLIT != 0) {
        const int nrem = total % G, nful = (2 * nrem <= G) ? total - nrem : total;
        if (SPLIT == 1) { if (L >= nful) return false; }
        else { if (L >= 2 * (total - nful)) return false; hs = L & 1; L = nful + (L >> 1); }
    } else { if (L >= total * REPF) return false; if (REPF > 1 && L >= total) L -= total; }
    int e = 0;
#pragma unroll
    for (int j = 1; j < NE; ++j) e += (L >= NTN * tb.tp[j]) ? 1 : 0;
    e = __builtin_amdgcn_readfirstlane(e);
    const int tpe = __builtin_amdgcn_readfirstlane(tb.tp[e]), tpe1 = __builtin_amdgcn_readfirstlane(tb.tp[e + 1]);
    const int local = L - NTN * tpe, nte = tpe1 - tpe;
    u.e = e; u.hs = hs; u.pn = __builtin_amdgcn_readfirstlane(local / nte); u.pm = local - u.pn * nte; u.rows = __builtin_amdgcn_readfirstlane(tb.cnt[e]) - 256 * u.pm; return true;
}
struct MoeGU {
    static constexpr bool PERM = true;
    const bf16* A; const float* W; const float* bias; const int* list; bf16* O; MoeTab tb; int G, c;
    __device__ bool next(int i, pg8::Unit& u) const { return moe_next<16, 1 + ((REP_MASK >> 11) & 1), 0>(tb, G, c, i, u); }
    __device__ const char* a_base() const { return (const char*)A; }
    __device__ void a_off(const pg8::Unit& u, unsigned (&v0)[2], unsigned (&v1)[2]) const {
        const int* lp = list + u.e * T + 256 * u.pm;
        int tb16 = (int)threadIdx.x * 16; asm volatile("" : "+v"(tb16));
#pragma unroll
        for (int i = 0; i < 2; ++i) { int R, C; pg8::stage_rc(tb16 + i * 8192, R, C);
            const int r0 = R < u.rows ? R : u.rows - 1, r1 = (128 + R) < u.rows ? (128 + R) : u.rows - 1;
            v0[i] = (unsigned)(lp[r0] * pg8::KD + C) * 2u; v1[i] = (unsigned)(lp[r1] * pg8::KD + C) * 2u; } }
    __device__ void bias_load(const pg8::Unit& u, int wc, int fq, f32x4 (&bi)[2][2]) const {
        int cb = wc * 32 + 8 * ((fq >> 1) + 2 * (fq & 1)); asm volatile("" : "+v"(cb));
        const float* bp = bias + (size_t)u.e * 2 * DFF + u.pn * 128 + cb;
#pragma unroll
        for (int bj = 0; bj < 2; ++bj)
            { const f32x4 t0 = *(const GAS f32x4*)(bp + bj * DFF), t1 = *(const GAS f32x4*)(bp + bj * DFF + 4); bi[bj][0] = (f32x4){t0[0], t1[0], t0[1], t1[1]}; bi[bj][1] = (f32x4){t0[2], t1[2], t0[3], t1[3]}; } }
    static constexpr int LDW_BYTES = 2 * DFF * 4, W_BYTES = DM * 2 * DFF * 4;
    __device__ const char* b_ptr(const pg8::Unit& u) const { return (const char*)(W + (size_t)u.e * DM * 2 * DFF); }
    static constexpr int HALF_BYTES = DFF * 4;
    __device__ unsigned b_col(const pg8::Unit& u, int lane) const { return (unsigned)(u.pn * 128 + 2 * lane) * 4u; }
    __device__ void epi(const f32x4 (&acc)[2][2][4][2], const pg8::Unit& u, int wr, int wc, int fr, int fq, const int ai) const {
        int rt0 = wr * 64 + fr, colt = u.pn * 128 + wc * 32 + 8 * ((fq >> 1) + 2 * (fq & 1)); asm volatile("" : "+v"(rt0), "+v"(colt)); const size_t slot0 = (size_t)__builtin_amdgcn_readfirstlane(tb.off[u.e]) + 256 * u.pm;
#pragma unroll
            for (int m = 0; m < 4; ++m) { const int rt = rt0 + ai * 128 + m * 16; float r[8];
#pragma unroll
                for (int n = 0; n < 2; ++n)
#pragma unroll
                    for (int j = 0; j < 4; ++j) { const int o = (j >> 1) + 2 * n + 4 * (j & 1);
                        float g = acc[ai][0][m][n][j], up = acc[ai][1][m][n][j];
                        g = fminf(g, 7.f); up = fminf(fmaxf(up, -7.f), 7.f);
                        r[o] = (up + 1.f) * g * __builtin_amdgcn_rcpf(1.f + __builtin_amdgcn_exp2f(-1.702f * LOG2E * g)); }
                if (rt < u.rows) { u32x4 w; w.x = cvt_pk_bf16(r[0], r[1]); w.y = cvt_pk_bf16(r[2], r[3]); w.z = cvt_pk_bf16(r[4], r[5]); w.w = cvt_pk_bf16(r[6], r[7]);
                    *(GAS u32x4*)(O + (slot0 + rt) * DFF + colt) = w; } }
    }
};
template <int SPLIT> struct MoeDownT {
    static constexpr bool PERM = true;
    const bf16* A; const float* W; const float* bias; const float* sw; bf16* O; MoeTab tb; int G, c;
    __device__ bool next(int i, pg8::Unit& u) const { return moe_next<8, 1 + ((REP_MASK >> 12) & 1), SPLIT>(tb, G, c, i, u); }
    __device__ const char* a_base() const { return (const char*)A; }
    __device__ void a_off(const pg8::Unit& u, unsigned (&v0)[2], unsigned (&v1)[2]) const {
        const int s0 = __builtin_amdgcn_readfirstlane(tb.off[u.e]) + 256 * u.pm;
        int tb16 = (int)threadIdx.x * 16; asm volatile("" : "+v"(tb16));
#pragma unroll
        for (int i = 0; i < 2; ++i) { int R, C; pg8::stage_rc(tb16 + i * 8192, R, C);
            v0[i] = (unsigned)((s0 + R) * pg8::KD + C) * 2u; v1[i] = (unsigned)((s0 + 128 + R) * pg8::KD + C) * 2u; } }
    __device__ void bias_load(const pg8::Unit& u, int wc, int fq, f32x4 (&bi)[2][2]) const {
        int cb = wc * 32 + 8 * ((fq >> 1) + 2 * (fq & 1)); asm volatile("" : "+v"(cb));
        const float* bp = bias + (size_t)u.e * DM + u.pn * 256 + u.hs * 128 + cb;
#pragma unroll
        for (int bj = 0; bj < (SPLIT == 2 ? 1 : 2); ++bj)
            { const f32x4 t0 = *(const GAS f32x4*)(bp + bj * 128), t1 = *(const GAS f32x4*)(bp + bj * 128 + 4); bi[bj][0] = (f32x4){t0[0], t1[0], t0[1], t1[1]}; bi[bj][1] = (f32x4){t0[2], t1[2], t0[3], t1[3]}; } }
    static constexpr int LDW_BYTES = DM * 4, W_BYTES = DFF * DM * 4;
    __device__ const char* b_ptr(const pg8::Unit& u) const { return (const char*)(W + (size_t)u.e * DFF * DM); }
    static constexpr int HALF_BYTES = 128 * 4;
    __device__ unsigned b_col(const pg8::Unit& u, int lane) const { return (unsigned)(u.pn * 256 + u.hs * 128 + 2 * lane) * 4u; }
    __device__ void epi(const f32x4 (&acc)[2][2][4][2], const pg8::Unit& u, int wr, int wc, int fr, int fq, const int ai) const {
        int rt0 = wr * 64 + fr, col0 = u.pn * 256 + u.hs * 128 + wc * 32 + 8 * ((fq >> 1) + 2 * (fq & 1)); asm volatile("" : "+v"(rt0), "+v"(col0)); const size_t slot0 = (size_t)__builtin_amdgcn_readfirstlane(tb.off[u.e]) + 256 * u.pm;
#pragma unroll
            for (int m = 0; m < 4; ++m) { const int rt = rt0 + ai * 128 + m * 16;
                if (rt < u.rows) { const float wgt = sw[(size_t)u.e * T + 256 * u.pm + rt]; bf16* rowp = O + (slot0 + rt) * DM + col0;
#pragma unroll
                    for (int bj = 0; bj < (SPLIT == 2 ? 1 : 2); ++bj) { float r[8];
#pragma unroll
                        for (int n = 0; n < 2; ++n)
#pragma unroll
                            for (int j = 0; j < 4; ++j) { const int o = (j >> 1) + 2 * n + 4 * (j & 1); r[o] = acc[ai][bj][m][n][j] * wgt; }
                        u32x4 w; w.x = cvt_pk_bf16(r[0], r[1]); w.y = cvt_pk_bf16(r[2], r[3]); w.z = cvt_pk_bf16(r[4], r[5]); w.w = cvt_pk_bf16(r[6], r[7]);
                        *(GAS u32x4*)(rowp + bj * 128) = w; } } }
    }
};

__device__ __forceinline__ void conv_unit(Frame& F, int ct) {
    const int b = ct / (SEQ / 32), s0 = (ct % (SEQ / 32)) * 32, tid = F.tid;
    const bf16* proj = WSP(bf16, WS_PROJ); bf16* mix = WSP(bf16, WS_MIX);
    LAS unsigned* z = (LAS unsigned*)F.lds;
    LAS float* st = (LAS float*)(F.lds + 126976);
    __syncthreads();
    { const int rq = tid >> 7, c8 = tid & 127;
#pragma unroll 1
      for (int hb = 0; hb < 2; ++hb) { u32x4 zz[8];
#pragma unroll
          for (int i = 0; i < 8; ++i) { const int r = 32 * hb + 4 * i + rq, s = s0 - 15 + r; const bool ok = (r < 62 && s >= 0 && s < SEQ); const int sc = ok ? s : 0;
              zz[i] = *(const GAS u32x4*)(proj + (size_t)(b * SEQ + sc) * INC + 3072 + 8 * c8); if (!ok) zz[i] = (u32x4){0u, 0u, 0u, 0u}; }
#pragma unroll
          for (int i = 0; i < 8; ++i) { const int r = 32 * hb + 4 * i + rq; if (r < 62) *(LAS u32x4*)(z + r * 512 + 4 * c8) = zz[i]; } } }
    typedef float f32x2c __attribute__((ext_vector_type(2)));
    float w0[CK], w1[CK];
#pragma unroll
    for (int j = 0; j < CK; ++j) { const f32x2c w = *(const GAS f32x2c*)(F.cw + j * CCH + 2 * tid); w0[j] = w.x; w1[j] = w.y; }
    const f32x2c cbv = *(const GAS f32x2c*)(F.cb + 2 * tid), lg = *(const GAS f32x2c*)(F.clg + 2 * tid), lb = *(const GAS f32x2c*)(F.clb + 2 * tid);
    __syncthreads();
#pragma unroll 1
    for (int hf = 0; hf < 2; ++hf) {
        float c0[16], c1[16];
#pragma unroll
        for (int g = 0; g < 4; ++g) {
            float zl[34], zh[34];
#pragma unroll
            for (int r = 0; r < 34; ++r) { const unsigned zz = z[(16 * hf + 4 * g + r) * 512 + tid]; zl[r] = __builtin_bit_cast(float, zz << 16); zh[r] = __builtin_bit_cast(float, zz & 0xffff0000u); }
#pragma unroll
            for (int t = 0; t < 4; ++t) { float a0 = cbv.x, a1 = cbv.y;
#pragma unroll
                for (int j = 0; j < CK; ++j) { a0 = fmaf(w0[j], zl[t + j], a0); a1 = fmaf(w1[j], zh[t + j], a1); }
                c0[4 * g + t] = a0; c1[4 * g + t] = a1; }
        }
#pragma unroll
        for (int t = 0; t < 16; ++t) { const float sm = wave_sum(c0[t] + c1[t]), q = wave_sum(c0[t] * c0[t] + c1[t] * c1[t]);
            if (F.lane == 0) { st[(F.wave * 16 + t) * 2] = sm; st[(F.wave * 16 + t) * 2 + 1] = q; } }
        __syncthreads();
        if (tid < 16) { float sm = 0.f, q = 0.f;
#pragma unroll
            for (int w = 0; w < 8; ++w) { sm += st[(w * 16 + tid) * 2]; q += st[(w * 16 + tid) * 2 + 1]; }
            const float mu = sm * (1.f / CCH), var = q * (1.f / CCH) - mu * mu; st[512 + tid * 2] = mu; st[512 + tid * 2 + 1] = rsqrtf(fmaxf(var, 0.f) + EPS); }
        __syncthreads();
#pragma unroll
        for (int t = 0; t < 16; ++t) { const float mu = st[512 + t * 2], rs = st[512 + t * 2 + 1];
            const float y0 = (c0[t] - mu) * rs * lg.x + lb.x, y1 = (c1[t] - mu) * rs * lg.y + lb.y;
            const float o0 = y0 * __builtin_amdgcn_rcpf(1.f + __builtin_amdgcn_exp2f(-LOG2E * y0)), o1 = y1 * __builtin_amdgcn_rcpf(1.f + __builtin_amdgcn_exp2f(-LOG2E * y1));
            *(GAS unsigned*)(mix + (size_t)(b * SEQ + s0 + 16 * hf + t) * DM + 1024 + 2 * tid) = cvt_pk_bf16(o0, o1); }
        __syncthreads();
    }
}

namespace att {
constexpr int KVBLK = 64; constexpr size_t SHM_V = KVBLK * 128 * 2, SHM_K = KVBLK * 128 * 2;
constexpr float C = 0.125f * LOG2E, THR2 = 8.f * LOG2E;
#define KSWZ(row, colB) ((row) * 256 + ((colB) ^ (((row) & 7) << 4)))
#define SBAR() __builtin_amdgcn_sched_barrier(0)
__device__ __forceinline__ int crow(int r, int hi) { return (r & 3) + 8 * (r >> 2) + 4 * hi; }
__device__ __forceinline__ int v_st(int k, int c) { const int kk = (k & ~0xC) | ((k & 4) << 1) | ((k & 8) >> 1); return ((kk >> 3) * 4 + (c >> 5)) * 512 + ((kk & 7) * 32 + (c & 31)) * 2; }
__device__ __forceinline__ int v_rd_base(int lane) { return ((lane & 3) << 3) | (((lane >> 2) & 3) << 6) | (((lane >> 4) & 1) << 5) | (((lane >> 5) & 1) << 8); }
constexpr int v_rd_off(int d0, int ks, int half) { return d0 * 512 + ks * 4096 + half * 2048; }
template <int OFF> __device__ __forceinline__ s16x4 tr_read(int vb) { s16x4 r; asm volatile("ds_read_b64_tr_b16 %0, %1 offset:%2" : "=&v"(r) : "v"(vb), "i"(OFF) : "memory"); return r; }
template <int D0> __device__ __forceinline__ void pv_one(f32x16& od, int vb, bf16x8 pa0, bf16x8 pa1, bf16x8 pa2, bf16x8 pa3) {
    const s16x4 l0 = tr_read<v_rd_off(D0, 0, 0)>(vb), h0 = tr_read<v_rd_off(D0, 0, 1)>(vb), l1 = tr_read<v_rd_off(D0, 1, 0)>(vb), h1 = tr_read<v_rd_off(D0, 1, 1)>(vb);
    const s16x4 l2 = tr_read<v_rd_off(D0, 2, 0)>(vb), h2 = tr_read<v_rd_off(D0, 2, 1)>(vb), l3 = tr_read<v_rd_off(D0, 3, 0)>(vb), h3 = tr_read<v_rd_off(D0, 3, 1)>(vb);
    asm volatile("s_waitcnt lgkmcnt(0)" ::: "memory"); SBAR();
#define PK(L, H) (bf16x8){L[0], L[1], L[2], L[3], H[0], H[1], H[2], H[3]}
    od = __builtin_amdgcn_mfma_f32_32x32x16_bf16(pa0, PK(l0, h0), od, 0, 0, 0);
    od = __builtin_amdgcn_mfma_f32_32x32x16_bf16(pa1, PK(l1, h1), od, 0, 0, 0);
    od = __builtin_amdgcn_mfma_f32_32x32x16_bf16(pa2, PK(l2, h2), od, 0, 0, 0);
    od = __builtin_amdgcn_mfma_f32_32x32x16_bf16(pa3, PK(l3, h3), od, 0, 0, 0);
#undef PK
}
__device__ __forceinline__ void pv_d0(f32x16* o, int vb, bf16x8 pa0, bf16x8 pa1, bf16x8 pa2, bf16x8 pa3) {
    pv_one<0>(o[0], vb, pa0, pa1, pa2, pa3); pv_one<1>(o[1], vb, pa0, pa1, pa2, pa3); pv_one<2>(o[2], vb, pa0, pa1, pa2, pa3); pv_one<3>(o[3], vb, pa0, pa1, pa2, pa3);
}
__device__ __forceinline__ void qkt(f32x16& p0, f32x16& p1, const LAS char* Ks, const bf16x8* qr, int r32, int hi, int map) {
    p0 = f32x16{}; p1 = f32x16{};
#pragma unroll
    for (int d0 = 0; d0 < 4; ++d0) { const int cb = ((map * 4 + d0) * 16 + hi * 8) * 2;
        const bf16x8 b0 = *(const LAS bf16x8*)(Ks + KSWZ(r32, cb)); const bf16x8 b1 = *(const LAS bf16x8*)(Ks + KSWZ(32 + r32, cb));
        p0 = __builtin_amdgcn_mfma_f32_32x32x16_bf16(b0, qr[d0], p0, 0, 0, 0);
        p1 = __builtin_amdgcn_mfma_f32_32x32x16_bf16(b1, qr[d0], p1, 0, 0, 0); }
}
__device__ __forceinline__ void partialSM(f32x16& p0, f32x16& p1, float& m_reg, float& mn, float& alpha, int relw, int relb, int hi, const LAS float* btab, float bneg, float bpos) {
    if (relw - 31 >= 91 || relw + 63 <= -91) {
        const float bc = (relw > 0) ? bpos : bneg;
        float pmax = p0[0];
#pragma unroll
        for (int r = 1; r < 16; ++r) pmax = fmaxf(pmax, p0[r]);
#pragma unroll
        for (int r = 0; r < 16; ++r) pmax = fmaxf(pmax, p1[r]);
        { auto rr = __builtin_amdgcn_permlane32_swap(__float_as_uint(pmax), __float_as_uint(pmax), false, false); pmax = fmaxf(__uint_as_float(rr[0]), __uint_as_float(rr[1])); }
        const float tmax = fmaf(pmax, C, bc);
        if (__builtin_expect(__all(tmax - m_reg <= THR2), 1)) { mn = m_reg; alpha = 1.f; }
        else { mn = fmaxf(m_reg, tmax); alpha = __builtin_amdgcn_exp2f(m_reg - mn); m_reg = mn; }
        const float off = bc - mn;
#pragma unroll
        for (int r = 0; r < 16; ++r) p0[r] = fmaf(p0[r], C, off);
#pragma unroll
        for (int r = 0; r < 16; ++r) p1[r] = fmaf(p1[r], C, off);
    } else {
#pragma unroll
        for (int r = 0; r < 16; ++r) { const int idx = relb + crow(r, hi) + 256; p0[r] = fmaf(p0[r], C, btab[idx]); p1[r] = fmaf(p1[r], C, btab[idx + 32]); }
        float pmax = p0[0];
#pragma unroll
        for (int r = 1; r < 16; ++r) pmax = fmaxf(pmax, p0[r]);
#pragma unroll
        for (int r = 0; r < 16; ++r) pmax = fmaxf(pmax, p1[r]);
        { auto rr = __builtin_amdgcn_permlane32_swap(__float_as_uint(pmax), __float_as_uint(pmax), false, false); pmax = fmaxf(__uint_as_float(rr[0]), __uint_as_float(rr[1])); }
        if (__builtin_expect(__all(pmax - m_reg <= THR2), 1)) { mn = m_reg; alpha = 1.f; }
        else { mn = fmaxf(m_reg, pmax); alpha = __builtin_amdgcn_exp2f(m_reg - mn); m_reg = mn; }
#pragma unroll
        for (int r = 0; r < 16; ++r) p0[r] -= mn;
#pragma unroll
        for (int r = 0; r < 16; ++r) p1[r] -= mn;
    }
#pragma unroll
    for (int r = 0; r < 16; ++r) p0[r] = __builtin_amdgcn_exp2f(p0[r]);
}
__device__ __forceinline__ void finishSM(f32x16& p0, f32x16& p1, float alpha, float& l_reg, bf16x8& pa0, bf16x8& pa1, bf16x8& pa2, bf16x8& pa3) {
#pragma unroll
    for (int r = 0; r < 16; ++r) p1[r] = __builtin_amdgcn_exp2f(p1[r]);
    float ps = 0;
#pragma unroll
    for (int r = 0; r < 16; ++r) ps += p0[r];
#pragma unroll
    for (int r = 0; r < 16; ++r) ps += p1[r];
    { auto rr = __builtin_amdgcn_permlane32_swap(__float_as_uint(ps), __float_as_uint(ps), false, false); ps = __uint_as_float(rr[0]) + __uint_as_float(rr[1]); }
    l_reg = l_reg * alpha + ps;
#define PK4(P, BASE, OUT) do { unsigned a0 = cvt_pk_bf16(P[BASE + 0], P[BASE + 1]), a1 = cvt_pk_bf16(P[BASE + 2], P[BASE + 3]);   \
    unsigned b0 = cvt_pk_bf16(P[BASE + 4], P[BASE + 5]), b1 = cvt_pk_bf16(P[BASE + 6], P[BASE + 7]);                              \
    auto r0 = __builtin_amdgcn_permlane32_swap(a0, b0, false, false); auto r1 = __builtin_amdgcn_permlane32_swap(a1, b1, false, false); \
    u32x4 w = {r0[0], r1[0], r0[1], r1[1]}; OUT = __builtin_bit_cast(bf16x8, w); } while (0)
    PK4(p0, 0, pa0); PK4(p0, 8, pa1); PK4(p1, 0, pa2); PK4(p1, 8, pa3);
#undef PK4
}
constexpr int L_V = 0, L_K = 32768, L_WS = 65536, L_BT = 67584, L_CB = 69632;
__device__ __forceinline__ void attn_unit(Frame& F, int unit) {
    const int bh = unit >> 4, qb = unit & 15, b = bh >> 3, h = bh & 7, q0 = qb * 128;
    const int tid = F.tid, wid = F.wave, lane = F.lane, r32 = lane & 31, hi = lane >> 5, rg = wid & 3, map = wid >> 2;
    const bf16* proj = WSP(bf16, WS_PROJ);
    const bf16* Kh = proj + (size_t)(b * SEQ) * INC + 1024 + h * 128; const bf16* Vh = proj + (size_t)(b * SEQ) * INC + 2048 + h * 128;
    LAS char* lds = (LAS char*)F.lds; LAS char* V_lds = lds + L_V; LAS char* K_lds = lds + L_K;
    LAS float* wsf = (LAS float*)(lds + L_WS) + wid * 64; LAS float* li_l = wsf; LAS float* al_l = wsf + 32;
    LAS float* btab = (LAS float*)(lds + L_BT);
    const float* bt = WSP(float, WS_BIAST) + h * 4096;
    __syncthreads();
    btab[tid] = bt[2048 - 256 + tid];
    const float bneg = bt[2048 - 200], bpos = bt[2048 + 200], lam = WSP(float, WS_BIAST)[AH * 4096];
    float m_reg = -1e30f, l_reg = 0; f32x16 o[4] = {}; bf16x8 qr[4];
    const int qw0 = q0 + 32 * rg;
    const bf16* Qw = proj + (size_t)(b * SEQ + qw0 + r32) * INC + h * 128 + map * 64 + hi * 8;
#pragma unroll
    for (int d0 = 0; d0 < 4; ++d0) qr[d0] = *(const GAS bf16x8*)(Qw + d0 * 16);
    const int sr = tid >> 4, sc = (tid & 15) * 8, vst0 = v_st(sr, sc), vst1 = v_st(32 + sr, sc);
    const int vb0 = (int)(uintptr_t)V_lds + v_rd_base(lane);
    struct { bf16x8 vs0, vs1, ks0, ks1; } sr_[2];
#define SLOAD(i, k0) do { sr_[i].vs0 = *(const GAS bf16x8*)&Vh[(size_t)((k0) + sr) * INC + sc]; sr_[i].vs1 = *(const GAS bf16x8*)&Vh[(size_t)((k0) + 32 + sr) * INC + sc]; \
    sr_[i].ks0 = *(const GAS bf16x8*)&Kh[(size_t)((k0) + sr) * INC + sc]; sr_[i].ks1 = *(const GAS bf16x8*)&Kh[(size_t)((k0) + 32 + sr) * INC + sc]; } while (0)
#define SWRITE(bb, i) do { *(LAS bf16x8*)(V_lds + (bb) * SHM_V + vst0) = sr_[i].vs0; *(LAS bf16x8*)(V_lds + (bb) * SHM_V + vst1) = sr_[i].vs1; const int kc = sc * 2; \
    *(LAS bf16x8*)(K_lds + (bb) * SHM_K + KSWZ(sr, kc)) = sr_[i].ks0; *(LAS bf16x8*)(K_lds + (bb) * SHM_K + KSWZ(32 + sr, kc)) = sr_[i].ks1; } while (0)
#define SWAIT() asm volatile("s_waitcnt vmcnt(4)" ::: "memory")
#define RESC(a) do { if (__any((a) < 1.f)) { if (hi == 0) al_l[r32] = (a); asm volatile("s_waitcnt lgkmcnt(0)" ::: "memory"); \
    _Pragma("unroll") for (int d = 0; d < 4; ++d) _Pragma("unroll") for (int r = 0; r < 16; ++r) o[d][r] *= al_l[crow(r, hi)]; } } while (0)
#define PSM(P0, P1, MN, AL, k0) partialSM(P0, P1, m_reg, MN, AL, (k0) - qw0, (k0) - qw0 - r32, hi, btab, bneg, bpos)
    f32x16 pA0, pA1, pB0, pB1; float mnA, mnB, alA, alB; bf16x8 pa0, pa1, pa2, pa3; constexpr int NT = SEQ / KVBLK;
    constexpr int SE = 0, SO = 1;
    SLOAD(SE, 0); asm volatile("s_waitcnt vmcnt(0)" ::: "memory"); SWRITE(0, SE); __syncthreads();
    qkt(pA0, pA1, K_lds, qr, r32, hi, map); PSM(pA0, pA1, mnA, alA, 0);
    SLOAD(SO, KVBLK); SLOAD(SE, 2 * KVBLK);
    SWAIT(); SWRITE(1, SO); __syncthreads();
    for (int j = 1; j + 1 < NT; j += 2) {
        SBAR(); qkt(pB0, pB1, K_lds + SHM_K, qr, r32, hi, map);
        finishSM(pA0, pA1, alA, l_reg, pa0, pa1, pa2, pa3); SBAR();
        SLOAD(SO, (j + 2) * KVBLK); SBAR();
        pv_d0(o, vb0, pa0, pa1, pa2, pa3); PSM(pB0, pB1, mnB, alB, j * KVBLK);
        __syncthreads(); SWAIT(); SWRITE(0, SE);
        RESC(alB); __syncthreads();
        SBAR(); qkt(pA0, pA1, K_lds, qr, r32, hi, map);
        finishSM(pB0, pB1, alB, l_reg, pa0, pa1, pa2, pa3); SBAR();
        if (j + 3 < NT) SLOAD(SE, (j + 3) * KVBLK); SBAR();
        pv_d0(o, vb0 + (int)SHM_V, pa0, pa1, pa2, pa3); PSM(pA0, pA1, mnA, alA, (j + 1) * KVBLK);
        __syncthreads(); SWAIT(); SWRITE(1, SO);
        RESC(alA); __syncthreads();
    }
    SBAR(); qkt(pB0, pB1, K_lds + SHM_K, qr, r32, hi, map);
    finishSM(pA0, pA1, alA, l_reg, pa0, pa1, pa2, pa3); SBAR();
    pv_d0(o, vb0, pa0, pa1, pa2, pa3); PSM(pB0, pB1, mnB, alB, (NT - 1) * KVBLK);
    __syncthreads(); RESC(alB);
    finishSM(pB0, pB1, alB, l_reg, pa0, pa1, pa2, pa3); SBAR();
    pv_d0(o, vb0 + (int)SHM_V, pa0, pa1, pa2, pa3);
    if (hi == 0) li_l[r32] = l_reg; asm volatile("s_waitcnt lgkmcnt(0)" ::: "memory");
    float rli[16];
#pragma unroll
    for (int r = 0; r < 16; ++r) rli[r] = __builtin_amdgcn_rcpf(li_l[crow(r, hi)]);
    LAS float* cbuf = (LAS float*)(lds + L_CB) + rg * 32 * 128;
    if (map == 1) {
#pragma unroll
        for (int r = 0; r < 16; ++r)
#pragma unroll
            for (int d0 = 0; d0 < 4; ++d0) cbuf[crow(r, hi) * 128 + d0 * 32 + r32] = -lam * o[d0][r] * rli[r];
    }
    __syncthreads();
    if (map == 0) {
        bf16* mix = WSP(bf16, WS_MIX) + (size_t)(b * SEQ + qw0) * DM + h * 128;
        float sg[4];
#pragma unroll
        for (int d0 = 0; d0 < 4; ++d0) sg[d0] = F.subln[d0 * 32 + r32] * 0.8f;
#pragma unroll
        for (int r = 0; r < 16; ++r) { float v[4], ss = 0.f;
#pragma unroll
            for (int d0 = 0; d0 < 4; ++d0) { v[d0] = o[d0][r] * rli[r] + cbuf[crow(r, hi) * 128 + d0 * 32 + r32]; ss += v[d0] * v[d0]; }
#pragma unroll
            for (int s = 1; s < 32; s <<= 1) ss += __shfl_xor(ss, s);
            const float rstd = rsqrtf(ss * (1.f / VD) + EPS);
#pragma unroll
            for (int d0 = 0; d0 < 4; ++d0) mix[(size_t)crow(r, hi) * DM + d0 * 32 + r32] = (bf16)f2bf(v[d0] * rstd * sg[d0]); }
    }
#undef SLOAD
#undef SWRITE
#undef SWAIT
#undef RESC
#undef PSM
}
}

__device__ __forceinline__ void p5_router(Frame& F, bool dry = false) {
    const float* mod = WSP(float, WS_MOD); const bf16* x1 = WSP(bf16, WS_X1); bf16* h2 = WSP(bf16, WS_H2);
    int* list = (int*)(F.ws + WS_ROUTE + RT_LIST); float* sw = (float*)(F.ws + WS_ROUTE + RT_SW); int* toke = (int*)(F.ws + WS_ROUTE + RT_TOKE); int* tokr = (int*)(F.ws + WS_ROUTE + RT_TOKR);
    constexpr int RS = 4096 + 16;
    LAS unsigned char* Ahi = F.lds; LAS unsigned char* Alo = F.lds + 16 * RS; LAS float* Pl = (LAS float*)(F.lds + 32 * RS);
    const unsigned char* wrf = WSP(unsigned char, WS_WRF);
    LAS int* lcnt = (LAS int*)(F.lds + TAB_OFF);
    LAS int* asg = lcnt + 64; LAS float* aw = (LAS float*)(asg + 1024);
    for (int tb0 = F.vcu; tb0 < T / 16; tb0 += 2 * F.G) {
      if (F.tid < 32) lcnt[F.tid] = 0;
#pragma unroll 1
      for (int it = 0; it < 2; ++it) {
        const int tb = tb0 + it * F.G;
        if (tb >= T / 16) { asg[it * 512 + F.tid] = -1; continue; }
        const int b = (tb * 16) / SEQ;
        __syncthreads();
        { f32x4 v[2][8]; float rstd[2];
#pragma unroll
          for (int rr = 0; rr < 2; ++rr) { const GAS u32x2* xr = (const GAS u32x2*)(x1 + (size_t)(tb * 16 + 2 * F.wave + rr) * DM) + F.lane;
#pragma unroll
              for (int j = 0; j < 8; ++j) { const u32x2 xx = xr[64 * j]; v[rr][j] = (f32x4){bf2f(xx.x & 0xffffu), bf2f(xx.x >> 16), bf2f(xx.y & 0xffffu), bf2f(xx.y >> 16)}; } }
#pragma unroll
          for (int rr = 0; rr < 2; ++rr) { float s = 0.f;
#pragma unroll
              for (int j = 0; j < 8; ++j) s += (v[rr][j].x * v[rr][j].x + v[rr][j].y * v[rr][j].y) + (v[rr][j].z * v[rr][j].z + v[rr][j].w * v[rr][j].w);
              rstd[rr] = rsqrtf(wave_sum(s) * (1.f / DM) + EPS); }
#pragma unroll
          for (int j = 0; j < 8; ++j) { const int k = 4 * F.lane + 256 * j;
              const f32x4 g = *(const GAS f32x4*)(F.g2 + k), sc = *(const GAS f32x4*)(mod + (size_t)b * 6 * DM + 4 * DM + k), sf = *(const GAS f32x4*)(mod + (size_t)b * 6 * DM + 3 * DM + k);
#pragma unroll
              for (int rr = 0; rr < 2; ++rr) { const int tl = 2 * F.wave + rr;
                  float hv[4]; unsigned hb[4], lb[4];
#pragma unroll
                  for (int q = 0; q < 4; ++q) { hv[q] = v[rr][j][q] * rstd[rr] * g[q] * (1.f + sc[q]) + sf[q]; hb[q] = f2bf(hv[q]); lb[q] = f2bf(hv[q] - bf2f(hb[q])); }
                  u32x2 wh, wl; wh.x = hb[0] | (hb[1] << 16); wh.y = hb[2] | (hb[3] << 16); wl.x = lb[0] | (lb[1] << 16); wl.y = lb[2] | (lb[3] << 16);
                  st_wt8((GAS u32x2*)(h2 + (size_t)(tb * 16 + tl) * DM) + F.lane + 64 * j, wh); *(LAS u32x2*)(Ahi + tl * RS + k * 2) = wh; *(LAS u32x2*)(Alo + tl * RS + k * 2) = wl; } }
        }
        __syncthreads();
        { f32x4 acc0 = {0.f, 0.f, 0.f, 0.f}, acc1 = {0.f, 0.f, 0.f, 0.f};
#pragma unroll 2
          for (int ks = 0; ks < 8; ++ks) { const int s = 8 * F.wave + ks, k0 = 32 * s + 8 * (F.lane >> 4);
            const bf16x8 ah = *(const LAS bf16x8*)(Ahi + (F.lane & 15) * RS + k0 * 2), al = *(const LAS bf16x8*)(Alo + (F.lane & 15) * RS + k0 * 2);
            const bf16x8 bh0 = *(const GAS bf16x8*)(wrf + ((size_t)(s * 2 + 0) * 64 + F.lane) * 16), bh1 = *(const GAS bf16x8*)(wrf + ((size_t)(s * 2 + 1) * 64 + F.lane) * 16);
            const bf16x8 bl0 = *(const GAS bf16x8*)(wrf + 131072 + ((size_t)(s * 2 + 0) * 64 + F.lane) * 16), bl1 = *(const GAS bf16x8*)(wrf + 131072 + ((size_t)(s * 2 + 1) * 64 + F.lane) * 16);
            acc0 = __builtin_amdgcn_mfma_f32_16x16x32_bf16(ah, bh0, acc0, 0, 0, 0); acc0 = __builtin_amdgcn_mfma_f32_16x16x32_bf16(ah, bl0, acc0, 0, 0, 0); acc0 = __builtin_amdgcn_mfma_f32_16x16x32_bf16(al, bh0, acc0, 0, 0, 0);
            acc1 = __builtin_amdgcn_mfma_f32_16x16x32_bf16(ah, bh1, acc1, 0, 0, 0); acc1 = __builtin_amdgcn_mfma_f32_16x16x32_bf16(ah, bl1, acc1, 0, 0, 0); acc1 = __builtin_amdgcn_mfma_f32_16x16x32_bf16(al, bh1, acc1, 0, 0, 0); }
#pragma unroll
          for (int r = 0; r < 4; ++r) { const int tk = 4 * (F.lane >> 4) + r; Pl[(F.wave * 16 + tk) * 32 + (F.lane & 15)] = acc0[r]; Pl[(F.wave * 16 + tk) * 32 + 16 + (F.lane & 15)] = acc1[r]; }
        }
        __syncthreads();
        { const int tl = F.tid >> 5, e = F.tid & 31, tok = tb * 16 + tl;
          float v = F.b_r[e];
#pragma unroll
          for (int w = 0; w < 8; ++w) v += Pl[(w * 16 + tl) * 32 + e];
          float tv[4]; int ti[4];
#pragma unroll
          for (int r = 0; r < 4; ++r) { float bv = v; int bi = e;
#pragma unroll
              for (int o = 16; o > 0; o >>= 1) { const float ov = __shfl_xor(bv, o); const int oi = __shfl_xor(bi, o); if (ov > bv || (ov == bv && oi < bi)) { bv = ov; bi = oi; } }
              tv[r] = bv; ti[r] = bi; if (e == bi) v = -3.0e38f; }
          float den = 0.f, w[4];
#pragma unroll
          for (int r = 0; r < 4; ++r) { w[r] = __expf(tv[r] - tv[0]); den += w[r]; }
          int sel = -1; float wsel = 0.f;
#pragma unroll
          for (int r = 0; r < 4; ++r) if (e == ti[r]) { sel = r; wsel = w[r]; }
          int code = -1;
          if (sel >= 0 && !dry) code = sel | (__hip_atomic_fetch_add(lcnt + e, 1, __ATOMIC_RELAXED, __HIP_MEMORY_SCOPE_WORKGROUP) << 8);
          asg[it * 512 + F.tid] = code; aw[it * 512 + F.tid] = wsel / den; (void)tok;
        }
      }
      __syncthreads();
      if (F.tid < 32) { const int n = lcnt[F.tid]; lcnt[32 + F.tid] = n > 0 ? (int)atomicAdd(F.ctl + CW_CNT + F.tid * CNT_STRIDE, (unsigned)n) : 0; }
      __syncthreads();
#pragma unroll
      for (int it = 0; it < 2; ++it) { const int code = asg[it * 512 + F.tid];
          if (code >= 0) { const int e = F.tid & 31, tok = (tb0 + it * F.G) * 16 + (F.tid >> 5), sel = code & 255, rank = lcnt[32 + e] + (code >> 8);
              list[e * T + rank] = tok; sw[e * T + rank] = aw[it * 512 + F.tid]; toke[tok * 4 + sel] = e; tokr[tok * 4 + sel] = rank; } }
      __syncthreads();
    }
}

__device__ __forceinline__ void p8_final(Frame& F) {
    const float* mod = WSP(float, WS_MOD); const bf16* x1 = WSP(bf16, WS_X1); const bf16* y = WSP(bf16, WS_Y);
    const int* toke = (const int*)(F.ws + WS_ROUTE + RT_TOKE); const int* tokr = (const int*)(F.ws + WS_ROUTE + RT_TOKR);
    moe_tables(F);
    const LAS int* off = (const LAS int*)(F.lds + TAB_OFF) + 40;
    for (int row = F.vcu * NWAVES + F.wave; row < T; row += F.G * NWAVES) {
        const int b = row / SEQ;
        size_t so[4];
#pragma unroll
        for (int r = 0; r < 4; ++r) so[r] = (size_t)(off[toke[row * 4 + r]] + tokr[row * 4 + r]) * DM;
        const GAS u32x2* xr = (const GAS u32x2*)(x1 + (size_t)row * DM) + F.lane;
        f32x4 v[8]; float s = 0.f;
#pragma unroll
        for (int j = 0; j < 8; ++j) { const int k = 4 * F.lane + 256 * j; f32x4 m = {0.f, 0.f, 0.f, 0.f};
#pragma unroll
            for (int r = 0; r < 4; ++r) { const u32x2 yy = *(const GAS u32x2*)(y + so[r] + k); m[0] += bf2f(yy.x & 0xffffu); m[1] += bf2f(yy.x >> 16); m[2] += bf2f(yy.y & 0xffffu); m[3] += bf2f(yy.y >> 16); }
            const f32x4 g = *(const GAS f32x4*)(mod + (size_t)b * 6 * DM + 5 * DM + k);
            const u32x2 xx = xr[64 * j]; v[j] = (f32x4){bf2f(xx.x & 0xffffu), bf2f(xx.x >> 16), bf2f(xx.y & 0xffffu), bf2f(xx.y >> 16)} + g * m; s += (v[j].x * v[j].x + v[j].y * v[j].y) + (v[j].z * v[j].z + v[j].w * v[j].w); }
        const float rstd = rsqrtf(wave_sum(s) * (1.f / DM) + EPS);
        GAS f32x4* orow = (GAS f32x4*)(F.out + (size_t)row * DM) + F.lane;
#pragma unroll
        for (int j = 0; j < 8; ++j) { const f32x4 g = *(const GAS f32x4*)(F.fg + 4 * F.lane + 256 * j); orow[64 * j] = v[j] * rstd * g; }
    }
}

struct Args { const float* in[25]; float* out; unsigned char* ws; int ph_lo, ph_hi, li, pad; };
__global__ void __launch_bounds__(NTHR, 2) mega_fwd(Args args) {
    extern __shared__ __attribute__((aligned(16))) unsigned char lds[];
    Frame F;
    F.lds = (LAS unsigned char*)lds; F.MISC = (volatile LAS unsigned*)(F.lds + MISC_OFF);
    F.tid = threadIdx.x; F.lane = F.tid & 63; F.wave = __builtin_amdgcn_readfirstlane(F.tid >> 6);
    F.G = gridDim.x; { const int bx = blockIdx.x; F.vcu = (F.G % 8 == 0) ? (bx % 8) * (F.G / 8) + bx / 8 : bx; }
    F.ws = args.ws; F.ctl = (unsigned*)(args.ws + WS_CTL); F.out = args.out;
    F.x = args.in[0]; F.c = args.in[1]; F.w_ada = args.in[2]; F.b_ada = args.in[3]; F.g1 = args.in[4]; F.w_in = args.in[5]; F.lq1 = args.in[6]; F.lk1 = args.in[7]; F.lq2 = args.in[8]; F.lk2 = args.in[9];
    F.subln = args.in[10]; F.relb = args.in[11]; F.cw = args.in[12]; F.cb = args.in[13]; F.clg = args.in[14]; F.clb = args.in[15]; F.w_out = args.in[16]; F.g2 = args.in[17]; F.w_r = args.in[18]; F.b_r = args.in[19];
    F.w_gu = args.in[20]; F.b_gu = args.in[21]; F.w_d = args.in[22]; F.b_d = args.in[23]; F.fg = args.in[24];
    for (int u = F.tid; u < 64; u += NTHR) ((LAS unsigned*)(F.lds + MISC_OFF))[u] = 0u;
    __syncthreads();
    XcdBarrier bar = xcd_barrier_post(F.ctl + CW_BAR + args.li * XCD_BAR_WORDS, F.MISC + 8);
    const int lo = args.ph_lo, hi = args.ph_hi;
#ifndef PH_MASK
#define PH_MASK 0x1ff
#endif
#define IN(k) (((PH_MASK >> (k)) & 1) && lo <= (k) && (k) < hi)
#define SEAM(k) do { if (IN(k) && IN((k) + 1)) { xcd_barrier(bar); if constexpr (((REP_MASK >> 14) & 1) != 0) xcd_barrier(bar); } } while (0)
#define REP2(k, ...) do { { __VA_ARGS__ } if constexpr (((REP_MASK >> (k)) & 1) != 0) { __VA_ARGS__ } } while (0)
#ifndef PROBE_TS
#define PROBE_TS -1
#endif
    unsigned long long* const tsb = (unsigned long long*)(F.ctl + 8192);
#define STAMP(k) do { if constexpr (PROBE_TS >= 0) { if (F.tid == 0) __hip_atomic_store(tsb + (k) * 256 + blockIdx.x, (unsigned long long)wall_clock64(), __ATOMIC_RELAXED, __HIP_MEMORY_SCOPE_AGENT); } } while (0)
    STAMP(0);
    if (IN(0)) { REP2(0, __syncthreads(); p0_prologue(F);); } STAMP(1); SEAM(0);
    if (IN(0) && IN(1)) F.vcu = xcd_virtual_cu(bar);
    if (IN(1)) { REP2(1, __syncthreads(); p1_norm1(F);); } STAMP(2); SEAM(1);
    if (IN(2)) { REP2(2, { InProjT<false> P{WSP(bf16, WS_H), WSP(bf16, WS_WIN), WSP(bf16, WS_PROJ), {}}; P.ord.init(T, INC, F.G, F.vcu, false, true); P.ord.rep = 1 + ((REP_MASK >> 15) & 1); __syncthreads(); pg8::gemm_run(F.lds, P); }
        { InProjT<true> P{WSP(bf16, WS_H), WSP(bf16, WS_WIN), WSP(bf16, WS_PROJ), {}}; P.ord.init(T, INC, F.G, F.vcu, true, true); __syncthreads(); pg8::gemm_run<InProjT<true>, true>(F.lds, P); }); } STAMP(3); SEAM(2);
    if (IN(3)) { REP2(3,
        for (int ct = F.vcu; ct < T / 32; ct += F.G) conv_unit(F, ct);
        if constexpr (((REP_MASK >> 9) & 1) != 0) { for (int ct = F.vcu; ct < T / 32; ct += F.G) conv_unit(F, ct); }
        for (int u = F.vcu; u < NB * AH * 16 * (1 + ((REP_MASK >> 10) & 1)); u += F.G) att::attn_unit(F, u % (NB * AH * 16));
    ); } STAMP(4); SEAM(3);
    if (IN(4)) { REP2(4, OutProj P{WSP(bf16, WS_MIX), WSP(bf16, WS_WOUT), F.x, WSP(float, WS_MOD), WSP(bf16, WS_X1), {}}; P.ord.init(T, DM, F.G, F.vcu); P.ord.rep = 1 + ((REP_MASK >> 16) & 1); __syncthreads(); pg8::gemm_run(F.lds, P);); } STAMP(5); SEAM(4);
    if (IN(5)) { p5_router(F); if constexpr (((REP_MASK >> 13) & 1) != 0) { __syncthreads(); p5_router(F, true); } } STAMP(6); SEAM(5);
    if (IN(6)) { REP2(6, moe_tables(F); const LAS int* tab = (const LAS int*)(F.lds + TAB_OFF);
        MoeGU P{WSP(bf16, WS_H2), F.w_gu, F.b_gu, (const int*)(F.ws + WS_ROUTE + RT_LIST), WSP(bf16, WS_ACT), {tab, tab + 40, tab + 80}, F.G, F.vcu}; pg8::gemm_run_bf32(F.lds, P);); } STAMP(7); SEAM(6);
    if (IN(7)) { REP2(7, moe_tables(F); const LAS int* tab = (const LAS int*)(F.lds + TAB_OFF);
        { MoeDownT<1> P{WSP(bf16, WS_ACT), F.w_d, F.b_d, (const float*)(F.ws + WS_ROUTE + RT_SW), WSP(bf16, WS_Y), {tab, tab + 40, tab + 80}, F.G, F.vcu}; pg8::gemm_run_bf32(F.lds, P); }
        { MoeDownT<2> P{WSP(bf16, WS_ACT), F.w_d, F.b_d, (const float*)(F.ws + WS_ROUTE + RT_SW), WSP(bf16, WS_Y), {tab, tab + 40, tab + 80}, F.G, F.vcu}; pg8::gemm_run_bf32<MoeDownT<2>, true>(F.lds, P); }); } STAMP(8); SEAM(7);
    if (IN(8)) { REP2(8, p8_final(F);); }
    if constexpr (PROBE_TS >= 0) {
        STAMP(9); xcd_barrier(bar);
        if (blockIdx.x == 0) {
            LAS unsigned long long* sh = (LAS unsigned long long*)F.lds;
            __syncthreads();
            if (F.tid < 256) { const int cu = F.tid < (int)gridDim.x ? F.tid : 0;
                sh[F.tid] = __hip_atomic_load(tsb + (PROBE_TS + 1) * 256 + cu, __ATOMIC_RELAXED, __HIP_MEMORY_SCOPE_AGENT);
                sh[256 + F.tid] = __hip_atomic_load(tsb + PROBE_TS * 256 + cu, __ATOMIC_RELAXED, __HIP_MEMORY_SCOPE_AGENT); }
            __syncthreads();
            if (F.tid == 0) { long long mx = 0, sum = 0; for (int i = 0; i < 256; ++i) { const long long d = (long long)(sh[i] - sh[256 + i]); mx = d > mx ? d : mx; sum += d; }
                const long long W = sum / 256 / 100, sk = (mx - sum / 256) / 100;
                const long long a = PROBE_TS == 9 ? 0 : W > 1023 ? 1023 : W, b = sk > 255 ? 255 : (sk < 0 ? 0 : sk);
                const unsigned long long wait = (unsigned long long)(10 * a + 0 * b) * 100ull, t0 = wall_clock64();
                while ((unsigned long long)wall_clock64() - t0 < wait) __builtin_amdgcn_s_sleep(32); }
            __syncthreads();
        }
    }
#undef IN
#undef SEAM
}

extern "C" void kernel_launch(void* const* d_in, const int* in_sizes, int n_in, void* d_out, int out_size, void* d_ws, size_t ws_size, hipStream_t stream) {
    static int grid = 0;
    if (grid == 0) {
        if (n_in != 25 || ws_size < WS_END || out_size != T * DM) { fprintf(stderr, "kernel_launch: n_in %d out %d ws %zu (need %zu); nothing launched\n", n_in, out_size, ws_size, (size_t)WS_END); grid = -1; return; }
        int dev = 0, cus = 0, per_cu = 0;
        if (hipGetDevice(&dev) != hipSuccess || hipDeviceGetAttribute(&cus, hipDeviceAttributeMultiprocessorCount, dev) != hipSuccess) { grid = -1; return; }
        if (hipFuncSetAttribute((const void*)mega_fwd, hipFuncAttributeMaxDynamicSharedMemorySize, LDS_BYTES) != hipSuccess) { fprintf(stderr, "kernel_launch: hipFuncSetAttribute failed\n"); grid = -1; return; }
        if (hipOccupancyMaxActiveBlocksPerMultiprocessor(&per_cu, (const void*)mega_fwd, NTHR, LDS_BYTES) != hipSuccess || per_cu < 1) { fprintf(stderr, "kernel_launch: occupancy query says %d blocks per CU\n", per_cu); }
        (void)hipGetLastError();
        grid = cus;
    }
    if (grid < 0) return;
    unsigned char* ws = (unsigned char*)d_ws;
    (void)hipMemsetAsync(ws + WS_CTL, 0, CTL_ZERO_BYTES, stream);
    Args a{};
    for (int i = 0; i < 25; ++i) a.in[i] = (const float*)d_in[i];
    a.out = (float*)d_out; a.ws = ws; a.ph_lo = 0; a.ph_hi = 9; a.li = 0; a.pad = 0;
    hipLaunchKernelGGL(mega_fwd, dim3(grid), dim3(NTHR), LDS_BYTES, stream, a);
}
```

```cpp
#include <hip/hip_runtime.h>
#include <cstdio>
#include <cstdint>

#ifndef REP_MASK
#define REP_MASK 0
#endif

constexpr int DM = 2048, NB = 4, SEQ = 2048, T = NB * SEQ;
constexpr int AH = 8, HD = 64, VD = 128, CCH = 1024, CK = 31;
constexpr int INC = 5120;
constexpr int NE = 32, TOPK = 4, DFF = 2048, NSLOT = T * TOPK;
constexpr float EPS = 1e-6f;
constexpr float LOG2E = 1.4426950408889634f;

typedef unsigned short bf16;
typedef short bf16x8 __attribute__((ext_vector_type(8)));
typedef short s16x4 __attribute__((ext_vector_type(4)));
typedef float f32x4 __attribute__((ext_vector_type(4)));
typedef float f32x16 __attribute__((ext_vector_type(16)));
typedef unsigned u32x4 __attribute__((ext_vector_type(4)));
typedef unsigned u32x2 __attribute__((ext_vector_type(2)));
#define GAS __attribute__((address_space(1)))
#define LAS __attribute__((address_space(3)))
typedef GAS unsigned gu32;

constexpr size_t MiB = 1u << 20;
constexpr size_t WS_CTL = 0, CTL_ZERO_BYTES = 64 * 1024;
constexpr size_t WS_MODP = 1 * MiB;
constexpr size_t WS_MOD = 3 * MiB;
constexpr size_t WS_BIAST = 4 * MiB;
constexpr size_t WS_WRF = 5 * MiB;
constexpr size_t WS_ROUTE = 6 * MiB;
constexpr size_t RT_LIST = 0;
constexpr size_t RT_SW = 1 * MiB;
constexpr size_t RT_TOKE = 2 * MiB;
constexpr size_t RT_TOKR = RT_TOKE + 128 * 1024;
constexpr size_t WS_WIN = 16 * MiB;
constexpr size_t WS_WOUT = WS_WIN + 20 * MiB;
constexpr size_t WS_H = WS_WOUT + 8 * MiB;
constexpr size_t WS_PROJ = WS_H + 32 * MiB;
constexpr size_t WS_MIX = WS_PROJ + 80 * MiB;
constexpr size_t WS_X1 = WS_MIX + 32 * MiB;
constexpr size_t WS_H2 = WS_X1 + 64 * MiB;
constexpr size_t WS_ACT = WS_H2 + 32 * MiB;
constexpr size_t WS_Y = WS_ACT + 130 * MiB;
constexpr size_t WS_END = WS_Y + 130 * MiB;
constexpr int CW_CNT = 5120, CNT_STRIDE = 64;
constexpr int CW_BAR = 1024;

__device__ __forceinline__ unsigned f2bf(float f) { unsigned u = __builtin_bit_cast(unsigned, f); return (u + 0x7fffu + ((u >> 16) & 1u)) >> 16; }
__device__ __forceinline__ float bf2f(unsigned h) { return __builtin_bit_cast(float, h << 16); }
__device__ __forceinline__ unsigned pk2(float lo, float hi) { return f2bf(lo) | (f2bf(hi) << 16); }
__device__ __forceinline__ unsigned cvt_pk_bf16(float lo, float hi) { unsigned r; asm volatile("v_cvt_pk_bf16_f32 %0, %1, %2" : "=v"(r) : "v"(lo), "v"(hi)); return r; }
__device__ __forceinline__ float silu_f(float v) { return v / (1.f + __expf(-v)); }
__device__ __forceinline__ void st_wt8(GAS u32x2* p, u32x2 v) { asm volatile("global_store_dwordx2 %0, %1, off sc0 sc1" :: "v"(p), "v"(v) : "memory"); }
__device__ __forceinline__ void st_wt16(GAS u32x4* p, u32x4 v) { asm volatile("global_store_dwordx4 %0, %1, off sc0 sc1" :: "v"(p), "v"(v) : "memory"); }
__device__ __forceinline__ float wave_sum(float v) {
#pragma unroll
    for (int o = 1; o < 64; o <<= 1) v += __shfl_xor(v, o);
    return v;
}
__host__ __device__ inline int t5_bucket(int rel) {
    int ret = rel > 0 ? 16 : 0; int n = rel < 0 ? -rel : rel;
    if (n < 8) return ret + n;
    int lg = n >= 91 ? 15 : n >= 64 ? 14 : n >= 46 ? 13 : n >= 32 ? 12 : n >= 23 ? 11 : n >= 16 ? 10 : n >= 12 ? 9 : 8;
    return ret + lg;
}
#define LDS_WAIT() asm volatile("s_waitcnt lgkmcnt(0)" ::: "memory")
#define VM_WAIT() asm volatile("s_waitcnt vmcnt(0)" ::: "memory")

#define XB_TMO      128
#define XB_XCNT(j)  (256  + 64 * (j))
#define XB_XSUB(j)  (1280 + 64 * (j))
#define XB_XGEN(j)  (2304 + 64 * (j))
#define XB_TOP      3328
#define XB_TOPGEN   3392
#define XCD_BAR_WORDS 3456
#define XB_SPIN_CAP (1u << 18)
__device__ __forceinline__ unsigned xb_ld(unsigned* p)              { return __hip_atomic_load(p, __ATOMIC_RELAXED, __HIP_MEMORY_SCOPE_AGENT); }
__device__ __forceinline__ unsigned xb_add(unsigned* p, unsigned v) { return __hip_atomic_fetch_add(p, v, __ATOMIC_RELAXED, __HIP_MEMORY_SCOPE_AGENT); }
__device__ __forceinline__ unsigned xb_xcc_id() { return (unsigned)__builtin_amdgcn_s_getreg((3 << 11) | 20) & 0xFu; }
#define XB_SPIN(cond, bar) do { unsigned _sp = 0; while (cond) { __builtin_amdgcn_s_sleep(1); \
    if ((++_sp & 255u) == 0u) { if (xb_ld(&(bar)[XB_TMO])) break; if (_sp > XB_SPIN_CAP) { atomicAdd(&(bar)[XB_TMO], 1u); break; } } } } while (0)
struct XcdBarrier { unsigned* bar; unsigned x; volatile LAS unsigned* st; };
__device__ __forceinline__ XcdBarrier xcd_barrier_post(unsigned* bar, volatile LAS unsigned* st) {
    XcdBarrier b; b.bar = bar; b.x = xb_xcc_id(); b.st = st;
    if (threadIdx.x == 0) st[2] = xb_add(&bar[XB_XCNT(b.x)], 1u);
    return b;
}
__device__ __forceinline__ int xcd_virtual_cu(const XcdBarrier& b) {
    if (threadIdx.x == 0) { unsigned pre = 0u; for (unsigned j = 0; j < 16; ++j) { const unsigned c = xb_ld(&b.bar[XB_XCNT(j)]); pre += (j < b.x) ? c : 0u; } b.st[3] = pre + b.st[2]; }
    __syncthreads();
    const int v = (int)b.st[3];
    __syncthreads();
    return __builtin_amdgcn_readfirstlane(v);
}
__device__ __forceinline__ void xcd_barrier_complete(unsigned* bar, unsigned x, unsigned& nloc, unsigned& nx) {
    const unsigned G = gridDim.x * gridDim.y * gridDim.z;
    unsigned sum, cnt, mine, sp = 0u;
    for (;;) {
        sum = 0u; cnt = 0u; mine = 0u;
#pragma unroll
        for (unsigned j = 0; j < 16; ++j) { const unsigned c = xb_ld(&bar[XB_XCNT(j)]); sum += c; cnt += (c > 0u) ? 1u : 0u; mine = (j == x) ? c : mine; }
        if (sum == G) break;
        __builtin_amdgcn_s_sleep(1);
        if ((++sp & 255u) == 0u) { if (xb_ld(&bar[XB_TMO])) break; if (sp > XB_SPIN_CAP) { atomicAdd(&bar[XB_TMO], 1u); break; } }
    }
    nloc = mine > 0u ? mine : 1u; nx = cnt > 0u ? cnt : 1u;
}
__device__ __forceinline__ void xcd_barrier(const XcdBarrier& b) {
    asm volatile("s_waitcnt vmcnt(0)" ::: "memory");
    __syncthreads();
    if (threadIdx.x == 0) {
        unsigned* bar = b.bar;
        __builtin_amdgcn_s_waitcnt(0);
        unsigned nloc = b.st[0], nx = b.st[1];
        if (nloc == 0u) { xcd_barrier_complete(bar, b.x, nloc, nx); b.st[0] = nloc; b.st[1] = nx; }
        const unsigned old = xb_add(&bar[XB_XSUB(b.x)], 1u);
        const unsigned gen = old / nloc;
        if (old + 1u == (gen + 1u) * nloc) {
            __builtin_amdgcn_fence(__ATOMIC_RELEASE, "agent");
            asm volatile("s_waitcnt vmcnt(0)" ::: "memory");
            const unsigned og = xb_add(&bar[XB_TOP], 1u);
            const unsigned tg = og / nx;
            if (og + 1u == (tg + 1u) * nx) xb_add(&bar[XB_TOPGEN], 1u);
            else XB_SPIN(xb_ld(&bar[XB_TOPGEN]) == tg, bar);
            __builtin_amdgcn_fence(__ATOMIC_ACQUIRE, "agent");
            xb_add(&bar[XB_XGEN(b.x)], 1u);
            asm volatile("s_waitcnt vmcnt(0)" ::: "memory");
        } else {
            XB_SPIN(xb_ld(&bar[XB_XGEN(b.x)]) == gen, bar);
            __builtin_amdgcn_fence(__ATOMIC_ACQUIRE, "agent");
            asm volatile("s_waitcnt vmcnt(0)" ::: "memory");
        }
    }
    __syncthreads();
}

namespace pg8 {
constexpr int BM = 256, BK = 64, HALF = 128, HTB = HALF * BK * 2, STAGE_BYTES = 8 * HTB, KD = 2048;
__host__ __device__ __forceinline__ int lds_byte(int r, int c) { const int st = (r >> 4) * 2 + (c >> 5), rr = r & 15, cc = c & 31, ob = rr * 64 + cc * 2; return st * 1024 + (ob ^ (((ob >> 9) & 1) << 5)); }
__host__ __device__ __forceinline__ void stage_rc(int b, int& R, int& C) { const int st = b / 1024, sb = b % 1024, swz = sb ^ (((sb >> 9) & 1) << 5); R = (st >> 1) * 16 + swz / 64; C = (st & 1) * 32 + (swz % 64) / 2; }
__host__ __device__ __forceinline__ int perm32(int rho) { const int n = rho >> 4, i = rho & 15; return 8 * (i >> 2) + 4 * n + (i & 3); }
struct Unit { int pm, pn, e, rows, hs, q; };

struct DenseOrder {
    int nM, nN, nwg, nfull, G, c, rep = 1; bool half;
    __device__ void init(int M, int N, int G_, int c_, bool half_ = false, bool split_tail = false) { nM = M / BM; nN = N / BM; nwg = nM * nN; G = G_; c = c_; half = half_; nfull = split_tail ? (nwg / G_) * G_ : nwg; }
    __device__ bool next(int i, Unit& u) const {
        long L = (long)i * G + c; int hsel = 0;
        if (half) { if (L >= 2L * (nwg - nfull)) return false; hsel = (int)(L & 1); L = nfull + (L >> 1); }
        else { if (L >= (long)nfull * rep) return false; if (rep > 1 && L >= nfull) L -= nfull; }
        const int wgid = (int)L;
        const int nig = 8 * nN, gid = wgid / nig, fm = gid * 8, gsz = (nM - fm) < 8 ? (nM - fm) : 8;
        u.pm = fm + ((wgid % nig) % gsz); u.pn = (wgid % nig) / gsz; u.e = 0; u.hs = 0; u.q = 0; u.rows = 256; if (half) { u.pm = 2 * u.pm + hsel; u.rows = 128; } return true;
    }
};

template <class P, bool HM = false>
__device__ __forceinline__ void gemm_run(LAS unsigned char* lds, const P& prob) {
    const int tid = threadIdx.x, wid = __builtin_amdgcn_readfirstlane(tid >> 6), lane = tid & 63, wr = wid >> 2, wc = wid & 3, fr = lane & 15, fq = lane >> 4;
    constexpr int K = KD, nt = K / BK;
    int Rr[2], Cc[2]; unsigned voffB[2];
#pragma unroll
    for (int i = 0; i < 2; ++i) { int R, C; stage_rc(tid * 16 + i * 8192, R, C); Rr[i] = R; Cc[i] = C; const int Rb = P::PERM ? ((R & ~31) + perm32(R & 31)) : R; voffB[i] = (unsigned)(Rb * K + C) * 2u; }
    constexpr size_t kstep = (size_t)(BK * 2), hstep = (size_t)HALF * K * 2;
    const unsigned ldsw = (unsigned)wid * 1024u;
    const int aoff = lds_byte(wr * 64 + fr, fq * 8), boff = lds_byte(wc * 32 + fr, fq * 8);
#define PG8_SA(b, h) (((b) * 2 + (h)) * HTB)
#define PG8_SB(b, h) ((4 + (b) * 2 + (h)) * HTB)
#define PG8_STAGE(bufoff, gbase, voff) do { _Pragma("unroll") for (int _i = 0; _i < 2; ++_i) \
        __builtin_amdgcn_global_load_lds((const unsigned*)((const char*)(gbase) + (voff)[_i]), (LAS unsigned*)(lds + (bufoff) + ldsw + _i * 8192), 16, 0, 0); } while (0)
#define PG8_LDA(dst, b, h) do { _Pragma("unroll") for (int m = 0; m < 4; ++m) _Pragma("unroll") for (int k = 0; k < 2; ++k) dst[m][k] = *(const LAS bf16x8*)(lds + PG8_SA(b, h) + aoff + m * 2048 + k * 1024); } while (0)
#define PG8_LDB(dst, b, h) do { _Pragma("unroll") for (int n = 0; n < 2; ++n) _Pragma("unroll") for (int k = 0; k < 2; ++k) dst[n][k] = *(const LAS bf16x8*)(lds + PG8_SB(b, h) + boff + n * 2048 + k * 1024); } while (0)
#define PG8_MMA(ai, bj, At, Bt) do { __builtin_amdgcn_s_setprio(1); _Pragma("unroll") for (int m = 0; m < 4; ++m) _Pragma("unroll") for (int n = 0; n < 2; ++n) _Pragma("unroll") for (int k = 0; k < 2; ++k) \
        acc[ai][bj][m][n] = __builtin_amdgcn_mfma_f32_16x16x32_bf16(Bt[n][k], At[m][k], acc[ai][bj][m][n], 0, 0, 0); __builtin_amdgcn_s_setprio(0); } while (0)
#define PG8_WAIT_V(n) asm volatile("s_waitcnt vmcnt(" #n ")" ::: "memory")
#define PG8_WAIT_L(n) asm volatile("s_waitcnt lgkmcnt(" #n ")" ::: "memory")
#define PG8_BAR __builtin_amdgcn_s_barrier()
#define PG8_SCHED __builtin_amdgcn_sched_barrier(0)
    Unit cur, nxt; int ui = 0;
    if (!prob.next(0, cur)) return;
    f32x4 acc[2][2][4][2];
#pragma unroll
    for (int a = 0; a < 2; ++a)
#pragma unroll
        for (int b = 0; b < 2; ++b)
#pragma unroll
            for (int m = 0; m < 4; ++m)
#pragma unroll
                for (int n = 0; n < 2; ++n) acc[a][b][m][n] = (f32x4){0.f, 0.f, 0.f, 0.f};
    bf16x8 At[4][2], B0[2][2], B1[2][2];
    unsigned vC0[2], vC1[2], vN0[2], vN1[2];
    prob.a_off(cur, Rr, Cc, vC0, vC1);
    const char* const Ab = prob.a_base();
    const char* cB = prob.b_base(cur);
    PG8_STAGE(PG8_SB(0, 0), cB, voffB); PG8_STAGE(PG8_SB(0, 1), cB + hstep, voffB); PG8_STAGE(PG8_SA(0, 0), Ab, vC0); if constexpr (!HM) PG8_STAGE(PG8_SA(0, 1), Ab, vC1);
    if (wr == 1) PG8_BAR;
    if constexpr (HM) PG8_WAIT_V(0); else PG8_WAIT_V(2);
    PG8_BAR;
    PG8_STAGE(PG8_SB(1, 0), cB + kstep, voffB); PG8_STAGE(PG8_SA(1, 0), Ab + kstep, vC0); PG8_STAGE(PG8_SB(1, 1), cB + hstep + kstep, voffB);
    PG8_WAIT_V(6); PG8_BAR;
    for (;;) {
        const bool has_next = prob.next(ui + 1, nxt);
        if (has_next) prob.a_off(nxt, Rr, Cc, vN0, vN1); else { vN0[0] = vC0[0]; vN0[1] = vC0[1]; vN1[0] = vC1[0]; vN1[1] = vC1[1]; }
        const char* nB = has_next ? prob.b_base(nxt) : cB;
        for (int t = 0; t < nt; t += 2) {
            const bool last = (t == nt - 2);
            const char* a1 = Ab + (size_t)(t + 1) * kstep;
            const char* a2 = last ? Ab : Ab + (size_t)(t + 2) * kstep; const char* b2 = last ? nB : cB + (size_t)(t + 2) * kstep;
            const char* a3 = a2 + kstep; const char* b3 = b2 + kstep;
            unsigned v20[2], v21[2];
            v20[0] = last ? vN0[0] : vC0[0]; v20[1] = last ? vN0[1] : vC0[1]; v21[0] = last ? vN1[0] : vC1[0]; v21[1] = last ? vN1[1] : vC1[1];
            PG8_LDB(B0, 0, 0); PG8_LDB(B1, 0, 1); PG8_SCHED; PG8_LDA(At, 0, 0); if constexpr (!HM) PG8_STAGE(PG8_SA(1, 1), a1, vC1);
            if constexpr (HM) PG8_WAIT_V(6); else PG8_WAIT_V(8); PG8_WAIT_L(0); PG8_BAR; PG8_MMA(0, 0, At, B0); PG8_MMA(0, 1, At, B1); PG8_BAR; PG8_SCHED;
            if constexpr (!HM) PG8_LDA(At, 0, 1); PG8_STAGE(PG8_SB(0, 0), b2, voffB); PG8_STAGE(PG8_SB(0, 1), b2 + hstep, voffB); PG8_STAGE(PG8_SA(0, 0), a2, v20);
            if constexpr (HM) PG8_WAIT_V(6); else PG8_WAIT_V(8);
            PG8_WAIT_L(0); PG8_BAR; if constexpr (!HM) { PG8_MMA(1, 0, At, B0); PG8_MMA(1, 1, At, B1); } PG8_BAR; PG8_SCHED;
            PG8_LDB(B0, 1, 0); PG8_LDB(B1, 1, 1); PG8_SCHED; PG8_LDA(At, 1, 0); if constexpr (!HM) PG8_STAGE(PG8_SA(0, 1), a2, v21);
            if constexpr (HM) PG8_WAIT_V(6); else PG8_WAIT_V(8); PG8_WAIT_L(0); PG8_BAR; PG8_MMA(0, 0, At, B0); PG8_MMA(0, 1, At, B1); PG8_BAR; PG8_SCHED;
            if constexpr (!HM) PG8_LDA(At, 1, 1); PG8_STAGE(PG8_SB(1, 0), b3, voffB); PG8_STAGE(PG8_SB(1, 1), b3 + hstep, voffB); PG8_STAGE(PG8_SA(1, 0), a3, v20);
            if constexpr (HM) PG8_WAIT_V(6); else PG8_WAIT_V(8);
            PG8_WAIT_L(0); PG8_BAR; if constexpr (!HM) { PG8_MMA(1, 0, At, B0); PG8_MMA(1, 1, At, B1); } PG8_BAR; PG8_SCHED;
        }
        if (wr == 0) PG8_BAR;
        prob.epi(acc, cur, wr, wc, fr, fq);
        if (!has_next) break;
#pragma unroll
        for (int a = 0; a < 2; ++a)
#pragma unroll
            for (int b = 0; b < 2; ++b)
#pragma unroll
                for (int m = 0; m < 4; ++m)
#pragma unroll
                    for (int n = 0; n < 2; ++n) acc[a][b][m][n] = (f32x4){0.f, 0.f, 0.f, 0.f};
        cur = nxt; cB = nB; ++ui; vC0[0] = vN0[0]; vC0[1] = vN0[1]; vC1[0] = vN1[0]; vC1[1] = vN1[1];
        if (wr == 1) PG8_BAR;
    }
    PG8_WAIT_V(0);
    PG8_BAR;
#undef PG8_SA
#undef PG8_SB
#undef PG8_STAGE
#undef PG8_LDA
#undef PG8_LDB
#undef PG8_MMA
#undef PG8_WAIT_V
#undef PG8_WAIT_L
#undef PG8_BAR
#undef PG8_SCHED
}

template <class P, bool HN = false>
__device__ __forceinline__ void gemm_run_bf32(LAS unsigned char* lds, const P& prob) {
    const int tid = threadIdx.x, wid = __builtin_amdgcn_readfirstlane(tid >> 6), lane = tid & 63, wr = wid >> 2, wc = wid & 3, fr = lane & 15, fq = lane >> 4;
    constexpr int K = KD, nt = K / BK;
    constexpr size_t kstep = (size_t)(BK * 2);
    constexpr size_t ldwB = (size_t)P::LDW_BYTES;
    const unsigned ldsw = (unsigned)wid * 1024u;
    const int aoff = lds_byte(wr * 64 + fr, fq * 8), boff = lds_byte(wc * 32 + fr, fq * 8);
    const int wbo0 = lds_byte(32 * (lane >> 4) + (((lane >> 1) & 1) | (((lane >> 3) & 1) << 2) | (((lane >> 2) & 1) << 3)), 8 * wid + 4 * (lane & 1));
#define PG8_SA(b, h) (((b) * 2 + (h)) * HTB)
#define PG8_SB(b, h) ((4 + (b) * 2 + (h)) * HTB)
#define PG8_STAGE(bufoff, gbase, voff) do { _Pragma("unroll") for (int _i = 0; _i < 2; ++_i) \
        __builtin_amdgcn_global_load_lds((const unsigned*)((const char*)(gbase) + (voff)[_i]), (LAS unsigned*)(lds + (bufoff) + ldsw + _i * 8192), 16, 0, 0); } while (0)
#define PG8_LDA(dst, b, h) do { _Pragma("unroll") for (int m = 0; m < 4; ++m) _Pragma("unroll") for (int k = 0; k < 2; ++k) dst[m][k] = *(const LAS bf16x8*)(lds + PG8_SA(b, h) + aoff + m * 2048 + k * 1024); } while (0)
#define PG8_LDB(dst, b, h) do { _Pragma("unroll") for (int n = 0; n < 2; ++n) _Pragma("unroll") for (int k = 0; k < 2; ++k) dst[n][k] = *(const LAS bf16x8*)(lds + PG8_SB(b, h) + boff + n * 2048 + k * 1024); } while (0)
#define PG8_MMA(ai, bj, At, Bt) do { __builtin_amdgcn_s_setprio(1); _Pragma("unroll") for (int m = 0; m < 4; ++m) _Pragma("unroll") for (int n = 0; n < 2; ++n) _Pragma("unroll") for (int k = 0; k < 2; ++k) \
        acc[ai][bj][m][n] = __builtin_amdgcn_mfma_f32_16x16x32_bf16(Bt[n][k], At[m][k], acc[ai][bj][m][n], 0, 0, 0); __builtin_amdgcn_s_setprio(0); } while (0)
#define PG8_WAIT_V(n) asm volatile("s_waitcnt vmcnt(" #n ")" ::: "memory")
#define PG8_WAIT_L(n) asm volatile("s_waitcnt lgkmcnt(" #n ")" ::: "memory")
#define PG8_BAR __builtin_amdgcn_s_barrier()
#define PG8_SCHED __builtin_amdgcn_sched_barrier(0)
#define PG8_BLOAD(kk, h) do { const bool nx_ = (kk) >= nt; const unsigned so_ = (nx_ ? nBo : cBo) + (unsigned)((nx_ ? (kk) - nt : (kk)) * BK + 8 * wid) * (unsigned)ldwB + (unsigned)(h) * (unsigned)P::HALF_BYTES; \
        const unsigned co_ = nx_ ? nCol : cCol; \
        asm volatile("s_nop 4" ::: "memory"); \
        _Pragma("unroll") for (int j_ = 0; j_ < 4; ++j_) asm volatile("buffer_load_dwordx4 %0, %1, %2, %3 offen" : "=v"(bv[j_]) : "v"(co_), "s"(wrs), "s"(so_ + (unsigned)j_ * (unsigned)ldwB) : "memory"); } while (0)
#define PG8_BWAIT(n) asm volatile("s_waitcnt vmcnt(" #n ")" : "+v"(bv[0]), "+v"(bv[1]), "+v"(bv[2]), "+v"(bv[3]) :: "memory")
#define PG8_BWRITE(b, h) do { _Pragma("unroll") for (int i_ = 0; i_ < 4; ++i_) { u32x2 o_; o_.x = cvt_pk_bf16(bv[0][i_], bv[1][i_]); o_.y = cvt_pk_bf16(bv[2][i_], bv[3][i_]); \
        *(LAS u32x2*)(lds + PG8_SB(b, h) + wbo0 + 128 * (i_ & 1) + 2048 * (i_ >> 1)) = o_; } } while (0)
    typedef float f32x2v __attribute__((ext_vector_type(2)));
    Unit cur, nxt; int ui = 0;
    if (!prob.next(0, cur)) return;
    f32x4 acc[2][2][4][2];
    bf16x8 At[4][2], B0[2][2], B1[2][2];
    f32x4 bv[4];
    unsigned vC0[2], vC1[2], vN0[2], vN1[2];
    prob.a_off(cur, vC0, vC1);
    const char* const Ab = prob.a_base();
    const __amdgpu_buffer_rsrc_t wrs = __builtin_amdgcn_make_buffer_rsrc((void*)prob.W, 0, (unsigned)NE * (unsigned)P::W_BYTES, 0x00020000);
    unsigned cBo = (unsigned)cur.e * (unsigned)P::W_BYTES, cCol = prob.b_col(cur, lane & ~1) + (unsigned)(lane & 1) * 4u * (unsigned)ldwB;
    unsigned nBo = cBo, nCol = cCol;
#define PG8_BLOADX(R, kk, h) do { const unsigned so_ = cBo + (unsigned)((kk) * BK + 8 * wid) * (unsigned)ldwB + (unsigned)(h) * (unsigned)P::HALF_BYTES; \
        _Pragma("unroll") for (int j_ = 0; j_ < 4; ++j_) asm volatile("buffer_load_dwordx4 %0, %1, %2, %3 offen" : "=v"(R[j_]) : "v"(cCol), "s"(wrs), "s"(so_ + (unsigned)j_ * (unsigned)ldwB) : "memory"); } while (0)
#define PG8_BWAITX(R, n) asm volatile("s_waitcnt vmcnt(" #n ")" : "+v"(R[0]), "+v"(R[1]), "+v"(R[2]), "+v"(R[3]) :: "memory")
#define PG8_BWRITEX(R, b, h) do { _Pragma("unroll") for (int i_ = 0; i_ < 4; ++i_) { u32x2 o_; o_.x = cvt_pk_bf16(R[0][i_], R[1][i_]); o_.y = cvt_pk_bf16(R[2][i_], R[3][i_]); \
        *(LAS u32x2*)(lds + PG8_SB(b, h) + wbo0 + 128 * (i_ & 1) + 2048 * (i_ >> 1)) = o_; } } while (0)
    { f32x4 bw[4], bx[4];
      asm volatile("s_nop 4" ::: "memory");
      PG8_BLOADX(bv, 0, 0); if constexpr (!HN) PG8_BLOADX(bw, 0, 1); PG8_BLOADX(bx, 1, 0);
      PG8_STAGE(PG8_SA(0, 0), Ab, vC0); PG8_STAGE(PG8_SA(0, 1), Ab, vC1);
      if constexpr (!HN) { PG8_BWAITX(bv, 12); PG8_BWRITEX(bv, 0, 0); PG8_BWAITX(bw, 8); PG8_BWRITEX(bw, 0, 1); }
      else { PG8_BWAITX(bv, 8); PG8_BWRITEX(bv, 0, 0); }
      PG8_BWAITX(bx, 4); PG8_BWRITEX(bx, 1, 0); }
    if constexpr (!HN) PG8_BLOAD(1, 1);
    if (wr == 1) PG8_BAR;
    if constexpr (!HN) PG8_WAIT_V(4); else PG8_WAIT_V(0);
    PG8_WAIT_L(0); PG8_BAR;
    PG8_STAGE(PG8_SA(1, 0), Ab + kstep, vC0);
    { f32x4 bini[2][2]; prob.bias_load(cur, wc, fq, bini);
#pragma unroll
      for (int a = 0; a < 2; ++a)
#pragma unroll
        for (int b = 0; b < 2; ++b)
#pragma unroll
            for (int m = 0; m < 4; ++m)
#pragma unroll
                for (int n = 0; n < 2; ++n) acc[a][b][m][n] = bini[b][n]; }
    PG8_WAIT_V(0); PG8_BAR;
    for (;;) {
        const bool has_next = prob.next(ui + 1, nxt);
        if (has_next) { prob.a_off(nxt, vN0, vN1); nBo = (unsigned)nxt.e * (unsigned)P::W_BYTES; nCol = prob.b_col(nxt, lane & ~1) + (unsigned)(lane & 1) * 4u * (unsigned)ldwB; }
        else { vN0[0] = vC0[0]; vN0[1] = vC0[1]; vN1[0] = vC1[0]; vN1[1] = vC1[1]; nBo = cBo; nCol = cCol; }
        for (int t = 0; t < nt; t += 2) {
            const bool last = (t == nt - 2);
            const char* a1 = Ab + (size_t)(t + 1) * kstep;
            const char* a2 = last ? Ab : Ab + (size_t)(t + 2) * kstep;
            const char* a3 = a2 + kstep;
            unsigned v20[2], v21[2];
            v20[0] = last ? vN0[0] : vC0[0]; v20[1] = last ? vN0[1] : vC0[1]; v21[0] = last ? vN1[0] : vC1[0]; v21[1] = last ? vN1[1] : vC1[1];
            PG8_LDB(B0, 0, 0); if constexpr (!HN) PG8_LDB(B1, 0, 1); PG8_SCHED; PG8_LDA(At, 0, 0); if constexpr (!HN) { PG8_BWAIT(2); PG8_BWRITE(1, 1); } PG8_BLOAD(t + 2, 0); PG8_STAGE(PG8_SA(1, 1), a1, vC1);
            if constexpr (HN) PG8_WAIT_V(8); else PG8_WAIT_V(12);
            PG8_WAIT_L(0); PG8_BAR; PG8_MMA(0, 0, At, B0); if constexpr (!HN) PG8_MMA(0, 1, At, B1); PG8_BAR; PG8_SCHED;
            PG8_LDA(At, 0, 1); PG8_BWAIT(2); PG8_BWRITE(0, 0); if constexpr (!HN) PG8_BLOAD(t + 2, 1); PG8_STAGE(PG8_SA(0, 0), a2, v20);
            if constexpr (HN) PG8_WAIT_V(8); else PG8_WAIT_V(12);
            PG8_WAIT_L(0); PG8_BAR; PG8_MMA(1, 0, At, B0); if constexpr (!HN) PG8_MMA(1, 1, At, B1); PG8_BAR; PG8_SCHED;
            PG8_LDB(B0, 1, 0); if constexpr (!HN) PG8_LDB(B1, 1, 1); PG8_SCHED; PG8_LDA(At, 1, 0); if constexpr (!HN) { PG8_BWAIT(2); PG8_BWRITE(0, 1); } PG8_BLOAD(t + 3, 0); PG8_STAGE(PG8_SA(0, 1), a2, v21);
            if constexpr (HN) PG8_WAIT_V(8); else PG8_WAIT_V(12);
            PG8_WAIT_L(0); PG8_BAR; PG8_MMA(0, 0, At, B0); if constexpr (!HN) PG8_MMA(0, 1, At, B1); PG8_BAR; PG8_SCHED;
            PG8_LDA(At, 1, 1); PG8_BWAIT(2); PG8_BWRITE(1, 0); if constexpr (!HN) PG8_BLOAD(t + 3, 1); PG8_STAGE(PG8_SA(1, 0), a3, v20);
            if constexpr (HN) PG8_WAIT_V(8); else PG8_WAIT_V(12);
            PG8_WAIT_L(0); PG8_BAR; PG8_MMA(1, 0, At, B0); if constexpr (!HN) PG8_MMA(1, 1, At, B1); PG8_BAR; PG8_SCHED;
        }
        if (wr == 0) PG8_BAR;
        prob.epi(acc, cur, wr, wc, fr, fq, 0);
        if (has_next) { f32x4 bini[2][2]; prob.bias_load(nxt, wc, fq, bini);
#pragma unroll
            for (int b = 0; b < 2; ++b)
#pragma unroll
                for (int m = 0; m < 4; ++m)
#pragma unroll
                    for (int n = 0; n < 2; ++n) acc[0][b][m][n] = bini[b][n]; }
        prob.epi(acc, cur, wr, wc, fr, fq, 1);
        if (!has_next) break;
#pragma unroll
        for (int b = 0; b < 2; ++b)
#pragma unroll
            for (int m = 0; m < 4; ++m)
#pragma unroll
                for (int n = 0; n < 2; ++n) acc[1][b][m][n] = acc[0][b][m][n];
        cur = nxt; cBo = nBo; cCol = nCol; ++ui; vC0[0] = vN0[0]; vC0[1] = vN0[1]; vC1[0] = vN1[0]; vC1[1] = vN1[1];
        if (wr == 1) PG8_BAR;
    }
    PG8_BWAIT(0);
    PG8_BAR;
#undef PG8_SA
#undef PG8_SB
#undef PG8_STAGE
#undef PG8_LDA
#undef PG8_LDB
#undef PG8_MMA
#undef PG8_WAIT_V
#undef PG8_WAIT_L
#undef PG8_BAR
#undef PG8_SCHED
#undef PG8_BLOAD
#undef PG8_BWAIT
#undef PG8_BWRITE
#undef PG8_BLOADX
#undef PG8_BWAITX
#undef PG8_BWRITEX
}
}

constexpr int NWAVES = 8, NTHR = 512;
constexpr int RING_BYTES = 131072;
constexpr int TAB_OFF = 147968;
constexpr int MISC_OFF = 163840 - 256;
constexpr int LDS_BYTES = 163840;

struct Frame {
    LAS unsigned char* lds; volatile LAS unsigned* MISC; unsigned* ctl;
    int tid, lane, wave, vcu, G;
    const float *x, *c, *w_ada, *b_ada, *g1, *w_in, *lq1, *lk1, *lq2, *lk2, *subln, *relb, *cw, *cb, *clg, *clb, *w_out, *g2, *w_r, *b_r, *w_gu, *b_gu, *w_d, *b_d, *fg;
    float* out; unsigned char* ws;
};
#define WSP(T_, off) ((T_*)(F.ws + (off)))

__device__ __forceinline__ void p0_transpose_item(const float* W, int ldn, int n0, int k0, bf16* dst, int drow0, LAS unsigned char* scr, int lane) {
    const int ng = lane & 31, kh = lane >> 5;
#pragma unroll
    for (int it = 0; it < 4; ++it) {
        f32x4 v[8];
#pragma unroll
        for (int j = 0; j < 8; ++j) v[j] = *(const GAS f32x4*)(W + (size_t)(k0 + 16 * it + 8 * kh + j) * ldn + n0 + 4 * ng);
        const int kc = 2 * it + kh;
#pragma unroll
        for (int i = 0; i < 4; ++i) { const int n = 4 * ng + i;
            u32x4 o; o.x = pk2(v[0][i], v[1][i]); o.y = pk2(v[2][i], v[3][i]); o.z = pk2(v[4][i], v[5][i]); o.w = pk2(v[6][i], v[7][i]);
            *(LAS u32x4*)(scr + n * 128 + ((kc ^ (ng & 7)) << 4)) = o; }
    }
    LDS_WAIT(); asm volatile("" ::: "memory");
#pragma unroll
    for (int j = 0; j < 16; ++j) { const int n = 8 * j + (lane >> 3), c = lane & 7;
        const u32x4 o = *(const LAS u32x4*)(scr + n * 128 + ((c ^ ((n >> 2) & 7)) << 4));
        *(GAS u32x4*)(dst + (size_t)(drow0 + n) * pg8::KD + k0 + 8 * c) = o; }
    LDS_WAIT(); asm volatile("" ::: "memory");
}
__device__ __forceinline__ void p0_prologue(Frame& F) {
    const int gw = F.vcu * NWAVES + F.wave, NGW = F.G * NWAVES, gt = F.vcu * NTHR + F.tid, NGT = F.G * NTHR;
    LAS float* cs = (LAS float*)(F.lds);
    for (int i = F.tid; i < NB * DM; i += NTHR) cs[i] = silu_f(F.c[i]);
    __syncthreads();
    float* modp = WSP(float, WS_MODP);
    for (int it = gw; it < 192 * 8; it += NGW) {
        const int cc = it % 192, kc = it / 192, r = F.lane >> 4, g = F.lane & 15;
        float acc[4][4];
#pragma unroll
        for (int b = 0; b < 4; ++b)
#pragma unroll
            for (int j = 0; j < 4; ++j) acc[b][j] = 0.f;
        const float* wp = F.w_ada + (size_t)(kc * 256 + r) * (6 * DM) + cc * 64 + g * 4;
#pragma unroll 8
        for (int s = 0; s < 64; ++s) {
            const f32x4 w = *(const GAS f32x4*)(wp + (size_t)(4 * s) * (6 * DM)); const int k = kc * 256 + 4 * s + r;
#pragma unroll
            for (int b = 0; b < 4; ++b) { const float cv = cs[b * DM + k];
#pragma unroll
                for (int j = 0; j < 4; ++j) acc[b][j] += cv * w[j]; }
        }
#pragma unroll
        for (int b = 0; b < 4; ++b)
#pragma unroll
            for (int j = 0; j < 4; ++j) { float v = acc[b][j]; v += __shfl_xor(v, 16); v += __shfl_xor(v, 32); acc[b][j] = v; }
        if (F.lane < 16)
#pragma unroll
            for (int b = 0; b < 4; ++b) *(GAS f32x4*)(modp + (size_t)(kc * 4 + b) * (6 * DM) + cc * 64 + g * 4) = (f32x4){acc[b][0], acc[b][1], acc[b][2], acc[b][3]};
    }
    __syncthreads();
    LAS unsigned char* scr = F.lds + F.wave * 16384;
    constexpr int I_IN = (INC / 128) * 32, I_OUT = (DM / 128) * 32;
    for (int it = gw; it < I_IN + I_OUT; it += NGW) {
        int r = it;
        if (r < I_IN) { const int nb = r >> 5, kb = r & 31;
            const int drow = nb < 24 ? nb * 128 : (nb < 32 ? 3072 + (nb - 24) * 256 : 3072 + (nb - 32) * 256 + 128);
            p0_transpose_item(F.w_in, INC, nb * 128, kb * 64, WSP(bf16, WS_WIN), drow, scr, F.lane); continue; } r -= I_IN;
        { const int nb = r >> 5, kb = r & 31; p0_transpose_item(F.w_out, DM, nb * 128, kb * 64, WSP(bf16, WS_WOUT), nb * 128, scr, F.lane); }
    }
    for (int i = gt; i < 64 * 2 * 64; i += NGT) {
        const int l = i & 63, nb = (i >> 6) & 1, s = i >> 7, e = 16 * nb + (l & 15), kb = 32 * s + 8 * (l >> 4);
        unsigned hi[8], lo[8];
#pragma unroll
        for (int j = 0; j < 8; ++j) { const float w = F.w_r[(size_t)(kb + j) * NE + e]; hi[j] = f2bf(w); lo[j] = f2bf(w - bf2f(hi[j])); }
        u32x4 oh, ol; oh.x = hi[0] | (hi[1] << 16); oh.y = hi[2] | (hi[3] << 16); oh.z = hi[4] | (hi[5] << 16); oh.w = hi[6] | (hi[7] << 16);
        ol.x = lo[0] | (lo[1] << 16); ol.y = lo[2] | (lo[3] << 16); ol.z = lo[4] | (lo[5] << 16); ol.w = lo[6] | (lo[7] << 16);
        *(GAS u32x4*)(WSP(unsigned char, WS_WRF) + (size_t)i * 16) = oh; *(GAS u32x4*)(WSP(unsigned char, WS_WRF) + 131072 + (size_t)i * 16) = ol;
    }
    float* bt = WSP(float, WS_BIAST);
    for (int i = gt; i < AH * 4096; i += NGT) { const int h = i >> 12, rel = (i & 4095) - 2048; bt[i] = F.relb[t5_bucket(rel) * AH + h] * LOG2E; }
    if (gt == 0) { float a = 0.f, b = 0.f; for (int i = 0; i < HD; ++i) { a += F.lq1[i] * F.lk1[i]; b += F.lq2[i] * F.lk2[i]; } bt[AH * 4096] = __expf(a) - __expf(b) + 0.2f; }
}

__device__ __forceinline__ void p1_norm1(Frame& F) {
    const float* modp = WSP(float, WS_MODP); float* mod = WSP(float, WS_MOD);
    for (int o = F.vcu * NTHR + F.tid; o < NB * 6 * DM; o += F.G * NTHR) { float s = F.b_ada[o % (6 * DM)];
#pragma unroll
        for (int kc = 0; kc < 8; ++kc) s += modp[(size_t)kc * (NB * 6 * DM) + o];
        mod[o] = s; }
    LAS float* gm = (LAS float*)F.lds; LAS float* sh = gm + DM;
    bf16* h = WSP(bf16, WS_H);
    for (int rb = F.vcu; rb < T / 32; rb += F.G) {
        const int b = rb / (SEQ / 32);
        __syncthreads();
        for (int k = F.tid; k < DM; k += NTHR) { float sc = F.b_ada[DM + k], sf = F.b_ada[k];
#pragma unroll
            for (int kc = 0; kc < 8; ++kc) { sc += modp[(size_t)(kc * 4 + b) * (6 * DM) + DM + k]; sf += modp[(size_t)(kc * 4 + b) * (6 * DM) + k]; }
            gm[k] = F.g1[k] * (1.f + sc); sh[k] = sf; }
        __syncthreads();
        for (int rr = F.wave; rr < 32; rr += NWAVES) {
            const int row = rb * 32 + rr;
            const GAS f32x4* xr = (const GAS f32x4*)(F.x + (size_t)row * DM) + F.lane;
            f32x4 v[8]; float s = 0.f;
#pragma unroll
            for (int j = 0; j < 8; ++j) { v[j] = xr[64 * j]; s += (v[j].x * v[j].x + v[j].y * v[j].y) + (v[j].z * v[j].z + v[j].w * v[j].w); }
            const float rstd = rsqrtf(wave_sum(s) * (1.f / DM) + EPS);
            GAS u32x2* o8 = (GAS u32x2*)(h + (size_t)row * DM) + F.lane;
#pragma unroll
            for (int j = 0; j < 8; ++j) { const int k = 4 * F.lane + 256 * j; const f32x4 g = *(const LAS f32x4*)(gm + k), s4 = *(const LAS f32x4*)(sh + k);
                u32x2 w; w.x = pk2(v[j].x * rstd * g.x + s4.x, v[j].y * rstd * g.y + s4.y); w.y = pk2(v[j].z * rstd * g.z + s4.z, v[j].w * rstd * g.w + s4.w); st_wt8(o8 + 64 * j, w); }
        }
    }
}

template <bool HMT> struct InProjT {
    static constexpr bool PERM = true;
    const bf16* A; const bf16* Bt; bf16* O; pg8::DenseOrder ord;
    __device__ bool next(int i, pg8::Unit& u) const { return ord.next(i, u); }
    __device__ const char* a_base() const { return (const char*)A; }
    __device__ void a_off(const pg8::Unit& u, const int (&R)[2], const int (&C)[2], unsigned (&v0)[2], unsigned (&v1)[2]) const {
#pragma unroll
        for (int i = 0; i < 2; ++i) { v0[i] = (unsigned)((u.pm * u.rows + R[i]) * pg8::KD + C[i]) * 2u; v1[i] = (unsigned)((u.pm * u.rows + 128 + R[i]) * pg8::KD + C[i]) * 2u; } }
    __device__ const char* b_base(const pg8::Unit& u) const { return (const char*)(Bt + (size_t)u.pn * 256 * pg8::KD); }
    __device__ void epi(const f32x4 (&acc)[2][2][4][2], const pg8::Unit& u, int wr, int wc, int fr, int fq) const {
        const int row0 = u.pm * u.rows + wr * 64 + fr, col0 = u.pn * 256 + wc * 32 + 8 * fq;
        if (u.pn >= 12) {
            const int zc = 3072 + (u.pn - 12) * 128 + wc * 32 + 8 * fq;
#pragma unroll
            for (int ai = 0; ai < (HMT ? 1 : 2); ++ai)
#pragma unroll
                for (int m = 0; m < 4; ++m) { float r[8];
#pragma unroll
                    for (int n = 0; n < 2; ++n)
#pragma unroll
                        for (int j = 0; j < 4; ++j) r[4 * n + j] = acc[ai][0][m][n][j] * __builtin_amdgcn_rcpf(1.f + __builtin_amdgcn_exp2f(-LOG2E * acc[ai][1][m][n][j]));
                    u32x4 w; w.x = cvt_pk_bf16(r[0], r[1]); w.y = cvt_pk_bf16(r[2], r[3]); w.z = cvt_pk_bf16(r[4], r[5]); w.w = cvt_pk_bf16(r[6], r[7]);
                    *(GAS u32x4*)(O + (size_t)(row0 + ai * 128 + m * 16) * INC + zc) = w; }
            return; }
#pragma unroll
        for (int ai = 0; ai < (HMT ? 1 : 2); ++ai)
#pragma unroll
            for (int m = 0; m < 4; ++m) { bf16* rowp = O + (size_t)(row0 + ai * 128 + m * 16) * INC + col0;
#pragma unroll
                for (int bj = 0; bj < 2; ++bj) { const f32x4 v0 = acc[ai][bj][m][0], v1 = acc[ai][bj][m][1];
                    u32x4 w; w.x = cvt_pk_bf16(v0[0], v0[1]); w.y = cvt_pk_bf16(v0[2], v0[3]); w.z = cvt_pk_bf16(v1[0], v1[1]); w.w = cvt_pk_bf16(v1[2], v1[3]);
                    *(GAS u32x4*)(rowp + bj * 128) = w; } }
    }
};
struct OutProj {
    static constexpr bool PERM = true;
    const bf16* A; const bf16* Bt; const float* x; const float* mod; bf16* O; pg8::DenseOrder ord;
    __device__ bool next(int i, pg8::Unit& u) const { return ord.next(i, u); }
    __device__ const char* a_base() const { return (const char*)A; }
    __device__ void a_off(const pg8::Unit& u, const int (&R)[2], const int (&C)[2], unsigned (&v0)[2], unsigned (&v1)[2]) const {
#pragma unroll
        for (int i = 0; i < 2; ++i) { v0[i] = (unsigned)((u.pm * 256 + R[i]) * pg8::KD + C[i]) * 2u; v1[i] = (unsigned)((u.pm * 256 + 128 + R[i]) * pg8::KD + C[i]) * 2u; } }
    __device__ const char* b_base(const pg8::Unit& u) const { return (const char*)(Bt + (size_t)u.pn * 256 * pg8::KD); }
    __device__ void epi(const f32x4 (&acc)[2][2][4][2], const pg8::Unit& u, int wr, int wc, int fr, int fq) const {
        const int row0 = u.pm * 256 + wr * 64 + fr, col0 = u.pn * 256 + wc * 32 + 8 * fq, b = (u.pm * 256) / SEQ;
        f32x4 gt[2][2];
#pragma unroll
        for (int bj = 0; bj < 2; ++bj)
#pragma unroll
            for (int n = 0; n < 2; ++n) gt[bj][n] = *(const GAS f32x4*)(mod + (size_t)b * 6 * DM + 2 * DM + col0 + bj * 128 + 4 * n);
#pragma unroll
        for (int ai = 0; ai < 2; ++ai)
#pragma unroll
            for (int m = 0; m < 4; ++m) { const size_t ro = (size_t)(row0 + ai * 128 + m * 16) * DM + col0;
#pragma unroll
                for (int bj = 0; bj < 2; ++bj) { const f32x4 x0 = *(const GAS f32x4*)(x + ro + bj * 128), x1v = *(const GAS f32x4*)(x + ro + bj * 128 + 4);
                    const f32x4 v0 = x0 + gt[bj][0] * acc[ai][bj][m][0], v1 = x1v + gt[bj][1] * acc[ai][bj][m][1];
                    u32x4 w; w.x = cvt_pk_bf16(v0[0], v0[1]); w.y = cvt_pk_bf16(v0[2], v0[3]); w.z = cvt_pk_bf16(v1[0], v1[1]); w.w = cvt_pk_bf16(v1[2], v1[3]);
                    *(GAS u32x4*)(O + ro + bj * 128) = w; } }
    }
};
struct MoeTab { const LAS int* tp; const LAS int* off; const LAS int* cnt; };
__device__ __forceinline__ void moe_tables(Frame& F) {
    LAS int* tab = (LAS int*)(F.lds + TAB_OFF);
    __syncthreads();
    if (F.tid < 64) {
        const int e = F.lane & 31;
        const int c = (int)__hip_atomic_load(F.ctl + CW_CNT + e * CNT_STRIDE, __ATOMIC_RELAXED, __HIP_MEMORY_SCOPE_AGENT);
        const int t0 = (c + 255) >> 8; int t = t0, o = c;
#pragma unroll
        for (int d = 1; d < 32; d <<= 1) { const int t2 = __shfl_up(t, d, 32), o2 = __shfl_up(o, d, 32); if (e >= d) { t += t2; o += o2; } }
        if (F.lane < NE) { tab[e] = t - t0; tab[40 + e] = o - c; tab[80 + e] = c; }
        if (F.lane == NE - 1) { tab[NE] = t; tab[40 + NE] = o; }
    }
    __syncthreads();
}
template <int NTN, int REPF, int SPLIT>
__device__ __forceinline__ bool moe_next(const MoeTab& tb, int G, int c, int i, pg8::Unit& u) {
    int L = i * G + c; const int total = NTN * __builtin_amdgcn_readfirstlane(tb.tp[NE]); int hs = 0;
    if (SPLIT != 0) {
        const int nrem = total % G, nful = (2 * nrem <= G) ? total - nrem : total;
        if (SPLIT == 1) { if (L >= nful) return false; }
        else { if (L >= 2 * (total - nful)) return false; hs = L & 1; L = nful + (L >> 1); }
    } else { if (L >= total * REPF) return false; if (REPF > 1 && L >= total) L -= total; }
    int e = 0;
#pragma unroll
    for (int j = 1; j < NE; ++j) e += (L >= NTN * tb.tp[j]) ? 1 : 0;
    e = __builtin_amdgcn_readfirstlane(e);
    const int tpe = __builtin_amdgcn_readfirstlane(tb.tp[e]), tpe1 = __builtin_amdgcn_readfirstlane(tb.tp[e + 1]);
    const int local = L - NTN * tpe, nte = tpe1 - tpe;
    u.e = e; u.hs = hs; u.q = i % 3; u.pn = __builtin_amdgcn_readfirstlane(local / nte); u.pm = local - u.pn * nte; u.rows = __builtin_amdgcn_readfirstlane(tb.cnt[e]) - 256 * u.pm; return true;
}
struct MoeGU {
    static constexpr bool PERM = true;
    const bf16* A; const float* W; const float* bias; const int* list; bf16* O; MoeTab tb; int G, c;
    __device__ bool next(int i, pg8::Unit& u) const { return moe_next<16, 1 + ((REP_MASK >> 11) & 1), 0>(tb, G, c, i, u); }
    __device__ const char* a_base() const { return (const char*)A; }
    __device__ void a_off(const pg8::Unit& u, unsigned (&v0)[2], unsigned (&v1)[2]) const {
        const int* lp = list + u.e * T + 256 * u.pm;
        int tb16 = (int)threadIdx.x * 16; asm volatile("" : "+v"(tb16));
#pragma unroll
        for (int i = 0; i < 2; ++i) { int R, C; pg8::stage_rc(tb16 + i * 8192, R, C);
            const int r0 = R < u.rows ? R : u.rows - 1, r1 = (128 + R) < u.rows ? (128 + R) : u.rows - 1;
            v0[i] = (unsigned)(lp[r0] * pg8::KD + C) * 2u; v1[i] = (unsigned)(lp[r1] * pg8::KD + C) * 2u; } }
    __device__ void bias_load(const pg8::Unit& u, int wc, int fq, f32x4 (&bi)[2][2]) const {
        int cb = wc * 32 + 8 * ((fq >> 1) + 2 * (fq & 1)); asm volatile("" : "+v"(cb));
        const float* bp = bias + (size_t)u.e * 2 * DFF + u.pn * 128 + cb;
#pragma unroll
        for (int bj = 0; bj < 2; ++bj)
            { const f32x4 t0 = *(const GAS f32x4*)(bp + bj * DFF), t1 = *(const GAS f32x4*)(bp + bj * DFF + 4); bi[bj][0] = (f32x4){t0[0], t1[0], t0[1], t1[1]}; bi[bj][1] = (f32x4){t0[2], t1[2], t0[3], t1[3]}; } }
    static constexpr int LDW_BYTES = 2 * DFF * 4, W_BYTES = DM * 2 * DFF * 4;
    __device__ const char* b_ptr(const pg8::Unit& u) const { return (const char*)(W + (size_t)u.e * DM * 2 * DFF); }
    static constexpr int HALF_BYTES = DFF * 4;
    __device__ unsigned b_col(const pg8::Unit& u, int lane) const { return (unsigned)(u.pn * 128 + 2 * lane) * 4u; }
    __device__ void epi(const f32x4 (&acc)[2][2][4][2], const pg8::Unit& u, int wr, int wc, int fr, int fq, const int ai) const {
        int rt0 = wr * 64 + fr, colt = u.pn * 128 + wc * 32 + 8 * ((fq >> 1) + 2 * (fq & 1)); asm volatile("" : "+v"(rt0), "+v"(colt)); const size_t slot0 = (size_t)__builtin_amdgcn_readfirstlane(tb.off[u.e]) + 256 * u.pm;
#pragma unroll
            for (int m = 0; m < 4; ++m) { const int rt = rt0 + ai * 128 + m * 16; float r[8];
#pragma unroll
                for (int n = 0; n < 2; ++n)
#pragma unroll
                    for (int j = 0; j < 4; ++j) { const int o = (j >> 1) + 2 * n + 4 * (j & 1);
                        float g = acc[ai][0][m][n][j], up = acc[ai][1][m][n][j];
                        g = fminf(g, 7.f); up = fminf(fmaxf(up, -7.f), 7.f);
                        r[o] = (up + 1.f) * g * __builtin_amdgcn_rcpf(1.f + __builtin_amdgcn_exp2f(-1.702f * LOG2E * g)); }
                if (rt < u.rows) { u32x4 w; w.x = cvt_pk_bf16(r[0], r[1]); w.y = cvt_pk_bf16(r[2], r[3]); w.z = cvt_pk_bf16(r[4], r[5]); w.w = cvt_pk_bf16(r[6], r[7]);
                    *(GAS u32x4*)(O + (slot0 + rt) * DFF + colt) = w; } }
    }
};
template <int SPLIT> struct MoeDownT {
    static constexpr bool PERM = true;
    const bf16* A; const float* W; const float* bias; const float* sw; bf16* O; MoeTab tb; int G, c; LAS float* swl;
    __device__ bool next(int i, pg8::Unit& u) const { return moe_next<8, 1 + ((REP_MASK >> 12) & 1), SPLIT>(tb, G, c, i, u); }
    __device__ const char* a_base() const { return (const char*)A; }
    __device__ void a_off(const pg8::Unit& u, unsigned (&v0)[2], unsigned (&v1)[2]) const {
        const int s0 = __builtin_amdgcn_readfirstlane(tb.off[u.e]) + 256 * u.pm;
        if (threadIdx.x < 256) { const int rt = (int)threadIdx.x < u.rows ? (int)threadIdx.x : u.rows - 1;
            __builtin_amdgcn_global_load_lds((const unsigned*)(sw + (size_t)u.e * T + 256 * u.pm + rt), (LAS unsigned*)(swl + u.q * 256 + (threadIdx.x & ~63)), 4, 0, 0); }
        int tb16 = (int)threadIdx.x * 16; asm volatile("" : "+v"(tb16));
#pragma unroll
        for (int i = 0; i < 2; ++i) { int R, C; pg8::stage_rc(tb16 + i * 8192, R, C);
            v0[i] = (unsigned)((s0 + R) * pg8::KD + C) * 2u; v1[i] = (unsigned)((s0 + 128 + R) * pg8::KD + C) * 2u; } }
    __device__ void bias_load(const pg8::Unit& u, int wc, int fq, f32x4 (&bi)[2][2]) const {
        int cb = wc * 32 + 8 * ((fq >> 1) + 2 * (fq & 1)); asm volatile("" : "+v"(cb));
        const float* bp = bias + (size_t)u.e * DM + u.pn * 256 + u.hs * 128 + cb;
#pragma unroll
        for (int bj = 0; bj < (SPLIT == 2 ? 1 : 2); ++bj)
            { const f32x4 t0 = *(const GAS f32x4*)(bp + bj * 128), t1 = *(const GAS f32x4*)(bp + bj * 128 + 4); bi[bj][0] = (f32x4){t0[0], t1[0], t0[1], t1[1]}; bi[bj][1] = (f32x4){t0[2], t1[2], t0[3], t1[3]}; } }
    static constexpr int LDW_BYTES = DM * 4, W_BYTES = DFF * DM * 4;
    __device__ const char* b_ptr(const pg8::Unit& u) const { return (const char*)(W + (size_t)u.e * DFF * DM); }
    static constexpr int HALF_BYTES = 128 * 4;
    __device__ unsigned b_col(const pg8::Unit& u, int lane) const { return (unsigned)(u.pn * 256 + u.hs * 128 + 2 * lane) * 4u; }
    __device__ void epi(const f32x4 (&acc)[2][2][4][2], const pg8::Unit& u, int wr, int wc, int fr, int fq, const int ai) const {
        int rt0 = wr * 64 + fr, col0 = u.pn * 256 + u.hs * 128 + wc * 32 + 8 * ((fq >> 1) + 2 * (fq & 1)); asm volatile("" : "+v"(rt0), "+v"(col0)); const size_t slot0 = (size_t)__builtin_amdgcn_readfirstlane(tb.off[u.e]) + 256 * u.pm;
#pragma unroll
            for (int m = 0; m < 4; ++m) { const int rt = rt0 + ai * 128 + m * 16;
                if (rt < u.rows) { const float wgt = swl[u.q * 256 + rt]; bf16* rowp = O + (slot0 + rt) * DM + col0;
#pragma unroll
                    for (int bj = 0; bj < (SPLIT == 2 ? 1 : 2); ++bj) { float r[8];
#pragma unroll
                        for (int n = 0; n < 2; ++n)
#pragma unroll
                            for (int j = 0; j < 4; ++j) { const int o = (j >> 1) + 2 * n + 4 * (j & 1); r[o] = acc[ai][bj][m][n][j] * wgt; }
                        u32x4 w; w.x = cvt_pk_bf16(r[0], r[1]); w.y = cvt_pk_bf16(r[2], r[3]); w.z = cvt_pk_bf16(r[4], r[5]); w.w = cvt_pk_bf16(r[6], r[7]);
                        *(GAS u32x4*)(rowp + bj * 128) = w; } } }
    }
};

__device__ __forceinline__ void conv_unit(Frame& F, int ct) {
    const int b = ct / (SEQ / 32), s0 = (ct % (SEQ / 32)) * 32, tid = F.tid;
    const bf16* proj = WSP(bf16, WS_PROJ); bf16* mix = WSP(bf16, WS_MIX);
    LAS unsigned* z = (LAS unsigned*)F.lds;
    LAS float* st = (LAS float*)(F.lds + 126976);
    __syncthreads();
    { const int rq = tid >> 7, c8 = tid & 127;
#pragma unroll 1
      for (int hb = 0; hb < 2; ++hb) { u32x4 zz[8];
#pragma unroll
          for (int i = 0; i < 8; ++i) { const int r = 32 * hb + 4 * i + rq, s = s0 - 15 + r; const bool ok = (r < 62 && s >= 0 && s < SEQ); const int sc = ok ? s : 0;
              zz[i] = *(const GAS u32x4*)(proj + (size_t)(b * SEQ + sc) * INC + 3072 + 8 * c8); if (!ok) zz[i] = (u32x4){0u, 0u, 0u, 0u}; }
#pragma unroll
          for (int i = 0; i < 8; ++i) { const int r = 32 * hb + 4 * i + rq; if (r < 62) *(LAS u32x4*)(z + r * 512 + 4 * c8) = zz[i]; } } }
    typedef float f32x2c __attribute__((ext_vector_type(2)));
    float w0[CK], w1[CK];
#pragma unroll
    for (int j = 0; j < CK; ++j) { const f32x2c w = *(const GAS f32x2c*)(F.cw + j * CCH + 2 * tid); w0[j] = w.x; w1[j] = w.y; }
    const f32x2c cbv = *(const GAS f32x2c*)(F.cb + 2 * tid), lg = *(const GAS f32x2c*)(F.clg + 2 * tid), lb = *(const GAS f32x2c*)(F.clb + 2 * tid);
    __syncthreads();
#pragma unroll 1
    for (int hf = 0; hf < 2; ++hf) {
        float c0[16], c1[16];
#pragma unroll
        for (int g = 0; g < 4; ++g) {
            float zl[34], zh[34];
#pragma unroll
            for (int r = 0; r < 34; ++r) { const unsigned zz = z[(16 * hf + 4 * g + r) * 512 + tid]; zl[r] = __builtin_bit_cast(float, zz << 16); zh[r] = __builtin_bit_cast(float, zz & 0xffff0000u); }
#pragma unroll
            for (int t = 0; t < 4; ++t) { float a0 = cbv.x, a1 = cbv.y;
#pragma unroll
                for (int j = 0; j < CK; ++j) { a0 = fmaf(w0[j], zl[t + j], a0); a1 = fmaf(w1[j], zh[t + j], a1); }
                c0[4 * g + t] = a0; c1[4 * g + t] = a1; }
        }
#pragma unroll
        for (int t = 0; t < 16; ++t) { const float sm = wave_sum(c0[t] + c1[t]), q = wave_sum(c0[t] * c0[t] + c1[t] * c1[t]);
            if (F.lane == 0) { st[(F.wave * 16 + t) * 2] = sm; st[(F.wave * 16 + t) * 2 + 1] = q; } }
        __syncthreads();
        if (tid < 16) { float sm = 0.f, q = 0.f;
#pragma unroll
            for (int w = 0; w < 8; ++w) { sm += st[(w * 16 + tid) * 2]; q += st[(w * 16 + tid) * 2 + 1]; }
            const float mu = sm * (1.f / CCH), var = q * (1.f / CCH) - mu * mu; st[512 + tid * 2] = mu; st[512 + tid * 2 + 1] = rsqrtf(fmaxf(var, 0.f) + EPS); }
        __syncthreads();
#pragma unroll
        for (int t = 0; t < 16; ++t) { const float mu = st[512 + t * 2], rs = st[512 + t * 2 + 1];
            const float y0 = (c0[t] - mu) * rs * lg.x + lb.x, y1 = (c1[t] - mu) * rs * lg.y + lb.y;
            const float o0 = y0 * __builtin_amdgcn_rcpf(1.f + __builtin_amdgcn_exp2f(-LOG2E * y0)), o1 = y1 * __builtin_amdgcn_rcpf(1.f + __builtin_amdgcn_exp2f(-LOG2E * y1));
            *(GAS unsigned*)(mix + (size_t)(b * SEQ + s0 + 16 * hf + t) * DM + 1024 + 2 * tid) = cvt_pk_bf16(o0, o1); }
        __syncthreads();
    }
}

namespace att {
constexpr int KVBLK = 64; constexpr size_t SHM_V = KVBLK * 128 * 2, SHM_K = KVBLK * 128 * 2;
constexpr float C = 0.125f * LOG2E, THR2 = 8.f * LOG2E;
#define KSWZ(row, colB) ((row) * 256 + ((colB) ^ (((row) & 7) << 4)))
#define SBAR() __builtin_amdgcn_sched_barrier(0)
__device__ __forceinline__ int crow(int r, int hi) { return (r & 3) + 8 * (r >> 2) + 4 * hi; }
__device__ __forceinline__ int v_st(int k, int c) { const int kk = (k & ~0xC) | ((k & 4) << 1) | ((k & 8) >> 1); return ((kk >> 3) * 4 + (c >> 5)) * 512 + ((kk & 7) * 32 + (c & 31)) * 2; }
__device__ __forceinline__ int v_rd_base(int lane) { return ((lane & 3) << 3) | (((lane >> 2) & 3) << 6) | (((lane >> 4) & 1) << 5) | (((lane >> 5) & 1) << 8); }
constexpr int v_rd_off(int d0, int ks, int half) { return d0 * 512 + ks * 4096 + half * 2048; }
template <int OFF> __device__ __forceinline__ s16x4 tr_read(int vb) { s16x4 r; asm volatile("ds_read_b64_tr_b16 %0, %1 offset:%2" : "=&v"(r) : "v"(vb), "i"(OFF) : "memory"); return r; }
template <int D0> __device__ __forceinline__ void pv_one(f32x16& od, int vb, bf16x8 pa0, bf16x8 pa1, bf16x8 pa2, bf16x8 pa3) {
    const s16x4 l0 = tr_read<v_rd_off(D0, 0, 0)>(vb), h0 = tr_read<v_rd_off(D0, 0, 1)>(vb), l1 = tr_read<v_rd_off(D0, 1, 0)>(vb), h1 = tr_read<v_rd_off(D0, 1, 1)>(vb);
    const s16x4 l2 = tr_read<v_rd_off(D0, 2, 0)>(vb), h2 = tr_read<v_rd_off(D0, 2, 1)>(vb), l3 = tr_read<v_rd_off(D0, 3, 0)>(vb), h3 = tr_read<v_rd_off(D0, 3, 1)>(vb);
    asm volatile("s_waitcnt lgkmcnt(0)" ::: "memory"); SBAR();
#define PK(L, H) (bf16x8){L[0], L[1], L[2], L[3], H[0], H[1], H[2], H[3]}
    od = __builtin_amdgcn_mfma_f32_32x32x16_bf16(pa0, PK(l0, h0), od, 0, 0, 0);
    od = __builtin_amdgcn_mfma_f32_32x32x16_bf16(pa1, PK(l1, h1), od, 0, 0, 0);
    od = __builtin_amdgcn_mfma_f32_32x32x16_bf16(pa2, PK(l2, h2), od, 0, 0, 0);
    od = __builtin_amdgcn_mfma_f32_32x32x16_bf16(pa3, PK(l3, h3), od, 0, 0, 0);
#undef PK
}
__device__ __forceinline__ void pv_d0(f32x16* o, int vb, bf16x8 pa0, bf16x8 pa1, bf16x8 pa2, bf16x8 pa3) {
    pv_one<0>(o[0], vb, pa0, pa1, pa2, pa3); pv_one<1>(o[1], vb, pa0, pa1, pa2, pa3); pv_one<2>(o[2], vb, pa0, pa1, pa2, pa3); pv_one<3>(o[3], vb, pa0, pa1, pa2, pa3);
}
__device__ __forceinline__ void qkt(f32x16& p0, f32x16& p1, const LAS char* Ks, const bf16x8* qr, int r32, int hi, int map) {
    p0 = f32x16{}; p1 = f32x16{};
#pragma unroll
    for (int d0 = 0; d0 < 4; ++d0) { const int cb = ((map * 4 + d0) * 16 + hi * 8) * 2;
        const bf16x8 b0 = *(const LAS bf16x8*)(Ks + KSWZ(r32, cb)); const bf16x8 b1 = *(const LAS bf16x8*)(Ks + KSWZ(32 + r32, cb));
        p0 = __builtin_amdgcn_mfma_f32_32x32x16_bf16(b0, qr[d0], p0, 0, 0, 0);
        p1 = __builtin_amdgcn_mfma_f32_32x32x16_bf16(b1, qr[d0], p1, 0, 0, 0); }
}
__device__ __forceinline__ void partialSM(f32x16& p0, f32x16& p1, float& m_reg, float& mn, float& alpha, int relw, int relb, int hi, const LAS float* btab, float bneg, float bpos) {
    if (relw - 31 >= 91 || relw + 63 <= -91) {
        const float bc = (relw > 0) ? bpos : bneg;
        float pmax = p0[0];
#pragma unroll
        for (int r = 1; r < 16; ++r) pmax = fmaxf(pmax, p0[r]);
#pragma unroll
        for (int r = 0; r < 16; ++r) pmax = fmaxf(pmax, p1[r]);
        { auto rr = __builtin_amdgcn_permlane32_swap(__float_as_uint(pmax), __float_as_uint(pmax), false, false); pmax = fmaxf(__uint_as_float(rr[0]), __uint_as_float(rr[1])); }
        const float tmax = fmaf(pmax, C, bc);
        if (__builtin_expect(__all(tmax - m_reg <= THR2), 1)) { mn = m_reg; alpha = 1.f; }
        else { mn = fmaxf(m_reg, tmax); alpha = __builtin_amdgcn_exp2f(m_reg - mn); m_reg = mn; }
        const float off = bc - mn;
#pragma unroll
        for (int r = 0; r < 16; ++r) p0[r] = fmaf(p0[r], C, off);
#pragma unroll
        for (int r = 0; r < 16; ++r) p1[r] = fmaf(p1[r], C, off);
    } else {
#pragma unroll
        for (int r = 0; r < 16; ++r) { const int idx = relb + crow(r, hi) + 256; p0[r] = fmaf(p0[r], C, btab[idx]); p1[r] = fmaf(p1[r], C, btab[idx + 32]); }
        float pmax = p0[0];
#pragma unroll
        for (int r = 1; r < 16; ++r) pmax = fmaxf(pmax, p0[r]);
#pragma unroll
        for (int r = 0; r < 16; ++r) pmax = fmaxf(pmax, p1[r]);
        { auto rr = __builtin_amdgcn_permlane32_swap(__float_as_uint(pmax), __float_as_uint(pmax), false, false); pmax = fmaxf(__uint_as_float(rr[0]), __uint_as_float(rr[1])); }
        if (__builtin_expect(__all(pmax - m_reg <= THR2), 1)) { mn = m_reg; alpha = 1.f; }
        else { mn = fmaxf(m_reg, pmax); alpha = __builtin_amdgcn_exp2f(m_reg - mn); m_reg = mn; }
#pragma unroll
        for (int r = 0; r < 16; ++r) p0[r] -= mn;
#pragma unroll
        for (int r = 0; r < 16; ++r) p1[r] -= mn;
    }
#pragma unroll
    for (int r = 0; r < 16; ++r) p0[r] = __builtin_amdgcn_exp2f(p0[r]);
}
__device__ __forceinline__ void finishSM(f32x16& p0, f32x16& p1, float alpha, float& l_reg, bf16x8& pa0, bf16x8& pa1, bf16x8& pa2, bf16x8& pa3) {
#pragma unroll
    for (int r = 0; r < 16; ++r) p1[r] = __builtin_amdgcn_exp2f(p1[r]);
    float ps = 0;
#pragma unroll
    for (int r = 0; r < 16; ++r) ps += p0[r];
#pragma unroll
    for (int r = 0; r < 16; ++r) ps += p1[r];
    { auto rr = __builtin_amdgcn_permlane32_swap(__float_as_uint(ps), __float_as_uint(ps), false, false); ps = __uint_as_float(rr[0]) + __uint_as_float(rr[1]); }
    l_reg = l_reg * alpha + ps;
#define PK4(P, BASE, OUT) do { unsigned a0 = cvt_pk_bf16(P[BASE + 0], P[BASE + 1]), a1 = cvt_pk_bf16(P[BASE + 2], P[BASE + 3]);   \
    unsigned b0 = cvt_pk_bf16(P[BASE + 4], P[BASE + 5]), b1 = cvt_pk_bf16(P[BASE + 6], P[BASE + 7]);                              \
    auto r0 = __builtin_amdgcn_permlane32_swap(a0, b0, false, false); auto r1 = __builtin_amdgcn_permlane32_swap(a1, b1, false, false); \
    u32x4 w = {r0[0], r1[0], r0[1], r1[1]}; OUT = __builtin_bit_cast(bf16x8, w); } while (0)
    PK4(p0, 0, pa0); PK4(p0, 8, pa1); PK4(p1, 0, pa2); PK4(p1, 8, pa3);
#undef PK4
}
constexpr int L_V = 0, L_K = 32768, L_WS = 65536, L_BT = 67584, L_CB = 69632;
__device__ __forceinline__ void attn_unit(Frame& F, int unit) {
    const int bh = unit >> 4, qb = unit & 15, b = bh >> 3, h = bh & 7, q0 = qb * 128;
    const int tid = F.tid, wid = F.wave, lane = F.lane, r32 = lane & 31, hi = lane >> 5, rg = wid & 3, map = wid >> 2;
    const bf16* proj = WSP(bf16, WS_PROJ);
    const bf16* Kh = proj + (size_t)(b * SEQ) * INC + 1024 + h * 128; const bf16* Vh = proj + (size_t)(b * SEQ) * INC + 2048 + h * 128;
    LAS char* lds = (LAS char*)F.lds; LAS char* V_lds = lds + L_V; LAS char* K_lds = lds + L_K;
    LAS float* wsf = (LAS float*)(lds + L_WS) + wid * 64; LAS float* li_l = wsf; LAS float* al_l = wsf + 32;
    LAS float* btab = (LAS float*)(lds + L_BT);
    const float* bt = WSP(float, WS_BIAST) + h * 4096;
    __syncthreads();
    btab[tid] = bt[2048 - 256 + tid];
    const float bneg = bt[2048 - 200], bpos = bt[2048 + 200], lam = WSP(float, WS_BIAST)[AH * 4096];
    float m_reg = -1e30f, l_reg = 0; f32x16 o[4] = {}; bf16x8 qr[4];
    const int qw0 = q0 + 32 * rg;
    const bf16* Qw = proj + (size_t)(b * SEQ + qw0 + r32) * INC + h * 128 + map * 64 + hi * 8;
#pragma unroll
    for (int d0 = 0; d0 < 4; ++d0) qr[d0] = *(const GAS bf16x8*)(Qw + d0 * 16);
    const int sr = tid >> 4, sc = (tid & 15) * 8, vst0 = v_st(sr, sc), vst1 = v_st(32 + sr, sc);
    const int vb0 = (int)(uintptr_t)V_lds + v_rd_base(lane);
    struct { bf16x8 vs0, vs1, ks0, ks1; } sr_[2];
#define SLOAD(i, k0) do { sr_[i].vs0 = *(const GAS bf16x8*)&Vh[(size_t)((k0) + sr) * INC + sc]; sr_[i].vs1 = *(const GAS bf16x8*)&Vh[(size_t)((k0) + 32 + sr) * INC + sc]; \
    sr_[i].ks0 = *(const GAS bf16x8*)&Kh[(size_t)((k0) + sr) * INC + sc]; sr_[i].ks1 = *(const GAS bf16x8*)&Kh[(size_t)((k0) + 32 + sr) * INC + sc]; } while (0)
#define SWRITE(bb, i) do { *(LAS bf16x8*)(V_lds + (bb) * SHM_V + vst0) = sr_[i].vs0; *(LAS bf16x8*)(V_lds + (bb) * SHM_V + vst1) = sr_[i].vs1; const int kc = sc * 2; \
    *(LAS bf16x8*)(K_lds + (bb) * SHM_K + KSWZ(sr, kc)) = sr_[i].ks0; *(LAS bf16x8*)(K_lds + (bb) * SHM_K + KSWZ(32 + sr, kc)) = sr_[i].ks1; } while (0)
#define SWAIT() asm volatile("s_waitcnt vmcnt(4)" ::: "memory")
#define RESC(a) do { if (__any((a) < 1.f)) { if (hi == 0) al_l[r32] = (a); asm volatile("s_waitcnt lgkmcnt(0)" ::: "memory"); \
    _Pragma("unroll") for (int d = 0; d < 4; ++d) _Pragma("unroll") for (int r = 0; r < 16; ++r) o[d][r] *= al_l[crow(r, hi)]; } } while (0)
#define PSM(P0, P1, MN, AL, k0) partialSM(P0, P1, m_reg, MN, AL, (k0) - qw0, (k0) - qw0 - r32, hi, btab, bneg, bpos)
    f32x16 pA0, pA1, pB0, pB1; float mnA, mnB, alA, alB; bf16x8 pa0, pa1, pa2, pa3; constexpr int NT = SEQ / KVBLK;
    constexpr int SE = 0, SO = 1;
    SLOAD(SE, 0); asm volatile("s_waitcnt vmcnt(0)" ::: "memory"); SWRITE(0, SE); __syncthreads();
    qkt(pA0, pA1, K_lds, qr, r32, hi, map); PSM(pA0, pA1, mnA, alA, 0);
    SLOAD(SO, KVBLK); SLOAD(SE, 2 * KVBLK);
    SWAIT(); SWRITE(1, SO); __syncthreads();
    for (int j = 1; j + 1 < NT; j += 2) {
        SBAR(); qkt(pB0, pB1, K_lds + SHM_K, qr, r32, hi, map);
        finishSM(pA0, pA1, alA, l_reg, pa0, pa1, pa2, pa3); SBAR();
        SLOAD(SO, (j + 2) * KVBLK); SBAR();
        pv_d0(o, vb0, pa0, pa1, pa2, pa3); PSM(pB0, pB1, mnB, alB, j * KVBLK);
        __syncthreads(); SWAIT(); SWRITE(0, SE);
        RESC(alB); __syncthreads();
        SBAR(); qkt(pA0, pA1, K_lds, qr, r32, hi, map);
        finishSM(pB0, pB1, alB, l_reg, pa0, pa1, pa2, pa3); SBAR();
        if (j + 3 < NT) SLOAD(SE, (j + 3) * KVBLK); SBAR();
        pv_d0(o, vb0 + (int)SHM_V, pa0, pa1, pa2, pa3); PSM(pA0, pA1, mnA, alA, (j + 1) * KVBLK);
        __syncthreads(); SWAIT(); SWRITE(1, SO);
        RESC(alA); __syncthreads();
    }
    SBAR(); qkt(pB0, pB1, K_lds + SHM_K, qr, r32, hi, map);
    finishSM(pA0, pA1, alA, l_reg, pa0, pa1, pa2, pa3); SBAR();
    pv_d0(o, vb0, pa0, pa1, pa2, pa3); PSM(pB0, pB1, mnB, alB, (NT - 1) * KVBLK);
    __syncthreads(); RESC(alB);
    finishSM(pB0, pB1, alB, l_reg, pa0, pa1, pa2, pa3); SBAR();
    pv_d0(o, vb0 + (int)SHM_V, pa0, pa1, pa2, pa3);
    if (hi == 0) li_l[r32] = l_reg; asm volatile("s_waitcnt lgkmcnt(0)" ::: "memory");
    float rli[16];
#pragma unroll
    for (int r = 0; r < 16; ++r) rli[r] = __builtin_amdgcn_rcpf(li_l[crow(r, hi)]);
    LAS float* cbuf = (LAS float*)(lds + L_CB) + rg * 32 * 128;
    if (map == 1) {
#pragma unroll
        for (int r = 0; r < 16; ++r)
#pragma unroll
            for (int d0 = 0; d0 < 4; ++d0) cbuf[crow(r, hi) * 128 + d0 * 32 + r32] = -lam * o[d0][r] * rli[r];
    }
    __syncthreads();
    if (map == 0) {
        bf16* mix = WSP(bf16, WS_MIX) + (size_t)(b * SEQ + qw0) * DM + h * 128;
        float sg[4];
#pragma unroll
        for (int d0 = 0; d0 < 4; ++d0) sg[d0] = F.subln[d0 * 32 + r32] * 0.8f;
#pragma unroll
        for (int r = 0; r < 16; ++r) { float v[4], ss = 0.f;
#pragma unroll
            for (int d0 = 0; d0 < 4; ++d0) { v[d0] = o[d0][r] * rli[r] + cbuf[crow(r, hi) * 128 + d0 * 32 + r32]; ss += v[d0] * v[d0]; }
#pragma unroll
            for (int s = 1; s < 32; s <<= 1) ss += __shfl_xor(ss, s);
            const float rstd = rsqrtf(ss * (1.f / VD) + EPS);
#pragma unroll
            for (int d0 = 0; d0 < 4; ++d0) mix[(size_t)crow(r, hi) * DM + d0 * 32 + r32] = (bf16)f2bf(v[d0] * rstd * sg[d0]); }
    }
#undef SLOAD
#undef SWRITE
#undef SWAIT
#undef RESC
#undef PSM
}
}

__device__ __forceinline__ void p5_router(Frame& F, bool dry = false) {
    const float* mod = WSP(float, WS_MOD); const bf16* x1 = WSP(bf16, WS_X1); bf16* h2 = WSP(bf16, WS_H2);
    int* list = (int*)(F.ws + WS_ROUTE + RT_LIST); float* sw = (float*)(F.ws + WS_ROUTE + RT_SW); int* toke = (int*)(F.ws + WS_ROUTE + RT_TOKE); int* tokr = (int*)(F.ws + WS_ROUTE + RT_TOKR);
    constexpr int RS = 4096 + 16;
    LAS unsigned char* Ahi = F.lds; LAS unsigned char* Alo = F.lds + 16 * RS; LAS float* Pl = (LAS float*)(F.lds + 32 * RS);
    const unsigned char* wrf = WSP(unsigned char, WS_WRF);
    LAS int* lcnt = (LAS int*)(F.lds + TAB_OFF);
    LAS int* asg = lcnt + 64; LAS float* aw = (LAS float*)(asg + 1024);
    for (int tb0 = F.vcu; tb0 < T / 16; tb0 += 2 * F.G) {
      if (F.tid < 32) lcnt[F.tid] = 0;
#pragma unroll 1
      for (int it = 0; it < 2; ++it) {
        const int tb = tb0 + it * F.G;
        if (tb >= T / 16) { asg[it * 512 + F.tid] = -1; continue; }
        const int b = (tb * 16) / SEQ;
        __syncthreads();
        { f32x4 v[2][8]; float rstd[2];
#pragma unroll
          for (int rr = 0; rr < 2; ++rr) { const GAS u32x2* xr = (const GAS u32x2*)(x1 + (size_t)(tb * 16 + 2 * F.wave + rr) * DM) + F.lane;
#pragma unroll
              for (int j = 0; j < 8; ++j) { const u32x2 xx = xr[64 * j]; v[rr][j] = (f32x4){bf2f(xx.x & 0xffffu), bf2f(xx.x >> 16), bf2f(xx.y & 0xffffu), bf2f(xx.y >> 16)}; } }
#pragma unroll
          for (int rr = 0; rr < 2; ++rr) { float s = 0.f;
#pragma unroll
              for (int j = 0; j < 8; ++j) s += (v[rr][j].x * v[rr][j].x + v[rr][j].y * v[rr][j].y) + (v[rr][j].z * v[rr][j].z + v[rr][j].w * v[rr][j].w);
              rstd[rr] = rsqrtf(wave_sum(s) * (1.f / DM) + EPS); }
#pragma unroll
          for (int j = 0; j < 8; ++j) { const int k = 4 * F.lane + 256 * j;
              const f32x4 g = *(const GAS f32x4*)(F.g2 + k), sc = *(const GAS f32x4*)(mod + (size_t)b * 6 * DM + 4 * DM + k), sf = *(const GAS f32x4*)(mod + (size_t)b * 6 * DM + 3 * DM + k);
#pragma unroll
              for (int rr = 0; rr < 2; ++rr) { const int tl = 2 * F.wave + rr;
                  float hv[4]; unsigned hb[4], lb[4];
#pragma unroll
                  for (int q = 0; q < 4; ++q) { hv[q] = v[rr][j][q] * rstd[rr] * g[q] * (1.f + sc[q]) + sf[q]; hb[q] = f2bf(hv[q]); lb[q] = f2bf(hv[q] - bf2f(hb[q])); }
                  u32x2 wh, wl; wh.x = hb[0] | (hb[1] << 16); wh.y = hb[2] | (hb[3] << 16); wl.x = lb[0] | (lb[1] << 16); wl.y = lb[2] | (lb[3] << 16);
                  st_wt8((GAS u32x2*)(h2 + (size_t)(tb * 16 + tl) * DM) + F.lane + 64 * j, wh); *(LAS u32x2*)(Ahi + tl * RS + k * 2) = wh; *(LAS u32x2*)(Alo + tl * RS + k * 2) = wl; } }
        }
        __syncthreads();
        { f32x4 acc0 = {0.f, 0.f, 0.f, 0.f}, acc1 = {0.f, 0.f, 0.f, 0.f};
#pragma unroll 2
          for (int ks = 0; ks < 8; ++ks) { const int s = 8 * F.wave + ks, k0 = 32 * s + 8 * (F.lane >> 4);
            const bf16x8 ah = *(const LAS bf16x8*)(Ahi + (F.lane & 15) * RS + k0 * 2), al = *(const LAS bf16x8*)(Alo + (F.lane & 15) * RS + k0 * 2);
            const bf16x8 bh0 = *(const GAS bf16x8*)(wrf + ((size_t)(s * 2 + 0) * 64 + F.lane) * 16), bh1 = *(const GAS bf16x8*)(wrf + ((size_t)(s * 2 + 1) * 64 + F.lane) * 16);
            const bf16x8 bl0 = *(const GAS bf16x8*)(wrf + 131072 + ((size_t)(s * 2 + 0) * 64 + F.lane) * 16), bl1 = *(const GAS bf16x8*)(wrf + 131072 + ((size_t)(s * 2 + 1) * 64 + F.lane) * 16);
            acc0 = __builtin_amdgcn_mfma_f32_16x16x32_bf16(ah, bh0, acc0, 0, 0, 0); acc0 = __builtin_amdgcn_mfma_f32_16x16x32_bf16(ah, bl0, acc0, 0, 0, 0); acc0 = __builtin_amdgcn_mfma_f32_16x16x32_bf16(al, bh0, acc0, 0, 0, 0);
            acc1 = __builtin_amdgcn_mfma_f32_16x16x32_bf16(ah, bh1, acc1, 0, 0, 0); acc1 = __builtin_amdgcn_mfma_f32_16x16x32_bf16(ah, bl1, acc1, 0, 0, 0); acc1 = __builtin_amdgcn_mfma_f32_16x16x32_bf16(al, bh1, acc1, 0, 0, 0); }
#pragma unroll
          for (int r = 0; r < 4; ++r) { const int tk = 4 * (F.lane >> 4) + r; Pl[(F.wave * 16 + tk) * 32 + (F.lane & 15)] = acc0[r]; Pl[(F.wave * 16 + tk) * 32 + 16 + (F.lane & 15)] = acc1[r]; }
        }
        __syncthreads();
        { const int tl = F.tid >> 5, e = F.tid & 31, tok = tb * 16 + tl;
          float v = F.b_r[e];
#pragma unroll
          for (int w = 0; w < 8; ++w) v += Pl[(w * 16 + tl) * 32 + e];
          float tv[4]; int ti[4];
#pragma unroll
          for (int r = 0; r < 4; ++r) { float bv = v; int bi = e;
#pragma unroll
              for (int o = 16; o > 0; o >>= 1) { const float ov = __shfl_xor(bv, o); const int oi = __shfl_xor(bi, o); if (ov > bv || (ov == bv && oi < bi)) { bv = ov; bi = oi; } }
              tv[r] = bv; ti[r] = bi; if (e == bi) v = -3.0e38f; }
          float den = 0.f, w[4];
#pragma unroll
          for (int r = 0; r < 4; ++r) { w[r] = __expf(tv[r] - tv[0]); den += w[r]; }
          int sel = -1; float wsel = 0.f;
#pragma unroll
          for (int r = 0; r < 4; ++r) if (e == ti[r]) { sel = r; wsel = w[r]; }
          int code = -1;
          if (sel >= 0 && !dry) code = sel | (__hip_atomic_fetch_add(lcnt + e, 1, __ATOMIC_RELAXED, __HIP_MEMORY_SCOPE_WORKGROUP) << 8);
          asg[it * 512 + F.tid] = code; aw[it * 512 + F.tid] = wsel / den; (void)tok;
        }
      }
      __syncthreads();
      if (F.tid < 32) { const int n = lcnt[F.tid]; lcnt[32 + F.tid] = n > 0 ? (int)atomicAdd(F.ctl + CW_CNT + F.tid * CNT_STRIDE, (unsigned)n) : 0; }
      __syncthreads();
#pragma unroll
      for (int it = 0; it < 2; ++it) { const int code = asg[it * 512 + F.tid];
          if (code >= 0) { const int e = F.tid & 31, tok = (tb0 + it * F.G) * 16 + (F.tid >> 5), sel = code & 255, rank = lcnt[32 + e] + (code >> 8);
              list[e * T + rank] = tok; sw[e * T + rank] = aw[it * 512 + F.tid]; toke[tok * 4 + sel] = e; tokr[tok * 4 + sel] = rank; } }
      __syncthreads();
    }
}

__device__ __forceinline__ void p8_final(Frame& F) {
    const float* mod = WSP(float, WS_MOD); const bf16* x1 = WSP(bf16, WS_X1); const bf16* y = WSP(bf16, WS_Y);
    const int* toke = (const int*)(F.ws + WS_ROUTE + RT_TOKE); const int* tokr = (const int*)(F.ws + WS_ROUTE + RT_TOKR);
    moe_tables(F);
    const LAS int* off = (const LAS int*)(F.lds + TAB_OFF) + 40;
    for (int row = F.vcu * NWAVES + F.wave; row < T; row += F.G * NWAVES) {
        const int b = row / SEQ;
        size_t so[4];
#pragma unroll
        for (int r = 0; r < 4; ++r) so[r] = (size_t)(off[toke[row * 4 + r]] + tokr[row * 4 + r]) * DM;
        const GAS u32x2* xr = (const GAS u32x2*)(x1 + (size_t)row * DM) + F.lane;
        f32x4 v[8]; float s = 0.f;
#pragma unroll
        for (int j = 0; j < 8; ++j) { const int k = 4 * F.lane + 256 * j; f32x4 m = {0.f, 0.f, 0.f, 0.f};
#pragma unroll
            for (int r = 0; r < 4; ++r) { const u32x2 yy = *(const GAS u32x2*)(y + so[r] + k); m[0] += bf2f(yy.x & 0xffffu); m[1] += bf2f(yy.x >> 16); m[2] += bf2f(yy.y & 0xffffu); m[3] += bf2f(yy.y >> 16); }
            const f32x4 g = *(const GAS f32x4*)(mod + (size_t)b * 6 * DM + 5 * DM + k);
            const u32x2 xx = xr[64 * j]; v[j] = (f32x4){bf2f(xx.x & 0xffffu), bf2f(xx.x >> 16), bf2f(xx.y & 0xffffu), bf2f(xx.y >> 16)} + g * m; s += (v[j].x * v[j].x + v[j].y * v[j].y) + (v[j].z * v[j].z + v[j].w * v[j].w); }
        const float rstd = rsqrtf(wave_sum(s) * (1.f / DM) + EPS);
        GAS f32x4* orow = (GAS f32x4*)(F.out + (size_t)row * DM) + F.lane;
#pragma unroll
        for (int j = 0; j < 8; ++j) { const f32x4 g = *(const GAS f32x4*)(F.fg + 4 * F.lane + 256 * j); orow[64 * j] = v[j] * rstd * g; }
    }
}

struct Args { const float* in[25]; float* out; unsigned char* ws; int ph_lo, ph_hi, li, pad; };
__global__ void __launch_bounds__(NTHR, 2) mega_fwd(Args args) {
    extern __shared__ __attribute__((aligned(16))) unsigned char lds[];
    Frame F;
    F.lds = (LAS unsigned char*)lds; F.MISC = (volatile LAS unsigned*)(F.lds + MISC_OFF);
    F.tid = threadIdx.x; F.lane = F.tid & 63; F.wave = __builtin_amdgcn_readfirstlane(F.tid >> 6);
    F.G = gridDim.x; { const int bx = blockIdx.x; F.vcu = (F.G % 8 == 0) ? (bx % 8) * (F.G / 8) + bx / 8 : bx; }
    F.ws = args.ws; F.ctl = (unsigned*)(args.ws + WS_CTL); F.out = args.out;
    F.x = args.in[0]; F.c = args.in[1]; F.w_ada = args.in[2]; F.b_ada = args.in[3]; F.g1 = args.in[4]; F.w_in = args.in[5]; F.lq1 = args.in[6]; F.lk1 = args.in[7]; F.lq2 = args.in[8]; F.lk2 = args.in[9];
    F.subln = args.in[10]; F.relb = args.in[11]; F.cw = args.in[12]; F.cb = args.in[13]; F.clg = args.in[14]; F.clb = args.in[15]; F.w_out = args.in[16]; F.g2 = args.in[17]; F.w_r = args.in[18]; F.b_r = args.in[19];
    F.w_gu = args.in[20]; F.b_gu = args.in[21]; F.w_d = args.in[22]; F.b_d = args.in[23]; F.fg = args.in[24];
    for (int u = F.tid; u < 64; u += NTHR) ((LAS unsigned*)(F.lds + MISC_OFF))[u] = 0u;
    __syncthreads();
    XcdBarrier bar = xcd_barrier_post(F.ctl + CW_BAR + args.li * XCD_BAR_WORDS, F.MISC + 8);
    const int lo = args.ph_lo, hi = args.ph_hi;
#ifndef PH_MASK
#define PH_MASK 0x1ff
#endif
#define IN(k) (((PH_MASK >> (k)) & 1) && lo <= (k) && (k) < hi)
#define SEAM(k) do { if (IN(k) && IN((k) + 1)) { xcd_barrier(bar); if constexpr (((REP_MASK >> 14) & 1) != 0) xcd_barrier(bar); } } while (0)
#define REP2(k, ...) do { { __VA_ARGS__ } if constexpr (((REP_MASK >> (k)) & 1) != 0) { __VA_ARGS__ } } while (0)
#ifndef PROBE_TS
#define PROBE_TS -1
#endif
    unsigned long long* const tsb = (unsigned long long*)(F.ctl + 8192);
#define STAMP(k) do { if constexpr (PROBE_TS >= 0) { if (F.tid == 0) __hip_atomic_store(tsb + (k) * 256 + blockIdx.x, (unsigned long long)wall_clock64(), __ATOMIC_RELAXED, __HIP_MEMORY_SCOPE_AGENT); } } while (0)
    STAMP(0);
    if (IN(0)) { REP2(0, __syncthreads(); p0_prologue(F);); } STAMP(1); SEAM(0);
    if (IN(0) && IN(1)) F.vcu = xcd_virtual_cu(bar);
    if (IN(1)) { REP2(1, __syncthreads(); p1_norm1(F);); } STAMP(2); SEAM(1);
    if (IN(2)) { REP2(2, { InProjT<false> P{WSP(bf16, WS_H), WSP(bf16, WS_WIN), WSP(bf16, WS_PROJ), {}}; P.ord.init(T, INC, F.G, F.vcu, false, true); P.ord.rep = 1 + ((REP_MASK >> 15) & 1); __syncthreads(); pg8::gemm_run(F.lds, P); }
        { InProjT<true> P{WSP(bf16, WS_H), WSP(bf16, WS_WIN), WSP(bf16, WS_PROJ), {}}; P.ord.init(T, INC, F.G, F.vcu, true, true); __syncthreads(); pg8::gemm_run<InProjT<true>, true>(F.lds, P); }); } STAMP(3); SEAM(2);
    if (IN(3)) { REP2(3,
        for (int ct = F.vcu; ct < T / 32; ct += F.G) conv_unit(F, ct);
        if constexpr (((REP_MASK >> 9) & 1) != 0) { for (int ct = F.vcu; ct < T / 32; ct += F.G) conv_unit(F, ct); }
        for (int u = F.vcu; u < NB * AH * 16 * (1 + ((REP_MASK >> 10) & 1)); u += F.G) att::attn_unit(F, u % (NB * AH * 16));
    ); } STAMP(4); SEAM(3);
    if (IN(4)) { REP2(4, OutProj P{WSP(bf16, WS_MIX), WSP(bf16, WS_WOUT), F.x, WSP(float, WS_MOD), WSP(bf16, WS_X1), {}}; P.ord.init(T, DM, F.G, F.vcu); P.ord.rep = 1 + ((REP_MASK >> 16) & 1); __syncthreads(); pg8::gemm_run(F.lds, P);); } STAMP(5); SEAM(4);
    if (IN(5)) { p5_router(F); if constexpr (((REP_MASK >> 13) & 1) != 0) { __syncthreads(); p5_router(F, true); } } STAMP(6); SEAM(5);
    if (IN(6)) { REP2(6, moe_tables(F); const LAS int* tab = (const LAS int*)(F.lds + TAB_OFF);
        MoeGU P{WSP(bf16, WS_H2), F.w_gu, F.b_gu, (const int*)(F.ws + WS_ROUTE + RT_LIST), WSP(bf16, WS_ACT), {tab, tab + 40, tab + 80}, F.G, F.vcu}; pg8::gemm_run_bf32(F.lds, P);); } STAMP(7); SEAM(6);
    if (IN(7)) { REP2(7, moe_tables(F); const LAS int* tab = (const LAS int*)(F.lds + TAB_OFF);
        { MoeDownT<1> P{WSP(bf16, WS_ACT), F.w_d, F.b_d, (const float*)(F.ws + WS_ROUTE + RT_SW), WSP(bf16, WS_Y), {tab, tab + 40, tab + 80}, F.G, F.vcu, (LAS float*)(F.lds + TAB_OFF + 3072)}; pg8::gemm_run_bf32(F.lds, P); }
        { MoeDownT<2> P{WSP(bf16, WS_ACT), F.w_d, F.b_d, (const float*)(F.ws + WS_ROUTE + RT_SW), WSP(bf16, WS_Y), {tab, tab + 40, tab + 80}, F.G, F.vcu, (LAS float*)(F.lds + TAB_OFF + 3072)}; pg8::gemm_run_bf32<MoeDownT<2>, true>(F.lds, P); }); } STAMP(8); SEAM(7);
    if (IN(8)) { REP2(8, p8_final(F);); }
    if constexpr (PROBE_TS >= 0) {
        STAMP(9); xcd_barrier(bar);
        if (blockIdx.x == 0) {
            LAS unsigned long long* sh = (LAS unsigned long long*)F.lds;
            __syncthreads();
            if (F.tid < 256) { const int cu = F.tid < (int)gridDim.x ? F.tid : 0;
                sh[F.tid] = __hip_atomic_load(tsb + (PROBE_TS + 1) * 256 + cu, __ATOMIC_RELAXED, __HIP_MEMORY_SCOPE_AGENT);
                sh[256 + F.tid] = __hip_atomic_load(tsb + PROBE_TS * 256 + cu, __ATOMIC_RELAXED, __HIP_MEMORY_SCOPE_AGENT); }
            __syncthreads();
            if (F.tid == 0) { long long mx = 0, sum = 0; for (int i = 0; i < 256; ++i) { const long long d = (long long)(sh[i] - sh[256 + i]); mx = d > mx ? d : mx; sum += d; }
                const long long W = sum / 256 / 100, sk = (mx - sum / 256) / 100;
                const long long a = PROBE_TS == 9 ? 0 : W > 1023 ? 1023 : W, b = sk > 255 ? 255 : (sk < 0 ? 0 : sk);
                const unsigned long long wait = (unsigned long long)(10 * a + 0 * b) * 100ull, t0 = wall_clock64();
                while ((unsigned long long)wall_clock64() - t0 < wait) __builtin_amdgcn_s_sleep(32); }
            __syncthreads();
        }
    }
#undef IN
#undef SEAM
}

extern "C" void kernel_launch(void* const* d_in, const int* in_sizes, int n_in, void* d_out, int out_size, void* d_ws, size_t ws_size, hipStream_t stream) {
    static int grid = 0;
    if (grid == 0) {
        if (n_in != 25 || ws_size < WS_END || out_size != T * DM) { fprintf(stderr, "kernel_launch: n_in %d out %d ws %zu (need %zu); nothing launched\n", n_in, out_size, ws_size, (size_t)WS_END); grid = -1; return; }
        int dev = 0, cus = 0, per_cu = 0;
        if (hipGetDevice(&dev) != hipSuccess || hipDeviceGetAttribute(&cus, hipDeviceAttributeMultiprocessorCount, dev) != hipSuccess) { grid = -1; return; }
        if (hipFuncSetAttribute((const void*)mega_fwd, hipFuncAttributeMaxDynamicSharedMemorySize, LDS_BYTES) != hipSuccess) { fprintf(stderr, "kernel_launch: hipFuncSetAttribute failed\n"); grid = -1; return; }
        if (hipOccupancyMaxActiveBlocksPerMultiprocessor(&per_cu, (const void*)mega_fwd, NTHR, LDS_BYTES) != hipSuccess || per_cu < 1) { fprintf(stderr, "kernel_launch: occupancy query says %d blocks per CU\n", per_cu); }
        (void)hipGetLastError();
        grid = cus;
    }
    if (grid < 0) return;
    unsigned char* ws = (unsigned char*)d_ws;
    (void)hipMemsetAsync(ws + WS_CTL, 0, CTL_ZERO_BYTES, stream);
    Args a{};
    for (int i = 0; i < 25; ++i) a.in[i] = (const float*)d_in[i];
    a.out = (float*)d_out; a.ws = ws; a.ph_lo = 0; a.ph_hi = 9; a.li = 0; a.pad = 0;
    hipLaunchKernelGGL(mega_fwd, dim3(grid), dim3(NTHR), LDS_BYTES, stream, a);
}
```

```cpp
#include <hip/hip_runtime.h>
#include <cstdio>
#include <cstdint>

#ifndef REP_MASK
#define REP_MASK 0
#endif

constexpr int DM = 2048, NB = 4, SEQ = 2048, T = NB * SEQ;
constexpr int AH = 8, HD = 64, VD = 128, CCH = 1024, CK = 31;
constexpr int INC = 5120;
constexpr int NE = 32, TOPK = 4, DFF = 2048, NSLOT = T * TOPK;
constexpr float EPS = 1e-6f;
constexpr float LOG2E = 1.4426950408889634f;

typedef unsigned short bf16;
typedef short bf16x8 __attribute__((ext_vector_type(8)));
typedef short s16x4 __attribute__((ext_vector_type(4)));
typedef float f32x4 __attribute__((ext_vector_type(4)));
typedef float f32x16 __attribute__((ext_vector_type(16)));
typedef unsigned u32x4 __attribute__((ext_vector_type(4)));
typedef unsigned u32x2 __attribute__((ext_vector_type(2)));
#define GAS __attribute__((address_space(1)))
#define LAS __attribute__((address_space(3)))
typedef GAS unsigned gu32;

constexpr size_t MiB = 1u << 20;
constexpr size_t WS_CTL = 0, CTL_ZERO_BYTES = 64 * 1024;
constexpr size_t WS_MODP = 10 * MiB;
constexpr size_t WS_MOD = 3 * MiB;
constexpr size_t WS_BIAST = 4 * MiB;
constexpr size_t WS_WRF = 5 * MiB;
constexpr size_t WS_ROUTE = 6 * MiB;
constexpr size_t RT_LIST = 0;
constexpr size_t RT_SW = 1 * MiB;
constexpr size_t RT_TOKE = 2 * MiB;
constexpr size_t RT_TOKR = RT_TOKE + 128 * 1024;
constexpr size_t WS_WIN = 16 * MiB;
constexpr size_t WS_WOUT = WS_WIN + 20 * MiB;
constexpr size_t WS_H = WS_WOUT + 8 * MiB;
constexpr size_t WS_PROJ = WS_H + 32 * MiB;
constexpr size_t WS_MIX = WS_PROJ + 80 * MiB;
constexpr size_t WS_X1 = WS_MIX + 32 * MiB;
constexpr size_t WS_H2 = WS_X1 + 64 * MiB;
constexpr size_t WS_ACT = WS_H2 + 32 * MiB;
constexpr size_t WS_Y = WS_ACT + 130 * MiB;
constexpr size_t WS_END = WS_Y + 130 * MiB;
constexpr int CW_CNT = 5120, CNT_STRIDE = 64;
constexpr int CW_BAR = 1024;

__device__ __forceinline__ unsigned f2bf(float f) { unsigned u = __builtin_bit_cast(unsigned, f); return (u + 0x7fffu + ((u >> 16) & 1u)) >> 16; }
__device__ __forceinline__ float bf2f(unsigned h) { return __builtin_bit_cast(float, h << 16); }
__device__ __forceinline__ unsigned pk2(float lo, float hi) { return f2bf(lo) | (f2bf(hi) << 16); }
__device__ __forceinline__ unsigned cvt_pk_bf16(float lo, float hi) { unsigned r; asm volatile("v_cvt_pk_bf16_f32 %0, %1, %2" : "=v"(r) : "v"(lo), "v"(hi)); return r; }
__device__ __forceinline__ float silu_f(float v) { return v / (1.f + __expf(-v)); }
__device__ __forceinline__ void st_wt8(GAS u32x2* p, u32x2 v) { asm volatile("global_store_dwordx2 %0, %1, off sc0 sc1" :: "v"(p), "v"(v) : "memory"); }
__device__ __forceinline__ void st_wt16(GAS u32x4* p, u32x4 v) { asm volatile("global_store_dwordx4 %0, %1, off sc0 sc1" :: "v"(p), "v"(v) : "memory"); }
__device__ __forceinline__ float wave_sum(float v) {
#pragma unroll
    for (int o = 1; o < 64; o <<= 1) v += __shfl_xor(v, o);
    return v;
}
__host__ __device__ inline int t5_bucket(int rel) {
    int ret = rel > 0 ? 16 : 0; int n = rel < 0 ? -rel : rel;
    if (n < 8) return ret + n;
    int lg = n >= 91 ? 15 : n >= 64 ? 14 : n >= 46 ? 13 : n >= 32 ? 12 : n >= 23 ? 11 : n >= 16 ? 10 : n >= 12 ? 9 : 8;
    return ret + lg;
}
#define LDS_WAIT() asm volatile("s_waitcnt lgkmcnt(0)" ::: "memory")
#define VM_WAIT() asm volatile("s_waitcnt vmcnt(0)" ::: "memory")

#define XB_TMO      128
#define XB_XCNT(j)  (256  + 64 * (j))
#define XB_XSUB(j)  (1280 + 64 * (j))
#define XB_XGEN(j)  (2304 + 64 * (j))
#define XB_TOP      3328
#define XB_TOPGEN   3392
#define XCD_BAR_WORDS 3456
#define XB_SPIN_CAP (1u << 18)
__device__ __forceinline__ unsigned xb_ld(unsigned* p)              { return __hip_atomic_load(p, __ATOMIC_RELAXED, __HIP_MEMORY_SCOPE_AGENT); }
__device__ __forceinline__ unsigned xb_add(unsigned* p, unsigned v) { return __hip_atomic_fetch_add(p, v, __ATOMIC_RELAXED, __HIP_MEMORY_SCOPE_AGENT); }
__device__ __forceinline__ unsigned xb_xcc_id() { return (unsigned)__builtin_amdgcn_s_getreg((3 << 11) | 20) & 0xFu; }
#define XB_SPIN(cond, bar) do { unsigned _sp = 0; while (cond) { __builtin_amdgcn_s_sleep(1); \
    if ((++_sp & 255u) == 0u) { if (xb_ld(&(bar)[XB_TMO])) break; if (_sp > XB_SPIN_CAP) { atomicAdd(&(bar)[XB_TMO], 1u); break; } } } } while (0)
struct XcdBarrier { unsigned* bar; unsigned x; volatile LAS unsigned* st; };
__device__ __forceinline__ XcdBarrier xcd_barrier_post(unsigned* bar, volatile LAS unsigned* st) {
    XcdBarrier b; b.bar = bar; b.x = xb_xcc_id(); b.st = st;
    if (threadIdx.x == 0) st[2] = xb_add(&bar[XB_XCNT(b.x)], 1u);
    return b;
}
__device__ __forceinline__ int xcd_virtual_cu(const XcdBarrier& b) {
    if (threadIdx.x == 0) { unsigned pre = 0u; for (unsigned j = 0; j < 16; ++j) { const unsigned c = xb_ld(&b.bar[XB_XCNT(j)]); pre += (j < b.x) ? c : 0u; } b.st[3] = pre + b.st[2]; }
    __syncthreads();
    const int v = (int)b.st[3];
    __syncthreads();
    return __builtin_amdgcn_readfirstlane(v);
}
__device__ __forceinline__ void xcd_barrier_complete(unsigned* bar, unsigned x, unsigned& nloc, unsigned& nx) {
    const unsigned G = gridDim.x * gridDim.y * gridDim.z;
    unsigned sum, cnt, mine, sp = 0u;
    for (;;) {
        sum = 0u; cnt = 0u; mine = 0u;
#pragma unroll
        for (unsigned j = 0; j < 16; ++j) { const unsigned c = xb_ld(&bar[XB_XCNT(j)]); sum += c; cnt += (c > 0u) ? 1u : 0u; mine = (j == x) ? c : mine; }
        if (sum == G) break;
        __builtin_amdgcn_s_sleep(1);
        if ((++sp & 255u) == 0u) { if (xb_ld(&bar[XB_TMO])) break; if (sp > XB_SPIN_CAP) { atomicAdd(&bar[XB_TMO], 1u); break; } }
    }
    nloc = mine > 0u ? mine : 1u; nx = cnt > 0u ? cnt : 1u;
}
__device__ __forceinline__ void xcd_barrier(const XcdBarrier& b) {
    asm volatile("s_waitcnt vmcnt(0)" ::: "memory");
    __syncthreads();
    if (threadIdx.x == 0) {
        unsigned* bar = b.bar;
        __builtin_amdgcn_s_waitcnt(0);
        unsigned nloc = b.st[0], nx = b.st[1];
        if (nloc == 0u) { xcd_barrier_complete(bar, b.x, nloc, nx); b.st[0] = nloc; b.st[1] = nx; }
        const unsigned old = xb_add(&bar[XB_XSUB(b.x)], 1u);
        const unsigned gen = old / nloc;
        if (old + 1u == (gen + 1u) * nloc) {
            __builtin_amdgcn_fence(__ATOMIC_RELEASE, "agent");
            asm volatile("s_waitcnt vmcnt(0)" ::: "memory");
            const unsigned og = xb_add(&bar[XB_TOP], 1u);
            const unsigned tg = og / nx;
            if (og + 1u == (tg + 1u) * nx) xb_add(&bar[XB_TOPGEN], 1u);
            else XB_SPIN(xb_ld(&bar[XB_TOPGEN]) == tg, bar);
            __builtin_amdgcn_fence(__ATOMIC_ACQUIRE, "agent");
            xb_add(&bar[XB_XGEN(b.x)], 1u);
            asm volatile("s_waitcnt vmcnt(0)" ::: "memory");
        } else {
            XB_SPIN(xb_ld(&bar[XB_XGEN(b.x)]) == gen, bar);
            __builtin_amdgcn_fence(__ATOMIC_ACQUIRE, "agent");
            asm volatile("s_waitcnt vmcnt(0)" ::: "memory");
        }
    }
    __syncthreads();
}

namespace pg8 {
constexpr int BM = 256, BK = 64, HALF = 128, HTB = HALF * BK * 2, STAGE_BYTES = 8 * HTB, KD = 2048;
__host__ __device__ __forceinline__ int lds_byte(int r, int c) { const int st = (r >> 4) * 2 + (c >> 5), rr = r & 15, cc = c & 31, ob = rr * 64 + cc * 2; return st * 1024 + (ob ^ (((ob >> 9) & 1) << 5)); }
__host__ __device__ __forceinline__ void stage_rc(int b, int& R, int& C) { const int st = b / 1024, sb = b % 1024, swz = sb ^ (((sb >> 9) & 1) << 5); R = (st >> 1) * 16 + swz / 64; C = (st & 1) * 32 + (swz % 64) / 2; }
__host__ __device__ __forceinline__ int perm32(int rho) { const int n = rho >> 4, i = rho & 15; return 8 * (i >> 2) + 4 * n + (i & 3); }
struct Unit { int pm, pn, e, rows, hs, q; };

struct DenseOrder {
    int nM, nN, nwg, nfull, G, c, rep = 1; bool half;
    __device__ void init(int M, int N, int G_, int c_, bool half_ = false, bool split_tail = false) { nM = M / BM; nN = N / BM; nwg = nM * nN; G = G_; c = c_; half = half_; nfull = split_tail ? (nwg / G_) * G_ : nwg; }
    __device__ bool next(int i, Unit& u) const {
        long L = (long)i * G + c; int hsel = 0;
        if (half) { if (L >= 2L * (nwg - nfull)) return false; hsel = (int)(L & 1); L = nfull + (L >> 1); }
        else { if (L >= (long)nfull * rep) return false; if (rep > 1 && L >= nfull) L -= nfull; }
        const int wgid = (int)L;
        const int nig = 8 * nN, gid = wgid / nig, fm = gid * 8, gsz = (nM - fm) < 8 ? (nM - fm) : 8;
        u.pm = fm + ((wgid % nig) % gsz); u.pn = (wgid % nig) / gsz; u.e = 0; u.hs = 0; u.q = 0; u.rows = 256; if (half) { u.pm = 2 * u.pm + hsel; u.rows = 128; } return true;
    }
};

template <class P, bool HM = false>
__device__ __forceinline__ void gemm_run(LAS unsigned char* lds, const P& prob) {
    const int tid = threadIdx.x, wid = __builtin_amdgcn_readfirstlane(tid >> 6), lane = tid & 63, wr = wid >> 2, wc = wid & 3, fr = lane & 15, fq = lane >> 4;
    constexpr int K = KD, nt = K / BK;
    int Rr[2], Cc[2]; unsigned voffB[2];
#pragma unroll
    for (int i = 0; i < 2; ++i) { int R, C; stage_rc(tid * 16 + i * 8192, R, C); Rr[i] = R; Cc[i] = C; const int Rb = P::PERM ? ((R & ~31) + perm32(R & 31)) : R; voffB[i] = (unsigned)(Rb * K + C) * 2u; }
    constexpr size_t kstep = (size_t)(BK * 2), hstep = (size_t)HALF * K * 2;
    const unsigned ldsw = (unsigned)wid * 1024u;
    const int aoff = lds_byte(wr * 64 + fr, fq * 8), boff = lds_byte(wc * 32 + fr, fq * 8);
#define PG8_SA(b, h) (((b) * 2 + (h)) * HTB)
#define PG8_SB(b, h) ((4 + (b) * 2 + (h)) * HTB)
#define PG8_STAGE(bufoff, gbase, voff) do { _Pragma("unroll") for (int _i = 0; _i < 2; ++_i) \
        __builtin_amdgcn_global_load_lds((const unsigned*)((const char*)(gbase) + (voff)[_i]), (LAS unsigned*)(lds + (bufoff) + ldsw + _i * 8192), 16, 0, 0); } while (0)
#define PG8_LDA(dst, b, h) do { _Pragma("unroll") for (int m = 0; m < 4; ++m) _Pragma("unroll") for (int k = 0; k < 2; ++k) dst[m][k] = *(const LAS bf16x8*)(lds + PG8_SA(b, h) + aoff + m * 2048 + k * 1024); } while (0)
#define PG8_LDB(dst, b, h) do { _Pragma("unroll") for (int n = 0; n < 2; ++n) _Pragma("unroll") for (int k = 0; k < 2; ++k) dst[n][k] = *(const LAS bf16x8*)(lds + PG8_SB(b, h) + boff + n * 2048 + k * 1024); } while (0)
#define PG8_MMA(ai, bj, At, Bt) do { __builtin_amdgcn_s_setprio(1); _Pragma("unroll") for (int m = 0; m < 4; ++m) _Pragma("unroll") for (int n = 0; n < 2; ++n) _Pragma("unroll") for (int k = 0; k < 2; ++k) \
        acc[ai][bj][m][n] = __builtin_amdgcn_mfma_f32_16x16x32_bf16(Bt[n][k], At[m][k], acc[ai][bj][m][n], 0, 0, 0); __builtin_amdgcn_s_setprio(0); } while (0)
#define PG8_WAIT_V(n) asm volatile("s_waitcnt vmcnt(" #n ")" ::: "memory")
#define PG8_WAIT_L(n) asm volatile("s_waitcnt lgkmcnt(" #n ")" ::: "memory")
#define PG8_BAR __builtin_amdgcn_s_barrier()
#define PG8_SCHED __builtin_amdgcn_sched_barrier(0)
    Unit cur, nxt; int ui = 0;
    if (!prob.next(0, cur)) return;
    f32x4 acc[2][2][4][2];
#pragma unroll
    for (int a = 0; a < 2; ++a)
#pragma unroll
        for (int b = 0; b < 2; ++b)
#pragma unroll
            for (int m = 0; m < 4; ++m)
#pragma unroll
                for (int n = 0; n < 2; ++n) acc[a][b][m][n] = (f32x4){0.f, 0.f, 0.f, 0.f};
    bf16x8 At[4][2], B0[2][2], B1[2][2];
    unsigned vC0[2], vC1[2], vN0[2], vN1[2];
    prob.a_off(cur, Rr, Cc, vC0, vC1);
    const char* const Ab = prob.a_base();
    const char* cB = prob.b_base(cur);
    PG8_STAGE(PG8_SB(0, 0), cB, voffB); PG8_STAGE(PG8_SB(0, 1), cB + hstep, voffB); PG8_STAGE(PG8_SA(0, 0), Ab, vC0); if constexpr (!HM) PG8_STAGE(PG8_SA(0, 1), Ab, vC1);
    if (wr == 1) PG8_BAR;
    if constexpr (HM) PG8_WAIT_V(0); else PG8_WAIT_V(2);
    PG8_BAR;
    PG8_STAGE(PG8_SB(1, 0), cB + kstep, voffB); PG8_STAGE(PG8_SA(1, 0), Ab + kstep, vC0); PG8_STAGE(PG8_SB(1, 1), cB + hstep + kstep, voffB);
    PG8_WAIT_V(6); PG8_BAR;
    for (;;) {
        const bool has_next = prob.next(ui + 1, nxt);
        if (has_next) prob.a_off(nxt, Rr, Cc, vN0, vN1); else { vN0[0] = vC0[0]; vN0[1] = vC0[1]; vN1[0] = vC1[0]; vN1[1] = vC1[1]; }
        const char* nB = has_next ? prob.b_base(nxt) : cB;
        for (int t = 0; t < nt; t += 2) {
            const bool last = (t == nt - 2);
            const char* a1 = Ab + (size_t)(t + 1) * kstep;
            const char* a2 = last ? Ab : Ab + (size_t)(t + 2) * kstep; const char* b2 = last ? nB : cB + (size_t)(t + 2) * kstep;
            const char* a3 = a2 + kstep; const char* b3 = b2 + kstep;
            unsigned v20[2], v21[2];
            v20[0] = last ? vN0[0] : vC0[0]; v20[1] = last ? vN0[1] : vC0[1]; v21[0] = last ? vN1[0] : vC1[0]; v21[1] = last ? vN1[1] : vC1[1];
            PG8_LDB(B0, 0, 0); PG8_LDB(B1, 0, 1); PG8_SCHED; PG8_LDA(At, 0, 0); if constexpr (!HM) PG8_STAGE(PG8_SA(1, 1), a1, vC1);
            if constexpr (HM) PG8_WAIT_V(6); else PG8_WAIT_V(8); PG8_WAIT_L(0); PG8_BAR; PG8_MMA(0, 0, At, B0); PG8_MMA(0, 1, At, B1); PG8_BAR; PG8_SCHED;
            if constexpr (!HM) PG8_LDA(At, 0, 1); PG8_STAGE(PG8_SB(0, 0), b2, voffB); PG8_STAGE(PG8_SB(0, 1), b2 + hstep, voffB); PG8_STAGE(PG8_SA(0, 0), a2, v20);
            if constexpr (HM) PG8_WAIT_V(6); else PG8_WAIT_V(8);
            PG8_WAIT_L(0); PG8_BAR; if constexpr (!HM) { PG8_MMA(1, 0, At, B0); PG8_MMA(1, 1, At, B1); } PG8_BAR; PG8_SCHED;
            PG8_LDB(B0, 1, 0); PG8_LDB(B1, 1, 1); PG8_SCHED; PG8_LDA(At, 1, 0); if constexpr (!HM) PG8_STAGE(PG8_SA(0, 1), a2, v21);
            if constexpr (HM) PG8_WAIT_V(6); else PG8_WAIT_V(8); PG8_WAIT_L(0); PG8_BAR; PG8_MMA(0, 0, At, B0); PG8_MMA(0, 1, At, B1); PG8_BAR; PG8_SCHED;
            if constexpr (!HM) PG8_LDA(At, 1, 1); PG8_STAGE(PG8_SB(1, 0), b3, voffB); PG8_STAGE(PG8_SB(1, 1), b3 + hstep, voffB); PG8_STAGE(PG8_SA(1, 0), a3, v20);
            if constexpr (HM) PG8_WAIT_V(6); else PG8_WAIT_V(8);
            PG8_WAIT_L(0); PG8_BAR; if constexpr (!HM) { PG8_MMA(1, 0, At, B0); PG8_MMA(1, 1, At, B1); } PG8_BAR; PG8_SCHED;
        }
        if (wr == 0) PG8_BAR;
        prob.epi(acc, cur, wr, wc, fr, fq);
        if (!has_next) break;
#pragma unroll
        for (int a = 0; a < 2; ++a)
#pragma unroll
            for (int b = 0; b < 2; ++b)
#pragma unroll
                for (int m = 0; m < 4; ++m)
#pragma unroll
                    for (int n = 0; n < 2; ++n) acc[a][b][m][n] = (f32x4){0.f, 0.f, 0.f, 0.f};
        cur = nxt; cB = nB; ++ui; vC0[0] = vN0[0]; vC0[1] = vN0[1]; vC1[0] = vN1[0]; vC1[1] = vN1[1];
        if (wr == 1) PG8_BAR;
    }
    PG8_WAIT_V(0);
    PG8_BAR;
#undef PG8_SA
#undef PG8_SB
#undef PG8_STAGE
#undef PG8_LDA
#undef PG8_LDB
#undef PG8_MMA
#undef PG8_WAIT_V
#undef PG8_WAIT_L
#undef PG8_BAR
#undef PG8_SCHED
}

template <class P, bool HN = false>
__device__ __forceinline__ void gemm_run_bf32(LAS unsigned char* lds, const P& prob) {
    const int tid = threadIdx.x, wid = __builtin_amdgcn_readfirstlane(tid >> 6), lane = tid & 63, wr = wid >> 2, wc = wid & 3, fr = lane & 15, fq = lane >> 4;
    constexpr int K = KD, nt = K / BK;
    constexpr size_t kstep = (size_t)(BK * 2);
    constexpr size_t ldwB = (size_t)P::LDW_BYTES;
    const unsigned ldsw = (unsigned)wid * 1024u;
    const int aoff = lds_byte(wr * 64 + fr, fq * 8), boff = lds_byte(wc * 32 + fr, fq * 8);
    const int wbo0 = lds_byte(32 * (lane >> 4) + (((lane >> 1) & 1) | (((lane >> 3) & 1) << 2) | (((lane >> 2) & 1) << 3)), 8 * wid + 4 * (lane & 1));
#define PG8_SA(b, h) (((b) * 2 + (h)) * HTB)
#define PG8_SB(b, h) ((4 + (b) * 2 + (h)) * HTB)
#define PG8_STAGE(bufoff, gbase, voff) do { _Pragma("unroll") for (int _i = 0; _i < 2; ++_i) \
        __builtin_amdgcn_global_load_lds((const unsigned*)((const char*)(gbase) + (voff)[_i]), (LAS unsigned*)(lds + (bufoff) + ldsw + _i * 8192), 16, 0, 0); } while (0)
#define PG8_LDA(dst, b, h) do { _Pragma("unroll") for (int m = 0; m < 4; ++m) _Pragma("unroll") for (int k = 0; k < 2; ++k) dst[m][k] = *(const LAS bf16x8*)(lds + PG8_SA(b, h) + aoff + m * 2048 + k * 1024); } while (0)
#define PG8_LDB(dst, b, h) do { _Pragma("unroll") for (int n = 0; n < 2; ++n) _Pragma("unroll") for (int k = 0; k < 2; ++k) dst[n][k] = *(const LAS bf16x8*)(lds + PG8_SB(b, h) + boff + n * 2048 + k * 1024); } while (0)
#define PG8_MMA(ai, bj, At, Bt) do { __builtin_amdgcn_s_setprio(1); _Pragma("unroll") for (int m = 0; m < 4; ++m) _Pragma("unroll") for (int n = 0; n < 2; ++n) _Pragma("unroll") for (int k = 0; k < 2; ++k) \
        acc[ai][bj][m][n] = __builtin_amdgcn_mfma_f32_16x16x32_bf16(Bt[n][k], At[m][k], acc[ai][bj][m][n], 0, 0, 0); __builtin_amdgcn_s_setprio(0); } while (0)
#define PG8_WAIT_V(n) asm volatile("s_waitcnt vmcnt(" #n ")" ::: "memory")
#define PG8_WAIT_L(n) asm volatile("s_waitcnt lgkmcnt(" #n ")" ::: "memory")
#define PG8_BAR __builtin_amdgcn_s_barrier()
#define PG8_SCHED __builtin_amdgcn_sched_barrier(0)
#define PG8_BLOAD(kk, h) do { const bool nx_ = (kk) >= nt; const unsigned so_ = (nx_ ? nBo : cBo) + (unsigned)((nx_ ? (kk) - nt : (kk)) * BK + 8 * wid) * (unsigned)ldwB + (unsigned)(h) * (unsigned)P::HALF_BYTES; \
        const unsigned co_ = nx_ ? nCol : cCol; \
        asm volatile("s_nop 4" ::: "memory"); \
        _Pragma("unroll") for (int j_ = 0; j_ < 4; ++j_) asm volatile("buffer_load_dwordx4 %0, %1, %2, %3 offen" : "=v"(bv[j_]) : "v"(co_), "s"(wrs), "s"(so_ + (unsigned)j_ * (unsigned)ldwB) : "memory"); } while (0)
#define PG8_BWAIT(n) asm volatile("s_waitcnt vmcnt(" #n ")" : "+v"(bv[0]), "+v"(bv[1]), "+v"(bv[2]), "+v"(bv[3]) :: "memory")
#define PG8_BWRITE(b, h) do { _Pragma("unroll") for (int i_ = 0; i_ < 4; ++i_) { u32x2 o_; o_.x = cvt_pk_bf16(bv[0][i_], bv[1][i_]); o_.y = cvt_pk_bf16(bv[2][i_], bv[3][i_]); \
        *(LAS u32x2*)(lds + PG8_SB(b, h) + wbo0 + 128 * (i_ & 1) + 2048 * (i_ >> 1)) = o_; } } while (0)
    typedef float f32x2v __attribute__((ext_vector_type(2)));
    Unit cur, nxt; int ui = 0;
    if (!prob.next(0, cur)) return;
    f32x4 acc[2][2][4][2];
    bf16x8 At[4][2], B0[2][2], B1[2][2];
    f32x4 bv[4];
    unsigned vC0[2], vC1[2], vN0[2], vN1[2];
    prob.a_off(cur, vC0, vC1);
    const char* const Ab = prob.a_base();
    const __amdgpu_buffer_rsrc_t wrs = __builtin_amdgcn_make_buffer_rsrc((void*)prob.W, 0, (unsigned)NE * (unsigned)P::W_BYTES, 0x00020000);
    unsigned cBo = (unsigned)cur.e * (unsigned)P::W_BYTES, cCol = prob.b_col(cur, lane & ~1) + (unsigned)(lane & 1) * 4u * (unsigned)ldwB;
    unsigned nBo = cBo, nCol = cCol;
#define PG8_BLOADX(R, kk, h) do { const unsigned so_ = cBo + (unsigned)((kk) * BK + 8 * wid) * (unsigned)ldwB + (unsigned)(h) * (unsigned)P::HALF_BYTES; \
        _Pragma("unroll") for (int j_ = 0; j_ < 4; ++j_) asm volatile("buffer_load_dwordx4 %0, %1, %2, %3 offen" : "=v"(R[j_]) : "v"(cCol), "s"(wrs), "s"(so_ + (unsigned)j_ * (unsigned)ldwB) : "memory"); } while (0)
#define PG8_BWAITX(R, n) asm volatile("s_waitcnt vmcnt(" #n ")" : "+v"(R[0]), "+v"(R[1]), "+v"(R[2]), "+v"(R[3]) :: "memory")
#define PG8_BWRITEX(R, b, h) do { _Pragma("unroll") for (int i_ = 0; i_ < 4; ++i_) { u32x2 o_; o_.x = cvt_pk_bf16(R[0][i_], R[1][i_]); o_.y = cvt_pk_bf16(R[2][i_], R[3][i_]); \
        *(LAS u32x2*)(lds + PG8_SB(b, h) + wbo0 + 128 * (i_ & 1) + 2048 * (i_ >> 1)) = o_; } } while (0)
    { f32x4 bw[4], bx[4];
      asm volatile("s_nop 4" ::: "memory");
      PG8_BLOADX(bv, 0, 0); if constexpr (!HN) PG8_BLOADX(bw, 0, 1); PG8_BLOADX(bx, 1, 0);
      PG8_STAGE(PG8_SA(0, 0), Ab, vC0); PG8_STAGE(PG8_SA(0, 1), Ab, vC1);
      if constexpr (!HN) { PG8_BWAITX(bv, 12); PG8_BWRITEX(bv, 0, 0); PG8_BWAITX(bw, 8); PG8_BWRITEX(bw, 0, 1); }
      else { PG8_BWAITX(bv, 8); PG8_BWRITEX(bv, 0, 0); }
      PG8_BWAITX(bx, 4); PG8_BWRITEX(bx, 1, 0); }
    if constexpr (!HN) PG8_BLOAD(1, 1);
    if (wr == 1) PG8_BAR;
    if constexpr (!HN) PG8_WAIT_V(4); else PG8_WAIT_V(0);
    PG8_WAIT_L(0); PG8_BAR;
    PG8_STAGE(PG8_SA(1, 0), Ab + kstep, vC0);
    { f32x4 bini[2][2]; prob.bias_load(cur, wc, fq, bini);
#pragma unroll
      for (int a = 0; a < 2; ++a)
#pragma unroll
        for (int b = 0; b < 2; ++b)
#pragma unroll
            for (int m = 0; m < 4; ++m)
#pragma unroll
                for (int n = 0; n < 2; ++n) acc[a][b][m][n] = bini[b][n]; }
    PG8_WAIT_V(0); PG8_BAR;
    for (;;) {
        const bool has_next = prob.next(ui + 1, nxt);
        if (has_next) { prob.a_off(nxt, vN0, vN1); nBo = (unsigned)nxt.e * (unsigned)P::W_BYTES; nCol = prob.b_col(nxt, lane & ~1) + (unsigned)(lane & 1) * 4u * (unsigned)ldwB; }
        else { vN0[0] = vC0[0]; vN0[1] = vC0[1]; vN1[0] = vC1[0]; vN1[1] = vC1[1]; nBo = cBo; nCol = cCol; }
        for (int t = 0; t < nt; t += 2) {
            const bool last = (t == nt - 2);
            const char* a1 = Ab + (size_t)(t + 1) * kstep;
            const char* a2 = last ? Ab : Ab + (size_t)(t + 2) * kstep;
            const char* a3 = a2 + kstep;
            unsigned v20[2], v21[2];
            v20[0] = last ? vN0[0] : vC0[0]; v20[1] = last ? vN0[1] : vC0[1]; v21[0] = last ? vN1[0] : vC1[0]; v21[1] = last ? vN1[1] : vC1[1];
            PG8_LDB(B0, 0, 0); if constexpr (!HN) PG8_LDB(B1, 0, 1); PG8_SCHED; PG8_LDA(At, 0, 0); if constexpr (!HN) { PG8_BWAIT(2); PG8_BWRITE(1, 1); } PG8_BLOAD(t + 2, 0); PG8_STAGE(PG8_SA(1, 1), a1, vC1);
            if constexpr (HN) PG8_WAIT_V(8); else PG8_WAIT_V(12);
            PG8_WAIT_L(0); PG8_BAR; PG8_MMA(0, 0, At, B0); if constexpr (!HN) PG8_MMA(0, 1, At, B1); PG8_BAR; PG8_SCHED;
            PG8_LDA(At, 0, 1); PG8_BWAIT(2); PG8_BWRITE(0, 0); if constexpr (!HN) PG8_BLOAD(t + 2, 1); PG8_STAGE(PG8_SA(0, 0), a2, v20);
            if constexpr (HN) PG8_WAIT_V(8); else PG8_WAIT_V(12);
            PG8_WAIT_L(0); PG8_BAR; PG8_MMA(1, 0, At, B0); if constexpr (!HN) PG8_MMA(1, 1, At, B1); PG8_BAR; PG8_SCHED;
            PG8_LDB(B0, 1, 0); if constexpr (!HN) PG8_LDB(B1, 1, 1); PG8_SCHED; PG8_LDA(At, 1, 0); if constexpr (!HN) { PG8_BWAIT(2); PG8_BWRITE(0, 1); } PG8_BLOAD(t + 3, 0); PG8_STAGE(PG8_SA(0, 1), a2, v21);
            if constexpr (HN) PG8_WAIT_V(8); else PG8_WAIT_V(12);
            PG8_WAIT_L(0); PG8_BAR; PG8_MMA(0, 0, At, B0); if constexpr (!HN) PG8_MMA(0, 1, At, B1); PG8_BAR; PG8_SCHED;
            PG8_LDA(At, 1, 1); PG8_BWAIT(2); PG8_BWRITE(1, 0); if constexpr (!HN) PG8_BLOAD(t + 3, 1); PG8_STAGE(PG8_SA(1, 0), a3, v20);
            if constexpr (HN) PG8_WAIT_V(8); else PG8_WAIT_V(12);
            PG8_WAIT_L(0); PG8_BAR; PG8_MMA(1, 0, At, B0); if constexpr (!HN) PG8_MMA(1, 1, At, B1); PG8_BAR; PG8_SCHED;
        }
        if (wr == 0) PG8_BAR;
        prob.epi(acc, cur, wr, wc, fr, fq, 0);
        if (has_next) { f32x4 bini[2][2]; prob.bias_load(nxt, wc, fq, bini);
#pragma unroll
            for (int b = 0; b < 2; ++b)
#pragma unroll
                for (int m = 0; m < 4; ++m)
#pragma unroll
                    for (int n = 0; n < 2; ++n) acc[0][b][m][n] = bini[b][n]; }
        prob.epi(acc, cur, wr, wc, fr, fq, 1);
        if (!has_next) break;
#pragma unroll
        for (int b = 0; b < 2; ++b)
#pragma unroll
            for (int m = 0; m < 4; ++m)
#pragma unroll
                for (int n = 0; n < 2; ++n) acc[1][b][m][n] = acc[0][b][m][n];
        cur = nxt; cBo = nBo; cCol = nCol; ++ui; vC0[0] = vN0[0]; vC0[1] = vN0[1]; vC1[0] = vN1[0]; vC1[1] = vN1[1];
        if (wr == 1) PG8_BAR;
    }
    PG8_BWAIT(0);
    PG8_BAR;
#undef PG8_SA
#undef PG8_SB
#undef PG8_STAGE
#undef PG8_LDA
#undef PG8_LDB
#undef PG8_MMA
#undef PG8_WAIT_V
#undef PG8_WAIT_L
#undef PG8_BAR
#undef PG8_SCHED
#undef PG8_BLOAD
#undef PG8_BWAIT
#undef PG8_BWRITE
#undef PG8_BLOADX
#undef PG8_BWAITX
#undef PG8_BWRITEX
}
}

constexpr int NWAVES = 8, NTHR = 512;
constexpr int RING_BYTES = 131072;
constexpr int TAB_OFF = 147968;
constexpr int MISC_OFF = 163840 - 256;
constexpr int LDS_BYTES = 163840;

struct Frame {
    LAS unsigned char* lds; volatile LAS unsigned* MISC; unsigned* ctl;
    int tid, lane, wave, vcu, G;
    const float *x, *c, *w_ada, *b_ada, *g1, *w_in, *lq1, *lk1, *lq2, *lk2, *subln, *relb, *cw, *cb, *clg, *clb, *w_out, *g2, *w_r, *b_r, *w_gu, *b_gu, *w_d, *b_d, *fg;
    float* out; unsigned char* ws;
};
#define WSP(T_, off) ((T_*)(F.ws + (off)))

__device__ __forceinline__ void p0_transpose_item(const float* W, int ldn, int n0, int k0, bf16* dst, int drow0, LAS unsigned char* scr, int lane) {
    const int ng = lane & 31, kh = lane >> 5;
#pragma unroll
    for (int it = 0; it < 4; ++it) {
        f32x4 v[8];
#pragma unroll
        for (int j = 0; j < 8; ++j) v[j] = *(const GAS f32x4*)(W + (size_t)(k0 + 16 * it + 8 * kh + j) * ldn + n0 + 4 * ng);
        const int kc = 2 * it + kh;
#pragma unroll
        for (int i = 0; i < 4; ++i) { const int n = 4 * ng + i;
            u32x4 o; o.x = pk2(v[0][i], v[1][i]); o.y = pk2(v[2][i], v[3][i]); o.z = pk2(v[4][i], v[5][i]); o.w = pk2(v[6][i], v[7][i]);
            *(LAS u32x4*)(scr + n * 128 + ((kc ^ (ng & 7)) << 4)) = o; }
    }
    LDS_WAIT(); asm volatile("" ::: "memory");
#pragma unroll
    for (int j = 0; j < 16; ++j) { const int n = 8 * j + (lane >> 3), c = lane & 7;
        const u32x4 o = *(const LAS u32x4*)(scr + n * 128 + ((c ^ ((n >> 2) & 7)) << 4));
        *(GAS u32x4*)(dst + (size_t)(drow0 + n) * pg8::KD + k0 + 8 * c) = o; }
    LDS_WAIT(); asm volatile("" ::: "memory");
}
__device__ __forceinline__ void p0_prologue(Frame& F) {
    const int gw = F.vcu * NWAVES + F.wave, NGW = F.G * NWAVES, gt = F.vcu * NTHR + F.tid, NGT = F.G * NTHR;
    LAS float* cs = (LAS float*)(F.lds);
    for (int i = F.tid; i < NB * DM; i += NTHR) cs[i] = silu_f(F.c[i]);
    __syncthreads();
    float* modp = WSP(float, WS_MODP);
    for (int it = gw; it < 96 * 16; it += NGW) {
        const int cc = it % 96, kc = it / 96, r = F.lane >> 5, g = F.lane & 31;
        float acc[4][4];
#pragma unroll
        for (int b = 0; b < 4; ++b)
#pragma unroll
            for (int j = 0; j < 4; ++j) acc[b][j] = 0.f;
        const float* wp = F.w_ada + (size_t)(kc * 128 + r) * (6 * DM) + cc * 128 + g * 4;
#pragma unroll 8
        for (int s = 0; s < 64; ++s) {
            const f32x4 w = *(const GAS f32x4*)(wp + (size_t)(2 * s) * (6 * DM)); const int k = kc * 128 + 2 * s + r;
#pragma unroll
            for (int b = 0; b < 4; ++b) { const float cv = cs[b * DM + k];
#pragma unroll
                for (int j = 0; j < 4; ++j) acc[b][j] += cv * w[j]; }
        }
#pragma unroll
        for (int b = 0; b < 4; ++b)
#pragma unroll
            for (int j = 0; j < 4; ++j) { float v = acc[b][j]; v += __shfl_xor(v, 32); acc[b][j] = v; }
        if (F.lane < 32)
#pragma unroll
            for (int b = 0; b < 4; ++b) *(GAS f32x4*)(modp + (size_t)(kc * 4 + b) * (6 * DM) + cc * 128 + g * 4) = (f32x4){acc[b][0], acc[b][1], acc[b][2], acc[b][3]};
    }
    __syncthreads();
    LAS unsigned char* scr = F.lds + F.wave * 16384;
    constexpr int I_IN = (INC / 128) * 32, I_OUT = (DM / 128) * 32;
    for (int it = gw; it < I_IN + I_OUT; it += NGW) {
        int r = it;
        if (r < I_IN) { const int nb = r >> 5, kb = r & 31;
            const int drow = nb < 24 ? nb * 128 : (nb < 32 ? 3072 + (nb - 24) * 256 : 3072 + (nb - 32) * 256 + 128);
            p0_transpose_item(F.w_in, INC, nb * 128, kb * 64, WSP(bf16, WS_WIN), drow, scr, F.lane); continue; } r -= I_IN;
        { const int nb = r >> 5, kb = r & 31; p0_transpose_item(F.w_out, DM, nb * 128, kb * 64, WSP(bf16, WS_WOUT), nb * 128, scr, F.lane); }
    }
    for (int i = gt; i < 64 * 2 * 64; i += NGT) {
        const int l = i & 63, nb = (i >> 6) & 1, s = i >> 7, e = 16 * nb + (l & 15), kb = 32 * s + 8 * (l >> 4);
        unsigned hi[8], lo[8];
#pragma unroll
        for (int j = 0; j < 8; ++j) { const float w = F.w_r[(size_t)(kb + j) * NE + e]; hi[j] = f2bf(w); lo[j] = f2bf(w - bf2f(hi[j])); }
        u32x4 oh, ol; oh.x = hi[0] | (hi[1] << 16); oh.y = hi[2] | (hi[3] << 16); oh.z = hi[4] | (hi[5] << 16); oh.w = hi[6] | (hi[7] << 16);
        ol.x = lo[0] | (lo[1] << 16); ol.y = lo[2] | (lo[3] << 16); ol.z = lo[4] | (lo[5] << 16); ol.w = lo[6] | (lo[7] << 16);
        *(GAS u32x4*)(WSP(unsigned char, WS_WRF) + (size_t)i * 16) = oh; *(GAS u32x4*)(WSP(unsigned char, WS_WRF) + 131072 + (size_t)i * 16) = ol;
    }
    float* bt = WSP(float, WS_BIAST);
    for (int i = gt; i < AH * 4096; i += NGT) { const int h = i >> 12, rel = (i & 4095) - 2048; bt[i] = F.relb[t5_bucket(rel) * AH + h] * LOG2E; }
    if (gt == 0) { float a = 0.f, b = 0.f; for (int i = 0; i < HD; ++i) { a += F.lq1[i] * F.lk1[i]; b += F.lq2[i] * F.lk2[i]; } bt[AH * 4096] = __expf(a) - __expf(b) + 0.2f; }
}

__device__ __forceinline__ void p1_norm1(Frame& F) {
    const float* modp = WSP(float, WS_MODP); float* mod = WSP(float, WS_MOD);
    for (int o = F.vcu * NTHR + F.tid; o < NB * 6 * DM; o += F.G * NTHR) { float s = F.b_ada[o % (6 * DM)];
#pragma unroll
        for (int kc = 0; kc < 16; ++kc) s += modp[(size_t)kc * (NB * 6 * DM) + o];
        mod[o] = s; }
    LAS float* gm = (LAS float*)F.lds; LAS float* sh = gm + DM;
    bf16* h = WSP(bf16, WS_H);
    for (int rb = F.vcu; rb < T / 32; rb += F.G) {
        const int b = rb / (SEQ / 32);
        __syncthreads();
        for (int k = F.tid; k < DM; k += NTHR) { float sc = F.b_ada[DM + k], sf = F.b_ada[k];
#pragma unroll
            for (int kc = 0; kc < 16; ++kc) { sc += modp[(size_t)(kc * 4 + b) * (6 * DM) + DM + k]; sf += modp[(size_t)(kc * 4 + b) * (6 * DM) + k]; }
            gm[k] = F.g1[k] * (1.f + sc); sh[k] = sf; }
        __syncthreads();
        for (int rr = F.wave; rr < 32; rr += NWAVES) {
            const int row = rb * 32 + rr;
            const GAS f32x4* xr = (const GAS f32x4*)(F.x + (size_t)row * DM) + F.lane;
            f32x4 v[8]; float s = 0.f;
#pragma unroll
            for (int j = 0; j < 8; ++j) { v[j] = xr[64 * j]; s += (v[j].x * v[j].x + v[j].y * v[j].y) + (v[j].z * v[j].z + v[j].w * v[j].w); }
            const float rstd = rsqrtf(wave_sum(s) * (1.f / DM) + EPS);
            GAS u32x2* o8 = (GAS u32x2*)(h + (size_t)row * DM) + F.lane;
#pragma unroll
            for (int j = 0; j < 8; ++j) { const int k = 4 * F.lane + 256 * j; const f32x4 g = *(const LAS f32x4*)(gm + k), s4 = *(const LAS f32x4*)(sh + k);
                u32x2 w; w.x = pk2(v[j].x * rstd * g.x + s4.x, v[j].y * rstd * g.y + s4.y); w.y = pk2(v[j].z * rstd * g.z + s4.z, v[j].w * rstd * g.w + s4.w); st_wt8(o8 + 64 * j, w); }
        }
    }
}

template <bool HMT> struct InProjT {
    static constexpr bool PERM = true;
    const bf16* A; const bf16* Bt; bf16* O; pg8::DenseOrder ord;
    __device__ bool next(int i, pg8::Unit& u) const { return ord.next(i, u); }
    __device__ const char* a_base() const { return (const char*)A; }
    __device__ void a_off(const pg8::Unit& u, const int (&R)[2], const int (&C)[2], unsigned (&v0)[2], unsigned (&v1)[2]) const {
#pragma unroll
        for (int i = 0; i < 2; ++i) { v0[i] = (unsigned)((u.pm * u.rows + R[i]) * pg8::KD + C[i]) * 2u; v1[i] = (unsigned)((u.pm * u.rows + 128 + R[i]) * pg8::KD + C[i]) * 2u; } }
    __device__ const char* b_base(const pg8::Unit& u) const { return (const char*)(Bt + (size_t)u.pn * 256 * pg8::KD); }
    __device__ void epi(const f32x4 (&acc)[2][2][4][2], const pg8::Unit& u, int wr, int wc, int fr, int fq) const {
        const int row0 = u.pm * u.rows + wr * 64 + fr, col0 = u.pn * 256 + wc * 32 + 8 * fq;
        if (u.pn >= 12) {
            const int zc = 3072 + (u.pn - 12) * 128 + wc * 32 + 8 * fq;
#pragma unroll
            for (int ai = 0; ai < (HMT ? 1 : 2); ++ai)
#pragma unroll
                for (int m = 0; m < 4; ++m) { float r[8];
#pragma unroll
                    for (int n = 0; n < 2; ++n)
#pragma unroll
                        for (int j = 0; j < 4; ++j) r[4 * n + j] = acc[ai][0][m][n][j] * __builtin_amdgcn_rcpf(1.f + __builtin_amdgcn_exp2f(-LOG2E * acc[ai][1][m][n][j]));
                    u32x4 w; w.x = cvt_pk_bf16(r[0], r[1]); w.y = cvt_pk_bf16(r[2], r[3]); w.z = cvt_pk_bf16(r[4], r[5]); w.w = cvt_pk_bf16(r[6], r[7]);
                    *(GAS u32x4*)(O + (size_t)(row0 + ai * 128 + m * 16) * INC + zc) = w; }
            return; }
#pragma unroll
        for (int ai = 0; ai < (HMT ? 1 : 2); ++ai)
#pragma unroll
            for (int m = 0; m < 4; ++m) { bf16* rowp = O + (size_t)(row0 + ai * 128 + m * 16) * INC + col0;
#pragma unroll
                for (int bj = 0; bj < 2; ++bj) { const f32x4 v0 = acc[ai][bj][m][0], v1 = acc[ai][bj][m][1];
                    u32x4 w; w.x = cvt_pk_bf16(v0[0], v0[1]); w.y = cvt_pk_bf16(v0[2], v0[3]); w.z = cvt_pk_bf16(v1[0], v1[1]); w.w = cvt_pk_bf16(v1[2], v1[3]);
                    *(GAS u32x4*)(rowp + bj * 128) = w; } }
    }
};
struct OutProj {
    static constexpr bool PERM = true;
    const bf16* A; const bf16* Bt; const float* x; const float* mod; bf16* O; pg8::DenseOrder ord;
    __device__ bool next(int i, pg8::Unit& u) const { return ord.next(i, u); }
    __device__ const char* a_base() const { return (const char*)A; }
    __device__ void a_off(const pg8::Unit& u, const int (&R)[2], const int (&C)[2], unsigned (&v0)[2], unsigned (&v1)[2]) const {
#pragma unroll
        for (int i = 0; i < 2; ++i) { v0[i] = (unsigned)((u.pm * 256 + R[i]) * pg8::KD + C[i]) * 2u; v1[i] = (unsigned)((u.pm * 256 + 128 + R[i]) * pg8::KD + C[i]) * 2u; } }
    __device__ const char* b_base(const pg8::Unit& u) const { return (const char*)(Bt + (size_t)u.pn * 256 * pg8::KD); }
    __device__ void epi(const f32x4 (&acc)[2][2][4][2], const pg8::Unit& u, int wr, int wc, int fr, int fq) const {
        const int row0 = u.pm * 256 + wr * 64 + fr, col0 = u.pn * 256 + wc * 32 + 8 * fq, b = (u.pm * 256) / SEQ;
        f32x4 gt[2][2];
#pragma unroll
        for (int bj = 0; bj < 2; ++bj)
#pragma unroll
            for (int n = 0; n < 2; ++n) gt[bj][n] = *(const GAS f32x4*)(mod + (size_t)b * 6 * DM + 2 * DM + col0 + bj * 128 + 4 * n);
#pragma unroll
        for (int ai = 0; ai < 2; ++ai)
#pragma unroll
            for (int m = 0; m < 4; ++m) { const size_t ro = (size_t)(row0 + ai * 128 + m * 16) * DM + col0;
#pragma unroll
                for (int bj = 0; bj < 2; ++bj) { const f32x4 x0 = *(const GAS f32x4*)(x + ro + bj * 128), x1v = *(const GAS f32x4*)(x + ro + bj * 128 + 4);
                    const f32x4 v0 = x0 + gt[bj][0] * acc[ai][bj][m][0], v1 = x1v + gt[bj][1] * acc[ai][bj][m][1];
                    u32x4 w; w.x = cvt_pk_bf16(v0[0], v0[1]); w.y = cvt_pk_bf16(v0[2], v0[3]); w.z = cvt_pk_bf16(v1[0], v1[1]); w.w = cvt_pk_bf16(v1[2], v1[3]);
                    *(GAS u32x4*)(O + ro + bj * 128) = w; } }
    }
};
struct MoeTab { const LAS int* tp; const LAS int* off; const LAS int* cnt; };
__device__ __forceinline__ void moe_tables(Frame& F) {
    LAS int* tab = (LAS int*)(F.lds + TAB_OFF);
    __syncthreads();
    if (F.tid < 64) {
        const int e = F.lane & 31;
        const int c = (int)__hip_atomic_load(F.ctl + CW_CNT + e * CNT_STRIDE, __ATOMIC_RELAXED, __HIP_MEMORY_SCOPE_AGENT);
        const int t0 = (c + 255) >> 8; int t = t0, o = c;
#pragma unroll
        for (int d = 1; d < 32; d <<= 1) { const int t2 = __shfl_up(t, d, 32), o2 = __shfl_up(o, d, 32); if (e >= d) { t += t2; o += o2; } }
        if (F.lane < NE) { tab[e] = t - t0; tab[40 + e] = o - c; tab[80 + e] = c; }
        if (F.lane == NE - 1) { tab[NE] = t; tab[40 + NE] = o; }
    }
    __syncthreads();
}
template <int NTN, int REPF, int SPLIT>
__device__ __forceinline__ bool moe_next(const MoeTab& tb, int G, int c, int i, pg8::Unit& u) {
    int L = i * G + c; const int total = NTN * __builtin_amdgcn_readfirstlane(tb.tp[NE]); int hs = 0;
    if (SPLIT != 0) {
        const int nrem = total % G, nful = (2 * nrem <= G) ? total - nrem : total;
        if (SPLIT == 1) { if (L >= nful) return false; }
        else { if (L >= 2 * (total - nful)) return false; hs = L & 1; L = nful + (L >> 1); }
    } else { if (L >= total * REPF) return false; if (REPF > 1 && L >= total) L -= total; }
    int e = 0;
#pragma unroll
    for (int j = 1; j < NE; ++j) e += (L >= NTN * tb.tp[j]) ? 1 : 0;
    e = __builtin_amdgcn_readfirstlane(e);
    const int tpe = __builtin_amdgcn_readfirstlane(tb.tp[e]), tpe1 = __builtin_amdgcn_readfirstlane(tb.tp[e + 1]);
    const int local = L - NTN * tpe, nte = tpe1 - tpe;
    u.e = e; u.hs = hs; u.q = i % 3; u.pn = __builtin_amdgcn_readfirstlane(local / nte); u.pm = local - u.pn * nte; u.rows = __builtin_amdgcn_readfirstlane(tb.cnt[e]) - 256 * u.pm; return true;
}
struct MoeGU {
    static constexpr bool PERM = true;
    const bf16* A; const float* W; const float* bias; const int* list; bf16* O; MoeTab tb; int G, c;
    __device__ bool next(int i, pg8::Unit& u) const { return moe_next<16, 1 + ((REP_MASK >> 11) & 1), 0>(tb, G, c, i, u); }
    __device__ const char* a_base() const { return (const char*)A; }
    __device__ void a_off(const pg8::Unit& u, unsigned (&v0)[2], unsigned (&v1)[2]) const {
        const int* lp = list + u.e * T + 256 * u.pm;
        int tb16 = (int)threadIdx.x * 16; asm volatile("" : "+v"(tb16));
#pragma unroll
        for (int i = 0; i < 2; ++i) { int R, C; pg8::stage_rc(tb16 + i * 8192, R, C);
            const int r0 = R < u.rows ? R : u.rows - 1, r1 = (128 + R) < u.rows ? (128 + R) : u.rows - 1;
            v0[i] = (unsigned)(lp[r0] * pg8::KD + C) * 2u; v1[i] = (unsigned)(lp[r1] * pg8::KD + C) * 2u; } }
    __device__ void bias_load(const pg8::Unit& u, int wc, int fq, f32x4 (&bi)[2][2]) const {
        int cb = wc * 32 + 8 * ((fq >> 1) + 2 * (fq & 1)); asm volatile("" : "+v"(cb));
        const float* bp = bias + (size_t)u.e * 2 * DFF + u.pn * 128 + cb;
#pragma unroll
        for (int bj = 0; bj < 2; ++bj)
            { const f32x4 t0 = *(const GAS f32x4*)(bp + bj * DFF), t1 = *(const GAS f32x4*)(bp + bj * DFF + 4); bi[bj][0] = (f32x4){t0[0], t1[0], t0[1], t1[1]}; bi[bj][1] = (f32x4){t0[2], t1[2], t0[3], t1[3]}; } }
    static constexpr int LDW_BYTES = 2 * DFF * 4, W_BYTES = DM * 2 * DFF * 4;
    __device__ const char* b_ptr(const pg8::Unit& u) const { return (const char*)(W + (size_t)u.e * DM * 2 * DFF); }
    static constexpr int HALF_BYTES = DFF * 4;
    __device__ unsigned b_col(const pg8::Unit& u, int lane) const { return (unsigned)(u.pn * 128 + 2 * lane) * 4u; }
    __device__ void epi(const f32x4 (&acc)[2][2][4][2], const pg8::Unit& u, int wr, int wc, int fr, int fq, const int ai) const {
        int rt0 = wr * 64 + fr, colt = u.pn * 128 + wc * 32 + 8 * ((fq >> 1) + 2 * (fq & 1)); asm volatile("" : "+v"(rt0), "+v"(colt)); const size_t slot0 = (size_t)__builtin_amdgcn_readfirstlane(tb.off[u.e]) + 256 * u.pm;
#pragma unroll
            for (int m = 0; m < 4; ++m) { const int rt = rt0 + ai * 128 + m * 16; float r[8];
#pragma unroll
                for (int n = 0; n < 2; ++n)
#pragma unroll
                    for (int j = 0; j < 4; ++j) { const int o = (j >> 1) + 2 * n + 4 * (j & 1);
                        float g = acc[ai][0][m][n][j], up = acc[ai][1][m][n][j];
                        g = fminf(g, 7.f); up = fminf(fmaxf(up, -7.f), 7.f);
                        r[o] = (up + 1.f) * g * __builtin_amdgcn_rcpf(1.f + __builtin_amdgcn_exp2f(-1.702f * LOG2E * g)); }
                if (rt < u.rows) { u32x4 w; w.x = cvt_pk_bf16(r[0], r[1]); w.y = cvt_pk_bf16(r[2], r[3]); w.z = cvt_pk_bf16(r[4], r[5]); w.w = cvt_pk_bf16(r[6], r[7]);
                    *(GAS u32x4*)(O + (slot0 + rt) * DFF + colt) = w; } }
    }
};
template <int SPLIT> struct MoeDownT {
    static constexpr bool PERM = true;
    const bf16* A; const float* W; const float* bias; const float* sw; bf16* O; MoeTab tb; int G, c; LAS float* swl;
    __device__ bool next(int i, pg8::Unit& u) const { return moe_next<8, 1 + ((REP_MASK >> 12) & 1), SPLIT>(tb, G, c, i, u); }
    __device__ const char* a_base() const { return (const char*)A; }
    __device__ void a_off(const pg8::Unit& u, unsigned (&v0)[2], unsigned (&v1)[2]) const {
        const int s0 = __builtin_amdgcn_readfirstlane(tb.off[u.e]) + 256 * u.pm;
        if (threadIdx.x < 256) { const int rt = (int)threadIdx.x < u.rows ? (int)threadIdx.x : u.rows - 1;
            __builtin_amdgcn_global_load_lds((const unsigned*)(sw + (size_t)u.e * T + 256 * u.pm + rt), (LAS unsigned*)(swl + u.q * 256 + (threadIdx.x & ~63)), 4, 0, 0); }
        int tb16 = (int)threadIdx.x * 16; asm volatile("" : "+v"(tb16));
#pragma unroll
        for (int i = 0; i < 2; ++i) { int R, C; pg8::stage_rc(tb16 + i * 8192, R, C);
            v0[i] = (unsigned)((s0 + R) * pg8::KD + C) * 2u; v1[i] = (unsigned)((s0 + 128 + R) * pg8::KD + C) * 2u; } }
    __device__ void bias_load(const pg8::Unit& u, int wc, int fq, f32x4 (&bi)[2][2]) const {
        int cb = wc * 32 + 8 * ((fq >> 1) + 2 * (fq & 1)); asm volatile("" : "+v"(cb));
        const float* bp = bias + (size_t)u.e * DM + u.pn * 256 + u.hs * 128 + cb;
#pragma unroll
        for (int bj = 0; bj < (SPLIT == 2 ? 1 : 2); ++bj)
            { const f32x4 t0 = *(const GAS f32x4*)(bp + bj * 128), t1 = *(const GAS f32x4*)(bp + bj * 128 + 4); bi[bj][0] = (f32x4){t0[0], t1[0], t0[1], t1[1]}; bi[bj][1] = (f32x4){t0[2], t1[2], t0[3], t1[3]}; } }
    static constexpr int LDW_BYTES = DM * 4, W_BYTES = DFF * DM * 4;
    __device__ const char* b_ptr(const pg8::Unit& u) const { return (const char*)(W + (size_t)u.e * DFF * DM); }
    static constexpr int HALF_BYTES = 128 * 4;
    __device__ unsigned b_col(const pg8::Unit& u, int lane) const { return (unsigned)(u.pn * 256 + u.hs * 128 + 2 * lane) * 4u; }
    __device__ void epi(const f32x4 (&acc)[2][2][4][2], const pg8::Unit& u, int wr, int wc, int fr, int fq, const int ai) const {
        int rt0 = wr * 64 + fr, col0 = u.pn * 256 + u.hs * 128 + wc * 32 + 8 * ((fq >> 1) + 2 * (fq & 1)); asm volatile("" : "+v"(rt0), "+v"(col0)); const size_t slot0 = (size_t)__builtin_amdgcn_readfirstlane(tb.off[u.e]) + 256 * u.pm;
#pragma unroll
            for (int m = 0; m < 4; ++m) { const int rt = rt0 + ai * 128 + m * 16;
                if (rt < u.rows) { const float wgt = swl[u.q * 256 + rt]; bf16* rowp = O + (slot0 + rt) * DM + col0;
#pragma unroll
                    for (int bj = 0; bj < (SPLIT == 2 ? 1 : 2); ++bj) { float r[8];
#pragma unroll
                        for (int n = 0; n < 2; ++n)
#pragma unroll
                            for (int j = 0; j < 4; ++j) { const int o = (j >> 1) + 2 * n + 4 * (j & 1); r[o] = acc[ai][bj][m][n][j] * wgt; }
                        u32x4 w; w.x = cvt_pk_bf16(r[0], r[1]); w.y = cvt_pk_bf16(r[2], r[3]); w.z = cvt_pk_bf16(r[4], r[5]); w.w = cvt_pk_bf16(r[6], r[7]);
                        *(GAS u32x4*)(rowp + bj * 128) = w; } } }
    }
};

__device__ __forceinline__ void conv_unit(Frame& F, int ct) {
    const int b = ct / (SEQ / 32), s0 = (ct % (SEQ / 32)) * 32, tid = F.tid;
    const bf16* proj = WSP(bf16, WS_PROJ); bf16* mix = WSP(bf16, WS_MIX);
    LAS unsigned* z = (LAS unsigned*)F.lds;
    LAS float* st = (LAS float*)(F.lds + 126976);
    __syncthreads();
    { const int rq = tid >> 7, c8 = tid & 127;
#pragma unroll 1
      for (int hb = 0; hb < 2; ++hb) { u32x4 zz[8];
#pragma unroll
          for (int i = 0; i < 8; ++i) { const int r = 32 * hb + 4 * i + rq, s = s0 - 15 + r; const bool ok = (r < 62 && s >= 0 && s < SEQ); const int sc = ok ? s : 0;
              zz[i] = *(const GAS u32x4*)(proj + (size_t)(b * SEQ + sc) * INC + 3072 + 8 * c8); if (!ok) zz[i] = (u32x4){0u, 0u, 0u, 0u}; }
#pragma unroll
          for (int i = 0; i < 8; ++i) { const int r = 32 * hb + 4 * i + rq; if (r < 62) *(LAS u32x4*)(z + r * 512 + 4 * c8) = zz[i]; } } }
    typedef float f32x2c __attribute__((ext_vector_type(2)));
    float w0[CK], w1[CK];
#pragma unroll
    for (int j = 0; j < CK; ++j) { const f32x2c w = *(const GAS f32x2c*)(F.cw + j * CCH + 2 * tid); w0[j] = w.x; w1[j] = w.y; }
    const f32x2c cbv = *(const GAS f32x2c*)(F.cb + 2 * tid), lg = *(const GAS f32x2c*)(F.clg + 2 * tid), lb = *(const GAS f32x2c*)(F.clb + 2 * tid);
    __syncthreads();
#pragma unroll 1
    for (int hf = 0; hf < 2; ++hf) {
        float c0[16], c1[16];
#pragma unroll
        for (int g = 0; g < 4; ++g) {
            float zl[34], zh[34];
#pragma unroll
            for (int r = 0; r < 34; ++r) { const unsigned zz = z[(16 * hf + 4 * g + r) * 512 + tid]; zl[r] = __builtin_bit_cast(float, zz << 16); zh[r] = __builtin_bit_cast(float, zz & 0xffff0000u); }
#pragma unroll
            for (int t = 0; t < 4; ++t) { float a0 = cbv.x, a1 = cbv.y;
#pragma unroll
                for (int j = 0; j < CK; ++j) { a0 = fmaf(w0[j], zl[t + j], a0); a1 = fmaf(w1[j], zh[t + j], a1); }
                c0[4 * g + t] = a0; c1[4 * g + t] = a1; }
        }
#pragma unroll
        for (int t = 0; t < 16; ++t) { const float sm = wave_sum(c0[t] + c1[t]), q = wave_sum(c0[t] * c0[t] + c1[t] * c1[t]);
            if (F.lane == 0) { st[(F.wave * 16 + t) * 2] = sm; st[(F.wave * 16 + t) * 2 + 1] = q; } }
        __syncthreads();
        if (tid < 16) { float sm = 0.f, q = 0.f;
#pragma unroll
            for (int w = 0; w < 8; ++w) { sm += st[(w * 16 + tid) * 2]; q += st[(w * 16 + tid) * 2 + 1]; }
            const float mu = sm * (1.f / CCH), var = q * (1.f / CCH) - mu * mu; st[512 + tid * 2] = mu; st[512 + tid * 2 + 1] = rsqrtf(fmaxf(var, 0.f) + EPS); }
        __syncthreads();
#pragma unroll
        for (int t = 0; t < 16; ++t) { const float mu = st[512 + t * 2], rs = st[512 + t * 2 + 1];
            const float y0 = (c0[t] - mu) * rs * lg.x + lb.x, y1 = (c1[t] - mu) * rs * lg.y + lb.y;
            const float o0 = y0 * __builtin_amdgcn_rcpf(1.f + __builtin_amdgcn_exp2f(-LOG2E * y0)), o1 = y1 * __builtin_amdgcn_rcpf(1.f + __builtin_amdgcn_exp2f(-LOG2E * y1));
            *(GAS unsigned*)(mix + (size_t)(b * SEQ + s0 + 16 * hf + t) * DM + 1024 + 2 * tid) = cvt_pk_bf16(o0, o1); }
        __syncthreads();
    }
}

namespace att {
constexpr int KVBLK = 64; constexpr size_t SHM_V = KVBLK * 128 * 2, SHM_K = KVBLK * 128 * 2;
constexpr float C = 0.125f * LOG2E, THR2 = 8.f * LOG2E;
#define KSWZ(row, colB) ((row) * 256 + ((colB) ^ (((row) & 7) << 4)))
#define SBAR() __builtin_amdgcn_sched_barrier(0)
__device__ __forceinline__ int crow(int r, int hi) { return (r & 3) + 8 * (r >> 2) + 4 * hi; }
__device__ __forceinline__ int v_st(int k, int c) { const int kk = (k & ~0xC) | ((k & 4) << 1) | ((k & 8) >> 1); return ((kk >> 3) * 4 + (c >> 5)) * 512 + ((kk & 7) * 32 + (c & 31)) * 2; }
__device__ __forceinline__ int v_rd_base(int lane) { return ((lane & 3) << 3) | (((lane >> 2) & 3) << 6) | (((lane >> 4) & 1) << 5) | (((lane >> 5) & 1) << 8); }
constexpr int v_rd_off(int d0, int ks, int half) { return d0 * 512 + ks * 4096 + half * 2048; }
template <int OFF> __device__ __forceinline__ s16x4 tr_read(int vb) { s16x4 r; asm volatile("ds_read_b64_tr_b16 %0, %1 offset:%2" : "=&v"(r) : "v"(vb), "i"(OFF) : "memory"); return r; }
template <int D0> __device__ __forceinline__ void pv_one(f32x16& od, int vb, bf16x8 pa0, bf16x8 pa1, bf16x8 pa2, bf16x8 pa3) {
    const s16x4 l0 = tr_read<v_rd_off(D0, 0, 0)>(vb), h0 = tr_read<v_rd_off(D0, 0, 1)>(vb), l1 = tr_read<v_rd_off(D0, 1, 0)>(vb), h1 = tr_read<v_rd_off(D0, 1, 1)>(vb);
    const s16x4 l2 = tr_read<v_rd_off(D0, 2, 0)>(vb), h2 = tr_read<v_rd_off(D0, 2, 1)>(vb), l3 = tr_read<v_rd_off(D0, 3, 0)>(vb), h3 = tr_read<v_rd_off(D0, 3, 1)>(vb);
    asm volatile("s_waitcnt lgkmcnt(0)" ::: "memory"); SBAR();
#define PK(L, H) (bf16x8){L[0], L[1], L[2], L[3], H[0], H[1], H[2], H[3]}
    od = __builtin_amdgcn_mfma_f32_32x32x16_bf16(pa0, PK(l0, h0), od, 0, 0, 0);
    od = __builtin_amdgcn_mfma_f32_32x32x16_bf16(pa1, PK(l1, h1), od, 0, 0, 0);
    od = __builtin_amdgcn_mfma_f32_32x32x16_bf16(pa2, PK(l2, h2), od, 0, 0, 0);
    od = __builtin_amdgcn_mfma_f32_32x32x16_bf16(pa3, PK(l3, h3), od, 0, 0, 0);
#undef PK
}
__device__ __forceinline__ void pv_d0(f32x16* o, int vb, bf16x8 pa0, bf16x8 pa1, bf16x8 pa2, bf16x8 pa3) {
    pv_one<0>(o[0], vb, pa0, pa1, pa2, pa3); pv_one<1>(o[1], vb, pa0, pa1, pa2, pa3); pv_one<2>(o[2], vb, pa0, pa1, pa2, pa3); pv_one<3>(o[3], vb, pa0, pa1, pa2, pa3);
}
__device__ __forceinline__ void qkt(f32x16& p0, f32x16& p1, const LAS char* Ks, const bf16x8* qr, int r32, int hi, int map) {
    p0 = f32x16{}; p1 = f32x16{};
#pragma unroll
    for (int d0 = 0; d0 < 4; ++d0) { const int cb = ((map * 4 + d0) * 16 + hi * 8) * 2;
        const bf16x8 b0 = *(const LAS bf16x8*)(Ks + KSWZ(r32, cb)); const bf16x8 b1 = *(const LAS bf16x8*)(Ks + KSWZ(32 + r32, cb));
        p0 = __builtin_amdgcn_mfma_f32_32x32x16_bf16(b0, qr[d0], p0, 0, 0, 0);
        p1 = __builtin_amdgcn_mfma_f32_32x32x16_bf16(b1, qr[d0], p1, 0, 0, 0); }
}
__device__ __forceinline__ void partialSM(f32x16& p0, f32x16& p1, float& m_reg, float& mn, float& alpha, int relw, int relb, int hi, const LAS float* btab, float bneg, float bpos) {
    if (relw - 31 >= 91 || relw + 63 <= -91) {
        const float bc = (relw > 0) ? bpos : bneg;
        float pmax = p0[0];
#pragma unroll
        for (int r = 1; r < 16; ++r) pmax = fmaxf(pmax, p0[r]);
#pragma unroll
        for (int r = 0; r < 16; ++r) pmax = fmaxf(pmax, p1[r]);
        { auto rr = __builtin_amdgcn_permlane32_swap(__float_as_uint(pmax), __float_as_uint(pmax), false, false); pmax = fmaxf(__uint_as_float(rr[0]), __uint_as_float(rr[1])); }
        const float tmax = fmaf(pmax, C, bc);
        if (__builtin_expect(__all(tmax - m_reg <= THR2), 1)) { mn = m_reg; alpha = 1.f; }
        else { mn = fmaxf(m_reg, tmax); alpha = __builtin_amdgcn_exp2f(m_reg - mn); m_reg = mn; }
        const float off = bc - mn;
#pragma unroll
        for (int r = 0; r < 16; ++r) p0[r] = fmaf(p0[r], C, off);
#pragma unroll
        for (int r = 0; r < 16; ++r) p1[r] = fmaf(p1[r], C, off);
    } else {
#pragma unroll
        for (int r = 0; r < 16; ++r) { const int idx = relb + crow(r, hi) + 256; p0[r] = fmaf(p0[r], C, btab[idx]); p1[r] = fmaf(p1[r], C, btab[idx + 32]); }
        float pmax = p0[0];
#pragma unroll
        for (int r = 1; r < 16; ++r) pmax = fmaxf(pmax, p0[r]);
#pragma unroll
        for (int r = 0; r < 16; ++r) pmax = fmaxf(pmax, p1[r]);
        { auto rr = __builtin_amdgcn_permlane32_swap(__float_as_uint(pmax), __float_as_uint(pmax), false, false); pmax = fmaxf(__uint_as_float(rr[0]), __uint_as_float(rr[1])); }
        if (__builtin_expect(__all(pmax - m_reg <= THR2), 1)) { mn = m_reg; alpha = 1.f; }
        else { mn = fmaxf(m_reg, pmax); alpha = __builtin_amdgcn_exp2f(m_reg - mn); m_reg = mn; }
#pragma unroll
        for (int r = 0; r < 16; ++r) p0[r] -= mn;
#pragma unroll
        for (int r = 0; r < 16; ++r) p1[r] -= mn;
    }
#pragma unroll
    for (int r = 0; r < 16; ++r) p0[r] = __builtin_amdgcn_exp2f(p0[r]);
}
__device__ __forceinline__ void finishSM(f32x16& p0, f32x16& p1, float alpha, float& l_reg, bf16x8& pa0, bf16x8& pa1, bf16x8& pa2, bf16x8& pa3) {
#pragma unroll
    for (int r = 0; r < 16; ++r) p1[r] = __builtin_amdgcn_exp2f(p1[r]);
    float ps = 0;
#pragma unroll
    for (int r = 0; r < 16; ++r) ps += p0[r];
#pragma unroll
    for (int r = 0; r < 16; ++r) ps += p1[r];
    { auto rr = __builtin_amdgcn_permlane32_swap(__float_as_uint(ps), __float_as_uint(ps), false, false); ps = __uint_as_float(rr[0]) + __uint_as_float(rr[1]); }
    l_reg = l_reg * alpha + ps;
#define PK4(P, BASE, OUT) do { unsigned a0 = cvt_pk_bf16(P[BASE + 0], P[BASE + 1]), a1 = cvt_pk_bf16(P[BASE + 2], P[BASE + 3]);   \
    unsigned b0 = cvt_pk_bf16(P[BASE + 4], P[BASE + 5]), b1 = cvt_pk_bf16(P[BASE + 6], P[BASE + 7]);                              \
    auto r0 = __builtin_amdgcn_permlane32_swap(a0, b0, false, false); auto r1 = __builtin_amdgcn_permlane32_swap(a1, b1, false, false); \
    u32x4 w = {r0[0], r1[0], r0[1], r1[1]}; OUT = __builtin_bit_cast(bf16x8, w); } while (0)
    PK4(p0, 0, pa0); PK4(p0, 8, pa1); PK4(p1, 0, pa2); PK4(p1, 8, pa3);
#undef PK4
}
constexpr int L_V = 0, L_K = 32768, L_WS = 65536, L_BT = 67584, L_CB = 69632;
__device__ __forceinline__ void attn_unit(Frame& F, int unit) {
    const int bh = unit >> 4, qb = unit & 15, b = bh >> 3, h = bh & 7, q0 = qb * 128;
    const int tid = F.tid, wid = F.wave, lane = F.lane, r32 = lane & 31, hi = lane >> 5, rg = wid & 3, map = wid >> 2;
    const bf16* proj = WSP(bf16, WS_PROJ);
    const bf16* Kh = proj + (size_t)(b * SEQ) * INC + 1024 + h * 128; const bf16* Vh = proj + (size_t)(b * SEQ) * INC + 2048 + h * 128;
    LAS char* lds = (LAS char*)F.lds; LAS char* V_lds = lds + L_V; LAS char* K_lds = lds + L_K;
    LAS float* wsf = (LAS float*)(lds + L_WS) + wid * 64; LAS float* li_l = wsf; LAS float* al_l = wsf + 32;
    LAS float* btab = (LAS float*)(lds + L_BT);
    const float* bt = WSP(float, WS_BIAST) + h * 4096;
    __syncthreads();
    btab[tid] = bt[2048 - 256 + tid];
    const float bneg = bt[2048 - 200], bpos = bt[2048 + 200], lam = WSP(float, WS_BIAST)[AH * 4096];
    float m_reg = -1e30f, l_reg = 0; f32x16 o[4] = {}; bf16x8 qr[4];
    const int qw0 = q0 + 32 * rg;
    const bf16* Qw = proj + (size_t)(b * SEQ + qw0 + r32) * INC + h * 128 + map * 64 + hi * 8;
#pragma unroll
    for (int d0 = 0; d0 < 4; ++d0) qr[d0] = *(const GAS bf16x8*)(Qw + d0 * 16);
    const int sr = tid >> 4, sc = (tid & 15) * 8, vst0 = v_st(sr, sc), vst1 = v_st(32 + sr, sc);
    const int vb0 = (int)(uintptr_t)V_lds + v_rd_base(lane);
    struct { bf16x8 vs0, vs1, ks0, ks1; } sr_[2];
#define SLOAD(i, k0) do { sr_[i].vs0 = *(const GAS bf16x8*)&Vh[(size_t)((k0) + sr) * INC + sc]; sr_[i].vs1 = *(const GAS bf16x8*)&Vh[(size_t)((k0) + 32 + sr) * INC + sc]; \
    sr_[i].ks0 = *(const GAS bf16x8*)&Kh[(size_t)((k0) + sr) * INC + sc]; sr_[i].ks1 = *(const GAS bf16x8*)&Kh[(size_t)((k0) + 32 + sr) * INC + sc]; } while (0)
#define SWRITE(bb, i) do { *(LAS bf16x8*)(V_lds + (bb) * SHM_V + vst0) = sr_[i].vs0; *(LAS bf16x8*)(V_lds + (bb) * SHM_V + vst1) = sr_[i].vs1; const int kc = sc * 2; \
    *(LAS bf16x8*)(K_lds + (bb) * SHM_K + KSWZ(sr, kc)) = sr_[i].ks0; *(LAS bf16x8*)(K_lds + (bb) * SHM_K + KSWZ(32 + sr, kc)) = sr_[i].ks1; } while (0)
#define SWAIT() asm volatile("s_waitcnt vmcnt(4)" ::: "memory")
#define RESC(a) do { if (__any((a) < 1.f)) { if (hi == 0) al_l[r32] = (a); asm volatile("s_waitcnt lgkmcnt(0)" ::: "memory"); \
    _Pragma("unroll") for (int d = 0; d < 4; ++d) _Pragma("unroll") for (int r = 0; r < 16; ++r) o[d][r] *= al_l[crow(r, hi)]; } } while (0)
#define PSM(P0, P1, MN, AL, k0) partialSM(P0, P1, m_reg, MN, AL, (k0) - qw0, (k0) - qw0 - r32, hi, btab, bneg, bpos)
    f32x16 pA0, pA1, pB0, pB1; float mnA, mnB, alA, alB; bf16x8 pa0, pa1, pa2, pa3; constexpr int NT = SEQ / KVBLK;
    constexpr int SE = 0, SO = 1;
    SLOAD(SE, 0); asm volatile("s_waitcnt vmcnt(0)" ::: "memory"); SWRITE(0, SE); __syncthreads();
    qkt(pA0, pA1, K_lds, qr, r32, hi, map); PSM(pA0, pA1, mnA, alA, 0);
    SLOAD(SO, KVBLK); SLOAD(SE, 2 * KVBLK);
    SWAIT(); SWRITE(1, SO); __syncthreads();
    for (int j = 1; j + 1 < NT; j += 2) {
        SBAR(); qkt(pB0, pB1, K_lds + SHM_K, qr, r32, hi, map);
        finishSM(pA0, pA1, alA, l_reg, pa0, pa1, pa2, pa3); SBAR();
        SLOAD(SO, (j + 2) * KVBLK); SBAR();
        pv_d0(o, vb0, pa0, pa1, pa2, pa3); PSM(pB0, pB1, mnB, alB, j * KVBLK);
        __syncthreads(); SWAIT(); SWRITE(0, SE);
        RESC(alB); __syncthreads();
        SBAR(); qkt(pA0, pA1, K_lds, qr, r32, hi, map);
        finishSM(pB0, pB1, alB, l_reg, pa0, pa1, pa2, pa3); SBAR();
        if (j + 3 < NT) SLOAD(SE, (j + 3) * KVBLK); SBAR();
        pv_d0(o, vb0 + (int)SHM_V, pa0, pa1, pa2, pa3); PSM(pA0, pA1, mnA, alA, (j + 1) * KVBLK);
        __syncthreads(); SWAIT(); SWRITE(1, SO);
        RESC(alA); __syncthreads();
    }
    SBAR(); qkt(pB0, pB1, K_lds + SHM_K, qr, r32, hi, map);
    finishSM(pA0, pA1, alA, l_reg, pa0, pa1, pa2, pa3); SBAR();
    pv_d0(o, vb0, pa0, pa1, pa2, pa3); PSM(pB0, pB1, mnB, alB, (NT - 1) * KVBLK);
    __syncthreads(); RESC(alB);
    finishSM(pB0, pB1, alB, l_reg, pa0, pa1, pa2, pa3); SBAR();
    pv_d0(o, vb0 + (int)SHM_V, pa0, pa1, pa2, pa3);
    if (hi == 0) li_l[r32] = l_reg; asm volatile("s_waitcnt lgkmcnt(0)" ::: "memory");
    float rli[16];
#pragma unroll
    for (int r = 0; r < 16; ++r) rli[r] = __builtin_amdgcn_rcpf(li_l[crow(r, hi)]);
    LAS float* cbuf = (LAS float*)(lds + L_CB) + rg * 32 * 128;
    if (map == 1) {
#pragma unroll
        for (int r = 0; r < 16; ++r)
#pragma unroll
            for (int d0 = 0; d0 < 4; ++d0) cbuf[crow(r, hi) * 128 + d0 * 32 + r32] = -lam * o[d0][r] * rli[r];
    }
    __syncthreads();
    if (map == 0) {
        bf16* mix = WSP(bf16, WS_MIX) + (size_t)(b * SEQ + qw0) * DM + h * 128;
        float sg[4];
#pragma unroll
        for (int d0 = 0; d0 < 4; ++d0) sg[d0] = F.subln[d0 * 32 + r32] * 0.8f;
#pragma unroll
        for (int r = 0; r < 16; ++r) { float v[4], ss = 0.f;
#pragma unroll
            for (int d0 = 0; d0 < 4; ++d0) { v[d0] = o[d0][r] * rli[r] + cbuf[crow(r, hi) * 128 + d0 * 32 + r32]; ss += v[d0] * v[d0]; }
#pragma unroll
            for (int s = 1; s < 32; s <<= 1) ss += __shfl_xor(ss, s);
            const float rstd = rsqrtf(ss * (1.f / VD) + EPS);
#pragma unroll
            for (int d0 = 0; d0 < 4; ++d0) mix[(size_t)crow(r, hi) * DM + d0 * 32 + r32] = (bf16)f2bf(v[d0] * rstd * sg[d0]); }
    }
#undef SLOAD
#undef SWRITE
#undef SWAIT
#undef RESC
#undef PSM
}
}

__device__ __forceinline__ void p5_router(Frame& F, bool dry = false) {
    const float* mod = WSP(float, WS_MOD); const bf16* x1 = WSP(bf16, WS_X1); bf16* h2 = WSP(bf16, WS_H2);
    int* list = (int*)(F.ws + WS_ROUTE + RT_LIST); float* sw = (float*)(F.ws + WS_ROUTE + RT_SW); int* toke = (int*)(F.ws + WS_ROUTE + RT_TOKE); int* tokr = (int*)(F.ws + WS_ROUTE + RT_TOKR);
    constexpr int RS = 4096 + 16;
    LAS unsigned char* Ahi = F.lds; LAS unsigned char* Alo = F.lds + 16 * RS; LAS float* Pl = (LAS float*)(F.lds + 32 * RS);
    const unsigned char* wrf = WSP(unsigned char, WS_WRF);
    LAS int* lcnt = (LAS int*)(F.lds + TAB_OFF);
    LAS int* asg = lcnt + 64; LAS float* aw = (LAS float*)(asg + 1024);
    for (int tb0 = F.vcu; tb0 < T / 16; tb0 += 2 * F.G) {
      if (F.tid < 32) lcnt[F.tid] = 0;
#pragma unroll 1
      for (int it = 0; it < 2; ++it) {
        const int tb = tb0 + it * F.G;
        if (tb >= T / 16) { asg[it * 512 + F.tid] = -1; continue; }
        const int b = (tb * 16) / SEQ;
        __syncthreads();
        { f32x4 v[2][8]; float rstd[2];
#pragma unroll
          for (int rr = 0; rr < 2; ++rr) { const GAS u32x2* xr = (const GAS u32x2*)(x1 + (size_t)(tb * 16 + 2 * F.wave + rr) * DM) + F.lane;
#pragma unroll
              for (int j = 0; j < 8; ++j) { const u32x2 xx = xr[64 * j]; v[rr][j] = (f32x4){bf2f(xx.x & 0xffffu), bf2f(xx.x >> 16), bf2f(xx.y & 0xffffu), bf2f(xx.y >> 16)}; } }
#pragma unroll
          for (int rr = 0; rr < 2; ++rr) { float s = 0.f;
#pragma unroll
              for (int j = 0; j < 8; ++j) s += (v[rr][j].x * v[rr][j].x + v[rr][j].y * v[rr][j].y) + (v[rr][j].z * v[rr][j].z + v[rr][j].w * v[rr][j].w);
              rstd[rr] = rsqrtf(wave_sum(s) * (1.f / DM) + EPS); }
#pragma unroll
          for (int j = 0; j < 8; ++j) { const int k = 4 * F.lane + 256 * j;
              const f32x4 g = *(const GAS f32x4*)(F.g2 + k), sc = *(const GAS f32x4*)(mod + (size_t)b * 6 * DM + 4 * DM + k), sf = *(const GAS f32x4*)(mod + (size_t)b * 6 * DM + 3 * DM + k);
#pragma unroll
              for (int rr = 0; rr < 2; ++rr) { const int tl = 2 * F.wave + rr;
                  float hv[4]; unsigned hb[4], lb[4];
#pragma unroll
                  for (int q = 0; q < 4; ++q) { hv[q] = v[rr][j][q] * rstd[rr] * g[q] * (1.f + sc[q]) + sf[q]; hb[q] = f2bf(hv[q]); lb[q] = f2bf(hv[q] - bf2f(hb[q])); }
                  u32x2 wh, wl; wh.x = hb[0] | (hb[1] << 16); wh.y = hb[2] | (hb[3] << 16); wl.x = lb[0] | (lb[1] << 16); wl.y = lb[2] | (lb[3] << 16);
                  st_wt8((GAS u32x2*)(h2 + (size_t)(tb * 16 + tl) * DM) + F.lane + 64 * j, wh); *(LAS u32x2*)(Ahi + tl * RS + k * 2) = wh; *(LAS u32x2*)(Alo + tl * RS + k * 2) = wl; } }
        }
        __syncthreads();
        { f32x4 acc0 = {0.f, 0.f, 0.f, 0.f}, acc1 = {0.f, 0.f, 0.f, 0.f};
#pragma unroll 2
          for (int ks = 0; ks < 8; ++ks) { const int s = 8 * F.wave + ks, k0 = 32 * s + 8 * (F.lane >> 4);
            const bf16x8 ah = *(const LAS bf16x8*)(Ahi + (F.lane & 15) * RS + k0 * 2), al = *(const LAS bf16x8*)(Alo + (F.lane & 15) * RS + k0 * 2);
            const bf16x8 bh0 = *(const GAS bf16x8*)(wrf + ((size_t)(s * 2 + 0) * 64 + F.lane) * 16), bh1 = *(const GAS bf16x8*)(wrf + ((size_t)(s * 2 + 1) * 64 + F.lane) * 16);
            const bf16x8 bl0 = *(const GAS bf16x8*)(wrf + 131072 + ((size_t)(s * 2 + 0) * 64 + F.lane) * 16), bl1 = *(const GAS bf16x8*)(wrf + 131072 + ((size_t)(s * 2 + 1) * 64 + F.lane) * 16);
            acc0 = __builtin_amdgcn_mfma_f32_16x16x32_bf16(ah, bh0, acc0, 0, 0, 0); acc0 = __builtin_amdgcn_mfma_f32_16x16x32_bf16(ah, bl0, acc0, 0, 0, 0); acc0 = __builtin_amdgcn_mfma_f32_16x16x32_bf16(al, bh0, acc0, 0, 0, 0);
            acc1 = __builtin_amdgcn_mfma_f32_16x16x32_bf16(ah, bh1, acc1, 0, 0, 0); acc1 = __builtin_amdgcn_mfma_f32_16x16x32_bf16(ah, bl1, acc1, 0, 0, 0); acc1 = __builtin_amdgcn_mfma_f32_16x16x32_bf16(al, bh1, acc1, 0, 0, 0); }
#pragma unroll
          for (int r = 0; r < 4; ++r) { const int tk = 4 * (F.lane >> 4) + r; Pl[(F.wave * 16 + tk) * 32 + (F.lane & 15)] = acc0[r]; Pl[(F.wave * 16 + tk) * 32 + 16 + (F.lane & 15)] = acc1[r]; }
        }
        __syncthreads();
        { const int tl = F.tid >> 5, e = F.tid & 31, tok = tb * 16 + tl;
          float v = F.b_r[e];
#pragma unroll
          for (int w = 0; w < 8; ++w) v += Pl[(w * 16 + tl) * 32 + e];
          float tv[4]; int ti[4];
#pragma unroll
          for (int r = 0; r < 4; ++r) { float bv = v; int bi = e;
#pragma unroll
              for (int o = 16; o > 0; o >>= 1) { const float ov = __shfl_xor(bv, o); const int oi = __shfl_xor(bi, o); if (ov > bv || (ov == bv && oi < bi)) { bv = ov; bi = oi; } }
              tv[r] = bv; ti[r] = bi; if (e == bi) v = -3.0e38f; }
          float den = 0.f, w[4];
#pragma unroll
          for (int r = 0; r < 4; ++r) { w[r] = __expf(tv[r] - tv[0]); den += w[r]; }
          int sel = -1; float wsel = 0.f;
#pragma unroll
          for (int r = 0; r < 4; ++r) if (e == ti[r]) { sel = r; wsel = w[r]; }
          int code = -1;
          if (sel >= 0 && !dry) code = sel | (__hip_atomic_fetch_add(lcnt + e, 1, __ATOMIC_RELAXED, __HIP_MEMORY_SCOPE_WORKGROUP) << 8);
          asg[it * 512 + F.tid] = code; aw[it * 512 + F.tid] = wsel / den; (void)tok;
        }
      }
      __syncthreads();
      if (F.tid < 32) { const int n = lcnt[F.tid]; lcnt[32 + F.tid] = n > 0 ? (int)atomicAdd(F.ctl + CW_CNT + F.tid * CNT_STRIDE, (unsigned)n) : 0; }
      __syncthreads();
#pragma unroll
      for (int it = 0; it < 2; ++it) { const int code = asg[it * 512 + F.tid];
          if (code >= 0) { const int e = F.tid & 31, tok = (tb0 + it * F.G) * 16 + (F.tid >> 5), sel = code & 255, rank = lcnt[32 + e] + (code >> 8);
              list[e * T + rank] = tok; sw[e * T + rank] = aw[it * 512 + F.tid]; toke[tok * 4 + sel] = e; tokr[tok * 4 + sel] = rank; } }
      __syncthreads();
    }
}

__device__ __forceinline__ void p8_final(Frame& F) {
    const float* mod = WSP(float, WS_MOD); const bf16* x1 = WSP(bf16, WS_X1); const bf16* y = WSP(bf16, WS_Y);
    const int* toke = (const int*)(F.ws + WS_ROUTE + RT_TOKE); const int* tokr = (const int*)(F.ws + WS_ROUTE + RT_TOKR);
    moe_tables(F);
    const LAS int* off = (const LAS int*)(F.lds + TAB_OFF) + 40;
    for (int row = F.vcu * NWAVES + F.wave; row < T; row += F.G * NWAVES) {
        const int b = row / SEQ;
        size_t so[4];
#pragma unroll
        for (int r = 0; r < 4; ++r) so[r] = (size_t)(off[toke[row * 4 + r]] + tokr[row * 4 + r]) * DM;
        const GAS u32x2* xr = (const GAS u32x2*)(x1 + (size_t)row * DM) + F.lane;
        f32x4 v[8]; float s = 0.f;
#pragma unroll
        for (int j = 0; j < 8; ++j) { const int k = 4 * F.lane + 256 * j; f32x4 m = {0.f, 0.f, 0.f, 0.f};
#pragma unroll
            for (int r = 0; r < 4; ++r) { const u32x2 yy = *(const GAS u32x2*)(y + so[r] + k); m[0] += bf2f(yy.x & 0xffffu); m[1] += bf2f(yy.x >> 16); m[2] += bf2f(yy.y & 0xffffu); m[3] += bf2f(yy.y >> 16); }
            const f32x4 g = *(const GAS f32x4*)(mod + (size_t)b * 6 * DM + 5 * DM + k);
            const u32x2 xx = xr[64 * j]; v[j] = (f32x4){bf2f(xx.x & 0xffffu), bf2f(xx.x >> 16), bf2f(xx.y & 0xffffu), bf2f(xx.y >> 16)} + g * m; s += (v[j].x * v[j].x + v[j].y * v[j].y) + (v[j].z * v[j].z + v[j].w * v[j].w); }
        const float rstd = rsqrtf(wave_sum(s) * (1.f / DM) + EPS);
        GAS f32x4* orow = (GAS f32x4*)(F.out + (size_t)row * DM) + F.lane;
#pragma unroll
        for (int j = 0; j < 8; ++j) { const f32x4 g = *(const GAS f32x4*)(F.fg + 4 * F.lane + 256 * j); orow[64 * j] = v[j] * rstd * g; }
    }
}

struct Args { const float* in[25]; float* out; unsigned char* ws; int ph_lo, ph_hi, li, pad; };
__global__ void __launch_bounds__(NTHR, 2) mega_fwd(Args args) {
    extern __shared__ __attribute__((aligned(16))) unsigned char lds[];
    Frame F;
    F.lds = (LAS unsigned char*)lds; F.MISC = (volatile LAS unsigned*)(F.lds + MISC_OFF);
    F.tid = threadIdx.x; F.lane = F.tid & 63; F.wave = __builtin_amdgcn_readfirstlane(F.tid >> 6);
    F.G = gridDim.x; { const int bx = blockIdx.x; F.vcu = (F.G % 8 == 0) ? (bx % 8) * (F.G / 8) + bx / 8 : bx; }
    F.ws = args.ws; F.ctl = (unsigned*)(args.ws + WS_CTL); F.out = args.out;
    F.x = args.in[0]; F.c = args.in[1]; F.w_ada = args.in[2]; F.b_ada = args.in[3]; F.g1 = args.in[4]; F.w_in = args.in[5]; F.lq1 = args.in[6]; F.lk1 = args.in[7]; F.lq2 = args.in[8]; F.lk2 = args.in[9];
    F.subln = args.in[10]; F.relb = args.in[11]; F.cw = args.in[12]; F.cb = args.in[13]; F.clg = args.in[14]; F.clb = args.in[15]; F.w_out = args.in[16]; F.g2 = args.in[17]; F.w_r = args.in[18]; F.b_r = args.in[19];
    F.w_gu = args.in[20]; F.b_gu = args.in[21]; F.w_d = args.in[22]; F.b_d = args.in[23]; F.fg = args.in[24];
    for (int u = F.tid; u < 64; u += NTHR) ((LAS unsigned*)(F.lds + MISC_OFF))[u] = 0u;
    __syncthreads();
    XcdBarrier bar = xcd_barrier_post(F.ctl + CW_BAR + args.li * XCD_BAR_WORDS, F.MISC + 8);
    const int lo = args.ph_lo, hi = args.ph_hi;
#ifndef PH_MASK
#define PH_MASK 0x1ff
#endif
#define IN(k) (((PH_MASK >> (k)) & 1) && lo <= (k) && (k) < hi)
#define SEAM(k) do { if (IN(k) && IN((k) + 1)) { xcd_barrier(bar); if constexpr (((REP_MASK >> 14) & 1) != 0) xcd_barrier(bar); } } while (0)
#define REP2(k, ...) do { { __VA_ARGS__ } if constexpr (((REP_MASK >> (k)) & 1) != 0) { __VA_ARGS__ } } while (0)
#ifndef PROBE_TS
#define PROBE_TS -1
#endif
    unsigned long long* const tsb = (unsigned long long*)(F.ctl + 8192);
#define STAMP(k) do { if constexpr (PROBE_TS >= 0) { if (F.tid == 0) __hip_atomic_store(tsb + (k) * 256 + blockIdx.x, (unsigned long long)wall_clock64(), __ATOMIC_RELAXED, __HIP_MEMORY_SCOPE_AGENT); } } while (0)
    STAMP(0);
    if (IN(0)) { REP2(0, __syncthreads(); p0_prologue(F);); } STAMP(1); SEAM(0);
    if (IN(0) && IN(1)) F.vcu = xcd_virtual_cu(bar);
    if (IN(1)) { REP2(1, __syncthreads(); p1_norm1(F);); } STAMP(2); SEAM(1);
    if (IN(2)) { REP2(2, { InProjT<false> P{WSP(bf16, WS_H), WSP(bf16, WS_WIN), WSP(bf16, WS_PROJ), {}}; P.ord.init(T, INC, F.G, F.vcu, false, true); P.ord.rep = 1 + ((REP_MASK >> 15) & 1); __syncthreads(); pg8::gemm_run(F.lds, P); }
        { InProjT<true> P{WSP(bf16, WS_H), WSP(bf16, WS_WIN), WSP(bf16, WS_PROJ), {}}; P.ord.init(T, INC, F.G, F.vcu, true, true); __syncthreads(); pg8::gemm_run<InProjT<true>, true>(F.lds, P); }); } STAMP(3); SEAM(2);
    if (IN(3)) { REP2(3,
        for (int ct = F.vcu; ct < T / 32; ct += F.G) conv_unit(F, ct);
        if constexpr (((REP_MASK >> 9) & 1) != 0) { for (int ct = F.vcu; ct < T / 32; ct += F.G) conv_unit(F, ct); }
        for (int u = F.vcu; u < NB * AH * 16 * (1 + ((REP_MASK >> 10) & 1)); u += F.G) att::attn_unit(F, u % (NB * AH * 16));
    ); } STAMP(4); SEAM(3);
    if (IN(4)) { REP2(4, OutProj P{WSP(bf16, WS_MIX), WSP(bf16, WS_WOUT), F.x, WSP(float, WS_MOD), WSP(bf16, WS_X1), {}}; P.ord.init(T, DM, F.G, F.vcu); P.ord.rep = 1 + ((REP_MASK >> 16) & 1); __syncthreads(); pg8::gemm_run(F.lds, P);); } STAMP(5); SEAM(4);
    if (IN(5)) { p5_router(F); if constexpr (((REP_MASK >> 13) & 1) != 0) { __syncthreads(); p5_router(F, true); } } STAMP(6); SEAM(5);
    if (IN(6)) { REP2(6, moe_tables(F); const LAS int* tab = (const LAS int*)(F.lds + TAB_OFF);
        MoeGU P{WSP(bf16, WS_H2), F.w_gu, F.b_gu, (const int*)(F.ws + WS_ROUTE + RT_LIST), WSP(bf16, WS_ACT), {tab, tab + 40, tab + 80}, F.G, F.vcu}; pg8::gemm_run_bf32(F.lds, P);); } STAMP(7); SEAM(6);
    if (IN(7)) { REP2(7, moe_tables(F); const LAS int* tab = (const LAS int*)(F.lds + TAB_OFF);
        { MoeDownT<1> P{WSP(bf16, WS_ACT), F.w_d, F.b_d, (const float*)(F.ws + WS_ROUTE + RT_SW), WSP(bf16, WS_Y), {tab, tab + 40, tab + 80}, F.G, F.vcu, (LAS float*)(F.lds + TAB_OFF + 3072)}; pg8::gemm_run_bf32(F.lds, P); }
        { MoeDownT<2> P{WSP(bf16, WS_ACT), F.w_d, F.b_d, (const float*)(F.ws + WS_ROUTE + RT_SW), WSP(bf16, WS_Y), {tab, tab + 40, tab + 80}, F.G, F.vcu, (LAS float*)(F.lds + TAB_OFF + 3072)}; pg8::gemm_run_bf32<MoeDownT<2>, true>(F.lds, P); }); } STAMP(8); SEAM(7);
    if (IN(8)) { REP2(8, p8_final(F);); }
    if constexpr (PROBE_TS >= 0) {
        STAMP(9); xcd_barrier(bar);
        if (blockIdx.x == 0) {
            LAS unsigned long long* sh = (LAS unsigned long long*)F.lds;
            __syncthreads();
            if (F.tid < 256) { const int cu = F.tid < (int)gridDim.x ? F.tid : 0;
                sh[F.tid] = __hip_atomic_load(tsb + (PROBE_TS + 1) * 256 + cu, __ATOMIC_RELAXED, __HIP_MEMORY_SCOPE_AGENT);
                sh[256 + F.tid] = __hip_atomic_load(tsb + PROBE_TS * 256 + cu, __ATOMIC_RELAXED, __HIP_MEMORY_SCOPE_AGENT); }
            __syncthreads();
            if (F.tid == 0) { long long mx = 0, sum = 0; for (int i = 0; i < 256; ++i) { const long long d = (long long)(sh[i] - sh[256 + i]); mx = d > mx ? d : mx; sum += d; }
                const long long W = sum / 256 / 100, sk = (mx - sum / 256) / 100;
                const long long a = PROBE_TS == 9 ? 0 : W > 1023 ? 1023 : W, b = sk > 255 ? 255 : (sk < 0 ? 0 : sk);
                const unsigned long long wait = (unsigned long long)(10 * a + 0 * b) * 100ull, t0 = wall_clock64();
                while ((unsigned long long)wall_clock64() - t0 < wait) __builtin_amdgcn_s_sleep(32); }
            __syncthreads();
        }
    }
#undef IN
#undef SEAM
}

extern "C" void kernel_launch(void* const* d_in, const int* in_sizes, int n_in, void* d_out, int out_size, void* d_ws, size_t ws_size, hipStream_t stream) {
    static int grid = 0;
    if (grid == 0) {
        if (n_in != 25 || ws_size < WS_END || out_size != T * DM) { fprintf(stderr, "kernel_launch: n_in %d out %d ws %zu (need %zu); nothing launched\n", n_in, out_size, ws_size, (size_t)WS_END); grid = -1; return; }
        int dev = 0, cus = 0, per_cu = 0;
        if (hipGetDevice(&dev) != hipSuccess || hipDeviceGetAttribute(&cus, hipDeviceAttributeMultiprocessorCount, dev) != hipSuccess) { grid = -1; return; }
        if (hipFuncSetAttribute((const void*)mega_fwd, hipFuncAttributeMaxDynamicSharedMemorySize, LDS_BYTES) != hipSuccess) { fprintf(stderr, "kernel_launch: hipFuncSetAttribute failed\n"); grid = -1; return; }
        if (hipOccupancyMaxActiveBlocksPerMultiprocessor(&per_cu, (const void*)mega_fwd, NTHR, LDS_BYTES) != hipSuccess || per_cu < 1) { fprintf(stderr, "kernel_launch: occupancy query says %d blocks per CU\n", per_cu); }
        (void)hipGetLastError();
        grid = cus;
    }
    if (grid < 0) return;
    unsigned char* ws = (unsigned char*)d_ws;
    (void)hipMemsetAsync(ws + WS_CTL, 0, CTL_ZERO_BYTES, stream);
    Args a{};
    for (int i = 0; i < 25; ++i) a.in[i] = (const float*)d_in[i];
    a.out = (float*)d_out; a.ws = ws; a.ph_lo = 0; a.ph_hi = 9; a.li = 0; a.pad = 0;
    hipLaunchKernelGGL(mega_fwd, dim3(grid), dim3(NTHR), LDS_BYTES, stream, a);
}
```
